# Optimizing an MI355X kernel written in HIP

```python
import math
import jax, jax.numpy as jnp
from jax import lax
import numpy as np

D_MODEL = 1024
BATCH = 8
SEQ = 2048
DEPTH = 1

SB_WIDTH = D_MODEL // 2
SB_HEAD_DIM = 64
SB_HEADS = SB_WIDTH // SB_HEAD_DIM
SB_BLOCK = 128
HGRN_WIDTH = D_MODEL // 2
HGRN_HEAD_DIM = 128
HGRN_HEADS = HGRN_WIDTH // HGRN_HEAD_DIM
HGRN_CHUNK = 64
N_EXPERTS = 32
TOP_K = 4
D_FF = D_MODEL
SWIGLU_ALPHA = 1.702
SWIGLU_LIMIT = 7.0
EXPERT_BLOCK = 128
DEEPNORM_ALPHA = (2 * DEPTH) ** 0.25
DEEPNORM_BETA = (8 * DEPTH) ** -0.25
LN_EPS = 1e-5
RMS_EPS = 1e-6
IN_SPLITS = (SB_WIDTH, SB_WIDTH, SB_WIDTH, HGRN_WIDTH, HGRN_WIDTH, HGRN_WIDTH, HGRN_WIDTH, D_MODEL, D_MODEL)
IN_WIDTH = sum(IN_SPLITS)

kernel_name = 'hybrid_stickbreak_hgrn2_moe_deepnorm'


def layer_norm(x, g, b):
    xf = x.astype(jnp.float32)
    mu = jnp.mean(xf, axis=-1, keepdims=True)
    var = jnp.mean(jnp.square(xf - mu), axis=-1, keepdims=True)
    return ((xf - mu) * lax.rsqrt(var + LN_EPS) * g + b).astype(x.dtype)


def stick_breaking_attention(q, k, v):
    T = q.shape[2]
    scale = SB_HEAD_DIM ** -0.5
    qf, kf, vf = q.astype(jnp.float32), k.astype(jnp.float32), v.astype(jnp.float32)
    outs = []
    for blk in range(T // SB_BLOCK):
        t0 = blk * SB_BLOCK
        t1 = t0 + SB_BLOCK
        z = jnp.einsum('bhtd,bhsd->bhts', qf[:, :, t0:t1], kf[:, :, :t1]) * scale
        mask = jnp.arange(t1)[None, :] < (t0 + jnp.arange(SB_BLOCK))[:, None]
        log_keep = jnp.where(mask, jax.nn.log_sigmoid(-z), 0.0)
        log_after = lax.cumsum(log_keep, axis=3, reverse=True) - log_keep
        weights = jnp.where(mask, jnp.exp(jax.nn.log_sigmoid(z) + log_after), 0.0)
        outs.append(jnp.einsum('bhts,bhsd->bhtd', weights, vf[:, :, :t1]))
    return jnp.concatenate(outs, axis=2).astype(q.dtype)


def hgrn2_recurrence(q, k, logf, v):
    B, T, H, dk = q.shape
    dv = v.shape[-1]
    n_chunks = T // HGRN_CHUNK

    def to_chunks(a):
        return a.reshape(B, n_chunks, HGRN_CHUNK, H, a.shape[-1]).transpose(1, 0, 3, 2, 4)

    causal = jnp.tril(jnp.ones((HGRN_CHUNK, HGRN_CHUNK), dtype=bool))

    def step(S, xs):
        qc, kc, gc, vc = xs
        b = jnp.cumsum(gc, axis=2)
        o_inter = jnp.einsum('bhtk,bhkv->bhtv', qc * jnp.exp(b), S)
        diff = b[:, :, :, None, :] - b[:, :, None, :, :]
        decay = jnp.exp(jnp.where(causal[:, :, None], diff, -jnp.inf))
        scores = jnp.einsum('bhtsk,bhsk->bhts', qc[:, :, :, None, :] * decay, kc)
        o = o_inter + jnp.einsum('bhts,bhsv->bhtv', scores, vc)
        b_last = b[:, :, -1:, :]
        S_new = jnp.exp(b_last[:, :, 0, :])[..., None] * S + jnp.einsum(
            'bhsk,bhsv->bhkv', kc * jnp.exp(b_last - b), vc)
        return S_new, o

    S0 = jnp.zeros((B, H, dk, dv), jnp.float32)
    _, o = lax.scan(step, S0, (to_chunks(q), to_chunks(k), to_chunks(logf), to_chunks(v)))
    return o.transpose(1, 0, 3, 2, 4).reshape(B, T, H, dv)


def hybrid_mixer(x, w_in, lower_bound, hgrn_norm_g, w_branch_sb, w_branch_hgrn, w_out):
    B, T, _ = x.shape
    proj = x @ w_in
    offsets = np.cumsum(IN_SPLITS)[:-1].tolist()
    sq, sk, sv, hq, hf, hi, hg, gate_sb, gate_hg = jnp.split(proj, offsets, axis=-1)

    def heads(a):
        return a.reshape(B, T, SB_HEADS, SB_HEAD_DIM).transpose(0, 2, 1, 3)
    o_sb = stick_breaking_attention(heads(sq), heads(sk), heads(sv))
    o_sb = o_sb.transpose(0, 2, 1, 3).reshape(B, T, SB_WIDTH)

    f = lower_bound + (1.0 - lower_bound) * jax.nn.sigmoid(hf.astype(jnp.float32))
    shp = (B, T, HGRN_HEADS, HGRN_HEAD_DIM)
    o_hg = hgrn2_recurrence(jax.nn.silu(hq.astype(jnp.float32)).reshape(shp),
                            (1.0 - f).reshape(shp),
                            jnp.log(f).reshape(shp),
                            hi.astype(jnp.float32).reshape(shp))
    o_hg = o_hg * lax.rsqrt(jnp.mean(jnp.square(o_hg), axis=-1, keepdims=True) + RMS_EPS)
    o_hg = (o_hg.reshape(B, T, HGRN_WIDTH) * hgrn_norm_g * jax.nn.sigmoid(hg.astype(jnp.float32))).astype(x.dtype)

    merged = jax.nn.sigmoid(gate_sb) * (o_sb @ w_branch_sb) + jax.nn.sigmoid(gate_hg) * (o_hg @ w_branch_hgrn)
    return merged @ w_out


def moe(h, router_w, router_b, w_up, b_up, w_down, b_down):
    B, T, D = h.shape
    N = B * T
    xt = h.reshape(N, D)
    logits = (xt @ router_w + router_b).astype(jnp.float32)
    top_vals, top_idx = lax.top_k(logits, TOP_K)
    gates = jax.nn.softmax(top_vals, axis=-1)

    e_flat = top_idx.reshape(-1)
    tok_flat = jnp.arange(N * TOP_K, dtype=jnp.int32) // TOP_K
    order = jnp.argsort(e_flat)
    e_sorted = e_flat[order]
    tok_sorted = tok_flat[order]
    gate_sorted = gates.reshape(-1)[order].astype(h.dtype)

    counts = jnp.bincount(e_flat, length=N_EXPERTS)
    padded = (counts + EXPERT_BLOCK - 1) // EXPERT_BLOCK * EXPERT_BLOCK
    start = jnp.cumsum(counts) - counts
    pad_end = jnp.cumsum(padded)
    pad_start = pad_end - padded
    dest = pad_start[e_sorted] + (jnp.arange(N * TOP_K) - start[e_sorted])

    cap = N * TOP_K + N_EXPERTS * (EXPERT_BLOCK - 1)
    n_blocks = -(-cap // EXPERT_BLOCK)
    n_slots = n_blocks * EXPERT_BLOCK
    slot_tok = jnp.full((n_slots,), N, dtype=jnp.int32).at[dest].set(tok_sorted)
    x_pad = jnp.concatenate([xt, jnp.zeros((1, D), xt.dtype)], axis=0)
    xb = x_pad[slot_tok].reshape(n_blocks, EXPERT_BLOCK, D)
    block_e = jnp.minimum(jnp.searchsorted(pad_end, jnp.arange(n_blocks) * EXPERT_BLOCK, side='right'),
                          N_EXPERTS - 1)

    def expert_block(args):
        xblk, e = args
        hcat = xblk @ w_up[e] + b_up[e]
        x_glu = jnp.minimum(hcat[:, 0::2], SWIGLU_LIMIT)
        x_lin = jnp.clip(hcat[:, 1::2], -SWIGLU_LIMIT, SWIGLU_LIMIT)
        act = x_glu * jax.nn.sigmoid(SWIGLU_ALPHA * x_glu) * (x_lin + 1.0)
        return act @ w_down[e] + b_down[e]

    y_slots = lax.map(expert_block, (xb, block_e)).reshape(n_slots, D)
    contrib = y_slots[dest] * gate_sorted[:, None]
    out = jax.ops.segment_sum(contrib, tok_sorted, num_segments=N)
    return out.reshape(B, T, D).astype(h.dtype)


def setup_inputs(seed: int = 0) -> dict:
    key = jax.random.key(seed)
    ks = jax.random.split(key, 18)
    nrm = jax.random.normal
    beta = DEEPNORM_BETA
    col_scale = jnp.concatenate([jnp.full((w,), s, jnp.float32) for w, s in
                                 zip(IN_SPLITS, (1.0, 1.0, beta, 1.0, 1.0, beta, 1.0, 1.0, 1.0))])
    x = nrm(ks[0], (BATCH, SEQ, D_MODEL), jnp.float32)
    w_in = nrm(ks[1], (DEPTH, D_MODEL, IN_WIDTH), jnp.float32) * D_MODEL ** -0.5 * col_scale
    hgrn_lb_logits = 1.0 + 0.1 * nrm(ks[2], (DEPTH + 1, HGRN_WIDTH), jnp.float32)
    hgrn_norm_g = 1.0 + 0.05 * nrm(ks[3], (DEPTH, HGRN_WIDTH), jnp.float32)
    w_branch_sb = nrm(ks[4], (DEPTH, SB_WIDTH, D_MODEL), jnp.float32) * SB_WIDTH ** -0.5
    w_branch_hgrn = nrm(ks[5], (DEPTH, HGRN_WIDTH, D_MODEL), jnp.float32) * HGRN_WIDTH ** -0.5
    w_out = nrm(ks[6], (DEPTH, D_MODEL, D_MODEL), jnp.float32) * D_MODEL ** -0.5 * beta
    ln1_g = 1.0 + 0.05 * nrm(ks[7], (DEPTH, D_MODEL), jnp.float32)
    ln1_b = 0.02 * nrm(ks[8], (DEPTH, D_MODEL), jnp.float32)
    router_w = nrm(ks[9], (DEPTH, D_MODEL, N_EXPERTS), jnp.float32) * D_MODEL ** -0.5
    router_b = 0.01 * nrm(ks[10], (DEPTH, N_EXPERTS), jnp.float32)
    expert_w_up = nrm(ks[11], (DEPTH, N_EXPERTS, D_MODEL, 2 * D_FF), jnp.float32) * D_MODEL ** -0.5 * beta
    expert_b_up = 0.01 * nrm(ks[12], (DEPTH, N_EXPERTS, 2 * D_FF), jnp.float32)
    expert_w_down = nrm(ks[13], (DEPTH, N_EXPERTS, D_FF, D_MODEL), jnp.float32) * D_FF ** -0.5 * beta
    expert_b_down = 0.01 * nrm(ks[14], (DEPTH, N_EXPERTS, D_MODEL), jnp.float32)
    ln2_g = 1.0 + 0.05 * nrm(ks[15], (DEPTH, D_MODEL), jnp.float32)
    ln2_b = 0.02 * nrm(ks[16], (DEPTH, D_MODEL), jnp.float32)
    return {'x': x, 'w_in': w_in, 'hgrn_lb_logits': hgrn_lb_logits, 'hgrn_norm_g': hgrn_norm_g,
            'w_branch_sb': w_branch_sb, 'w_branch_hgrn': w_branch_hgrn, 'w_out': w_out,
            'ln1_g': ln1_g, 'ln1_b': ln1_b, 'router_w': router_w, 'router_b': router_b,
            'expert_w_up': expert_w_up, 'expert_b_up': expert_b_up,
            'expert_w_down': expert_w_down, 'expert_b_down': expert_b_down,
            'ln2_g': ln2_g, 'ln2_b': ln2_b}


def reference(x, w_in, hgrn_lb_logits, hgrn_norm_g, w_branch_sb, w_branch_hgrn, w_out,
              ln1_g, ln1_b, router_w, router_b, expert_w_up, expert_b_up,
              expert_w_down, expert_b_down, ln2_g, ln2_b):
    lower_bounds = jnp.cumsum(jax.nn.softmax(hgrn_lb_logits.astype(jnp.float32), axis=0), axis=0)
    h = x
    for l in range(DEPTH):
        mix = hybrid_mixer(h, w_in[l], lower_bounds[l], hgrn_norm_g[l],
                           w_branch_sb[l], w_branch_hgrn[l], w_out[l])
        h = layer_norm(DEEPNORM_ALPHA * h + mix, ln1_g[l], ln1_b[l])
        ffn = moe(h, router_w[l], router_b[l], expert_w_up[l], expert_b_up[l],
                  expert_w_down[l], expert_b_down[l])
        h = layer_norm(DEEPNORM_ALPHA * h + ffn, ln2_g[l], ln2_b[l])
    return h
```

```cpp
#include <hip/hip_runtime.h>
#include <stdint.h>
#include <cstdio>

#define LAS __attribute__((address_space(3)))
typedef unsigned short bf16_t;
typedef short bf16x8 __attribute__((ext_vector_type(8)));
typedef float f32x4 __attribute__((ext_vector_type(4)));
typedef unsigned u32x4 __attribute__((ext_vector_type(4)));

constexpr int NTOK = 16384, DM = 1024, INW = 5632, SBW = 512, HGW = 512, NEXP = 32, TOPK = 4, DFF = 1024, UPW = 2048;
constexpr int SEQ = 2048, SBH = 8, SBD = 64, HGH = 4, HGD = 128;
constexpr int NASSIGN = NTOK * TOPK;
constexpr int SLOT_PAD = 256;
constexpr int NSLOT_MAX = NASSIGN + NEXP * SLOT_PAD;
constexpr int NTILE_MAX = NSLOT_MAX / SLOT_PAD;
constexpr float LN_EPS = 1e-5f, RMS_EPS = 1e-6f, DN_ALPHA = 1.189207115002721f, SW_ALPHA = 1.702f, SW_LIMIT = 7.0f;

constexpr size_t MiB = 1u << 20;
constexpr size_t WS_CTL = 0;
constexpr size_t WS_LB = 1 * MiB;
constexpr size_t WS_TOPI = WS_LB + 4096;
constexpr size_t WS_TOPG = WS_TOPI + 262144;
constexpr size_t WS_DEST = WS_TOPG + 262144;
constexpr size_t WS_SLOTTOK = WS_DEST + 262144;
constexpr size_t WS_XB = 3 * MiB;
constexpr size_t WS_WINT = WS_XB + 32 * MiB;
constexpr size_t WS_WBST = WS_WINT + 12 * MiB;
constexpr size_t WS_WBHT = WS_WBST + 1 * MiB;
constexpr size_t WS_WOT = WS_WBHT + 1 * MiB;
constexpr size_t WS_WUPT = WS_WOT + 2 * MiB;
constexpr size_t WS_WDNT = WS_WUPT + 128 * MiB;
constexpr size_t WS_Q = WS_WDNT + 64 * MiB;
constexpr size_t WS_K = WS_Q + 16 * MiB;
constexpr size_t WS_V = WS_K + 16 * MiB;
constexpr size_t WS_HQ = WS_V + 16 * MiB;
constexpr size_t WS_HK = WS_HQ + 16 * MiB;
constexpr size_t WS_HV = WS_HK + 16 * MiB;
constexpr size_t WS_HG = WS_HV + 16 * MiB;
constexpr size_t WS_LOGF = WS_HG + 16 * MiB;
constexpr size_t WS_GS = WS_LOGF + 32 * MiB;
constexpr size_t WS_GH = WS_GS + 32 * MiB;
constexpr size_t WS_OSB = WS_GH + 32 * MiB;
constexpr size_t WS_OHG = WS_OSB + 16 * MiB;
constexpr size_t WS_ORAW = WS_OHG + 16 * MiB;
constexpr size_t WS_MERGED = WS_ORAW + 32 * MiB;
constexpr size_t WS_H = WS_MERGED + 32 * MiB;
constexpr size_t WS_HB = WS_H + 64 * MiB;
constexpr size_t WS_ACT = WS_HB + 32 * MiB;
constexpr size_t WS_END = WS_ACT + 144 * MiB;
constexpr size_t WS_PRE = WS_Q;
constexpr size_t WS_Y = WS_HK;
static_assert(WS_Y + 144 * MiB <= WS_OSB && WS_PRE + 64 * MiB <= WS_HK, "overlays");
static_assert(WS_END <= 1000 * MiB, "ws budget");
constexpr int CW_CNT = 0;
constexpr int CW_CUR = 64;
constexpr int CW_PADSTART = 128;
constexpr int CW_NTILES = 192;
constexpr int CW_TILEEXP = 256;

__device__ __forceinline__ unsigned f2bf(float f) { unsigned u = __builtin_bit_cast(unsigned, f); return (u + 0x7fffu + ((u >> 16) & 1u)) >> 16; }
__device__ __forceinline__ float bf2f(unsigned short b) { return __builtin_bit_cast(float, (unsigned)b << 16); }
__device__ __forceinline__ float sigmoidf_(float v) { return 1.0f / (1.0f + expf(-v)); }
__device__ __forceinline__ float wave_sum(float v) {
#pragma unroll
    for (int o = 1; o < 64; o <<= 1) v += __shfl_xor(v, o);
    return v;
}

__global__ __launch_bounds__(256) void k_transpose_bf16(const float* __restrict__ W, bf16_t* __restrict__ WT, int K, int N) {
    __shared__ float tile[64][65];
    const size_t g = blockIdx.z; W += g * (size_t)K * N; WT += g * (size_t)K * N;
    const int k0 = blockIdx.y * 64, n0 = blockIdx.x * 64, tx = threadIdx.x & 63, ty = threadIdx.x >> 6;
    for (int i = ty; i < 64; i += 4) tile[i][tx] = W[(size_t)(k0 + i) * N + n0 + tx];
    __syncthreads();
    for (int i = ty; i < 64; i += 4) WT[(size_t)(n0 + i) * K + k0 + tx] = (bf16_t)f2bf(tile[tx][i]);
}
__global__ __launch_bounds__(256) void k_convert_x(const float* __restrict__ x, bf16_t* __restrict__ xb, const float* __restrict__ lbl, float* __restrict__ lb) {
    const size_t i = (size_t)blockIdx.x * 256 + threadIdx.x;
    const f32x4 v = ((const f32x4*)x)[i];
    uint2 o; o.x = f2bf(v[0]) | (f2bf(v[1]) << 16); o.y = f2bf(v[2]) | (f2bf(v[3]) << 16);
    ((uint2*)xb)[i] = o;
    if (blockIdx.x == 0) for (int c = threadIdx.x; c < HGW; c += 256) { const float l0 = lbl[c], l1 = lbl[HGW + c]; lb[c] = 1.0f / (1.0f + expf(l1 - l0)); }
}

constexpr int G_BM = 128, G_BK = 32, G_HTB = G_BM * G_BK * 2;
__device__ __forceinline__ void g128_loop(f32x4 (&acc)[4][4], const bf16_t* a0, const bf16_t* a1, const bf16_t* b0, const bf16_t* b1, int K, LAS unsigned char* shm) {
    const int tid = threadIdx.x, wid = tid >> 6, lane = tid & 63, wr = wid >> 1, wc = wid & 1, fr = lane & 15, fq = lane >> 4;
    LAS unsigned char* SA = shm; LAS unsigned char* SB = shm + G_HTB;
    for (int t = 0; t < K / G_BK; ++t) {
        __builtin_amdgcn_global_load_lds((const unsigned*)(a0 + t * G_BK), (LAS unsigned*)(SA + tid * 16), 16, 0, 0);
        __builtin_amdgcn_global_load_lds((const unsigned*)(a1 + t * G_BK), (LAS unsigned*)(SA + tid * 16 + 4096), 16, 0, 0);
        __builtin_amdgcn_global_load_lds((const unsigned*)(b0 + t * G_BK), (LAS unsigned*)(SB + tid * 16), 16, 0, 0);
        __builtin_amdgcn_global_load_lds((const unsigned*)(b1 + t * G_BK), (LAS unsigned*)(SB + tid * 16 + 4096), 16, 0, 0);
        asm volatile("s_waitcnt vmcnt(0)" ::: "memory"); __syncthreads();
        bf16x8 At[4], Bt[4];
#pragma unroll
        for (int m = 0; m < 4; ++m) { At[m] = *(const LAS bf16x8*)(SA + (wr * 64 + m * 16 + fr) * (G_BK * 2) + fq * 16); Bt[m] = *(const LAS bf16x8*)(SB + (wc * 64 + m * 16 + fr) * (G_BK * 2) + fq * 16); }
        asm volatile("s_waitcnt lgkmcnt(0)" ::: "memory"); __builtin_amdgcn_sched_barrier(0);
#pragma unroll
        for (int m = 0; m < 4; ++m)
#pragma unroll
            for (int n = 0; n < 4; ++n) acc[m][n] = __builtin_amdgcn_mfma_f32_16x16x32_bf16(At[m], Bt[n], acc[m][n], 0, 0, 0);
        __syncthreads();
    }
}
#define G128_ZERO(acc) _Pragma("unroll") for (int m_ = 0; m_ < 4; ++m_) _Pragma("unroll") for (int n_ = 0; n_ < 4; ++n_) acc[m_][n_] = (f32x4){0.f, 0.f, 0.f, 0.f}
#define G128_FOREACH(...) do { const int wid_ = threadIdx.x >> 6, lane_ = threadIdx.x & 63, wr_ = wid_ >> 1, wc_ = wid_ & 1, fr_ = lane_ & 15, fq_ = lane_ >> 4; \
    _Pragma("unroll") for (int m_ = 0; m_ < 4; ++m_) _Pragma("unroll") for (int n_ = 0; n_ < 4; ++n_) _Pragma("unroll") for (int j_ = 0; j_ < 4; ++j_) { \
        const int trow = wr_ * 64 + m_ * 16 + fq_ * 4 + j_, tcol = wc_ * 64 + n_ * 16 + fr_; __VA_ARGS__ } } while (0)

struct InProjOut { bf16_t *Q, *K, *V, *HQ, *HK, *HV, *HG, *GS, *GH; float* LOGF; const float* lb; };

__global__ __launch_bounds__(256) void k_inproj(const bf16_t* __restrict__ XB, const bf16_t* __restrict__ WinT, InProjOut o) {
    __shared__ __attribute__((aligned(16))) unsigned char shm[2 * G_HTB];
    const int bcol = blockIdx.x * G_BM, brow = blockIdx.y * G_BM, tid = threadIdx.x, r0 = tid >> 2, c = (tid & 3) * 8;
    f32x4 acc[4][4]; G128_ZERO(acc);
    g128_loop(acc, XB + (size_t)(brow + r0) * DM + c, XB + (size_t)(brow + r0 + 64) * DM + c, WinT + (size_t)(bcol + r0) * DM + c, WinT + (size_t)(bcol + r0 + 64) * DM + c, DM, (LAS unsigned char*)shm);
    const int seg = bcol / 512;
    G128_FOREACH({
        const int row = brow + trow, col = bcol + tcol; const float v = acc[m_][n_][j_];
        if (seg == 0) o.Q[(size_t)row * 512 + col] = (bf16_t)f2bf(v * 0.125f);
        else if (seg == 1) o.K[(size_t)row * 512 + (col - 512)] = (bf16_t)f2bf(v);
        else if (seg == 2) o.V[(size_t)row * 512 + (col - 1024)] = (bf16_t)f2bf(v);
        else if (seg == 3) o.HQ[(size_t)row * 512 + (col - 1536)] = (bf16_t)f2bf(v * sigmoidf_(v));
        else if (seg == 4) { const int cc = col - 2048; const float l = o.lb[cc], f = l + (1.0f - l) * sigmoidf_(v);
            o.HK[(size_t)row * 512 + cc] = (bf16_t)f2bf(1.0f - f); o.LOGF[(size_t)row * 512 + cc] = logf(f); }
        else if (seg == 5) o.HV[(size_t)row * 512 + (col - 2560)] = (bf16_t)f2bf(v);
        else if (seg == 6) o.HG[(size_t)row * 512 + (col - 3072)] = (bf16_t)f2bf(sigmoidf_(v));
        else if (seg < 9) o.GS[(size_t)row * 1024 + (col - 3584)] = (bf16_t)f2bf(sigmoidf_(v));
        else o.GH[(size_t)row * 1024 + (col - 4608)] = (bf16_t)f2bf(sigmoidf_(v));
    });
}

__global__ __launch_bounds__(256) void k_branch(const bf16_t* __restrict__ OSB, const bf16_t* __restrict__ OHG, const bf16_t* __restrict__ WbsT, const bf16_t* __restrict__ WbhT,
                                                const bf16_t* __restrict__ GS, const bf16_t* __restrict__ GH, bf16_t* __restrict__ MERGED) {
    __shared__ __attribute__((aligned(16))) unsigned char shm[2 * G_HTB];
    const int bcol = blockIdx.x * G_BM, brow = blockIdx.y * G_BM, tid = threadIdx.x, r0 = tid >> 2, c = (tid & 3) * 8;
    f32x4 accA[4][4], accB[4][4]; G128_ZERO(accA); G128_ZERO(accB);
    g128_loop(accA, OSB + (size_t)(brow + r0) * SBW + c, OSB + (size_t)(brow + r0 + 64) * SBW + c, WbsT + (size_t)(bcol + r0) * SBW + c, WbsT + (size_t)(bcol + r0 + 64) * SBW + c, SBW, (LAS unsigned char*)shm);
    g128_loop(accB, OHG + (size_t)(brow + r0) * HGW + c, OHG + (size_t)(brow + r0 + 64) * HGW + c, WbhT + (size_t)(bcol + r0) * HGW + c, WbhT + (size_t)(bcol + r0 + 64) * HGW + c, HGW, (LAS unsigned char*)shm);
    G128_FOREACH({
        const size_t idx = (size_t)(brow + trow) * DM + bcol + tcol;
        MERGED[idx] = (bf16_t)f2bf(bf2f(GS[idx]) * accA[m_][n_][j_] + bf2f(GH[idx]) * accB[m_][n_][j_]);
    });
}

__global__ __launch_bounds__(256) void k_outproj(const bf16_t* __restrict__ MERGED, const bf16_t* __restrict__ WoT, const float* __restrict__ x, float* __restrict__ PRE) {
    __shared__ __attribute__((aligned(16))) unsigned char shm[2 * G_HTB];
    const int bcol = blockIdx.x * G_BM, brow = blockIdx.y * G_BM, tid = threadIdx.x, r0 = tid >> 2, c = (tid & 3) * 8;
    f32x4 acc[4][4]; G128_ZERO(acc);
    g128_loop(acc, MERGED + (size_t)(brow + r0) * DM + c, MERGED + (size_t)(brow + r0 + 64) * DM + c, WoT + (size_t)(bcol + r0) * DM + c, WoT + (size_t)(bcol + r0 + 64) * DM + c, DM, (LAS unsigned char*)shm);
    G128_FOREACH({ const size_t idx = (size_t)(brow + trow) * DM + bcol + tcol; PRE[idx] = DN_ALPHA * x[idx] + acc[m_][n_][j_]; });
}

__global__ __launch_bounds__(256) void k_moe_up(const bf16_t* __restrict__ HB, const bf16_t* __restrict__ WupT, const float* __restrict__ b_up, const int* __restrict__ ctl,
                                                const int* __restrict__ slot_tok, bf16_t* __restrict__ ACT) {
    __shared__ __attribute__((aligned(16))) unsigned char shm[2 * G_HTB];
    const int rt = blockIdx.y; if (rt >= 2 * ctl[CW_NTILES]) return;
    const int e = ctl[CW_TILEEXP + (rt >> 1)];
    const int bcol = blockIdx.x * G_BM, brow = rt * G_BM, tid = threadIdx.x, r0 = tid >> 2, c = (tid & 3) * 8;
    int t0 = slot_tok[brow + r0], t1 = slot_tok[brow + r0 + 64]; if (t0 < 0) t0 = 0; if (t1 < 0) t1 = 0;
    const bf16_t* W = WupT + (size_t)e * UPW * DM;
    f32x4 acc[4][4]; G128_ZERO(acc);
    g128_loop(acc, HB + (size_t)t0 * DM + c, HB + (size_t)t1 * DM + c, W + (size_t)(bcol + r0) * DM + c, W + (size_t)(bcol + r0 + 64) * DM + c, DM, (LAS unsigned char*)shm);
    G128_FOREACH({
        const int col = bcol + tcol; const float v = acc[m_][n_][j_] + b_up[e * UPW + col];
        const float other = __shfl_xor(v, 1);
        if ((col & 1) == 0) { const float g = fminf(v, SW_LIMIT), l = fminf(fmaxf(other, -SW_LIMIT), SW_LIMIT);
            ACT[(size_t)(brow + trow) * DFF + (col >> 1)] = (bf16_t)f2bf(g * sigmoidf_(SW_ALPHA * g) * (l + 1.0f)); }
    });
}
__global__ __launch_bounds__(256) void k_moe_down(const bf16_t* __restrict__ ACT, const bf16_t* __restrict__ WdnT, const float* __restrict__ b_dn, const int* __restrict__ ctl, bf16_t* __restrict__ Y) {
    __shared__ __attribute__((aligned(16))) unsigned char shm[2 * G_HTB];
    const int rt = blockIdx.y; if (rt >= 2 * ctl[CW_NTILES]) return;
    const int e = ctl[CW_TILEEXP + (rt >> 1)];
    const int bcol = blockIdx.x * G_BM, brow = rt * G_BM, tid = threadIdx.x, r0 = tid >> 2, c = (tid & 3) * 8;
    const bf16_t* W = WdnT + (size_t)e * DM * DFF;
    f32x4 acc[4][4]; G128_ZERO(acc);
    g128_loop(acc, ACT + (size_t)(brow + r0) * DFF + c, ACT + (size_t)(brow + r0 + 64) * DFF + c, W + (size_t)(bcol + r0) * DFF + c, W + (size_t)(bcol + r0 + 64) * DFF + c, DFF, (LAS unsigned char*)shm);
    G128_FOREACH({ const int col = bcol + tcol; Y[(size_t)(brow + trow) * DM + col] = (bf16_t)f2bf(acc[m_][n_][j_] + b_dn[e * DM + col]); });
}

__global__ __launch_bounds__(64) void k_attn_naive(const bf16_t* __restrict__ Q, const bf16_t* __restrict__ K, const bf16_t* __restrict__ V, bf16_t* __restrict__ O) {
    const int qb = 31 - (int)blockIdx.x, bh = blockIdx.y, b = bh >> 3, h = bh & 7;
    const int t = qb * 64 + threadIdx.x; const size_t rowbase = (size_t)b * SEQ;
    float q[64], o[64];
    { const bf16_t* qp = Q + (rowbase + t) * SBW + h * SBD;
#pragma unroll
      for (int d = 0; d < 64; ++d) { q[d] = bf2f(qp[d]); o[d] = 0.f; } }
    float R = 1.0f;
    for (int s = qb * 64 + 63; s >= 0; --s) {
        const bf16_t* kr = K + (rowbase + s) * SBW + h * SBD; const bf16_t* vr = V + (rowbase + s) * SBW + h * SBD;
        float z = 0.f;
#pragma unroll
        for (int d = 0; d < 64; ++d) z += q[d] * bf2f(kr[d]);
        const bool valid = s < t;
        const float ez = expf(fminf(z, 60.0f)), keep = 1.0f / (1.0f + ez);
        const float a = valid ? ez * keep * R : 0.f;
        R = valid ? R * keep : R;
#pragma unroll
        for (int d = 0; d < 64; ++d) o[d] += a * bf2f(vr[d]);
    }
    bf16_t* op = O + (rowbase + t) * SBW + h * SBD;
#pragma unroll
    for (int d = 0; d < 64; ++d) op[d] = (bf16_t)f2bf(o[d]);
}

__global__ __launch_bounds__(128) void k_hgrn_naive(const bf16_t* __restrict__ HQ, const bf16_t* __restrict__ HK, const float* __restrict__ LOGF, const bf16_t* __restrict__ HV, float* __restrict__ ORAW) {
    __shared__ __attribute__((aligned(16))) float sf[128], sk[128], sq[128];
    const int bh = blockIdx.x, b = bh >> 2, hh = bh & 3, v = threadIdx.x;
    float S[128];
#pragma unroll
    for (int k = 0; k < 128; ++k) S[k] = 0.f;
    for (int t = 0; t < SEQ; ++t) {
        const size_t base = ((size_t)b * SEQ + t) * HGW + hh * HGD;
        sf[v] = expf(LOGF[base + v]); sk[v] = bf2f(HK[base + v]); sq[v] = bf2f(HQ[base + v]);
        const float vv = bf2f(HV[base + v]);
        __syncthreads();
        float o = 0.f;
#pragma unroll
        for (int k = 0; k < 128; ++k) { S[k] = sf[k] * S[k] + sk[k] * vv; o += sq[k] * S[k]; }
        ORAW[base + v] = o;
        __syncthreads();
    }
}
__global__ __launch_bounds__(256) void k_hgrn_post(const float* __restrict__ ORAW, const bf16_t* __restrict__ HG, const float* __restrict__ norm_g, bf16_t* __restrict__ OHG) {
    const int gw = blockIdx.x * 4 + (threadIdx.x >> 6), lane = threadIdx.x & 63;
    const size_t base = (size_t)gw * HGD; const int c0 = (gw & 3) * HGD;
    const float x0 = ORAW[base + lane], x1 = ORAW[base + 64 + lane];
    const float r = 1.0f / sqrtf(wave_sum(x0 * x0 + x1 * x1) * (1.0f / HGD) + RMS_EPS);
    OHG[base + lane] = (bf16_t)f2bf(x0 * r * norm_g[c0 + lane] * bf2f(HG[base + lane]));
    OHG[base + 64 + lane] = (bf16_t)f2bf(x1 * r * norm_g[c0 + 64 + lane] * bf2f(HG[base + 64 + lane]));
}

__global__ __launch_bounds__(256) void k_ln1_router(const float* __restrict__ PRE, const float* __restrict__ g, const float* __restrict__ bta, const float* __restrict__ rw, const float* __restrict__ rb,
                                                    float* __restrict__ H, bf16_t* __restrict__ HB, int* __restrict__ TOPI, float* __restrict__ TOPG) {
    __shared__ __attribute__((aligned(16))) float hs[4][DM];
    const int w = threadIdx.x >> 6, lane = threadIdx.x & 63, row = blockIdx.x * 4 + w;
    f32x4 v[4]; float s = 0.f;
#pragma unroll
    for (int j = 0; j < 4; ++j) { v[j] = *(const f32x4*)(PRE + (size_t)row * DM + lane * 4 + 256 * j); s += (v[j][0] + v[j][1]) + (v[j][2] + v[j][3]); }
    const float mean = wave_sum(s) * (1.0f / DM); float s2 = 0.f;
#pragma unroll
    for (int j = 0; j < 4; ++j) { v[j] = v[j] - mean; s2 += (v[j][0] * v[j][0] + v[j][1] * v[j][1]) + (v[j][2] * v[j][2] + v[j][3] * v[j][3]); }
    const float rstd = 1.0f / sqrtf(wave_sum(s2) * (1.0f / DM) + LN_EPS);
#pragma unroll
    for (int j = 0; j < 4; ++j) { const int c = lane * 4 + 256 * j; const f32x4 gg = *(const f32x4*)(g + c), bb = *(const f32x4*)(bta + c);
        f32x4 hv = v[j] * rstd * gg + bb; *(f32x4*)(H + (size_t)row * DM + c) = hv; *(f32x4*)(&hs[w][c]) = hv;
        uint2 o; o.x = f2bf(hv[0]) | (f2bf(hv[1]) << 16); o.y = f2bf(hv[2]) | (f2bf(hv[3]) << 16); *(uint2*)(HB + (size_t)row * DM + c) = o; }
    __syncthreads();
    const int e = lane & 31, half = lane >> 5; float a = 0.f;
    for (int c = half * 512; c < half * 512 + 512; ++c) a += hs[w][c] * rw[c * NEXP + e];
    a += __shfl_xor(a, 32);
    float val = (lane < 32) ? a + rb[e] : -INFINITY; int idx = e;
    float tv[4]; int ti[4];
#pragma unroll
    for (int r = 0; r < 4; ++r) {
        float bv = val; int bi = idx;
#pragma unroll
        for (int off = 32; off >= 1; off >>= 1) { const float ov = __shfl_xor(bv, off); const int oi = __shfl_xor(bi, off); if (ov > bv || (ov == bv && oi < bi)) { bv = ov; bi = oi; } }
        tv[r] = bv; ti[r] = bi; if (lane < 32 && e == bi) val = -INFINITY;
    }
    if (lane == 0) { const float e1 = expf(tv[1] - tv[0]), e2 = expf(tv[2] - tv[0]), e3 = expf(tv[3] - tv[0]), inv = 1.0f / (1.0f + e1 + e2 + e3);
        *(int4*)(TOPI + row * 4) = make_int4(ti[0], ti[1], ti[2], ti[3]); *(float4*)(TOPG + row * 4) = make_float4(inv, e1 * inv, e2 * inv, e3 * inv); }
}

__global__ __launch_bounds__(256) void k_count(const int* __restrict__ TOPI, int* __restrict__ ctl, int* __restrict__ slot_tok) {
    __shared__ int hist[NEXP];
    if (threadIdx.x < NEXP) hist[threadIdx.x] = 0;
    __syncthreads();
    const int i = blockIdx.x * 256 + threadIdx.x;
    atomicAdd(&hist[TOPI[i]], 1);
    __syncthreads();
    if (threadIdx.x < NEXP) atomicAdd(&ctl[CW_CNT + threadIdx.x], hist[threadIdx.x]);
    for (int s = i; s < NSLOT_MAX; s += NASSIGN) slot_tok[s] = -1;
}
__global__ __launch_bounds__(64) void k_plan(int* __restrict__ ctl) {
    if (threadIdx.x == 0) { int ps = 0, nt = 0;
        for (int e = 0; e < NEXP; ++e) { ctl[CW_PADSTART + e] = ps; const int te = (ctl[CW_CNT + e] + SLOT_PAD - 1) / SLOT_PAD; for (int i = 0; i < te; ++i) ctl[CW_TILEEXP + nt++] = e; ps += te * SLOT_PAD; }
        ctl[CW_PADSTART + NEXP] = ps; ctl[CW_NTILES] = nt; }
}
__global__ __launch_bounds__(256) void k_assign(const int* __restrict__ TOPI, int* __restrict__ ctl, int* __restrict__ slot_tok, int* __restrict__ DEST) {
    const int i = blockIdx.x * 256 + threadIdx.x, e = TOPI[i];
    const int slot = ctl[CW_PADSTART + e] + atomicAdd(&ctl[CW_CUR + e], 1);
    slot_tok[slot] = i >> 2; DEST[i] = slot;
}
__global__ __launch_bounds__(256) void k_combine_ln2(const float* __restrict__ H, const bf16_t* __restrict__ Y, const int* __restrict__ DEST, const float* __restrict__ TOPG,
                                                     const float* __restrict__ g, const float* __restrict__ bta, float* __restrict__ out) {
    const int lane = threadIdx.x & 63, row = blockIdx.x * 4 + (threadIdx.x >> 6);
    const int4 d = *(const int4*)(DEST + row * 4); const float4 gt = *(const float4*)(TOPG + row * 4);
    const int ds[4] = {d.x, d.y, d.z, d.w}; const float gs[4] = {gt.x, gt.y, gt.z, gt.w};
    f32x4 v[4]; float s = 0.f;
#pragma unroll
    for (int j = 0; j < 4; ++j) { const int c = lane * 4 + 256 * j; f32x4 a = *(const f32x4*)(H + (size_t)row * DM + c) * DN_ALPHA;
#pragma unroll
        for (int k = 0; k < 4; ++k) { const uint2 y = *(const uint2*)(Y + (size_t)ds[k] * DM + c);
            a[0] += gs[k] * bf2f(y.x & 0xffff); a[1] += gs[k] * bf2f(y.x >> 16); a[2] += gs[k] * bf2f(y.y & 0xffff); a[3] += gs[k] * bf2f(y.y >> 16); }
        v[j] = a; s += (a[0] + a[1]) + (a[2] + a[3]); }
    const float mean = wave_sum(s) * (1.0f / DM); float s2 = 0.f;
#pragma unroll
    for (int j = 0; j < 4; ++j) { v[j] = v[j] - mean; s2 += (v[j][0] * v[j][0] + v[j][1] * v[j][1]) + (v[j][2] * v[j][2] + v[j][3] * v[j][3]); }
    const float rstd = 1.0f / sqrtf(wave_sum(s2) * (1.0f / DM) + LN_EPS);
#pragma unroll
    for (int j = 0; j < 4; ++j) { const int c = lane * 4 + 256 * j; *(f32x4*)(out + (size_t)row * DM + c) = v[j] * rstd * *(const f32x4*)(g + c) + *(const f32x4*)(bta + c); }
}

extern "C" void kernel_launch(void* const* d_in, const int* in_sizes, int n_in, void* d_out, int out_size, void* d_ws, size_t ws_size, hipStream_t stream) {
    if (n_in != 17 || ws_size < WS_END) { fprintf(stderr, "kernel_launch: unexpected n_in %d or ws_size %zu (< %zu)\n", n_in, ws_size, (size_t)WS_END); return; }
    const float* x = (const float*)d_in[0]; const float* w_in = (const float*)d_in[1]; const float* lbl = (const float*)d_in[2]; const float* norm_g = (const float*)d_in[3];
    const float* w_bs = (const float*)d_in[4]; const float* w_bh = (const float*)d_in[5]; const float* w_out = (const float*)d_in[6];
    const float* ln1_g = (const float*)d_in[7]; const float* ln1_b = (const float*)d_in[8]; const float* rw = (const float*)d_in[9]; const float* rb = (const float*)d_in[10];
    const float* w_up = (const float*)d_in[11]; const float* b_up = (const float*)d_in[12]; const float* w_dn = (const float*)d_in[13]; const float* b_dn = (const float*)d_in[14];
    const float* ln2_g = (const float*)d_in[15]; const float* ln2_b = (const float*)d_in[16];
    unsigned char* ws = (unsigned char*)d_ws;
    int* ctl = (int*)(ws + WS_CTL); float* lb = (float*)(ws + WS_LB);
    int* TOPI = (int*)(ws + WS_TOPI); float* TOPG = (float*)(ws + WS_TOPG); int* DEST = (int*)(ws + WS_DEST); int* SLOTTOK = (int*)(ws + WS_SLOTTOK);
    bf16_t* XB = (bf16_t*)(ws + WS_XB); bf16_t* WinT = (bf16_t*)(ws + WS_WINT); bf16_t* WbsT = (bf16_t*)(ws + WS_WBST); bf16_t* WbhT = (bf16_t*)(ws + WS_WBHT); bf16_t* WoT = (bf16_t*)(ws + WS_WOT);
    bf16_t* WupT = (bf16_t*)(ws + WS_WUPT); bf16_t* WdnT = (bf16_t*)(ws + WS_WDNT);
    InProjOut ip{}; ip.Q = (bf16_t*)(ws + WS_Q); ip.K = (bf16_t*)(ws + WS_K); ip.V = (bf16_t*)(ws + WS_V); ip.HQ = (bf16_t*)(ws + WS_HQ); ip.HK = (bf16_t*)(ws + WS_HK); ip.HV = (bf16_t*)(ws + WS_HV);
    ip.HG = (bf16_t*)(ws + WS_HG); ip.GS = (bf16_t*)(ws + WS_GS); ip.GH = (bf16_t*)(ws + WS_GH); ip.LOGF = (float*)(ws + WS_LOGF); ip.lb = lb;
    bf16_t* OSB = (bf16_t*)(ws + WS_OSB); bf16_t* OHG = (bf16_t*)(ws + WS_OHG); float* ORAW = (float*)(ws + WS_ORAW); bf16_t* MERGED = (bf16_t*)(ws + WS_MERGED);
    float* PRE = (float*)(ws + WS_PRE); float* H = (float*)(ws + WS_H); bf16_t* HB = (bf16_t*)(ws + WS_HB); bf16_t* ACT = (bf16_t*)(ws + WS_ACT); bf16_t* Y = (bf16_t*)(ws + WS_Y);

    (void)hipMemsetAsync(ws + WS_CTL, 0, 4096, stream);
    k_convert_x<<<NTOK * DM / 4 / 256, 256, 0, stream>>>(x, XB, lbl, lb);
    k_transpose_bf16<<<dim3(INW / 64, DM / 64, 1), 256, 0, stream>>>(w_in, WinT, DM, INW);
    k_transpose_bf16<<<dim3(DM / 64, SBW / 64, 1), 256, 0, stream>>>(w_bs, WbsT, SBW, DM);
    k_transpose_bf16<<<dim3(DM / 64, HGW / 64, 1), 256, 0, stream>>>(w_bh, WbhT, HGW, DM);
    k_transpose_bf16<<<dim3(DM / 64, DM / 64, 1), 256, 0, stream>>>(w_out, WoT, DM, DM);
    k_transpose_bf16<<<dim3(UPW / 64, DM / 64, NEXP), 256, 0, stream>>>(w_up, WupT, DM, UPW);
    k_transpose_bf16<<<dim3(DM / 64, DFF / 64, NEXP), 256, 0, stream>>>(w_dn, WdnT, DFF, DM);
    k_inproj<<<dim3(INW / G_BM, NTOK / G_BM), 256, 0, stream>>>(XB, WinT, ip);
    k_attn_naive<<<dim3(32, 64), 64, 0, stream>>>(ip.Q, ip.K, ip.V, OSB);
    k_hgrn_naive<<<32, 128, 0, stream>>>(ip.HQ, ip.HK, ip.LOGF, ip.HV, ORAW);
    k_hgrn_post<<<NTOK * HGH / 4, 256, 0, stream>>>(ORAW, ip.HG, norm_g, OHG);
    k_branch<<<dim3(DM / G_BM, NTOK / G_BM), 256, 0, stream>>>(OSB, OHG, WbsT, WbhT, ip.GS, ip.GH, MERGED);
    k_outproj<<<dim3(DM / G_BM, NTOK / G_BM), 256, 0, stream>>>(MERGED, WoT, x, PRE);
    k_ln1_router<<<NTOK / 4, 256, 0, stream>>>(PRE, ln1_g, ln1_b, rw, rb, H, HB, TOPI, TOPG);
    k_count<<<NASSIGN / 256, 256, 0, stream>>>(TOPI, ctl, SLOTTOK);
    k_plan<<<1, 64, 0, stream>>>(ctl);
    k_assign<<<NASSIGN / 256, 256, 0, stream>>>(TOPI, ctl, SLOTTOK, DEST);
    k_moe_up<<<dim3(UPW / G_BM, NSLOT_MAX / G_BM), 256, 0, stream>>>(HB, WupT, b_up, ctl, SLOTTOK, ACT);
    k_moe_down<<<dim3(DM / G_BM, NSLOT_MAX / G_BM), 256, 0, stream>>>(ACT, WdnT, b_dn, ctl, Y);
    k_combine_ln2<<<NTOK / 4, 256, 0, stream>>>(H, Y, DEST, TOPG, ln2_g, ln2_b, (float*)d_out);
}
```

```cpp
#include <hip/hip_runtime.h>
#include <stdint.h>
#include <cstdio>

#define LAS __attribute__((address_space(3)))
#define GAS __attribute__((address_space(1)))
typedef unsigned short bf16_t;
typedef short bf16x8 __attribute__((ext_vector_type(8)));
typedef float f32x4 __attribute__((ext_vector_type(4)));
typedef float f32x16 __attribute__((ext_vector_type(16)));
typedef unsigned u32x4 __attribute__((ext_vector_type(4)));
typedef unsigned u32x2 __attribute__((ext_vector_type(2)));

constexpr int NTOK = 16384, DM = 1024, INW = 5632, SBW = 512, HGW = 512, NEXP = 32, TOPK = 4, DFF = 1024, UPW = 2048;
constexpr int SEQ = 2048, SBH = 8, SBD = 64, HGH = 4, HGD = 128;
constexpr int NASSIGN = NTOK * TOPK;
constexpr int SLOT_PAD = 256;
constexpr int NSLOT_MAX = NASSIGN + NEXP * SLOT_PAD;
constexpr int NTILE_MAX = NSLOT_MAX / SLOT_PAD;
constexpr float LN_EPS = 1e-5f, RMS_EPS = 1e-6f, DN_ALPHA = 1.189207115002721f, SW_ALPHA = 1.702f, SW_LIMIT = 7.0f, LOG2E = 1.4426950408889634f, LN2 = 0.6931471805599453f;
constexpr int NWAVES = 8, NTHREADS = 512;
#ifndef MK_MODE
#ifndef MK_P1_ALIGN
#define MK_P1_ALIGN true
#endif
#ifndef MK_P1_SP2
#define MK_P1_SP2 true
#endif
#ifndef MK_HEAD_V1
#define MK_HEAD_V1 0
#endif
#define MK_MODE 0
#endif

constexpr size_t MiB = 1u << 20;
constexpr size_t WS_CTL = 0, CTL_ZERO_BYTES = 262144;
constexpr size_t WS_LB = 1 * MiB;
constexpr size_t WS_CNTM = WS_LB + 4096;
constexpr size_t WS_TOPG = WS_CNTM + 32768;
constexpr size_t WS_DEST = WS_TOPG + 262144;
constexpr size_t WS_RWT = WS_DEST + 262144;
constexpr size_t WS_XB = 3 * MiB;
constexpr size_t WS_WINT = WS_XB + 32 * MiB;
constexpr size_t WS_WBST = WS_WINT + 12 * MiB;
constexpr size_t WS_WBHT = WS_WBST + 1 * MiB;
constexpr size_t WS_WOT = WS_WBHT + 1 * MiB;
constexpr size_t WS_WUPT = WS_WOT + 2 * MiB;
constexpr size_t WS_WDNT = WS_WUPT + 128 * MiB;
constexpr size_t WS_Q = WS_WDNT + 64 * MiB;
constexpr size_t WS_K = WS_Q + 16 * MiB;
constexpr size_t WS_V = WS_K + 16 * MiB;
constexpr size_t WS_HQ = WS_V + 16 * MiB;
constexpr size_t WS_HK = WS_HQ + 16 * MiB;
constexpr size_t WS_HV = WS_HK + 16 * MiB;
constexpr size_t WS_HG = WS_HV + 16 * MiB;
constexpr size_t WS_LOGF = WS_HG + 16 * MiB;
constexpr size_t WS_GS = WS_LOGF + 32 * MiB;
constexpr size_t WS_GH = WS_GS + 32 * MiB;
constexpr size_t WS_OSB = WS_GH + 32 * MiB;
constexpr size_t WS_OHG = WS_OSB + 16 * MiB;
constexpr size_t WS_ORAW = WS_OHG + 16 * MiB;
constexpr size_t WS_MERGED = WS_ORAW + 32 * MiB;
constexpr size_t WS_H = WS_MERGED + 32 * MiB;
constexpr size_t WS_XS = WS_H + 64 * MiB;
constexpr size_t WS_ACT = WS_XS + 144 * MiB;
constexpr size_t WS_END = WS_ACT + 144 * MiB;
constexpr size_t WS_PRE = WS_Q;
constexpr size_t WS_Y = WS_HK;
static_assert(WS_Y + 144 * MiB <= WS_OSB && WS_PRE + 64 * MiB <= WS_HK, "overlays");
static_assert(WS_END <= 1020 * MiB, "ws budget");
constexpr int CW_NTILES = 16;
constexpr int CW_TILEEXP = 64;
constexpr int CW_BAR = 1024;
constexpr int LDS_SCRATCH = 147456;
constexpr int LDSCTL_OFF = LDS_SCRATCH, LDS_BYTES = LDS_SCRATCH + 512;
constexpr int MISC_OFF = LDSCTL_OFF;

__device__ __forceinline__ unsigned f2bf(float f) { unsigned u = __builtin_bit_cast(unsigned, f); return (u + 0x7fffu + ((u >> 16) & 1u)) >> 16; }
__device__ __forceinline__ unsigned pk2(float lo, float hi) { return f2bf(lo) | (f2bf(hi) << 16); }
__device__ __forceinline__ float bf2f(unsigned short b) { return __builtin_bit_cast(float, (unsigned)b << 16); }
__device__ __forceinline__ float bflo(unsigned w) { return __builtin_bit_cast(float, w << 16); }
__device__ __forceinline__ float bfhi(unsigned w) { return __builtin_bit_cast(float, w & 0xffff0000u); }
__device__ __forceinline__ float fsigmoid(float v) { return __builtin_amdgcn_rcpf(1.0f + __builtin_amdgcn_exp2f(-v * LOG2E)); }
__device__ __forceinline__ float wave_sum(float v) {
#pragma unroll
    for (int o = 1; o < 64; o <<= 1) v += __shfl_xor(v, o);
    return v;
}
#define LDS_WAIT() asm volatile("s_waitcnt lgkmcnt(0)" ::: "memory")
#define VM_WAIT() asm volatile("s_waitcnt vmcnt(0)" ::: "memory")

struct InProjOut { bf16_t *Q, *K, *V, *HQ, *HK, *HV, *HG, *GS, *GH; float* LOGF; const float* lb; };

namespace pg8 {
#define PG8_LAS __attribute__((address_space(3)))
constexpr int BM = 256, BK = 64, HALF = 128, HTB = HALF * BK * 2  , STAGE_BYTES = 8 * HTB, NXCD = 8, WGM = 8;
__host__ __device__ __forceinline__ int lds_byte(int r, int c) { const int st = (r >> 4) * 2 + (c >> 5), rr = r & 15, cc = c & 31, ob = rr * 64 + cc * 2; return st * 1024 + (ob ^ (((ob >> 9) & 1) << 5)); }
__host__ __device__ __forceinline__ void stage_rc(int b, int& R, int& C) { const int st = b / 1024, sb = b % 1024, swz = sb ^ (((sb >> 9) & 1) << 5); R = (st >> 1) * 16 + swz / 64; C = (st & 1) * 32 + (swz % 64) / 2; }
__host__ __device__ __forceinline__ int perm32(int rho) { const int n = rho >> 4, i = rho & 15; return 8 * (i >> 2) + 4 * n + (i & 3); }

struct Unit { int pm, pn, aux; const char* a; const char* b; };
struct Gemm { int K; };
struct TileOrder {
    int nM, nN, nwg, G, c;
    __device__ void init(int nM_, int nN_, int G_, int c_) { nM = nM_; nN = nN_; nwg = nM * nN; G = G_; c = c_; }
    __device__ bool tile(int i, int& pm, int& pn) const {
        const long L = (long)i * G + c; if (L >= nwg) return false;
        int wgid = (int)L; { const int q = nwg / NXCD, r = nwg % NXCD, xcd = wgid % NXCD, off = wgid / NXCD; wgid = (xcd < r ? xcd * (q + 1) : r * (q + 1) + (xcd - r) * q) + off; }
        const int nig = WGM * nN, gid = wgid / nig, fm = gid * WGM, gsz = (nM - fm) < WGM ? (nM - fm) : WGM;
        pm = fm + ((wgid % nig) % gsz); pn = (wgid % nig) / gsz; return true;
    }
};
struct DenseSched { TileOrder o; const char* A; const char* Bt; size_t tstep;
    __device__ __forceinline__ bool next(int i, Unit& u) const { if (!o.tile(i, u.pm, u.pn)) return false; u.aux = 0; u.a = A + (size_t)u.pm * tstep; u.b = Bt + (size_t)u.pn * tstep; return true; }
    __device__ __forceinline__ void a_ready(const Unit&) const {}
    __device__ __forceinline__ void done(const Unit&) const {} };
struct BranchSched { TileOrder o; const char *A0, *B0, *A1, *B1; size_t tstep;
    __device__ __forceinline__ bool next(int i, Unit& u) const { if (!o.tile(i >> 1, u.pm, u.pn)) return false; u.aux = i & 1; u.a = ((i & 1) ? A1 : A0) + (size_t)u.pm * tstep; u.b = ((i & 1) ? B1 : B0) + (size_t)u.pn * tstep; return true; }
    __device__ __forceinline__ void a_ready(const Unit&) const {}
    __device__ __forceinline__ void done(const Unit&) const {} };
struct MoeSched { TileOrder o; const char* A; const char* W; const int* tile_exp; size_t tstep, estep;
    __device__ __forceinline__ bool next(int i, Unit& u) const { if (!o.tile(i, u.pm, u.pn)) return false; const int e = __builtin_amdgcn_readfirstlane(__hip_atomic_load(tile_exp + u.pm, __ATOMIC_RELAXED, __HIP_MEMORY_SCOPE_AGENT)); u.aux = e; u.a = A + (size_t)u.pm * tstep; u.b = W + (size_t)e * estep + (size_t)u.pn * tstep; return true; }
    __device__ __forceinline__ void a_ready(const Unit&) const {}
    __device__ __forceinline__ void done(const Unit&) const {} };

typedef float f32x2_t __attribute__((ext_vector_type(2))); typedef __bf16 bf16x2_t __attribute__((ext_vector_type(2)));
__device__ __forceinline__ unsigned cvt_pk_bf16(float lo, float hi) { f32x2_t v = {lo, hi}; bf16x2_t b = __builtin_convertvector(v, bf16x2_t); return __builtin_bit_cast(unsigned, b); }
template <int MODE> __device__ __forceinline__ void inproj_store(const f32x4 (&acc)[2][2][4][2], bf16_t* dst, int ld, int row0, int col0, float scale, const float* lb, float* logf_out) {
    f32x4 lbv[2][2];
    if (MODE == 2) {
#pragma unroll
        for (int bj = 0; bj < 2; ++bj)
#pragma unroll
            for (int n = 0; n < 2; ++n) lbv[bj][n] = *(const f32x4*)(lb + col0 + bj * HALF + 4 * n);
    }
#pragma unroll
    for (int ai = 0; ai < 2; ++ai)
#pragma unroll
        for (int m = 0; m < 4; ++m)
#pragma unroll
            for (int bj = 0; bj < 2; ++bj) {
                const size_t off = (size_t)(row0 + ai * HALF + m * 16) * ld + col0 + bj * HALF;
                f32x4 v[2] = {acc[ai][bj][m][0], acc[ai][bj][m][1]};
                if (MODE == 0) { v[0] = v[0] * scale; v[1] = v[1] * scale; }
                if (MODE == 1) {
#pragma unroll
                    for (int n = 0; n < 2; ++n)
#pragma unroll
                        for (int j = 0; j < 4; ++j) v[n][j] = v[n][j] * fsigmoid(v[n][j]); }
                if (MODE == 3) {
#pragma unroll
                    for (int n = 0; n < 2; ++n)
#pragma unroll
                        for (int j = 0; j < 4; ++j) v[n][j] = fsigmoid(v[n][j]); }
                if (MODE == 2) {
                    f32x4 lg[2];
#pragma unroll
                    for (int n = 0; n < 2; ++n)
#pragma unroll
                        for (int j = 0; j < 4; ++j) { const float l = lbv[bj][n][j], f = l + (1.0f - l) * fsigmoid(v[n][j]); v[n][j] = 1.0f - f; lg[n][j] = __builtin_amdgcn_logf(f) * LN2; }
                    *(f32x4*)(logf_out + off) = lg[0]; *(f32x4*)(logf_out + off + 4) = lg[1];
                }
                u32x4 w; w.x = cvt_pk_bf16(v[0][0], v[0][1]); w.y = cvt_pk_bf16(v[0][2], v[0][3]); w.z = cvt_pk_bf16(v[1][0], v[1][1]); w.w = cvt_pk_bf16(v[1][2], v[1][3]);
                *(u32x4*)(dst + off) = w;
            }
}
struct EpiInProj { static constexpr bool PERM = true, AFTER_DRAIN = false, ACC_CHAIN = false; InProjOut o;
    __device__ __forceinline__ void operator()(f32x4 (&acc)[2][2][4][2], const Unit& u, int wr, int wc, int fr, int fq) const {
        const int row0 = u.pm * BM + wr * 64 + fr, pn = u.pn;
        int seg, cb, ld;
        if (pn < 14) { seg = pn >> 1; cb = (pn & 1) * 256; ld = 512; } else if (pn < 18) { seg = 7; cb = (pn - 14) * 256; ld = 1024; } else { seg = 8; cb = (pn - 18) * 256; ld = 1024; }
        const int col0 = cb + wc * 32 + 8 * fq;
        switch (seg) {
            case 0: inproj_store<0>(acc, o.Q, ld, row0, col0, 0.125f, nullptr, nullptr); break;
            case 1: inproj_store<0>(acc, o.K, ld, row0, col0, 1.0f, nullptr, nullptr); break;
            case 2: inproj_store<0>(acc, o.V, ld, row0, col0, 1.0f, nullptr, nullptr); break;
            case 3: inproj_store<1>(acc, o.HQ, ld, row0, col0, 1.0f, nullptr, nullptr); break;
            case 4: inproj_store<2>(acc, o.HK, ld, row0, col0, 1.0f, o.lb, o.LOGF); break;
            case 5: inproj_store<0>(acc, o.HV, ld, row0, col0, 1.0f, nullptr, nullptr); break;
            case 6: inproj_store<3>(acc, o.HG, ld, row0, col0, 1.0f, nullptr, nullptr); break;
            case 7: inproj_store<3>(acc, o.GS, ld, row0, col0, 1.0f, nullptr, nullptr); break;
            default: inproj_store<3>(acc, o.GH, ld, row0, col0, 1.0f, nullptr, nullptr); break;
        }
    }
};
struct EpiBranch { static constexpr bool PERM = true, AFTER_DRAIN = false, ACC_CHAIN = true; const bf16_t* GS; const bf16_t* GH; bf16_t* MERGED;
    __device__ __forceinline__ void operator()(f32x4 (&acc)[2][2][4][2], const Unit& u, int wr, int wc, int fr, int fq) const {
        const int row0 = u.pm * BM + wr * 64 + fr, col0 = u.pn * BM + wc * 32 + 8 * fq;
#pragma unroll
        for (int ai = 0; ai < 2; ++ai)
#pragma unroll
            for (int m = 0; m < 4; ++m)
#pragma unroll
                for (int bj = 0; bj < 2; ++bj) {
                    const size_t off = (size_t)(row0 + ai * HALF + m * 16) * DM + col0 + bj * HALF;
                    const u32x4 gh = *(const u32x4*)(GH + off);
                    const float h[8] = {bflo(gh.x), bfhi(gh.x), bflo(gh.y), bfhi(gh.y), bflo(gh.z), bfhi(gh.z), bflo(gh.w), bfhi(gh.w)};
                    if (u.aux == 0) {
                        const u32x4 gs = *(const u32x4*)(GS + off);
                        const float s[8] = {bflo(gs.x), bfhi(gs.x), bflo(gs.y), bfhi(gs.y), bflo(gs.z), bfhi(gs.z), bflo(gs.w), bfhi(gs.w)};
#pragma unroll
                        for (int n = 0; n < 2; ++n)
#pragma unroll
                            for (int j = 0; j < 4; ++j) acc[ai][bj][m][n][j] *= s[4 * n + j] / h[4 * n + j];
                    } else {
                        float r[8];
#pragma unroll
                        for (int n = 0; n < 2; ++n)
#pragma unroll
                            for (int j = 0; j < 4; ++j) { r[4 * n + j] = acc[ai][bj][m][n][j] * h[4 * n + j]; acc[ai][bj][m][n][j] = 0.f; }
                        u32x4 w; w.x = cvt_pk_bf16(r[0], r[1]); w.y = cvt_pk_bf16(r[2], r[3]); w.z = cvt_pk_bf16(r[4], r[5]); w.w = cvt_pk_bf16(r[6], r[7]);
                        *(u32x4*)(MERGED + off) = w;
                    }
                }
    }
};
struct EpiOut { static constexpr bool PERM = false, AFTER_DRAIN = false, ACC_CHAIN = false; const float* x; float* PRE;
    __device__ __forceinline__ void operator()(f32x4 (&acc)[2][2][4][2], const Unit& u, int wr, int wc, int fr, int fq) const {
        const int row0 = u.pm * BM + wr * 64 + fr, col0 = u.pn * BM + wc * 32 + 4 * fq;
#pragma unroll
        for (int ai = 0; ai < 2; ++ai)
#pragma unroll
            for (int m = 0; m < 4; ++m) { const size_t ro = (size_t)(row0 + ai * HALF + m * 16) * DM + col0;
#pragma unroll
                for (int bj = 0; bj < 2; ++bj)
#pragma unroll
                    for (int n = 0; n < 2; ++n) { const size_t off = ro + bj * HALF + n * 16; *(f32x4*)(PRE + off) = *(const f32x4*)(x + off) * DN_ALPHA + acc[ai][bj][m][n]; } }
    }
};
struct EpiUp { static constexpr bool PERM = true, AFTER_DRAIN = false, ACC_CHAIN = false; const float* b_up; bf16_t* ACT;
    __device__ __forceinline__ void operator()(f32x4 (&acc)[2][2][4][2], const Unit& u, int wr, int wc, int fr, int fq) const {
        const int row0 = u.pm * BM + wr * 64 + fr, col0 = u.pn * BM + wc * 32 + 8 * fq; const float* bias = b_up + (size_t)u.aux * UPW + col0;
        f32x4 bv[2][2];
#pragma unroll
        for (int bj = 0; bj < 2; ++bj)
#pragma unroll
            for (int n = 0; n < 2; ++n) bv[bj][n] = *(const f32x4*)(bias + bj * HALF + 4 * n);
#pragma unroll
        for (int ai = 0; ai < 2; ++ai)
#pragma unroll
            for (int m = 0; m < 4; ++m)
#pragma unroll
                for (int bj = 0; bj < 2; ++bj) {
                    const f32x4 v0 = acc[ai][bj][m][0] + bv[bj][0], v1 = acc[ai][bj][m][1] + bv[bj][1];
                    const float gl[4] = {v0[0], v0[2], v1[0], v1[2]}, li[4] = {v0[1], v0[3], v1[1], v1[3]}; float a[4];
#pragma unroll
                    for (int p = 0; p < 4; ++p) { const float g = fminf(gl[p], SW_LIMIT), l = fminf(fmaxf(li[p], -SW_LIMIT), SW_LIMIT); a[p] = g * fsigmoid(SW_ALPHA * g) * (l + 1.0f); }
                    u32x2 w; w.x = cvt_pk_bf16(a[0], a[1]); w.y = cvt_pk_bf16(a[2], a[3]);
                    *(u32x2*)(ACT + (size_t)(row0 + ai * HALF + m * 16) * DFF + ((col0 + bj * HALF) >> 1)) = w;
                }
    }
};
struct EpiDown { static constexpr bool PERM = true, AFTER_DRAIN = false, ACC_CHAIN = false; const float* b_dn; bf16_t* Y;
    __device__ __forceinline__ void operator()(f32x4 (&acc)[2][2][4][2], const Unit& u, int wr, int wc, int fr, int fq) const {
        const int row0 = u.pm * BM + wr * 64 + fr, col0 = u.pn * BM + wc * 32 + 8 * fq; const float* bias = b_dn + (size_t)u.aux * DM + col0;
        f32x4 bv[2][2];
#pragma unroll
        for (int bj = 0; bj < 2; ++bj)
#pragma unroll
            for (int n = 0; n < 2; ++n) bv[bj][n] = *(const f32x4*)(bias + bj * HALF + 4 * n);
#pragma unroll
        for (int ai = 0; ai < 2; ++ai)
#pragma unroll
            for (int m = 0; m < 4; ++m)
#pragma unroll
                for (int bj = 0; bj < 2; ++bj) {
                    const f32x4 v0 = acc[ai][bj][m][0] + bv[bj][0], v1 = acc[ai][bj][m][1] + bv[bj][1];
                    u32x4 w; w.x = cvt_pk_bf16(v0[0], v0[1]); w.y = cvt_pk_bf16(v0[2], v0[3]); w.z = cvt_pk_bf16(v1[0], v1[1]); w.w = cvt_pk_bf16(v1[2], v1[3]);
                    *(u32x4*)(Y + (size_t)(row0 + ai * HALF + m * 16) * DM + col0 + bj * HALF) = w;
                }
    }
};

template <class Epi, class Sched, bool ALIGN_EPI = false, bool SP2 = false>
__device__ __forceinline__ void gemm_phase(PG8_LAS unsigned char* lds, const Gemm g, const Sched& S, const Epi& E) {
    const int tid = threadIdx.x, wid = __builtin_amdgcn_readfirstlane(tid >> 6), lane = tid & 63, wr = wid >> 2, wc = wid & 3, fr = lane & 15, fq = lane >> 4;
    const int K = g.K, nt = K / BK;
    unsigned voffA[2], voffB[2];
#pragma unroll
    for (int i = 0; i < 2; ++i) { int R, C; stage_rc(tid * 16 + i * 8192, R, C); const int Rb = Epi::PERM ? ((R & ~31) + perm32(R & 31)) : R;
        voffA[i] = (unsigned)(R * K + C) * 2u; voffB[i] = (unsigned)(Rb * K + C) * 2u; }
    const size_t kstep = (size_t)(BK * 2);
    const size_t hstep = (size_t)HALF * K * 2;
    const unsigned ldsw = (unsigned)wid * 1024u;
    const int aoff = lds_byte(wr * 64 + fr, fq * 8), boff = lds_byte(wc * 32 + fr, fq * 8);
#define PG8_SA(b, h) (((b) * 2 + (h)) * HTB)
#define PG8_SB(b, h) ((4 + (b) * 2 + (h)) * HTB)
#define PG8_STAGE(bufoff, gbase, voff) do { _Pragma("unroll") for (int _i = 0; _i < 2; ++_i) \
        __builtin_amdgcn_global_load_lds((const unsigned*)((const char*)(gbase) + (voff)[_i]), (PG8_LAS unsigned*)(lds + (bufoff) + ldsw + _i * 8192), 16, 0, 0); } while (0)
#define PG8_LDA(dst, b, h) do { _Pragma("unroll") for (int m = 0; m < 4; ++m) _Pragma("unroll") for (int k = 0; k < 2; ++k) dst[m][k] = *(const PG8_LAS bf16x8*)(lds + PG8_SA(b, h) + aoff + m * 2048 + k * 1024); } while (0)
#define PG8_LDB(dst, b, h) do { _Pragma("unroll") for (int n = 0; n < 2; ++n) _Pragma("unroll") for (int k = 0; k < 2; ++k) dst[n][k] = *(const PG8_LAS bf16x8*)(lds + PG8_SB(b, h) + boff + n * 2048 + k * 1024); } while (0)
#define PG8_MMA(ai, bj, At, Bt) do { __builtin_amdgcn_s_setprio(1); _Pragma("unroll") for (int m = 0; m < 4; ++m) _Pragma("unroll") for (int n = 0; n < 2; ++n) _Pragma("unroll") for (int k = 0; k < 2; ++k) \
        acc[ai][bj][m][n] = __builtin_amdgcn_mfma_f32_16x16x32_bf16(Bt[n][k], At[m][k], acc[ai][bj][m][n], 0, 0, 0); __builtin_amdgcn_s_setprio(0); } while (0)
#define PG8_WAIT_V(n) asm volatile("s_waitcnt vmcnt(" #n ")" ::: "memory")
#define PG8_WAIT_L(n) asm volatile("s_waitcnt lgkmcnt(" #n ")" ::: "memory")
#define PG8_BAR __builtin_amdgcn_s_barrier()
#define PG8_SCHED __builtin_amdgcn_sched_barrier(0)
    Unit cur, nxt; int ui = 0;
    if (!S.next(0, cur)) return;
    f32x4 acc[2][2][4][2];
#pragma unroll
    for (int a = 0; a < 2; ++a)
#pragma unroll
        for (int b = 0; b < 2; ++b)
#pragma unroll
            for (int m = 0; m < 4; ++m)
#pragma unroll
                for (int n = 0; n < 2; ++n) acc[a][b][m][n] = (f32x4){0.f, 0.f, 0.f, 0.f};
    bf16x8 At[4][2], B0[2][2], B1[2][2];
    const char* cA = cur.a; const char* cB = cur.b;
    S.a_ready(cur);
    if constexpr (SP2) {
        PG8_STAGE(PG8_SB(0, 0), cB, voffB); PG8_STAGE(PG8_SB(0, 1), cB + hstep, voffB); PG8_STAGE(PG8_SA(0, 0), cA, voffA); PG8_STAGE(PG8_SA(0, 1), cA + hstep, voffA);
        if (wr == 1) PG8_BAR;
        PG8_WAIT_V(2); PG8_BAR;
        PG8_STAGE(PG8_SB(1, 0), cB + kstep, voffB); PG8_STAGE(PG8_SA(1, 0), cA + kstep, voffA); PG8_STAGE(PG8_SB(1, 1), cB + hstep + kstep, voffB);
        PG8_WAIT_V(6); PG8_BAR;
    } else {
        PG8_STAGE(PG8_SB(0, 0), cB, voffB); PG8_STAGE(PG8_SA(0, 0), cA, voffA); PG8_STAGE(PG8_SB(0, 1), cB + hstep, voffB); PG8_STAGE(PG8_SA(0, 1), cA + hstep, voffA);
        if (wr == 1) PG8_BAR;
        PG8_WAIT_V(4); PG8_BAR;
        PG8_STAGE(PG8_SB(1, 0), cB + kstep, voffB); PG8_STAGE(PG8_SA(1, 0), cA + kstep, voffA); PG8_STAGE(PG8_SB(1, 1), cB + hstep + kstep, voffB);
        PG8_WAIT_V(6); PG8_BAR;
    }
    for (;;) {
        const bool has_next = S.next(ui + 1, nxt);
        const char* nA = has_next ? nxt.a : cA; const char* nB = has_next ? nxt.b : cB;
        for (int t = 0; t < nt; t += 2) {
            const bool last = (t == nt - 2);
            const char* a1 = cA + (size_t)(t + 1) * kstep;
            const char* a2 = last ? nA : cA + (size_t)(t + 2) * kstep; const char* b2 = last ? nB : cB + (size_t)(t + 2) * kstep;
            const char* a3 = a2 + kstep; const char* b3 = b2 + kstep;
            if (last && has_next) S.a_ready(nxt);
            if constexpr (SP2) {
            PG8_LDB(B0, 0, 0); PG8_LDB(B1, 0, 1); PG8_SCHED; PG8_LDA(At, 0, 0); PG8_STAGE(PG8_SA(1, 1), a1 + hstep, voffA);
            PG8_WAIT_V(8); PG8_WAIT_L(0); PG8_BAR; PG8_MMA(0, 0, At, B0); PG8_MMA(0, 1, At, B1); PG8_BAR; PG8_SCHED;
            PG8_LDA(At, 0, 1); PG8_STAGE(PG8_SB(0, 0), b2, voffB); PG8_STAGE(PG8_SB(0, 1), b2 + hstep, voffB); PG8_STAGE(PG8_SA(0, 0), a2, voffA);
            PG8_WAIT_V(8); PG8_WAIT_L(0); PG8_BAR; PG8_MMA(1, 0, At, B0); PG8_MMA(1, 1, At, B1); PG8_BAR; PG8_SCHED;
            PG8_LDB(B0, 1, 0); PG8_LDB(B1, 1, 1); PG8_SCHED; PG8_LDA(At, 1, 0); PG8_STAGE(PG8_SA(0, 1), a2 + hstep, voffA);
            PG8_WAIT_V(8); PG8_WAIT_L(0); PG8_BAR; PG8_MMA(0, 0, At, B0); PG8_MMA(0, 1, At, B1); PG8_BAR; PG8_SCHED;
            PG8_LDA(At, 1, 1); PG8_STAGE(PG8_SB(1, 0), b3, voffB); PG8_STAGE(PG8_SB(1, 1), b3 + hstep, voffB); PG8_STAGE(PG8_SA(1, 0), a3, voffA);
            PG8_WAIT_V(8); PG8_WAIT_L(0); PG8_BAR; PG8_MMA(1, 0, At, B0); PG8_MMA(1, 1, At, B1); PG8_BAR; PG8_SCHED;
            } else {
            PG8_LDB(B0, 0, 0); PG8_SCHED; PG8_LDA(At, 0, 0); PG8_STAGE(PG8_SA(1, 1), a1 + hstep, voffA);
            PG8_WAIT_L(8); PG8_BAR; PG8_WAIT_L(0); PG8_MMA(0, 0, At, B0); PG8_BAR; PG8_SCHED;
            PG8_LDB(B1, 0, 1); PG8_STAGE(PG8_SB(0, 0), b2, voffB);
            PG8_BAR; PG8_WAIT_L(0); PG8_MMA(0, 1, At, B1); PG8_BAR;
            PG8_LDA(At, 0, 1); PG8_STAGE(PG8_SA(0, 0), a2, voffA);
            PG8_BAR; PG8_WAIT_L(0); PG8_MMA(1, 0, At, B0); PG8_BAR; PG8_SCHED;
            PG8_STAGE(PG8_SB(0, 1), b2 + hstep, voffB);
            PG8_WAIT_V(6); PG8_BAR; PG8_MMA(1, 1, At, B1); PG8_BAR;
            PG8_LDB(B0, 1, 0); PG8_SCHED; PG8_LDA(At, 1, 0); PG8_STAGE(PG8_SA(0, 1), a2 + hstep, voffA);
            PG8_WAIT_L(8); PG8_BAR; PG8_WAIT_L(0); PG8_MMA(0, 0, At, B0); PG8_BAR; PG8_SCHED;
            PG8_LDB(B1, 1, 1); PG8_STAGE(PG8_SB(1, 0), b3, voffB);
            PG8_BAR; PG8_WAIT_L(0); PG8_MMA(0, 1, At, B1); PG8_BAR;
            PG8_LDA(At, 1, 1); PG8_STAGE(PG8_SA(1, 0), a3, voffA);
            PG8_BAR; PG8_WAIT_L(0); PG8_MMA(1, 0, At, B0); PG8_BAR; PG8_SCHED;
            PG8_STAGE(PG8_SB(1, 1), b3 + hstep, voffB);
            PG8_WAIT_V(6); PG8_BAR; PG8_MMA(1, 1, At, B1); PG8_BAR;
            }
        }
        if constexpr (ALIGN_EPI) { if (wr == 0) PG8_BAR; }
        if constexpr (!Epi::AFTER_DRAIN) { E(acc, cur, wr, wc, fr, fq); S.done(cur); }
        if (!has_next) break;
        if constexpr (!Epi::ACC_CHAIN) {
#pragma unroll
        for (int a = 0; a < 2; ++a)
#pragma unroll
            for (int b = 0; b < 2; ++b)
#pragma unroll
                for (int m = 0; m < 4; ++m)
#pragma unroll
                    for (int n = 0; n < 2; ++n) acc[a][b][m][n] = (f32x4){0.f, 0.f, 0.f, 0.f};
        }
        cur = nxt; cA = nA; cB = nB; ++ui;
        if constexpr (ALIGN_EPI) { if (wr == 1) PG8_BAR; }
    }
    PG8_WAIT_V(0);
    if constexpr (!ALIGN_EPI) { if (wr == 0) PG8_BAR; }
    PG8_BAR;
    if constexpr (Epi::AFTER_DRAIN) { E.fused(acc, cur, wr, wc, fr, fq, lds, wid, lane); S.done(cur); }
#undef PG8_SA
#undef PG8_SB
#undef PG8_STAGE
#undef PG8_LDA
#undef PG8_LDB
#undef PG8_MMA
#undef PG8_WAIT_V
#undef PG8_WAIT_L
#undef PG8_BAR
#undef PG8_SCHED
}
}

typedef GAS unsigned gu32;
#define RLX_AGENT __ATOMIC_RELAXED, __HIP_MEMORY_SCOPE_AGENT
#define XB_TMO      128
#define XB_XCNT(j)  (256  + 64 * (j))
#define XB_XSUB(j)  (1280 + 64 * (j))
#define XB_XGEN(j)  (2304 + 64 * (j))
#define XB_TOP      3328
#define XB_TOPGEN   3392
#define XCD_BAR_WORDS 3456
#define XB_SPIN_CAP (1u << 26)

__device__ __forceinline__ unsigned xb_ld(unsigned* p)              { return __hip_atomic_load(p, __ATOMIC_RELAXED, __HIP_MEMORY_SCOPE_AGENT); }
__device__ __forceinline__ unsigned xb_add(unsigned* p, unsigned v) { return __hip_atomic_fetch_add(p, v, __ATOMIC_RELAXED, __HIP_MEMORY_SCOPE_AGENT); }
__device__ __forceinline__ unsigned xb_xcc_id() { return (unsigned)__builtin_amdgcn_s_getreg((3 << 11) | 20) & 0xFu; }
#define XB_SPIN(cond, bar) do { unsigned _sp = 0; while (cond) { __builtin_amdgcn_s_sleep(1); \
    if ((++_sp & 255u) == 0u) { if (xb_ld(&(bar)[XB_TMO])) break; if (_sp > XB_SPIN_CAP) { atomicAdd(&(bar)[XB_TMO], 1u); break; } } } } while (0)

struct XcdBarrier {
    unsigned* bar; unsigned x;
    volatile LAS unsigned* st;
};

__device__ __forceinline__ XcdBarrier xcd_barrier_post(unsigned* bar, volatile LAS unsigned* st) {
    XcdBarrier b; b.bar = bar; b.x = xb_xcc_id(); b.st = st;
    if (threadIdx.x == 0) (void)xb_add(&bar[XB_XCNT(b.x)], 1u);
    return b;
}
__device__ __forceinline__ void xcd_barrier_complete(unsigned* bar, unsigned x, unsigned& nloc, unsigned& nx) {
    const unsigned G = gridDim.x * gridDim.y * gridDim.z;
    unsigned sum, cnt, mine, sp = 0u;
    for (;;) {
        sum = 0u; cnt = 0u; mine = 0u;
#pragma unroll
        for (unsigned j = 0; j < 16; ++j) { const unsigned c = xb_ld(&bar[XB_XCNT(j)]); sum += c; cnt += (c > 0u) ? 1u : 0u; mine = (j == x) ? c : mine; }
        if (sum == G) break;
        __builtin_amdgcn_s_sleep(1);
        if ((++sp & 255u) == 0u) { if (xb_ld(&bar[XB_TMO])) break; if (sp > XB_SPIN_CAP) { atomicAdd(&bar[XB_TMO], 1u); break; } }
    }
    nloc = mine > 0u ? mine : 1u; nx = cnt > 0u ? cnt : 1u;
}

__device__ __forceinline__ void xcd_barrier(const XcdBarrier& b) {
    asm volatile("s_waitcnt vmcnt(0)" ::: "memory");
    __syncthreads();
    if (threadIdx.x == 0) {
        unsigned* bar = b.bar;
        __builtin_amdgcn_s_waitcnt(0);
        unsigned nloc = b.st[0], nx = b.st[1];
        if (nloc == 0u) { xcd_barrier_complete(bar, b.x, nloc, nx); b.st[0] = nloc; b.st[1] = nx; }
        const unsigned old = xb_add(&bar[XB_XSUB(b.x)], 1u);
        const unsigned gen = old / nloc;
        if (old + 1u == (gen + 1u) * nloc) {
            __builtin_amdgcn_fence(__ATOMIC_RELEASE, "agent");
            asm volatile("s_waitcnt vmcnt(0)" ::: "memory");
            const unsigned og = xb_add(&bar[XB_TOP], 1u);
            const unsigned tg = og / nx;
            if (og + 1u == (tg + 1u) * nx) xb_add(&bar[XB_TOPGEN], 1u);
            else XB_SPIN(xb_ld(&bar[XB_TOPGEN]) == tg, bar);
            __builtin_amdgcn_fence(__ATOMIC_ACQUIRE, "agent");
            xb_add(&bar[XB_XGEN(b.x)], 1u);
            asm volatile("s_waitcnt vmcnt(0)" ::: "memory");
        } else {
            XB_SPIN(xb_ld(&bar[XB_XGEN(b.x)]) == gen, bar);
            __builtin_amdgcn_fence(__ATOMIC_ACQUIRE, "agent");
            asm volatile("s_waitcnt vmcnt(0)" ::: "memory");
        }
    }
    __syncthreads();
}


struct Args { const float* in[17]; float* out; unsigned char* ws; int ph_lo, ph_hi, li, pad; };

__device__ __forceinline__ void p0_transpose_item(const float* W, int K, int N, bf16_t* WT, LAS float* scr, int item, int lane) {
    const int nblk = N / 32, kb = item / nblk, nb = item % nblk, k0 = 64 * kb, n0 = 32 * nb;
#pragma unroll 8
    for (int i = 0; i < 32; ++i) { const int kk = 2 * i + (lane >> 5); scr[kk * 33 + (lane & 31)] = W[(size_t)(k0 + kk) * N + n0 + (lane & 31)]; }
    LDS_WAIT(); asm volatile("" ::: "memory");
    const int c = lane & 7;
#pragma unroll
    for (int j = 0; j < 4; ++j) { const int n = (lane >> 3) + 8 * j; const LAS float* s = scr + (8 * c) * 33 + n;
        u32x4 o; o.x = pk2(s[0 * 33], s[1 * 33]); o.y = pk2(s[2 * 33], s[3 * 33]); o.z = pk2(s[4 * 33], s[5 * 33]); o.w = pk2(s[6 * 33], s[7 * 33]);
        *(GAS u32x4*)(WT + (size_t)(n0 + n) * K + k0 + 8 * c) = o; }
    LDS_WAIT(); asm volatile("" ::: "memory");
}
__device__ __forceinline__ void phase_prologue(const Args& A, LAS unsigned char* lds, int gw, int NGW, int lane, int wave) {
    unsigned char* ws = A.ws;
    LAS float* scr = (LAS float*)(lds + wave * 16384);
    constexpr int I_IN = (DM / 64) * (INW / 32), I_BS = (SBW / 64) * (DM / 32), I_WO = (DM / 64) * (DM / 32), I_RW = (DM / 64) * (NEXP / 32);
    constexpr int I_UP1 = (DM / 64) * (UPW / 32), I_DN1 = (DFF / 64) * (DM / 32), I_UP = NEXP * I_UP1, I_DN = NEXP * I_DN1;
    constexpr int NITEMS = I_IN + 2 * I_BS + I_WO + I_RW + I_UP + I_DN;
    for (int it = gw; it < NITEMS; it += NGW) {
        int r = it;
        if (r < I_IN) { p0_transpose_item(A.in[1], DM, INW, (bf16_t*)(ws + WS_WINT), scr, r, lane); continue; } r -= I_IN;
        if (r < I_BS) { p0_transpose_item(A.in[4], SBW, DM, (bf16_t*)(ws + WS_WBST), scr, r, lane); continue; } r -= I_BS;
        if (r < I_BS) { p0_transpose_item(A.in[5], HGW, DM, (bf16_t*)(ws + WS_WBHT), scr, r, lane); continue; } r -= I_BS;
        if (r < I_WO) { p0_transpose_item(A.in[6], DM, DM, (bf16_t*)(ws + WS_WOT), scr, r, lane); continue; } r -= I_WO;
        if (r < I_RW) { p0_transpose_item(A.in[9], DM, NEXP, (bf16_t*)(ws + WS_RWT), scr, r, lane); continue; } r -= I_RW;
        if (r < I_UP) { const int e = r / I_UP1; p0_transpose_item(A.in[11] + (size_t)e * DM * UPW, DM, UPW, (bf16_t*)(ws + WS_WUPT) + (size_t)e * DM * UPW, scr, r % I_UP1, lane); continue; } r -= I_UP;
        { const int e = r / I_DN1; p0_transpose_item(A.in[13] + (size_t)e * DFF * DM, DFF, DM, (bf16_t*)(ws + WS_WDNT) + (size_t)e * DFF * DM, scr, r % I_DN1, lane); }
    }
    bf16_t* XB = (bf16_t*)(ws + WS_XB);
    for (int m = gw; m < NTOK; m += NGW) {
        const GAS f32x4* xr = (const GAS f32x4*)(A.in[0] + (size_t)m * DM) + lane; GAS u32x2* o8 = (GAS u32x2*)(XB + (size_t)m * DM) + lane;
#pragma unroll
        for (int j = 0; j < 4; ++j) { const f32x4 v = xr[64 * j]; u32x2 w; w.x = pk2(v[0], v[1]); w.y = pk2(v[2], v[3]); o8[64 * j] = w; }
    }
    if (gw < 8) { const int c = gw * 64 + lane; const float l0 = A.in[2][c], l1 = A.in[2][HGW + c]; ((float*)(ws + WS_LB))[c] = 1.0f / (1.0f + expf(l1 - l0)); }
}

__device__ __forceinline__ void attn_naive_unit(const bf16_t* __restrict__ Q, const bf16_t* __restrict__ K, const bf16_t* __restrict__ V, bf16_t* __restrict__ O, int bh, int qb, int lane) {
    const int b = bh >> 3, h = bh & 7, t = qb * 64 + lane; const size_t rowbase = (size_t)b * SEQ;
    float q[64], o[64];
    { const bf16_t* qp = Q + (rowbase + t) * SBW + h * SBD;
#pragma unroll
      for (int d = 0; d < 64; ++d) { q[d] = bf2f(qp[d]); o[d] = 0.f; } }
    float R = 1.0f;
    for (int s = qb * 64 + 63; s >= 0; --s) {
        const bf16_t* kr = K + (rowbase + s) * SBW + h * SBD; const bf16_t* vr = V + (rowbase + s) * SBW + h * SBD;
        float z = 0.f;
#pragma unroll
        for (int d = 0; d < 64; ++d) z += q[d] * bf2f(kr[d]);
        const bool valid = s < t;
        const float ez = expf(fminf(z, 60.0f)), keep = 1.0f / (1.0f + ez);
        const float a = valid ? ez * keep * R : 0.f;
        R = valid ? R * keep : R;
#pragma unroll
        for (int d = 0; d < 64; ++d) o[d] += a * bf2f(vr[d]);
    }
    bf16_t* op = O + (rowbase + t) * SBW + h * SBD;
#pragma unroll
    for (int d = 0; d < 64; ++d) op[d] = (bf16_t)f2bf(o[d]);
}
__device__ __forceinline__ void hgrn_naive_block(const bf16_t* __restrict__ HQ, const bf16_t* __restrict__ HK, const float* __restrict__ LOGF, const bf16_t* __restrict__ HV, float* __restrict__ ORAW,
                                                 LAS unsigned char* lds, int blk, int tid) {
    const int grp = tid >> 7, v = tid & 127, bh = blk * 4 + grp, b = bh >> 2, hh = bh & 3;
    LAS float* sf = (LAS float*)lds + grp * 384; LAS float* sk = sf + 128; LAS float* sq = sf + 256;
    float S[128];
#pragma unroll
    for (int k = 0; k < 128; ++k) S[k] = 0.f;
    for (int t = 0; t < SEQ; ++t) {
        const size_t base = ((size_t)b * SEQ + t) * HGW + hh * HGD;
        sf[v] = expf(LOGF[base + v]); sk[v] = bf2f(HK[base + v]); sq[v] = bf2f(HQ[base + v]);
        const float vv = bf2f(HV[base + v]);
        __syncthreads();
        float o = 0.f;
#pragma unroll
        for (int k = 0; k < 128; ++k) { S[k] = sf[k] * S[k] + sk[k] * vv; o += sq[k] * S[k]; }
        ORAW[base + v] = o;
        __syncthreads();
    }
}
__device__ __forceinline__ void hgrn_post_item(const float* __restrict__ ORAW, const bf16_t* __restrict__ HG, const float* __restrict__ norm_g, bf16_t* __restrict__ OHG, int item, int lane) {
    const size_t base = (size_t)item * HGD; const int c0 = (item & 3) * HGD;
    const float x0 = ORAW[base + lane], x1 = ORAW[base + 64 + lane];
    const float r = 1.0f / sqrtf(wave_sum(x0 * x0 + x1 * x1) * (1.0f / HGD) + RMS_EPS);
    OHG[base + lane] = (bf16_t)f2bf(x0 * r * norm_g[c0 + lane] * bf2f(HG[base + lane]));
    OHG[base + 64 + lane] = (bf16_t)f2bf(x1 * r * norm_g[c0 + 64 + lane] * bf2f(HG[base + 64 + lane]));
}

constexpr int TROW = 2064;
constexpr int L_TILE = 0, L_LOGITS = 64 * TROW, L_TOPI = L_LOGITS + 64 * 32 * 4, L_HIST = L_TOPI + 1024, L_SLOT = L_HIST + 128, L_TOT = L_SLOT + 1024, L_BEF = L_TOT + 128, L_PAD = L_BEF + 128, L_PART = L_PAD + 256, L_END5 = L_PART + 2 * 16 * 32 * 4;
static_assert(L_END5 <= LDS_SCRATCH, "P5/P6 LDS map");
__device__ __forceinline__ void phase_ln1_router(const Args& A, LAS unsigned char* lds, int vb, int tid, int lane, int wave) {
    unsigned char* ws = A.ws;
    const float* PRE = (const float*)(ws + WS_PRE); float* H = (float*)(ws + WS_H); const float* g = A.in[7]; const float* bta = A.in[8];
    LAS int* HIST = (LAS int*)(lds + L_HIST);
    if (tid < NEXP) HIST[tid] = 0;
    for (int rr = 0; rr < 8; ++rr) {
        const int rl = wave * 8 + rr, row = vb * 64 + rl;
        f32x4 v[4]; float s = 0.f;
#pragma unroll
        for (int j = 0; j < 4; ++j) { v[j] = *(const f32x4*)(PRE + (size_t)row * DM + lane * 4 + 256 * j); s += (v[j][0] + v[j][1]) + (v[j][2] + v[j][3]); }
        const float mean = wave_sum(s) * (1.0f / DM); float s2 = 0.f;
#pragma unroll
        for (int j = 0; j < 4; ++j) { v[j] = v[j] - mean; s2 += (v[j][0] * v[j][0] + v[j][1] * v[j][1]) + (v[j][2] * v[j][2] + v[j][3] * v[j][3]); }
        const float rstd = 1.0f / sqrtf(wave_sum(s2) * (1.0f / DM) + LN_EPS);
#pragma unroll
        for (int j = 0; j < 4; ++j) { const int c = lane * 4 + 256 * j; const f32x4 hv = v[j] * rstd * *(const f32x4*)(g + c) + *(const f32x4*)(bta + c);
            *(f32x4*)(H + (size_t)row * DM + c) = hv;
            u32x2 w; w.x = pk2(hv[0], hv[1]); w.y = pk2(hv[2], hv[3]); *(LAS u32x2*)(lds + L_TILE + rl * TROW + c * 2) = w; }
    }
    __syncthreads();
    {
        const int rt = wave & 1, kq = wave >> 1, r = lane & 31, hh = lane >> 5;
        const bf16_t* RWT = (const bf16_t*)(ws + WS_RWT);
        f32x16 acc = {};
#pragma unroll 4
        for (int ks = 0; ks < 16; ++ks) {
            const int k = 256 * kq + 16 * ks + 8 * hh;
            const bf16x8 af = *(const LAS bf16x8*)(lds + L_TILE + (32 * rt + r) * TROW + k * 2);
            const bf16x8 bf = *(const bf16x8*)(RWT + (size_t)r * DM + k);
            acc = __builtin_amdgcn_mfma_f32_32x32x16_bf16(af, bf, acc, 0, 0, 0);
        }
        LAS float* LG = (LAS float*)(lds + L_LOGITS);
        for (int q = 0; q < 4; ++q) {
            if (kq == q) {
#pragma unroll
                for (int i = 0; i < 16; ++i) { const int rowl = 32 * rt + (i & 3) + 8 * (i >> 2) + 4 * hh; LAS float* p = LG + rowl * 32 + r; if (q == 0) *p = acc[i]; else *p += acc[i]; }
            }
            __syncthreads();
        }
    }
    {
        const float* rb = A.in[10]; float* TOPG = (float*)(ws + WS_TOPG); LAS int* TOPI = (LAS int*)(lds + L_TOPI); const LAS float* LG = (const LAS float*)(lds + L_LOGITS);
        const int e = lane & 31, half = lane >> 5;
        for (int it = 0; it < 4; ++it) {
            const int rl = wave * 8 + it * 2 + half;
            float val = LG[rl * 32 + e] + rb[e]; int idx = e; float tv[4]; int ti[4];
#pragma unroll
            for (int rnk = 0; rnk < 4; ++rnk) {
                float bv = val; int bi = idx;
#pragma unroll
                for (int off = 16; off >= 1; off >>= 1) { const float ov = __shfl_xor(bv, off); const int oi = __shfl_xor(bi, off); if (ov > bv || (ov == bv && oi < bi)) { bv = ov; bi = oi; } }
                tv[rnk] = bv; ti[rnk] = bi; if (e == bi) val = -INFINITY;
            }
            if (e == 0) {
                const float e1 = expf(tv[1] - tv[0]), e2 = expf(tv[2] - tv[0]), e3 = expf(tv[3] - tv[0]), inv = 1.0f / (1.0f + e1 + e2 + e3);
                *(float4*)(TOPG + (size_t)(vb * 64 + rl) * 4) = make_float4(inv, e1 * inv, e2 * inv, e3 * inv);
#pragma unroll
                for (int k = 0; k < 4; ++k) { TOPI[rl * 4 + k] = ti[k]; __hip_atomic_fetch_add(&HIST[ti[k]], 1, __ATOMIC_RELAXED, __HIP_MEMORY_SCOPE_WORKGROUP); }
            }
        }
    }
    __syncthreads();
    if (tid < NEXP) ((int*)(ws + WS_CNTM))[vb * NEXP + tid] = HIST[tid];
}
__device__ __forceinline__ void phase_assign(const Args& A, LAS unsigned char* lds, int vb, int G, int tid, int lane, int wave) {
    unsigned char* ws = A.ws; const int* CNTM = (const int*)(ws + WS_CNTM); int* ctl = (int*)(ws + WS_CTL);
    LAS int* PART = (LAS int*)(lds + L_PART); LAS int* TOT = (LAS int*)(lds + L_TOT); LAS int* BEF = (LAS int*)(lds + L_BEF); LAS int* PAD = (LAS int*)(lds + L_PAD);
    LAS int* TOPI = (LAS int*)(lds + L_TOPI); LAS int* SLOT = (LAS int*)(lds + L_SLOT);
    { const int e = tid & 31, part = tid >> 5; int tot = 0, bef = 0;
      for (int b2 = part * 16; b2 < part * 16 + 16; ++b2) { const int c = (b2 < G) ? CNTM[b2 * NEXP + e] : 0; tot += c; if (b2 < vb) bef += c; }
      PART[part * 32 + e] = tot; PART[512 + part * 32 + e] = bef; }
    __syncthreads();
    if (tid < NEXP) { int tot = 0, bef = 0;
#pragma unroll
        for (int p = 0; p < 16; ++p) { tot += PART[p * 32 + tid]; bef += PART[512 + p * 32 + tid]; }
        TOT[tid] = tot; BEF[tid] = bef; }
    __syncthreads();
    if (tid == 0) { int ps = 0, nt = 0;
        for (int e = 0; e < NEXP; ++e) { PAD[e] = ps; const int te = (TOT[e] + SLOT_PAD - 1) / SLOT_PAD; if (vb == 0) for (int i = 0; i < te; ++i) ctl[CW_TILEEXP + nt + i] = e; nt += te; ps += te * SLOT_PAD; }
        if (vb == 0) ctl[CW_NTILES] = nt; }
    __syncthreads();
    if (tid < 256) { const int e = TOPI[tid]; int rank = 0; for (int j = 0; j < tid; ++j) rank += (TOPI[j] == e) ? 1 : 0;
        const int slot = PAD[e] + BEF[e] + rank; SLOT[tid] = slot; ((int*)(ws + WS_DEST))[vb * 256 + tid] = slot; }
    __syncthreads();
    bf16_t* XS = (bf16_t*)(ws + WS_XS);
    for (int i = wave * 32; i < wave * 32 + 32; ++i) {
        const int slot = SLOT[i]; const LAS unsigned char* src = lds + L_TILE + (i >> 2) * TROW; unsigned char* dst = (unsigned char*)(XS + (size_t)slot * DM);
        const u32x4 a = *(const LAS u32x4*)(src + lane * 16), b = *(const LAS u32x4*)(src + 1024 + lane * 16);
        *(u32x4*)(dst + lane * 16) = a; *(u32x4*)(dst + 1024 + lane * 16) = b;
    }
}
__device__ __forceinline__ void combine_row(const Args& A, int row, int lane) {
    unsigned char* ws = A.ws; const float* H = (const float*)(ws + WS_H); const bf16_t* Y = (const bf16_t*)(ws + WS_Y);
    const int4 d = *(const int4*)((const int*)(ws + WS_DEST) + row * 4); const float4 gt = *(const float4*)((const float*)(ws + WS_TOPG) + row * 4);
    const int ds[4] = {d.x, d.y, d.z, d.w}; const float gs[4] = {gt.x, gt.y, gt.z, gt.w};
    f32x4 v[4]; float s = 0.f;
#pragma unroll
    for (int j = 0; j < 4; ++j) { const int c = lane * 4 + 256 * j; f32x4 a = *(const f32x4*)(H + (size_t)row * DM + c) * DN_ALPHA;
#pragma unroll
        for (int k = 0; k < 4; ++k) { const u32x2 y = *(const u32x2*)(Y + (size_t)ds[k] * DM + c);
            a[0] += gs[k] * bflo(y.x); a[1] += gs[k] * bfhi(y.x); a[2] += gs[k] * bflo(y.y); a[3] += gs[k] * bfhi(y.y); }
        v[j] = a; s += (a[0] + a[1]) + (a[2] + a[3]); }
    const float mean = wave_sum(s) * (1.0f / DM); float s2 = 0.f;
#pragma unroll
    for (int j = 0; j < 4; ++j) { v[j] = v[j] - mean; s2 += (v[j][0] * v[j][0] + v[j][1] * v[j][1]) + (v[j][2] * v[j][2] + v[j][3] * v[j][3]); }
    const float rstd = 1.0f / sqrtf(wave_sum(s2) * (1.0f / DM) + LN_EPS);
#pragma unroll
    for (int j = 0; j < 4; ++j) { const int c = lane * 4 + 256 * j; *(f32x4*)(A.out + (size_t)row * DM + c) = v[j] * rstd * *(const f32x4*)(A.in[15] + c) + *(const f32x4*)(A.in[16] + c); }
}

template <int LO, int HI> __global__ void __launch_bounds__(NTHREADS, 2) mk_fwd(Args args) {
    extern __shared__ __attribute__((aligned(16))) unsigned char lds_raw[];
    LAS unsigned char* lds = (LAS unsigned char*)lds_raw;
    volatile LAS unsigned* MISC = (volatile LAS unsigned*)(lds + MISC_OFF);
    const int tid = threadIdx.x, lane = tid & 63, wave = __builtin_amdgcn_readfirstlane(tid >> 6);
    const int G = gridDim.x, bx = blockIdx.x, vcu = (G % 8 == 0) ? (bx % 8) * (G / 8) + bx / 8 : bx;
    const int gw = vcu * NWAVES + wave, NGW = G * NWAVES;
    unsigned char* ws = args.ws;
    for (int u = tid; u < (LDS_BYTES - LDSCTL_OFF) / 4; u += NTHREADS) ((LAS unsigned*)(lds + LDSCTL_OFF))[u] = 0u;
    __syncthreads();
    XcdBarrier bar = xcd_barrier_post((unsigned*)(ws + WS_CTL) + CW_BAR + args.li * XCD_BAR_WORDS, MISC + 8);
#define IN(k) (LO <= (k) && (k) < HI)
#define SEAM(k) do { if constexpr (IN(k) && IN((k) + 1)) xcd_barrier(bar); } while (0)
    InProjOut ip; ip.Q = (bf16_t*)(ws + WS_Q); ip.K = (bf16_t*)(ws + WS_K); ip.V = (bf16_t*)(ws + WS_V); ip.HQ = (bf16_t*)(ws + WS_HQ); ip.HK = (bf16_t*)(ws + WS_HK); ip.HV = (bf16_t*)(ws + WS_HV);
    ip.HG = (bf16_t*)(ws + WS_HG); ip.GS = (bf16_t*)(ws + WS_GS); ip.GH = (bf16_t*)(ws + WS_GH); ip.LOGF = (float*)(ws + WS_LOGF); ip.lb = (const float*)(ws + WS_LB);

    if constexpr (IN(0)) phase_prologue(args, lds, gw, NGW, lane, wave);
    SEAM(0);
    if constexpr (IN(1)) { pg8::Gemm g{DM}; pg8::DenseSched S; S.o.init(NTOK / 256, INW / 256, G, bx); S.A = (const char*)(ws + WS_XB); S.Bt = (const char*)(ws + WS_WINT); S.tstep = (size_t)256 * DM * 2;
      pg8::EpiInProj E{ip};
      pg8::gemm_phase<pg8::EpiInProj, pg8::DenseSched, MK_P1_ALIGN, MK_P1_SP2>(lds, g, S, E); }
    SEAM(1);
    if constexpr (IN(2)) {
    { const int u = gw; if (u < 2048) attn_naive_unit(ip.Q, ip.K, ip.V, (bf16_t*)(ws + WS_OSB), u & 63, 31 - (u >> 6), lane); }
    __syncthreads();
    if (vcu < 8) hgrn_naive_block(ip.HQ, ip.HK, ip.LOGF, ip.HV, (float*)(ws + WS_ORAW), lds, vcu, tid);
    }
    SEAM(2);
    if constexpr (IN(3)) for (int it = gw; it < NTOK * HGH; it += NGW) hgrn_post_item((const float*)(ws + WS_ORAW), ip.HG, args.in[3], (bf16_t*)(ws + WS_OHG), it, lane);
    SEAM(3);
    if constexpr (IN(4)) { pg8::Gemm g{SBW}; pg8::BranchSched S; S.o.init(NTOK / 256, DM / 256, G, bx); S.A0 = (const char*)(ws + WS_OSB); S.B0 = (const char*)(ws + WS_WBST); S.A1 = (const char*)(ws + WS_OHG); S.B1 = (const char*)(ws + WS_WBHT); S.tstep = (size_t)256 * SBW * 2;
      pg8::EpiBranch E{ip.GS, ip.GH, (bf16_t*)(ws + WS_MERGED)};
      pg8::gemm_phase<pg8::EpiBranch, pg8::BranchSched, true, true>(lds, g, S, E); }
    SEAM(4);
    if constexpr (IN(5)) { pg8::Gemm g{DM}; pg8::DenseSched S; S.o.init(NTOK / 256, DM / 256, G, bx); S.A = (const char*)(ws + WS_MERGED); S.Bt = (const char*)(ws + WS_WOT); S.tstep = (size_t)256 * DM * 2;
      pg8::EpiOut E{args.in[0], (float*)(ws + WS_PRE)};
      pg8::gemm_phase<pg8::EpiOut, pg8::DenseSched, true, true>(lds, g, S, E); }
    SEAM(5);
    if constexpr (IN(6)) phase_ln1_router(args, lds, bx, tid, lane, wave);
    SEAM(6);
    if constexpr (IN(7)) phase_assign(args, lds, bx, G, tid, lane, wave);
    SEAM(7);
    int ntiles = 0; if constexpr (IN(8) || IN(9)) ntiles = __builtin_amdgcn_readfirstlane(__hip_atomic_load((const int*)(ws + WS_CTL) + CW_NTILES, __ATOMIC_RELAXED, __HIP_MEMORY_SCOPE_AGENT)); const int* tile_exp = (const int*)(ws + WS_CTL) + CW_TILEEXP;
    if constexpr (IN(8)) { pg8::Gemm g{DM}; pg8::MoeSched S; S.o.init(ntiles, UPW / 256, G, bx); S.A = (const char*)(ws + WS_XS); S.W = (const char*)(ws + WS_WUPT); S.tile_exp = tile_exp; S.tstep = (size_t)256 * DM * 2; S.estep = (size_t)UPW * DM * 2;
      pg8::EpiUp E{args.in[12], (bf16_t*)(ws + WS_ACT)};
      pg8::gemm_phase<pg8::EpiUp, pg8::MoeSched, true, true>(lds, g, S, E); }
    SEAM(8);
    if constexpr (IN(9)) { pg8::Gemm g{DFF}; pg8::MoeSched S; S.o.init(ntiles, DM / 256, G, bx); S.A = (const char*)(ws + WS_ACT); S.W = (const char*)(ws + WS_WDNT); S.tile_exp = tile_exp; S.tstep = (size_t)256 * DFF * 2; S.estep = (size_t)DM * DFF * 2;
      pg8::EpiDown E{args.in[14], (bf16_t*)(ws + WS_Y)};
      pg8::gemm_phase<pg8::EpiDown, pg8::MoeSched, true, true>(lds, g, S, E); }
    SEAM(9);
    if constexpr (IN(10)) for (int row = gw; row < NTOK; row += NGW) combine_row(args, row, lane);
}


namespace v1 {
constexpr int CW_CNT = 60000, CW_CUR = 60064, CW_PADSTART = 60128, CW_NTILES = 60192, CW_TILEEXP = 60256;
__device__ __forceinline__ float sigmoidf_(float v) { return 1.0f / (1.0f + expf(-v)); }
__global__ __launch_bounds__(256) void k_transpose_bf16(const float* __restrict__ W, bf16_t* __restrict__ WT, int K, int N) {
    __shared__ float tile[64][65];
    const size_t g = blockIdx.z; W += g * (size_t)K * N; WT += g * (size_t)K * N;
    const int k0 = blockIdx.y * 64, n0 = blockIdx.x * 64, tx = threadIdx.x & 63, ty = threadIdx.x >> 6;
    for (int i = ty; i < 64; i += 4) tile[i][tx] = W[(size_t)(k0 + i) * N + n0 + tx];
    __syncthreads();
    for (int i = ty; i < 64; i += 4) WT[(size_t)(n0 + i) * K + k0 + tx] = (bf16_t)f2bf(tile[tx][i]);
}
__global__ __launch_bounds__(256) void k_convert_x(const float* __restrict__ x, bf16_t* __restrict__ xb, const float* __restrict__ lbl, float* __restrict__ lb) {
    const size_t i = (size_t)blockIdx.x * 256 + threadIdx.x;
    const f32x4 v = ((const f32x4*)x)[i];
    uint2 o; o.x = f2bf(v[0]) | (f2bf(v[1]) << 16); o.y = f2bf(v[2]) | (f2bf(v[3]) << 16);
    ((uint2*)xb)[i] = o;
    if (blockIdx.x == 0) for (int c = threadIdx.x; c < HGW; c += 256) { const float l0 = lbl[c], l1 = lbl[HGW + c]; lb[c] = 1.0f / (1.0f + expf(l1 - l0)); }
}

constexpr int G_BM = 128, G_BK = 32, G_HTB = G_BM * G_BK * 2;
__device__ __forceinline__ void g128_loop(f32x4 (&acc)[4][4], const bf16_t* a0, const bf16_t* a1, const bf16_t* b0, const bf16_t* b1, int K, LAS unsigned char* shm) {
    const int tid = threadIdx.x, wid = tid >> 6, lane = tid & 63, wr = wid >> 1, wc = wid & 1, fr = lane & 15, fq = lane >> 4;
    LAS unsigned char* SA = shm; LAS unsigned char* SB = shm + G_HTB;
    for (int t = 0; t < K / G_BK; ++t) {
        __builtin_amdgcn_global_load_lds((const unsigned*)(a0 + t * G_BK), (LAS unsigned*)(SA + tid * 16), 16, 0, 0);
        __builtin_amdgcn_global_load_lds((const unsigned*)(a1 + t * G_BK), (LAS unsigned*)(SA + tid * 16 + 4096), 16, 0, 0);
        __builtin_amdgcn_global_load_lds((const unsigned*)(b0 + t * G_BK), (LAS unsigned*)(SB + tid * 16), 16, 0, 0);
        __builtin_amdgcn_global_load_lds((const unsigned*)(b1 + t * G_BK), (LAS unsigned*)(SB + tid * 16 + 4096), 16, 0, 0);
        asm volatile("s_waitcnt vmcnt(0)" ::: "memory"); __syncthreads();
        bf16x8 At[4], Bt[4];
#pragma unroll
        for (int m = 0; m < 4; ++m) { At[m] = *(const LAS bf16x8*)(SA + (wr * 64 + m * 16 + fr) * (G_BK * 2) + fq * 16); Bt[m] = *(const LAS bf16x8*)(SB + (wc * 64 + m * 16 + fr) * (G_BK * 2) + fq * 16); }
        asm volatile("s_waitcnt lgkmcnt(0)" ::: "memory"); __builtin_amdgcn_sched_barrier(0);
#pragma unroll
        for (int m = 0; m < 4; ++m)
#pragma unroll
            for (int n = 0; n < 4; ++n) acc[m][n] = __builtin_amdgcn_mfma_f32_16x16x32_bf16(At[m], Bt[n], acc[m][n], 0, 0, 0);
        __syncthreads();
    }
}
#define G128_ZERO(acc) _Pragma("unroll") for (int m_ = 0; m_ < 4; ++m_) _Pragma("unroll") for (int n_ = 0; n_ < 4; ++n_) acc[m_][n_] = (f32x4){0.f, 0.f, 0.f, 0.f}
#define G128_FOREACH(...) do { const int wid_ = threadIdx.x >> 6, lane_ = threadIdx.x & 63, wr_ = wid_ >> 1, wc_ = wid_ & 1, fr_ = lane_ & 15, fq_ = lane_ >> 4; \
    _Pragma("unroll") for (int m_ = 0; m_ < 4; ++m_) _Pragma("unroll") for (int n_ = 0; n_ < 4; ++n_) _Pragma("unroll") for (int j_ = 0; j_ < 4; ++j_) { \
        const int trow = wr_ * 64 + m_ * 16 + fq_ * 4 + j_, tcol = wc_ * 64 + n_ * 16 + fr_; __VA_ARGS__ } } while (0)


__global__ __launch_bounds__(256) void k_inproj(const bf16_t* __restrict__ XB, const bf16_t* __restrict__ WinT, InProjOut o) {
    __shared__ __attribute__((aligned(16))) unsigned char shm[2 * G_HTB];
    const int bcol = blockIdx.x * G_BM, brow = blockIdx.y * G_BM, tid = threadIdx.x, r0 = tid >> 2, c = (tid & 3) * 8;
    f32x4 acc[4][4]; G128_ZERO(acc);
    g128_loop(acc, XB + (size_t)(brow + r0) * DM + c, XB + (size_t)(brow + r0 + 64) * DM + c, WinT + (size_t)(bcol + r0) * DM + c, WinT + (size_t)(bcol + r0 + 64) * DM + c, DM, (LAS unsigned char*)shm);
    const int seg = bcol / 512;
    G128_FOREACH({
        const int row = brow + trow, col = bcol + tcol; const float v = acc[m_][n_][j_];
        if (seg == 0) o.Q[(size_t)row * 512 + col] = (bf16_t)f2bf(v * 0.125f);
        else if (seg == 1) o.K[(size_t)row * 512 + (col - 512)] = (bf16_t)f2bf(v);
        else if (seg == 2) o.V[(size_t)row * 512 + (col - 1024)] = (bf16_t)f2bf(v);
        else if (seg == 3) o.HQ[(size_t)row * 512 + (col - 1536)] = (bf16_t)f2bf(v * sigmoidf_(v));
        else if (seg == 4) { const int cc = col - 2048; const float l = o.lb[cc], f = l + (1.0f - l) * sigmoidf_(v);
            o.HK[(size_t)row * 512 + cc] = (bf16_t)f2bf(1.0f - f); o.LOGF[(size_t)row * 512 + cc] = logf(f); }
        else if (seg == 5) o.HV[(size_t)row * 512 + (col - 2560)] = (bf16_t)f2bf(v);
        else if (seg == 6) o.HG[(size_t)row * 512 + (col - 3072)] = (bf16_t)f2bf(sigmoidf_(v));
        else if (seg < 9) o.GS[(size_t)row * 1024 + (col - 3584)] = (bf16_t)f2bf(sigmoidf_(v));
        else o.GH[(size_t)row * 1024 + (col - 4608)] = (bf16_t)f2bf(sigmoidf_(v));
    });
}

__global__ __launch_bounds__(256) void k_branch(const bf16_t* __restrict__ OSB, const bf16_t* __restrict__ OHG, const bf16_t* __restrict__ WbsT, const bf16_t* __restrict__ WbhT,
                                                const bf16_t* __restrict__ GS, const bf16_t* __restrict__ GH, bf16_t* __restrict__ MERGED) {
    __shared__ __attribute__((aligned(16))) unsigned char shm[2 * G_HTB];
    const int bcol = blockIdx.x * G_BM, brow = blockIdx.y * G_BM, tid = threadIdx.x, r0 = tid >> 2, c = (tid & 3) * 8;
    f32x4 accA[4][4], accB[4][4]; G128_ZERO(accA); G128_ZERO(accB);
    g128_loop(accA, OSB + (size_t)(brow + r0) * SBW + c, OSB + (size_t)(brow + r0 + 64) * SBW + c, WbsT + (size_t)(bcol + r0) * SBW + c, WbsT + (size_t)(bcol + r0 + 64) * SBW + c, SBW, (LAS unsigned char*)shm);
    g128_loop(accB, OHG + (size_t)(brow + r0) * HGW + c, OHG + (size_t)(brow + r0 + 64) * HGW + c, WbhT + (size_t)(bcol + r0) * HGW + c, WbhT + (size_t)(bcol + r0 + 64) * HGW + c, HGW, (LAS unsigned char*)shm);
    G128_FOREACH({
        const size_t idx = (size_t)(brow + trow) * DM + bcol + tcol;
        MERGED[idx] = (bf16_t)f2bf(bf2f(GS[idx]) * accA[m_][n_][j_] + bf2f(GH[idx]) * accB[m_][n_][j_]);
    });
}

__global__ __launch_bounds__(256) void k_outproj(const bf16_t* __restrict__ MERGED, const bf16_t* __restrict__ WoT, const float* __restrict__ x, float* __restrict__ PRE) {
    __shared__ __attribute__((aligned(16))) unsigned char shm[2 * G_HTB];
    const int bcol = blockIdx.x * G_BM, brow = blockIdx.y * G_BM, tid = threadIdx.x, r0 = tid >> 2, c = (tid & 3) * 8;
    f32x4 acc[4][4]; G128_ZERO(acc);
    g128_loop(acc, MERGED + (size_t)(brow + r0) * DM + c, MERGED + (size_t)(brow + r0 + 64) * DM + c, WoT + (size_t)(bcol + r0) * DM + c, WoT + (size_t)(bcol + r0 + 64) * DM + c, DM, (LAS unsigned char*)shm);
    G128_FOREACH({ const size_t idx = (size_t)(brow + trow) * DM + bcol + tcol; PRE[idx] = DN_ALPHA * x[idx] + acc[m_][n_][j_]; });
}

__global__ __launch_bounds__(256) void k_moe_up(const bf16_t* __restrict__ HB, const bf16_t* __restrict__ WupT, const float* __restrict__ b_up, const int* __restrict__ ctl,
                                                const int* __restrict__ slot_tok, bf16_t* __restrict__ ACT) {
    __shared__ __attribute__((aligned(16))) unsigned char shm[2 * G_HTB];
    const int rt = blockIdx.y; if (rt >= 2 * ctl[CW_NTILES]) return;
    const int e = ctl[CW_TILEEXP + (rt >> 1)];
    const int bcol = blockIdx.x * G_BM, brow = rt * G_BM, tid = threadIdx.x, r0 = tid >> 2, c = (tid & 3) * 8;
    int t0 = slot_tok[brow + r0], t1 = slot_tok[brow + r0 + 64]; if (t0 < 0) t0 = 0; if (t1 < 0) t1 = 0;
    const bf16_t* W = WupT + (size_t)e * UPW * DM;
    f32x4 acc[4][4]; G128_ZERO(acc);
    g128_loop(acc, HB + (size_t)t0 * DM + c, HB + (size_t)t1 * DM + c, W + (size_t)(bcol + r0) * DM + c, W + (size_t)(bcol + r0 + 64) * DM + c, DM, (LAS unsigned char*)shm);
    G128_FOREACH({
        const int col = bcol + tcol; const float v = acc[m_][n_][j_] + b_up[e * UPW + col];
        const float other = __shfl_xor(v, 1);
        if ((col & 1) == 0) { const float g = fminf(v, SW_LIMIT), l = fminf(fmaxf(other, -SW_LIMIT), SW_LIMIT);
            ACT[(size_t)(brow + trow) * DFF + (col >> 1)] = (bf16_t)f2bf(g * sigmoidf_(SW_ALPHA * g) * (l + 1.0f)); }
    });
}
__global__ __launch_bounds__(256) void k_moe_down(const bf16_t* __restrict__ ACT, const bf16_t* __restrict__ WdnT, const float* __restrict__ b_dn, const int* __restrict__ ctl, bf16_t* __restrict__ Y) {
    __shared__ __attribute__((aligned(16))) unsigned char shm[2 * G_HTB];
    const int rt = blockIdx.y; if (rt >= 2 * ctl[CW_NTILES]) return;
    const int e = ctl[CW_TILEEXP + (rt >> 1)];
    const int bcol = blockIdx.x * G_BM, brow = rt * G_BM, tid = threadIdx.x, r0 = tid >> 2, c = (tid & 3) * 8;
    const bf16_t* W = WdnT + (size_t)e * DM * DFF;
    f32x4 acc[4][4]; G128_ZERO(acc);
    g128_loop(acc, ACT + (size_t)(brow + r0) * DFF + c, ACT + (size_t)(brow + r0 + 64) * DFF + c, W + (size_t)(bcol + r0) * DFF + c, W + (size_t)(bcol + r0 + 64) * DFF + c, DFF, (LAS unsigned char*)shm);
    G128_FOREACH({ const int col = bcol + tcol; Y[(size_t)(brow + trow) * DM + col] = (bf16_t)f2bf(acc[m_][n_][j_] + b_dn[e * DM + col]); });
}

__global__ __launch_bounds__(64) void k_attn_naive(const bf16_t* __restrict__ Q, const bf16_t* __restrict__ K, const bf16_t* __restrict__ V, bf16_t* __restrict__ O) {
    const int qb = 31 - (int)blockIdx.x, bh = blockIdx.y, b = bh >> 3, h = bh & 7;
    const int t = qb * 64 + threadIdx.x; const size_t rowbase = (size_t)b * SEQ;
    float q[64], o[64];
    { const bf16_t* qp = Q + (rowbase + t) * SBW + h * SBD;
#pragma unroll
      for (int d = 0; d < 64; ++d) { q[d] = bf2f(qp[d]); o[d] = 0.f; } }
    float R = 1.0f;
    for (int s = qb * 64 + 63; s >= 0; --s) {
        const bf16_t* kr = K + (rowbase + s) * SBW + h * SBD; const bf16_t* vr = V + (rowbase + s) * SBW + h * SBD;
        float z = 0.f;
#pragma unroll
        for (int d = 0; d < 64; ++d) z += q[d] * bf2f(kr[d]);
        const bool valid = s < t;
        const float ez = expf(fminf(z, 60.0f)), keep = 1.0f / (1.0f + ez);
        const float a = valid ? ez * keep * R : 0.f;
        R = valid ? R * keep : R;
#pragma unroll
        for (int d = 0; d < 64; ++d) o[d] += a * bf2f(vr[d]);
    }
    bf16_t* op = O + (rowbase + t) * SBW + h * SBD;
#pragma unroll
    for (int d = 0; d < 64; ++d) op[d] = (bf16_t)f2bf(o[d]);
}

__global__ __launch_bounds__(128) void k_hgrn_naive(const bf16_t* __restrict__ HQ, const bf16_t* __restrict__ HK, const float* __restrict__ LOGF, const bf16_t* __restrict__ HV, float* __restrict__ ORAW) {
    __shared__ __attribute__((aligned(16))) float sf[128], sk[128], sq[128];
    const int bh = blockIdx.x, b = bh >> 2, hh = bh & 3, v = threadIdx.x;
    float S[128];
#pragma unroll
    for (int k = 0; k < 128; ++k) S[k] = 0.f;
    for (int t = 0; t < SEQ; ++t) {
        const size_t base = ((size_t)b * SEQ + t) * HGW + hh * HGD;
        sf[v] = expf(LOGF[base + v]); sk[v] = bf2f(HK[base + v]); sq[v] = bf2f(HQ[base + v]);
        const float vv = bf2f(HV[base + v]);
        __syncthreads();
        float o = 0.f;
#pragma unroll
        for (int k = 0; k < 128; ++k) { S[k] = sf[k] * S[k] + sk[k] * vv; o += sq[k] * S[k]; }
        ORAW[base + v] = o;
        __syncthreads();
    }
}
__global__ __launch_bounds__(256) void k_hgrn_post(const float* __restrict__ ORAW, const bf16_t* __restrict__ HG, const float* __restrict__ norm_g, bf16_t* __restrict__ OHG) {
    const int gw = blockIdx.x * 4 + (threadIdx.x >> 6), lane = threadIdx.x & 63;
    const size_t base = (size_t)gw * HGD; const int c0 = (gw & 3) * HGD;
    const float x0 = ORAW[base + lane], x1 = ORAW[base + 64 + lane];
    const float r = 1.0f / sqrtf(wave_sum(x0 * x0 + x1 * x1) * (1.0f / HGD) + RMS_EPS);
    OHG[base + lane] = (bf16_t)f2bf(x0 * r * norm_g[c0 + lane] * bf2f(HG[base + lane]));
    OHG[base + 64 + lane] = (bf16_t)f2bf(x1 * r * norm_g[c0 + 64 + lane] * bf2f(HG[base + 64 + lane]));
}

__global__ __launch_bounds__(256) void k_ln1_router(const float* __restrict__ PRE, const float* __restrict__ g, const float* __restrict__ bta, const float* __restrict__ rw, const float* __restrict__ rb,
                                                    float* __restrict__ H, bf16_t* __restrict__ HB, int* __restrict__ TOPI, float* __restrict__ TOPG) {
    __shared__ __attribute__((aligned(16))) float hs[4][DM];
    const int w = threadIdx.x >> 6, lane = threadIdx.x & 63, row = blockIdx.x * 4 + w;
    f32x4 v[4]; float s = 0.f;
#pragma unroll
    for (int j = 0; j < 4; ++j) { v[j] = *(const f32x4*)(PRE + (size_t)row * DM + lane * 4 + 256 * j); s += (v[j][0] + v[j][1]) + (v[j][2] + v[j][3]); }
    const float mean = wave_sum(s) * (1.0f / DM); float s2 = 0.f;
#pragma unroll
    for (int j = 0; j < 4; ++j) { v[j] = v[j] - mean; s2 += (v[j][0] * v[j][0] + v[j][1] * v[j][1]) + (v[j][2] * v[j][2] + v[j][3] * v[j][3]); }
    const float rstd = 1.0f / sqrtf(wave_sum(s2) * (1.0f / DM) + LN_EPS);
#pragma unroll
    for (int j = 0; j < 4; ++j) { const int c = lane * 4 + 256 * j; const f32x4 gg = *(const f32x4*)(g + c), bb = *(const f32x4*)(bta + c);
        f32x4 hv = v[j] * rstd * gg + bb; *(f32x4*)(H + (size_t)row * DM + c) = hv; *(f32x4*)(&hs[w][c]) = hv;
        uint2 o; o.x = f2bf(hv[0]) | (f2bf(hv[1]) << 16); o.y = f2bf(hv[2]) | (f2bf(hv[3]) << 16); *(uint2*)(HB + (size_t)row * DM + c) = o; }
    __syncthreads();
    const int e = lane & 31, half = lane >> 5; float a = 0.f;
    for (int c = half * 512; c < half * 512 + 512; ++c) a += hs[w][c] * rw[c * NEXP + e];
    a += __shfl_xor(a, 32);
    float val = (lane < 32) ? a + rb[e] : -INFINITY; int idx = e;
    float tv[4]; int ti[4];
#pragma unroll
    for (int r = 0; r < 4; ++r) {
        float bv = val; int bi = idx;
#pragma unroll
        for (int off = 32; off >= 1; off >>= 1) { const float ov = __shfl_xor(bv, off); const int oi = __shfl_xor(bi, off); if (ov > bv || (ov == bv && oi < bi)) { bv = ov; bi = oi; } }
        tv[r] = bv; ti[r] = bi; if (lane < 32 && e == bi) val = -INFINITY;
    }
    if (lane == 0) { const float e1 = expf(tv[1] - tv[0]), e2 = expf(tv[2] - tv[0]), e3 = expf(tv[3] - tv[0]), inv = 1.0f / (1.0f + e1 + e2 + e3);
        *(int4*)(TOPI + row * 4) = make_int4(ti[0], ti[1], ti[2], ti[3]); *(float4*)(TOPG + row * 4) = make_float4(inv, e1 * inv, e2 * inv, e3 * inv); }
}

__global__ __launch_bounds__(256) void k_count(const int* __restrict__ TOPI, int* __restrict__ ctl, int* __restrict__ slot_tok) {
    __shared__ int hist[NEXP];
    if (threadIdx.x < NEXP) hist[threadIdx.x] = 0;
    __syncthreads();
    const int i = blockIdx.x * 256 + threadIdx.x;
    atomicAdd(&hist[TOPI[i]], 1);
    __syncthreads();
    if (threadIdx.x < NEXP) atomicAdd(&ctl[CW_CNT + threadIdx.x], hist[threadIdx.x]);
    for (int s = i; s < NSLOT_MAX; s += NASSIGN) slot_tok[s] = -1;
}
__global__ __launch_bounds__(64) void k_plan(int* __restrict__ ctl) {
    if (threadIdx.x == 0) { int ps = 0, nt = 0;
        for (int e = 0; e < NEXP; ++e) { ctl[CW_PADSTART + e] = ps; const int te = (ctl[CW_CNT + e] + SLOT_PAD - 1) / SLOT_PAD; for (int i = 0; i < te; ++i) ctl[CW_TILEEXP + nt++] = e; ps += te * SLOT_PAD; }
        ctl[CW_PADSTART + NEXP] = ps; ctl[CW_NTILES] = nt; }
}
__global__ __launch_bounds__(256) void k_assign(const int* __restrict__ TOPI, int* __restrict__ ctl, int* __restrict__ slot_tok, int* __restrict__ DEST) {
    const int i = blockIdx.x * 256 + threadIdx.x, e = TOPI[i];
    const int slot = ctl[CW_PADSTART + e] + atomicAdd(&ctl[CW_CUR + e], 1);
    slot_tok[slot] = i >> 2; DEST[i] = slot;
}
__global__ __launch_bounds__(256) void k_combine_ln2(const float* __restrict__ H, const bf16_t* __restrict__ Y, const int* __restrict__ DEST, const float* __restrict__ TOPG,
                                                     const float* __restrict__ g, const float* __restrict__ bta, float* __restrict__ out) {
    const int lane = threadIdx.x & 63, row = blockIdx.x * 4 + (threadIdx.x >> 6);
    const int4 d = *(const int4*)(DEST + row * 4); const float4 gt = *(const float4*)(TOPG + row * 4);
    const int ds[4] = {d.x, d.y, d.z, d.w}; const float gs[4] = {gt.x, gt.y, gt.z, gt.w};
    f32x4 v[4]; float s = 0.f;
#pragma unroll
    for (int j = 0; j < 4; ++j) { const int c = lane * 4 + 256 * j; f32x4 a = *(const f32x4*)(H + (size_t)row * DM + c) * DN_ALPHA;
#pragma unroll
        for (int k = 0; k < 4; ++k) { const uint2 y = *(const uint2*)(Y + (size_t)ds[k] * DM + c);
            a[0] += gs[k] * bf2f(y.x & 0xffff); a[1] += gs[k] * bf2f(y.x >> 16); a[2] += gs[k] * bf2f(y.y & 0xffff); a[3] += gs[k] * bf2f(y.y >> 16); }
        v[j] = a; s += (a[0] + a[1]) + (a[2] + a[3]); }
    const float mean = wave_sum(s) * (1.0f / DM); float s2 = 0.f;
#pragma unroll
    for (int j = 0; j < 4; ++j) { v[j] = v[j] - mean; s2 += (v[j][0] * v[j][0] + v[j][1] * v[j][1]) + (v[j][2] * v[j][2] + v[j][3] * v[j][3]); }
    const float rstd = 1.0f / sqrtf(wave_sum(s2) * (1.0f / DM) + LN_EPS);
#pragma unroll
    for (int j = 0; j < 4; ++j) { const int c = lane * 4 + 256 * j; *(f32x4*)(out + (size_t)row * DM + c) = v[j] * rstd * *(const f32x4*)(g + c) + *(const f32x4*)(bta + c); }
}

}
extern "C" void kernel_launch(void* const* d_in, const int* in_sizes, int n_in, void* d_out, int out_size, void* d_ws, size_t ws_size, hipStream_t stream) {
    static int grid = 0;
    if (grid == 0) {
        if (n_in != 17 || ws_size < WS_END) { fprintf(stderr, "kernel_launch: unexpected n_in %d or ws_size %zu (< %zu)\n", n_in, ws_size, (size_t)WS_END); grid = -1; return; }
        int dev = 0, cus = 0;
        if (hipGetDevice(&dev) != hipSuccess || hipDeviceGetAttribute(&cus, hipDeviceAttributeMultiprocessorCount, dev) != hipSuccess) { grid = -1; return; }
#define MK_ATTR(LO_, HI_) if (hipFuncSetAttribute((const void*)mk_fwd<LO_, HI_>, hipFuncAttributeMaxDynamicSharedMemorySize, LDS_BYTES) != hipSuccess) { fprintf(stderr, "kernel_launch: hipFuncSetAttribute failed\n"); grid = -1; return; }
#if MK_MODE == 0
        MK_ATTR(0, 11)
#elif MK_MODE == 2
        MK_ATTR(0, 1) MK_ATTR(1, 2) MK_ATTR(2, 3) MK_ATTR(3, 4) MK_ATTR(4, 5) MK_ATTR(5, 6)
#else
        MK_ATTR(0, 1) MK_ATTR(1, 2) MK_ATTR(2, 3) MK_ATTR(3, 4) MK_ATTR(4, 5) MK_ATTR(5, 6) MK_ATTR(6, 8) MK_ATTR(8, 9) MK_ATTR(9, 10) MK_ATTR(10, 11)
#endif
        grid = cus;
        if (grid != 256) fprintf(stderr, "kernel_launch: %d CUs (built for 256)\n", grid);
    }
    if (grid < 0) return;
    (void)hipMemsetAsync((char*)d_ws + WS_CTL, 0, CTL_ZERO_BYTES, stream);
    Args a{};
    for (int i = 0; i < 17; ++i) a.in[i] = (const float*)d_in[i];
    a.out = (float*)d_out; a.ws = (unsigned char*)d_ws;
#define MK_LAUNCH(LO_, HI_, LI_) do { a.ph_lo = LO_; a.ph_hi = HI_; a.li = LI_; hipLaunchKernelGGL((mk_fwd<LO_, HI_>), dim3(grid), dim3(NTHREADS), LDS_BYTES, stream, a); } while (0)
#if MK_MODE == 0
    MK_LAUNCH(0, 11, 0);
#elif MK_MODE == 2
    { unsigned char* ws = (unsigned char*)d_ws;
      InProjOut ip{}; ip.Q = (bf16_t*)(ws + WS_Q); ip.K = (bf16_t*)(ws + WS_K); ip.V = (bf16_t*)(ws + WS_V); ip.HQ = (bf16_t*)(ws + WS_HQ); ip.HK = (bf16_t*)(ws + WS_HK); ip.HV = (bf16_t*)(ws + WS_HV);
      ip.HG = (bf16_t*)(ws + WS_HG); ip.GS = (bf16_t*)(ws + WS_GS); ip.GH = (bf16_t*)(ws + WS_GH); ip.LOGF = (float*)(ws + WS_LOGF); ip.lb = (const float*)(ws + WS_LB);
#if MK_HEAD_V1 >= 1
      v1::k_convert_x<<<NTOK * DM / 4 / 256, 256, 0, stream>>>(a.in[0], (bf16_t*)(ws + WS_XB), a.in[2], (float*)(ws + WS_LB));
      v1::k_transpose_bf16<<<dim3(INW / 64, DM / 64, 1), 256, 0, stream>>>(a.in[1], (bf16_t*)(ws + WS_WINT), DM, INW);
      v1::k_transpose_bf16<<<dim3(DM / 64, SBW / 64, 1), 256, 0, stream>>>(a.in[4], (bf16_t*)(ws + WS_WBST), SBW, DM);
      v1::k_transpose_bf16<<<dim3(DM / 64, HGW / 64, 1), 256, 0, stream>>>(a.in[5], (bf16_t*)(ws + WS_WBHT), HGW, DM);
      v1::k_transpose_bf16<<<dim3(DM / 64, DM / 64, 1), 256, 0, stream>>>(a.in[6], (bf16_t*)(ws + WS_WOT), DM, DM);
      v1::k_transpose_bf16<<<dim3(UPW / 64, DM / 64, NEXP), 256, 0, stream>>>(a.in[11], (bf16_t*)(ws + WS_WUPT), DM, UPW);
      v1::k_transpose_bf16<<<dim3(DM / 64, DFF / 64, NEXP), 256, 0, stream>>>(a.in[13], (bf16_t*)(ws + WS_WDNT), DFF, DM);
#else
      MK_LAUNCH(0, 1, 0);
#endif
#if MK_HEAD_V1 >= 2
      v1::k_inproj<<<dim3(INW / v1::G_BM, NTOK / v1::G_BM), 256, 0, stream>>>((const bf16_t*)(ws + WS_XB), (const bf16_t*)(ws + WS_WINT), ip);
#else
      MK_LAUNCH(1, 2, 1);
#endif
      MK_LAUNCH(2, 3, 2); MK_LAUNCH(3, 4, 3); MK_LAUNCH(4, 5, 4); MK_LAUNCH(5, 6, 5); }
    { unsigned char* ws = (unsigned char*)d_ws; int* ctl = (int*)(ws + WS_CTL); bf16_t* HB = (bf16_t*)(ws + WS_XS); int* TOPI = (int*)(ws + WS_XS + 32 * MiB); int* SLOTTOK = (int*)(ws + WS_XS + 33 * MiB);
      float* TOPG = (float*)(ws + WS_TOPG); int* DEST = (int*)(ws + WS_DEST); float* H = (float*)(ws + WS_H); bf16_t* ACT = (bf16_t*)(ws + WS_ACT); bf16_t* Y = (bf16_t*)(ws + WS_Y);
      v1::k_ln1_router<<<NTOK / 4, 256, 0, stream>>>((const float*)(ws + WS_PRE), a.in[7], a.in[8], a.in[9], a.in[10], H, HB, TOPI, TOPG);
      v1::k_count<<<NASSIGN / 256, 256, 0, stream>>>(TOPI, ctl, SLOTTOK);
      v1::k_plan<<<1, 64, 0, stream>>>(ctl);
      v1::k_assign<<<NASSIGN / 256, 256, 0, stream>>>(TOPI, ctl, SLOTTOK, DEST);
      v1::k_moe_up<<<dim3(UPW / v1::G_BM, NSLOT_MAX / v1::G_BM), 256, 0, stream>>>(HB, (const bf16_t*)(ws + WS_WUPT), a.in[12], ctl, SLOTTOK, ACT);
      v1::k_moe_down<<<dim3(DM / v1::G_BM, NSLOT_MAX / v1::G_BM), 256, 0, stream>>>(ACT, (const bf16_t*)(ws + WS_WDNT), a.in[14], ctl, Y);
      v1::k_combine_ln2<<<NTOK / 4, 256, 0, stream>>>(H, Y, DEST, TOPG, a.in[15], a.in[16], (float*)d_out); }
#else
    MK_LAUNCH(0, 1, 0); MK_LAUNCH(1, 2, 1); MK_LAUNCH(2, 3, 2); MK_LAUNCH(3, 4, 3); MK_LAUNCH(4, 5, 4); MK_LAUNCH(5, 6, 5); MK_LAUNCH(6, 8, 6); MK_LAUNCH(8, 9, 7); MK_LAUNCH(9, 10, 8); MK_LAUNCH(10, 11, 9);
#endif
}
```

```cpp
#include <hip/hip_runtime.h>
#include <stdint.h>
#include <cstdio>

#define LAS __attribute__((address_space(3)))
#define GAS __attribute__((address_space(1)))
typedef unsigned short bf16_t;
typedef short bf16x8 __attribute__((ext_vector_type(8)));
typedef float f32x4 __attribute__((ext_vector_type(4)));
typedef float f32x16 __attribute__((ext_vector_type(16)));
typedef unsigned u32x4 __attribute__((ext_vector_type(4)));
typedef unsigned u32x2 __attribute__((ext_vector_type(2)));

constexpr int NTOK = 16384, DM = 1024, INW = 5632, SBW = 512, HGW = 512, NEXP = 32, TOPK = 4, DFF = 1024, UPW = 2048;
constexpr int SEQ = 2048, SBH = 8, SBD = 64, HGH = 4, HGD = 128;
constexpr int NASSIGN = NTOK * TOPK;
constexpr int SLOT_PAD = 256;
constexpr int NSLOT_MAX = NASSIGN + NEXP * SLOT_PAD;
constexpr int NTILE_MAX = NSLOT_MAX / SLOT_PAD;
constexpr float LN_EPS = 1e-5f, RMS_EPS = 1e-6f, DN_ALPHA = 1.189207115002721f, SW_ALPHA = 1.702f, SW_LIMIT = 7.0f, LOG2E = 1.4426950408889634f, LN2 = 0.6931471805599453f;
constexpr int NWAVES = 8, NTHREADS = 512;
#ifndef MK_NAIVE_MIX
#define MK_NAIVE_MIX 0
#endif
#ifndef MK_MODE
#ifndef MK_P1_ALIGN
#define MK_P1_ALIGN true
#endif
#ifndef MK_P1_SP2
#define MK_P1_SP2 true
#endif
#ifndef MK_HEAD_V1
#define MK_HEAD_V1 0
#endif
#define MK_MODE 0
#endif

constexpr size_t MiB = 1u << 20;
constexpr size_t WS_CTL = 0, CTL_ZERO_BYTES = 262144;
constexpr size_t WS_LB = 1 * MiB;
constexpr size_t WS_CNTM = WS_LB + 4096;
constexpr size_t WS_TOPG = WS_CNTM + 32768;
constexpr size_t WS_DEST = WS_TOPG + 262144;
constexpr size_t WS_RWT = WS_DEST + 262144;
constexpr size_t WS_XB = 3 * MiB;
constexpr size_t WS_WINT = WS_XB + 32 * MiB;
constexpr size_t WS_WBST = WS_WINT + 12 * MiB;
constexpr size_t WS_WBHT = WS_WBST + 1 * MiB;
constexpr size_t WS_WOT = WS_WBHT + 1 * MiB;
constexpr size_t WS_WUPT = WS_WOT + 2 * MiB;
constexpr size_t WS_WDNT = WS_WUPT + 128 * MiB;
constexpr size_t WS_Q = WS_WDNT + 64 * MiB;
constexpr size_t WS_K = WS_Q + 16 * MiB;
constexpr size_t WS_V = WS_K + 16 * MiB;
constexpr size_t WS_HQ = WS_V + 16 * MiB;
constexpr size_t WS_HK = WS_HQ + 16 * MiB;
constexpr size_t WS_HV = WS_HK + 16 * MiB;
constexpr size_t WS_HG = WS_HV + 16 * MiB;
constexpr size_t WS_LOGF = WS_HG + 16 * MiB;
constexpr size_t WS_GS = WS_LOGF + 32 * MiB;
constexpr size_t WS_GH = WS_GS + 32 * MiB;
constexpr size_t WS_OSB = WS_GH + 32 * MiB;
constexpr size_t WS_OHG = WS_OSB + 16 * MiB;
constexpr size_t WS_ORAW = WS_OHG + 16 * MiB;
constexpr size_t WS_MERGED = WS_ORAW + 32 * MiB;
constexpr size_t WS_H = WS_MERGED + 32 * MiB;
constexpr size_t WS_XS = WS_H + 64 * MiB;
constexpr size_t WS_ACT = WS_XS + 144 * MiB;
constexpr size_t WS_END = WS_ACT + 144 * MiB;
constexpr size_t WS_PRE = WS_Q;
constexpr size_t WS_Y = WS_HK;
static_assert(WS_Y + 144 * MiB <= WS_OSB && WS_PRE + 64 * MiB <= WS_HK, "overlays");
static_assert(WS_END <= 1020 * MiB, "ws budget");
constexpr int CW_NTILES = 16;
constexpr int CW_ATTNQ = 32;
constexpr int CW_TILEEXP = 64;
constexpr int CW_BAR = 1024;
constexpr int LDS_SCRATCH = 147456;
constexpr int LDSCTL_OFF = LDS_SCRATCH, LDS_BYTES = LDS_SCRATCH + 512;
constexpr int MISC_OFF = LDSCTL_OFF;

__device__ __forceinline__ unsigned f2bf(float f) { unsigned u = __builtin_bit_cast(unsigned, f); return (u + 0x7fffu + ((u >> 16) & 1u)) >> 16; }
__device__ __forceinline__ unsigned pk2(float lo, float hi) { return f2bf(lo) | (f2bf(hi) << 16); }
__device__ __forceinline__ float bf2f(unsigned short b) { return __builtin_bit_cast(float, (unsigned)b << 16); }
__device__ __forceinline__ float bflo(unsigned w) { return __builtin_bit_cast(float, w << 16); }
__device__ __forceinline__ float bfhi(unsigned w) { return __builtin_bit_cast(float, w & 0xffff0000u); }
__device__ __forceinline__ float fsigmoid(float v) { return __builtin_amdgcn_rcpf(1.0f + __builtin_amdgcn_exp2f(-v * LOG2E)); }
__device__ __forceinline__ float wave_sum(float v) {
#pragma unroll
    for (int o = 1; o < 64; o <<= 1) v += __shfl_xor(v, o);
    return v;
}
#define LDS_WAIT() asm volatile("s_waitcnt lgkmcnt(0)" ::: "memory")
#define VM_WAIT() asm volatile("s_waitcnt vmcnt(0)" ::: "memory")

struct InProjOut { bf16_t *Q, *K, *V, *HQ, *HK, *HV, *HG, *GS, *GH; float* LOGF; const float* lb; };

namespace pg8 {
#define PG8_LAS __attribute__((address_space(3)))
constexpr int BM = 256, BK = 64, HALF = 128, HTB = HALF * BK * 2  , STAGE_BYTES = 8 * HTB, NXCD = 8, WGM = 8;
__host__ __device__ __forceinline__ int lds_byte(int r, int c) { const int st = (r >> 4) * 2 + (c >> 5), rr = r & 15, cc = c & 31, ob = rr * 64 + cc * 2; return st * 1024 + (ob ^ (((ob >> 9) & 1) << 5)); }
__host__ __device__ __forceinline__ void stage_rc(int b, int& R, int& C) { const int st = b / 1024, sb = b % 1024, swz = sb ^ (((sb >> 9) & 1) << 5); R = (st >> 1) * 16 + swz / 64; C = (st & 1) * 32 + (swz % 64) / 2; }
__host__ __device__ __forceinline__ int perm32(int rho) { const int n = rho >> 4, i = rho & 15; return 8 * (i >> 2) + 4 * n + (i & 3); }

struct Unit { int pm, pn, aux; const char* a; const char* b; };
struct Gemm { int K; };
struct TileOrder {
    int nM, nN, nwg, G, c;
    __device__ void init(int nM_, int nN_, int G_, int c_) { nM = nM_; nN = nN_; nwg = nM * nN; G = G_; c = c_; }
    __device__ bool tile(int i, int& pm, int& pn) const {
        const long L = (long)i * G + c; if (L >= nwg) return false;
        int wgid = (int)L; { const int q = nwg / NXCD, r = nwg % NXCD, xcd = wgid % NXCD, off = wgid / NXCD; wgid = (xcd < r ? xcd * (q + 1) : r * (q + 1) + (xcd - r) * q) + off; }
        const int nig = WGM * nN, gid = wgid / nig, fm = gid * WGM, gsz = (nM - fm) < WGM ? (nM - fm) : WGM;
        pm = fm + ((wgid % nig) % gsz); pn = (wgid % nig) / gsz; return true;
    }
};
struct DenseSched { TileOrder o; const char* A; const char* Bt; size_t tstep;
    __device__ __forceinline__ bool next(int i, Unit& u) const { if (!o.tile(i, u.pm, u.pn)) return false; u.aux = 0; u.a = A + (size_t)u.pm * tstep; u.b = Bt + (size_t)u.pn * tstep; return true; }
    __device__ __forceinline__ void a_ready(const Unit&) const {}
    __device__ __forceinline__ void done(const Unit&) const {} };
struct BranchSched { TileOrder o; const char *A0, *B0, *A1, *B1; size_t tstep;
    __device__ __forceinline__ bool next(int i, Unit& u) const { if (!o.tile(i >> 1, u.pm, u.pn)) return false; u.aux = i & 1; u.a = ((i & 1) ? A1 : A0) + (size_t)u.pm * tstep; u.b = ((i & 1) ? B1 : B0) + (size_t)u.pn * tstep; return true; }
    __device__ __forceinline__ void a_ready(const Unit&) const {}
    __device__ __forceinline__ void done(const Unit&) const {} };
struct MoeSched { TileOrder o; const char* A; const char* W; const int* tile_exp; size_t tstep, estep;
    __device__ __forceinline__ bool next(int i, Unit& u) const { if (!o.tile(i, u.pm, u.pn)) return false; const int e = __builtin_amdgcn_readfirstlane(__hip_atomic_load(tile_exp + u.pm, __ATOMIC_RELAXED, __HIP_MEMORY_SCOPE_AGENT)); u.aux = e; u.a = A + (size_t)u.pm * tstep; u.b = W + (size_t)e * estep + (size_t)u.pn * tstep; return true; }
    __device__ __forceinline__ void a_ready(const Unit&) const {}
    __device__ __forceinline__ void done(const Unit&) const {} };

typedef float f32x2_t __attribute__((ext_vector_type(2))); typedef __bf16 bf16x2_t __attribute__((ext_vector_type(2)));
__device__ __forceinline__ unsigned cvt_pk_bf16(float lo, float hi) { f32x2_t v = {lo, hi}; bf16x2_t b = __builtin_convertvector(v, bf16x2_t); return __builtin_bit_cast(unsigned, b); }
template <int MODE> __device__ __forceinline__ void inproj_store(const f32x4 (&acc)[2][2][4][2], bf16_t* dst, int ld, int row0, int col0, float scale, const float* lb, float* logf_out) {
    f32x4 lbv[2][2];
    if (MODE == 2) {
#pragma unroll
        for (int bj = 0; bj < 2; ++bj)
#pragma unroll
            for (int n = 0; n < 2; ++n) lbv[bj][n] = *(const f32x4*)(lb + col0 + bj * HALF + 4 * n);
    }
#pragma unroll
    for (int ai = 0; ai < 2; ++ai)
#pragma unroll
        for (int m = 0; m < 4; ++m)
#pragma unroll
            for (int bj = 0; bj < 2; ++bj) {
                const size_t off = (size_t)(row0 + ai * HALF + m * 16) * ld + col0 + bj * HALF;
                f32x4 v[2] = {acc[ai][bj][m][0], acc[ai][bj][m][1]};
                if (MODE == 0) { v[0] = v[0] * scale; v[1] = v[1] * scale; }
                if (MODE == 1) {
#pragma unroll
                    for (int n = 0; n < 2; ++n)
#pragma unroll
                        for (int j = 0; j < 4; ++j) v[n][j] = v[n][j] * fsigmoid(v[n][j]); }
                if (MODE == 3) {
#pragma unroll
                    for (int n = 0; n < 2; ++n)
#pragma unroll
                        for (int j = 0; j < 4; ++j) v[n][j] = fsigmoid(v[n][j]); }
                if (MODE == 2) {
                    f32x4 lg[2];
#pragma unroll
                    for (int n = 0; n < 2; ++n)
#pragma unroll
                        for (int j = 0; j < 4; ++j) { const float l = lbv[bj][n][j], f = l + (1.0f - l) * fsigmoid(v[n][j]); v[n][j] = 1.0f - f; lg[n][j] = __builtin_amdgcn_logf(f) * LN2; }
                    *(f32x4*)(logf_out + off) = lg[0]; *(f32x4*)(logf_out + off + 4) = lg[1];
                }
                u32x4 w; w.x = cvt_pk_bf16(v[0][0], v[0][1]); w.y = cvt_pk_bf16(v[0][2], v[0][3]); w.z = cvt_pk_bf16(v[1][0], v[1][1]); w.w = cvt_pk_bf16(v[1][2], v[1][3]);
                *(u32x4*)(dst + off) = w;
            }
}
struct EpiInProj { static constexpr bool PERM = true, AFTER_DRAIN = false, ACC_CHAIN = false; InProjOut o;
    __device__ __forceinline__ void operator()(f32x4 (&acc)[2][2][4][2], const Unit& u, int wr, int wc, int fr, int fq) const {
        const int row0 = u.pm * BM + wr * 64 + fr, pn = u.pn;
        int seg, cb, ld;
        if (pn < 14) { seg = pn >> 1; cb = (pn & 1) * 256; ld = 512; } else if (pn < 18) { seg = 7; cb = (pn - 14) * 256; ld = 1024; } else { seg = 8; cb = (pn - 18) * 256; ld = 1024; }
        const int col0 = cb + wc * 32 + 8 * fq;
        switch (seg) {
            case 0: inproj_store<0>(acc, o.Q, ld, row0, col0, 0.125f, nullptr, nullptr); break;
            case 1: inproj_store<0>(acc, o.K, ld, row0, col0, 1.0f, nullptr, nullptr); break;
            case 2: inproj_store<0>(acc, o.V, ld, row0, col0, 1.0f, nullptr, nullptr); break;
            case 3: inproj_store<1>(acc, o.HQ, ld, row0, col0, 1.0f, nullptr, nullptr); break;
            case 4: inproj_store<2>(acc, o.HK, ld, row0, col0, 1.0f, o.lb, o.LOGF); break;
            case 5: inproj_store<0>(acc, o.HV, ld, row0, col0, 1.0f, nullptr, nullptr); break;
            case 6: inproj_store<3>(acc, o.HG, ld, row0, col0, 1.0f, nullptr, nullptr); break;
            case 7: inproj_store<3>(acc, o.GS, ld, row0, col0, 1.0f, nullptr, nullptr); break;
            default: inproj_store<3>(acc, o.GH, ld, row0, col0, 1.0f, nullptr, nullptr); break;
        }
    }
};
struct EpiBranch { static constexpr bool PERM = true, AFTER_DRAIN = false, ACC_CHAIN = true; const bf16_t* GS; const bf16_t* GH; bf16_t* MERGED;
    __device__ __forceinline__ void operator()(f32x4 (&acc)[2][2][4][2], const Unit& u, int wr, int wc, int fr, int fq) const {
        const int row0 = u.pm * BM + wr * 64 + fr, col0 = u.pn * BM + wc * 32 + 8 * fq;
#pragma unroll
        for (int ai = 0; ai < 2; ++ai)
#pragma unroll
            for (int m = 0; m < 4; ++m)
#pragma unroll
                for (int bj = 0; bj < 2; ++bj) {
                    const size_t off = (size_t)(row0 + ai * HALF + m * 16) * DM + col0 + bj * HALF;
                    const u32x4 gh = *(const u32x4*)(GH + off);
                    const float h[8] = {bflo(gh.x), bfhi(gh.x), bflo(gh.y), bfhi(gh.y), bflo(gh.z), bfhi(gh.z), bflo(gh.w), bfhi(gh.w)};
                    if (u.aux == 0) {
                        const u32x4 gs = *(const u32x4*)(GS + off);
                        const float s[8] = {bflo(gs.x), bfhi(gs.x), bflo(gs.y), bfhi(gs.y), bflo(gs.z), bfhi(gs.z), bflo(gs.w), bfhi(gs.w)};
#pragma unroll
                        for (int n = 0; n < 2; ++n)
#pragma unroll
                            for (int j = 0; j < 4; ++j) acc[ai][bj][m][n][j] *= s[4 * n + j] / h[4 * n + j];
                    } else {
                        float r[8];
#pragma unroll
                        for (int n = 0; n < 2; ++n)
#pragma unroll
                            for (int j = 0; j < 4; ++j) { r[4 * n + j] = acc[ai][bj][m][n][j] * h[4 * n + j]; acc[ai][bj][m][n][j] = 0.f; }
                        u32x4 w; w.x = cvt_pk_bf16(r[0], r[1]); w.y = cvt_pk_bf16(r[2], r[3]); w.z = cvt_pk_bf16(r[4], r[5]); w.w = cvt_pk_bf16(r[6], r[7]);
                        *(u32x4*)(MERGED + off) = w;
                    }
                }
    }
};
struct EpiOut { static constexpr bool PERM = false, AFTER_DRAIN = false, ACC_CHAIN = false; const float* x; float* PRE;
    __device__ __forceinline__ void operator()(f32x4 (&acc)[2][2][4][2], const Unit& u, int wr, int wc, int fr, int fq) const {
        const int row0 = u.pm * BM + wr * 64 + fr, col0 = u.pn * BM + wc * 32 + 4 * fq;
#pragma unroll
        for (int ai = 0; ai < 2; ++ai)
#pragma unroll
            for (int m = 0; m < 4; ++m) { const size_t ro = (size_t)(row0 + ai * HALF + m * 16) * DM + col0;
#pragma unroll
                for (int bj = 0; bj < 2; ++bj)
#pragma unroll
                    for (int n = 0; n < 2; ++n) { const size_t off = ro + bj * HALF + n * 16; *(f32x4*)(PRE + off) = *(const f32x4*)(x + off) * DN_ALPHA + acc[ai][bj][m][n]; } }
    }
};
struct EpiUp { static constexpr bool PERM = true, AFTER_DRAIN = false, ACC_CHAIN = false; const float* b_up; bf16_t* ACT;
    __device__ __forceinline__ void operator()(f32x4 (&acc)[2][2][4][2], const Unit& u, int wr, int wc, int fr, int fq) const {
        const int row0 = u.pm * BM + wr * 64 + fr, col0 = u.pn * BM + wc * 32 + 8 * fq; const float* bias = b_up + (size_t)u.aux * UPW + col0;
        f32x4 bv[2][2];
#pragma unroll
        for (int bj = 0; bj < 2; ++bj)
#pragma unroll
            for (int n = 0; n < 2; ++n) bv[bj][n] = *(const f32x4*)(bias + bj * HALF + 4 * n);
#pragma unroll
        for (int ai = 0; ai < 2; ++ai)
#pragma unroll
            for (int m = 0; m < 4; ++m)
#pragma unroll
                for (int bj = 0; bj < 2; ++bj) {
                    const f32x4 v0 = acc[ai][bj][m][0] + bv[bj][0], v1 = acc[ai][bj][m][1] + bv[bj][1];
                    const float gl[4] = {v0[0], v0[2], v1[0], v1[2]}, li[4] = {v0[1], v0[3], v1[1], v1[3]}; float a[4];
#pragma unroll
                    for (int p = 0; p < 4; ++p) { const float g = fminf(gl[p], SW_LIMIT), l = fminf(fmaxf(li[p], -SW_LIMIT), SW_LIMIT); a[p] = g * fsigmoid(SW_ALPHA * g) * (l + 1.0f); }
                    u32x2 w; w.x = cvt_pk_bf16(a[0], a[1]); w.y = cvt_pk_bf16(a[2], a[3]);
                    *(u32x2*)(ACT + (size_t)(row0 + ai * HALF + m * 16) * DFF + ((col0 + bj * HALF) >> 1)) = w;
                }
    }
};
struct EpiDown { static constexpr bool PERM = true, AFTER_DRAIN = false, ACC_CHAIN = false; const float* b_dn; bf16_t* Y;
    __device__ __forceinline__ void operator()(f32x4 (&acc)[2][2][4][2], const Unit& u, int wr, int wc, int fr, int fq) const {
        const int row0 = u.pm * BM + wr * 64 + fr, col0 = u.pn * BM + wc * 32 + 8 * fq; const float* bias = b_dn + (size_t)u.aux * DM + col0;
        f32x4 bv[2][2];
#pragma unroll
        for (int bj = 0; bj < 2; ++bj)
#pragma unroll
            for (int n = 0; n < 2; ++n) bv[bj][n] = *(const f32x4*)(bias + bj * HALF + 4 * n);
#pragma unroll
        for (int ai = 0; ai < 2; ++ai)
#pragma unroll
            for (int m = 0; m < 4; ++m)
#pragma unroll
                for (int bj = 0; bj < 2; ++bj) {
                    const f32x4 v0 = acc[ai][bj][m][0] + bv[bj][0], v1 = acc[ai][bj][m][1] + bv[bj][1];
                    u32x4 w; w.x = cvt_pk_bf16(v0[0], v0[1]); w.y = cvt_pk_bf16(v0[2], v0[3]); w.z = cvt_pk_bf16(v1[0], v1[1]); w.w = cvt_pk_bf16(v1[2], v1[3]);
                    *(u32x4*)(Y + (size_t)(row0 + ai * HALF + m * 16) * DM + col0 + bj * HALF) = w;
                }
    }
};

template <class Epi, class Sched, bool ALIGN_EPI = false, bool SP2 = false>
__device__ __forceinline__ void gemm_phase(PG8_LAS unsigned char* lds, const Gemm g, const Sched& S, const Epi& E) {
    const int tid = threadIdx.x, wid = __builtin_amdgcn_readfirstlane(tid >> 6), lane = tid & 63, wr = wid >> 2, wc = wid & 3, fr = lane & 15, fq = lane >> 4;
    const int K = g.K, nt = K / BK;
    unsigned voffA[2], voffB[2];
#pragma unroll
    for (int i = 0; i < 2; ++i) { int R, C; stage_rc(tid * 16 + i * 8192, R, C); const int Rb = Epi::PERM ? ((R & ~31) + perm32(R & 31)) : R;
        voffA[i] = (unsigned)(R * K + C) * 2u; voffB[i] = (unsigned)(Rb * K + C) * 2u; }
    const size_t kstep = (size_t)(BK * 2);
    const size_t hstep = (size_t)HALF * K * 2;
    const unsigned ldsw = (unsigned)wid * 1024u;
    const int aoff = lds_byte(wr * 64 + fr, fq * 8), boff = lds_byte(wc * 32 + fr, fq * 8);
#define PG8_SA(b, h) (((b) * 2 + (h)) * HTB)
#define PG8_SB(b, h) ((4 + (b) * 2 + (h)) * HTB)
#define PG8_STAGE(bufoff, gbase, voff) do { _Pragma("unroll") for (int _i = 0; _i < 2; ++_i) \
        __builtin_amdgcn_global_load_lds((const unsigned*)((const char*)(gbase) + (voff)[_i]), (PG8_LAS unsigned*)(lds + (bufoff) + ldsw + _i * 8192), 16, 0, 0); } while (0)
#define PG8_LDA(dst, b, h) do { _Pragma("unroll") for (int m = 0; m < 4; ++m) _Pragma("unroll") for (int k = 0; k < 2; ++k) dst[m][k] = *(const PG8_LAS bf16x8*)(lds + PG8_SA(b, h) + aoff + m * 2048 + k * 1024); } while (0)
#define PG8_LDB(dst, b, h) do { _Pragma("unroll") for (int n = 0; n < 2; ++n) _Pragma("unroll") for (int k = 0; k < 2; ++k) dst[n][k] = *(const PG8_LAS bf16x8*)(lds + PG8_SB(b, h) + boff + n * 2048 + k * 1024); } while (0)
#define PG8_MMA(ai, bj, At, Bt) do { __builtin_amdgcn_s_setprio(1); _Pragma("unroll") for (int m = 0; m < 4; ++m) _Pragma("unroll") for (int n = 0; n < 2; ++n) _Pragma("unroll") for (int k = 0; k < 2; ++k) \
        acc[ai][bj][m][n] = __builtin_amdgcn_mfma_f32_16x16x32_bf16(Bt[n][k], At[m][k], acc[ai][bj][m][n], 0, 0, 0); __builtin_amdgcn_s_setprio(0); } while (0)
#define PG8_WAIT_V(n) asm volatile("s_waitcnt vmcnt(" #n ")" ::: "memory")
#define PG8_WAIT_L(n) asm volatile("s_waitcnt lgkmcnt(" #n ")" ::: "memory")
#define PG8_BAR __builtin_amdgcn_s_barrier()
#define PG8_SCHED __builtin_amdgcn_sched_barrier(0)
    Unit cur, nxt; int ui = 0;
    if (!S.next(0, cur)) return;
    f32x4 acc[2][2][4][2];
#pragma unroll
    for (int a = 0; a < 2; ++a)
#pragma unroll
        for (int b = 0; b < 2; ++b)
#pragma unroll
            for (int m = 0; m < 4; ++m)
#pragma unroll
                for (int n = 0; n < 2; ++n) acc[a][b][m][n] = (f32x4){0.f, 0.f, 0.f, 0.f};
    bf16x8 At[4][2], B0[2][2], B1[2][2];
    const char* cA = cur.a; const char* cB = cur.b;
    S.a_ready(cur);
    if constexpr (SP2) {
        PG8_STAGE(PG8_SB(0, 0), cB, voffB); PG8_STAGE(PG8_SB(0, 1), cB + hstep, voffB); PG8_STAGE(PG8_SA(0, 0), cA, voffA); PG8_STAGE(PG8_SA(0, 1), cA + hstep, voffA);
        if (wr == 1) PG8_BAR;
        PG8_WAIT_V(2); PG8_BAR;
        PG8_STAGE(PG8_SB(1, 0), cB + kstep, voffB); PG8_STAGE(PG8_SA(1, 0), cA + kstep, voffA); PG8_STAGE(PG8_SB(1, 1), cB + hstep + kstep, voffB);
        PG8_WAIT_V(6); PG8_BAR;
    } else {
        PG8_STAGE(PG8_SB(0, 0), cB, voffB); PG8_STAGE(PG8_SA(0, 0), cA, voffA); PG8_STAGE(PG8_SB(0, 1), cB + hstep, voffB); PG8_STAGE(PG8_SA(0, 1), cA + hstep, voffA);
        if (wr == 1) PG8_BAR;
        PG8_WAIT_V(4); PG8_BAR;
        PG8_STAGE(PG8_SB(1, 0), cB + kstep, voffB); PG8_STAGE(PG8_SA(1, 0), cA + kstep, voffA); PG8_STAGE(PG8_SB(1, 1), cB + hstep + kstep, voffB);
        PG8_WAIT_V(6); PG8_BAR;
    }
    for (;;) {
        const bool has_next = S.next(ui + 1, nxt);
        const char* nA = has_next ? nxt.a : cA; const char* nB = has_next ? nxt.b : cB;
        for (int t = 0; t < nt; t += 2) {
            const bool last = (t == nt - 2);
            const char* a1 = cA + (size_t)(t + 1) * kstep;
            const char* a2 = last ? nA : cA + (size_t)(t + 2) * kstep; const char* b2 = last ? nB : cB + (size_t)(t + 2) * kstep;
            const char* a3 = a2 + kstep; const char* b3 = b2 + kstep;
            if (last && has_next) S.a_ready(nxt);
            if constexpr (SP2) {
            PG8_LDB(B0, 0, 0); PG8_LDB(B1, 0, 1); PG8_SCHED; PG8_LDA(At, 0, 0); PG8_STAGE(PG8_SA(1, 1), a1 + hstep, voffA);
            PG8_WAIT_V(8); PG8_WAIT_L(0); PG8_BAR; PG8_MMA(0, 0, At, B0); PG8_MMA(0, 1, At, B1); PG8_BAR; PG8_SCHED;
            PG8_LDA(At, 0, 1); PG8_STAGE(PG8_SB(0, 0), b2, voffB); PG8_STAGE(PG8_SB(0, 1), b2 + hstep, voffB); PG8_STAGE(PG8_SA(0, 0), a2, voffA);
            PG8_WAIT_V(8); PG8_WAIT_L(0); PG8_BAR; PG8_MMA(1, 0, At, B0); PG8_MMA(1, 1, At, B1); PG8_BAR; PG8_SCHED;
            PG8_LDB(B0, 1, 0); PG8_LDB(B1, 1, 1); PG8_SCHED; PG8_LDA(At, 1, 0); PG8_STAGE(PG8_SA(0, 1), a2 + hstep, voffA);
            PG8_WAIT_V(8); PG8_WAIT_L(0); PG8_BAR; PG8_MMA(0, 0, At, B0); PG8_MMA(0, 1, At, B1); PG8_BAR; PG8_SCHED;
            PG8_LDA(At, 1, 1); PG8_STAGE(PG8_SB(1, 0), b3, voffB); PG8_STAGE(PG8_SB(1, 1), b3 + hstep, voffB); PG8_STAGE(PG8_SA(1, 0), a3, voffA);
            PG8_WAIT_V(8); PG8_WAIT_L(0); PG8_BAR; PG8_MMA(1, 0, At, B0); PG8_MMA(1, 1, At, B1); PG8_BAR; PG8_SCHED;
            } else {
            PG8_LDB(B0, 0, 0); PG8_SCHED; PG8_LDA(At, 0, 0); PG8_STAGE(PG8_SA(1, 1), a1 + hstep, voffA);
            PG8_WAIT_L(8); PG8_BAR; PG8_WAIT_L(0); PG8_MMA(0, 0, At, B0); PG8_BAR; PG8_SCHED;
            PG8_LDB(B1, 0, 1); PG8_STAGE(PG8_SB(0, 0), b2, voffB);
            PG8_BAR; PG8_WAIT_L(0); PG8_MMA(0, 1, At, B1); PG8_BAR;
            PG8_LDA(At, 0, 1); PG8_STAGE(PG8_SA(0, 0), a2, voffA);
            PG8_BAR; PG8_WAIT_L(0); PG8_MMA(1, 0, At, B0); PG8_BAR; PG8_SCHED;
            PG8_STAGE(PG8_SB(0, 1), b2 + hstep, voffB);
            PG8_WAIT_V(6); PG8_BAR; PG8_MMA(1, 1, At, B1); PG8_BAR;
            PG8_LDB(B0, 1, 0); PG8_SCHED; PG8_LDA(At, 1, 0); PG8_STAGE(PG8_SA(0, 1), a2 + hstep, voffA);
            PG8_WAIT_L(8); PG8_BAR; PG8_WAIT_L(0); PG8_MMA(0, 0, At, B0); PG8_BAR; PG8_SCHED;
            PG8_LDB(B1, 1, 1); PG8_STAGE(PG8_SB(1, 0), b3, voffB);
            PG8_BAR; PG8_WAIT_L(0); PG8_MMA(0, 1, At, B1); PG8_BAR;
            PG8_LDA(At, 1, 1); PG8_STAGE(PG8_SA(1, 0), a3, voffA);
            PG8_BAR; PG8_WAIT_L(0); PG8_MMA(1, 0, At, B0); PG8_BAR; PG8_SCHED;
            PG8_STAGE(PG8_SB(1, 1), b3 + hstep, voffB);
            PG8_WAIT_V(6); PG8_BAR; PG8_MMA(1, 1, At, B1); PG8_BAR;
            }
        }
        if constexpr (ALIGN_EPI) { if (wr == 0) PG8_BAR; }
        if constexpr (!Epi::AFTER_DRAIN) { E(acc, cur, wr, wc, fr, fq); S.done(cur); }
        if (!has_next) break;
        if constexpr (!Epi::ACC_CHAIN) {
#pragma unroll
        for (int a = 0; a < 2; ++a)
#pragma unroll
            for (int b = 0; b < 2; ++b)
#pragma unroll
                for (int m = 0; m < 4; ++m)
#pragma unroll
                    for (int n = 0; n < 2; ++n) acc[a][b][m][n] = (f32x4){0.f, 0.f, 0.f, 0.f};
        }
        cur = nxt; cA = nA; cB = nB; ++ui;
        if constexpr (ALIGN_EPI) { if (wr == 1) PG8_BAR; }
    }
    PG8_WAIT_V(0);
    if constexpr (!ALIGN_EPI) { if (wr == 0) PG8_BAR; }
    PG8_BAR;
    if constexpr (Epi::AFTER_DRAIN) { E.fused(acc, cur, wr, wc, fr, fq, lds, wid, lane); S.done(cur); }
#undef PG8_SA
#undef PG8_SB
#undef PG8_STAGE
#undef PG8_LDA
#undef PG8_LDB
#undef PG8_MMA
#undef PG8_WAIT_V
#undef PG8_WAIT_L
#undef PG8_BAR
#undef PG8_SCHED
}
}

typedef GAS unsigned gu32;
#define RLX_AGENT __ATOMIC_RELAXED, __HIP_MEMORY_SCOPE_AGENT
#define XB_TMO      128
#define XB_XCNT(j)  (256  + 64 * (j))
#define XB_XSUB(j)  (1280 + 64 * (j))
#define XB_XGEN(j)  (2304 + 64 * (j))
#define XB_TOP      3328
#define XB_TOPGEN   3392
#define XCD_BAR_WORDS 3456
#define XB_SPIN_CAP (1u << 26)

__device__ __forceinline__ unsigned xb_ld(unsigned* p)              { return __hip_atomic_load(p, __ATOMIC_RELAXED, __HIP_MEMORY_SCOPE_AGENT); }
__device__ __forceinline__ unsigned xb_add(unsigned* p, unsigned v) { return __hip_atomic_fetch_add(p, v, __ATOMIC_RELAXED, __HIP_MEMORY_SCOPE_AGENT); }
__device__ __forceinline__ unsigned xb_xcc_id() { return (unsigned)__builtin_amdgcn_s_getreg((3 << 11) | 20) & 0xFu; }
#define XB_SPIN(cond, bar) do { unsigned _sp = 0; while (cond) { __builtin_amdgcn_s_sleep(1); \
    if ((++_sp & 255u) == 0u) { if (xb_ld(&(bar)[XB_TMO])) break; if (_sp > XB_SPIN_CAP) { atomicAdd(&(bar)[XB_TMO], 1u); break; } } } } while (0)

struct XcdBarrier {
    unsigned* bar; unsigned x;
    volatile LAS unsigned* st;
};

__device__ __forceinline__ XcdBarrier xcd_barrier_post(unsigned* bar, volatile LAS unsigned* st) {
    XcdBarrier b; b.bar = bar; b.x = xb_xcc_id(); b.st = st;
    if (threadIdx.x == 0) (void)xb_add(&bar[XB_XCNT(b.x)], 1u);
    return b;
}
__device__ __forceinline__ void xcd_barrier_complete(unsigned* bar, unsigned x, unsigned& nloc, unsigned& nx) {
    const unsigned G = gridDim.x * gridDim.y * gridDim.z;
    unsigned sum, cnt, mine, sp = 0u;
    for (;;) {
        sum = 0u; cnt = 0u; mine = 0u;
#pragma unroll
        for (unsigned j = 0; j < 16; ++j) { const unsigned c = xb_ld(&bar[XB_XCNT(j)]); sum += c; cnt += (c > 0u) ? 1u : 0u; mine = (j == x) ? c : mine; }
        if (sum == G) break;
        __builtin_amdgcn_s_sleep(1);
        if ((++sp & 255u) == 0u) { if (xb_ld(&bar[XB_TMO])) break; if (sp > XB_SPIN_CAP) { atomicAdd(&bar[XB_TMO], 1u); break; } }
    }
    nloc = mine > 0u ? mine : 1u; nx = cnt > 0u ? cnt : 1u;
}

__device__ __forceinline__ void xcd_barrier(const XcdBarrier& b) {
    asm volatile("s_waitcnt vmcnt(0)" ::: "memory");
    __syncthreads();
    if (threadIdx.x == 0) {
        unsigned* bar = b.bar;
        __builtin_amdgcn_s_waitcnt(0);
        unsigned nloc = b.st[0], nx = b.st[1];
        if (nloc == 0u) { xcd_barrier_complete(bar, b.x, nloc, nx); b.st[0] = nloc; b.st[1] = nx; }
        const unsigned old = xb_add(&bar[XB_XSUB(b.x)], 1u);
        const unsigned gen = old / nloc;
        if (old + 1u == (gen + 1u) * nloc) {
            __builtin_amdgcn_fence(__ATOMIC_RELEASE, "agent");
            asm volatile("s_waitcnt vmcnt(0)" ::: "memory");
            const unsigned og = xb_add(&bar[XB_TOP], 1u);
            const unsigned tg = og / nx;
            if (og + 1u == (tg + 1u) * nx) xb_add(&bar[XB_TOPGEN], 1u);
            else XB_SPIN(xb_ld(&bar[XB_TOPGEN]) == tg, bar);
            __builtin_amdgcn_fence(__ATOMIC_ACQUIRE, "agent");
            xb_add(&bar[XB_XGEN(b.x)], 1u);
            asm volatile("s_waitcnt vmcnt(0)" ::: "memory");
        } else {
            XB_SPIN(xb_ld(&bar[XB_XGEN(b.x)]) == gen, bar);
            __builtin_amdgcn_fence(__ATOMIC_ACQUIRE, "agent");
            asm volatile("s_waitcnt vmcnt(0)" ::: "memory");
        }
    }
    __syncthreads();
}


struct Args { const float* in[17]; float* out; unsigned char* ws; int ph_lo, ph_hi, li, pad; };

__device__ __forceinline__ void p0_transpose_item(const float* W, int K, int N, bf16_t* WT, LAS float* scr, int item, int lane) {
    const int nblk = N / 32, kb = item / nblk, nb = item % nblk, k0 = 64 * kb, n0 = 32 * nb;
#pragma unroll 8
    for (int i = 0; i < 32; ++i) { const int kk = 2 * i + (lane >> 5); scr[kk * 33 + (lane & 31)] = W[(size_t)(k0 + kk) * N + n0 + (lane & 31)]; }
    LDS_WAIT(); asm volatile("" ::: "memory");
    const int c = lane & 7;
#pragma unroll
    for (int j = 0; j < 4; ++j) { const int n = (lane >> 3) + 8 * j; const LAS float* s = scr + (8 * c) * 33 + n;
        u32x4 o; o.x = pk2(s[0 * 33], s[1 * 33]); o.y = pk2(s[2 * 33], s[3 * 33]); o.z = pk2(s[4 * 33], s[5 * 33]); o.w = pk2(s[6 * 33], s[7 * 33]);
        *(GAS u32x4*)(WT + (size_t)(n0 + n) * K + k0 + 8 * c) = o; }
    LDS_WAIT(); asm volatile("" ::: "memory");
}
__device__ __forceinline__ void phase_prologue(const Args& A, LAS unsigned char* lds, int gw, int NGW, int lane, int wave) {
    unsigned char* ws = A.ws;
    LAS float* scr = (LAS float*)(lds + wave * 16384);
    constexpr int I_IN = (DM / 64) * (INW / 32), I_BS = (SBW / 64) * (DM / 32), I_WO = (DM / 64) * (DM / 32), I_RW = (DM / 64) * (NEXP / 32);
    constexpr int I_UP1 = (DM / 64) * (UPW / 32), I_DN1 = (DFF / 64) * (DM / 32), I_UP = NEXP * I_UP1, I_DN = NEXP * I_DN1;
    constexpr int NITEMS = I_IN + 2 * I_BS + I_WO + I_RW + I_UP + I_DN;
    for (int it = gw; it < NITEMS; it += NGW) {
        int r = it;
        if (r < I_IN) { p0_transpose_item(A.in[1], DM, INW, (bf16_t*)(ws + WS_WINT), scr, r, lane); continue; } r -= I_IN;
        if (r < I_BS) { p0_transpose_item(A.in[4], SBW, DM, (bf16_t*)(ws + WS_WBST), scr, r, lane); continue; } r -= I_BS;
        if (r < I_BS) { p0_transpose_item(A.in[5], HGW, DM, (bf16_t*)(ws + WS_WBHT), scr, r, lane); continue; } r -= I_BS;
        if (r < I_WO) { p0_transpose_item(A.in[6], DM, DM, (bf16_t*)(ws + WS_WOT), scr, r, lane); continue; } r -= I_WO;
        if (r < I_RW) { p0_transpose_item(A.in[9], DM, NEXP, (bf16_t*)(ws + WS_RWT), scr, r, lane); continue; } r -= I_RW;
        if (r < I_UP) { const int e = r / I_UP1; p0_transpose_item(A.in[11] + (size_t)e * DM * UPW, DM, UPW, (bf16_t*)(ws + WS_WUPT) + (size_t)e * DM * UPW, scr, r % I_UP1, lane); continue; } r -= I_UP;
        { const int e = r / I_DN1; p0_transpose_item(A.in[13] + (size_t)e * DFF * DM, DFF, DM, (bf16_t*)(ws + WS_WDNT) + (size_t)e * DFF * DM, scr, r % I_DN1, lane); }
    }
    bf16_t* XB = (bf16_t*)(ws + WS_XB);
    for (int m = gw; m < NTOK; m += NGW) {
        const GAS f32x4* xr = (const GAS f32x4*)(A.in[0] + (size_t)m * DM) + lane; GAS u32x2* o8 = (GAS u32x2*)(XB + (size_t)m * DM) + lane;
#pragma unroll
        for (int j = 0; j < 4; ++j) { const f32x4 v = xr[64 * j]; u32x2 w; w.x = pk2(v[0], v[1]); w.y = pk2(v[2], v[3]); o8[64 * j] = w; }
    }
    if (gw < 8) { const int c = gw * 64 + lane; const float l0 = A.in[2][c], l1 = A.in[2][HGW + c]; ((float*)(ws + WS_LB))[c] = 1.0f / (1.0f + expf(l1 - l0)); }
}

__device__ __forceinline__ void attn_naive_unit(const bf16_t* __restrict__ Q, const bf16_t* __restrict__ K, const bf16_t* __restrict__ V, bf16_t* __restrict__ O, int bh, int qb, int lane) {
    const int b = bh >> 3, h = bh & 7, t = qb * 64 + lane; const size_t rowbase = (size_t)b * SEQ;
    float q[64], o[64];
    { const bf16_t* qp = Q + (rowbase + t) * SBW + h * SBD;
#pragma unroll
      for (int d = 0; d < 64; ++d) { q[d] = bf2f(qp[d]); o[d] = 0.f; } }
    float R = 1.0f;
    for (int s = qb * 64 + 63; s >= 0; --s) {
        const bf16_t* kr = K + (rowbase + s) * SBW + h * SBD; const bf16_t* vr = V + (rowbase + s) * SBW + h * SBD;
        float z = 0.f;
#pragma unroll
        for (int d = 0; d < 64; ++d) z += q[d] * bf2f(kr[d]);
        const bool valid = s < t;
        const float ez = expf(fminf(z, 60.0f)), keep = 1.0f / (1.0f + ez);
        const float a = valid ? ez * keep * R : 0.f;
        R = valid ? R * keep : R;
#pragma unroll
        for (int d = 0; d < 64; ++d) o[d] += a * bf2f(vr[d]);
    }
    bf16_t* op = O + (rowbase + t) * SBW + h * SBD;
#pragma unroll
    for (int d = 0; d < 64; ++d) op[d] = (bf16_t)f2bf(o[d]);
}
__device__ __forceinline__ void hgrn_naive_block(const bf16_t* __restrict__ HQ, const bf16_t* __restrict__ HK, const float* __restrict__ LOGF, const bf16_t* __restrict__ HV, float* __restrict__ ORAW,
                                                 LAS unsigned char* lds, int blk, int tid) {
    const int grp = tid >> 7, v = tid & 127, bh = blk * 4 + grp, b = bh >> 2, hh = bh & 3;
    LAS float* sf = (LAS float*)lds + grp * 384; LAS float* sk = sf + 128; LAS float* sq = sf + 256;
    float S[128];
#pragma unroll
    for (int k = 0; k < 128; ++k) S[k] = 0.f;
    for (int t = 0; t < SEQ; ++t) {
        const size_t base = ((size_t)b * SEQ + t) * HGW + hh * HGD;
        sf[v] = expf(LOGF[base + v]); sk[v] = bf2f(HK[base + v]); sq[v] = bf2f(HQ[base + v]);
        const float vv = bf2f(HV[base + v]);
        __syncthreads();
        float o = 0.f;
#pragma unroll
        for (int k = 0; k < 128; ++k) { S[k] = sf[k] * S[k] + sk[k] * vv; o += sq[k] * S[k]; }
        ORAW[base + v] = o;
        __syncthreads();
    }
}
__device__ __forceinline__ void hgrn_post_item(const float* __restrict__ ORAW, const bf16_t* __restrict__ HG, const float* __restrict__ norm_g, bf16_t* __restrict__ OHG, int item, int lane) {
    const size_t base = (size_t)item * HGD; const int c0 = (item & 3) * HGD;
    const float x0 = ORAW[base + lane], x1 = ORAW[base + 64 + lane];
    const float r = 1.0f / sqrtf(wave_sum(x0 * x0 + x1 * x1) * (1.0f / HGD) + RMS_EPS);
    OHG[base + lane] = (bf16_t)f2bf(x0 * r * norm_g[c0 + lane] * bf2f(HG[base + lane]));
    OHG[base + 64 + lane] = (bf16_t)f2bf(x1 * r * norm_g[c0 + 64 + lane] * bf2f(HG[base + 64 + lane]));
}

__device__ __forceinline__ int crow(int r, int hi) { return (r & 3) + 8 * (r >> 2) + 4 * hi; }
typedef short v4i16_t __attribute__((ext_vector_type(4)));
__device__ __forceinline__ v4i16_t tr16(LAS const unsigned char* p) { return __builtin_amdgcn_ds_read_tr16_b64_v4i16((LAS v4i16_t*)p); }
__device__ __forceinline__ bf16x8 cat8(v4i16_t lo, v4i16_t hi) { return (bf16x8){lo[0], lo[1], lo[2], lo[3], hi[0], hi[1], hi[2], hi[3]}; }
__device__ __forceinline__ bf16x8 pack8(const f32x16& p, int base) {
    u32x4 w; w.x = pg8::cvt_pk_bf16(p[base + 0], p[base + 1]); w.y = pg8::cvt_pk_bf16(p[base + 2], p[base + 3]); w.z = pg8::cvt_pk_bf16(p[base + 4], p[base + 5]); w.w = pg8::cvt_pk_bf16(p[base + 6], p[base + 7]);
    return __builtin_bit_cast(bf16x8, w);
}
__device__ __forceinline__ float xhalf(float v) {
    auto rr = __builtin_amdgcn_permlane32_swap(__float_as_uint(v), __float_as_uint(v), false, false);
    return __uint_as_float((threadIdx.x & 32) ? rr[0] : rr[1]);
}
#define WAIT_ALL_BAR() asm volatile("s_waitcnt vmcnt(0) lgkmcnt(0)\n\ts_barrier" ::: "memory")

constexpr int AT_K = 0, AT_V = 16384, AT_OST = 32768, AT_Q = 65536;
__device__ __forceinline__ void attn_unit(const bf16_t* Q, const bf16_t* K, const bf16_t* V, bf16_t* O, int bh, int qb, LAS unsigned char* lds, int lane, int wid) {
    const int b = bh >> 3, h = bh & 7, r32 = lane & 31, hi = lane >> 5;
    const size_t rowbase = (size_t)b * SEQ; const int q0 = qb * 256, qw0 = q0 + wid * 32;
    bf16x8 qr[4];
    { const bf16_t* qp = Q + (rowbase + qw0 + r32) * SBW + h * SBD + hi * 8;
#pragma unroll
      for (int d0 = 0; d0 < 4; ++d0) qr[d0] = *(const bf16x8*)(qp + d0 * 16); }
    f32x16 o0 = {}, o1 = {}; float R = 1.0f;
    const int NT = 4 * qb + 4;
    const bf16_t* ksrc = K + (rowbase + lane) * SBW + h * SBD + wid * 8;
    const bf16_t* vsrc = V + (rowbase + 16 * (wid & 3) + (lane >> 2)) * SBW + h * SBD + (wid >> 2) * 32 + (lane & 3) * 8;
    LAS unsigned char* kdst = lds + AT_K + wid * 1024; LAS unsigned char* vdst = lds + AT_V + wid * 1024;
    const int vb = ((lane >> 4) & 1) * 32 + (lane & 3) * 8 + (4 * hi + ((lane & 15) >> 2)) * 64;
    { const size_t go = (size_t)(NT - 1) * 64 * SBW;
      __builtin_amdgcn_global_load_lds((const unsigned*)(ksrc + go), (LAS unsigned*)kdst, 16, 0, 0);
      __builtin_amdgcn_global_load_lds((const unsigned*)(vsrc + go), (LAS unsigned*)vdst, 16, 0, 0); }
    for (int it = 0; it < NT; ++it) {
        const int kt = NT - 1 - it, slot = (it & 1) * 8192, k0 = kt * 64;
        WAIT_ALL_BAR();
        if (it + 1 < NT) { const size_t go = (size_t)(kt - 1) * 64 * SBW;
            __builtin_amdgcn_global_load_lds((const unsigned*)(ksrc + go), (LAS unsigned*)(kdst + (slot ^ 8192)), 16, 0, 0);
            __builtin_amdgcn_global_load_lds((const unsigned*)(vsrc + go), (LAS unsigned*)(vdst + (slot ^ 8192)), 16, 0, 0); }
        if (k0 < qw0 + 31) {
            f32x16 p0 = {}, p1 = {};
            const LAS unsigned char* kb = lds + AT_K + slot + hi * 1024 + r32 * 16;
#pragma unroll
            for (int d0 = 0; d0 < 4; ++d0) {
                const bf16x8 a0 = *(const LAS bf16x8*)(kb + d0 * 2048), a1 = *(const LAS bf16x8*)(kb + d0 * 2048 + 512);
                p0 = __builtin_amdgcn_mfma_f32_32x32x16_bf16(a0, qr[d0], p0, 0, 0, 0);
                p1 = __builtin_amdgcn_mfma_f32_32x32x16_bf16(a1, qr[d0], p1, 0, 0, 0);
            }
            const int tq = qw0 + r32 - k0 - 4 * hi;
#pragma unroll
            for (int r = 0; r < 16; ++r) {
                const int kv = (r & 3) + 8 * (r >> 2);
                float k0v = __builtin_amdgcn_rcpf(1.0f + __builtin_amdgcn_exp2f(p0[r] * LOG2E)), k1v = __builtin_amdgcn_rcpf(1.0f + __builtin_amdgcn_exp2f(p1[r] * LOG2E));
                p0[r] = (kv >= tq) ? 1.0f : k0v; p1[r] = (kv + 32 >= tq) ? 1.0f : k1v;
            }
            float gm[8], gp[8];
#pragma unroll
            for (int i = 0; i < 4; ++i) { gm[i] = (p0[4 * i] * p0[4 * i + 1]) * (p0[4 * i + 2] * p0[4 * i + 3]); gm[4 + i] = (p1[4 * i] * p1[4 * i + 1]) * (p1[4 * i + 2] * p1[4 * i + 3]); }
#pragma unroll
            for (int i = 0; i < 8; ++i) gp[i] = xhalf(gm[i]);
            float run = R, E[8];
#pragma unroll
            for (int i = 7; i >= 0; --i) {
                const float pre = hi ? 1.0f : gp[i], post = hi ? gp[i] : 1.0f;
                run *= pre; E[i] = run; run *= gm[i]; run *= post;
            }
            R = run;
#pragma unroll
            for (int i = 0; i < 4; ++i) {
                { float X = E[i];
#pragma unroll
                  for (int j = 3; j >= 0; --j) { const float s = p0[4 * i + j] * X; p0[4 * i + j] = X - s; X = s; } }
                { float X = E[4 + i];
#pragma unroll
                  for (int j = 3; j >= 0; --j) { const float s = p1[4 * i + j] * X; p1[4 * i + j] = X - s; X = s; } }
            }
            const bf16x8 pa0 = pack8(p0, 0), pa1 = pack8(p0, 8), pa2 = pack8(p1, 0), pa3 = pack8(p1, 8);
            const LAS unsigned char* vp = lds + AT_V + slot + vb;
#pragma unroll
            for (int d0 = 0; d0 < 2; ++d0) {
                f32x16 acc = d0 ? o1 : o0;
                acc = __builtin_amdgcn_mfma_f32_32x32x16_bf16(pa0, cat8(tr16(vp + d0 * 4096), tr16(vp + d0 * 4096 + 512)), acc, 0, 0, 0);
                acc = __builtin_amdgcn_mfma_f32_32x32x16_bf16(pa1, cat8(tr16(vp + d0 * 4096 + 1024), tr16(vp + d0 * 4096 + 1024 + 512)), acc, 0, 0, 0);
                acc = __builtin_amdgcn_mfma_f32_32x32x16_bf16(pa2, cat8(tr16(vp + d0 * 4096 + 2048), tr16(vp + d0 * 4096 + 2048 + 512)), acc, 0, 0, 0);
                acc = __builtin_amdgcn_mfma_f32_32x32x16_bf16(pa3, cat8(tr16(vp + d0 * 4096 + 3072), tr16(vp + d0 * 4096 + 3072 + 512)), acc, 0, 0, 0);
                if (d0) o1 = acc; else o0 = acc;
            }
        }
    }
    { LAS unsigned short* stg = (LAS unsigned short*)(lds + AT_OST + wid * 4096);
#pragma unroll
      for (int r = 0; r < 16; ++r) { const int orow = crow(r, hi); stg[orow * 64 + r32] = (unsigned short)f2bf(o0[r]); stg[orow * 64 + 32 + r32] = (unsigned short)f2bf(o1[r]); }
      LDS_WAIT();
      bf16_t* Ow = O + (rowbase + qw0) * SBW + h * SBD;
#pragma unroll
      for (int i = 0; i < 4; ++i) { const int row = i * 8 + (lane >> 3), ch = lane & 7; const u32x4 v = *(const LAS u32x4*)((LAS unsigned char*)stg + row * 128 + ch * 16); *(u32x4*)(Ow + (size_t)row * SBW + ch * 8) = v; } }
}

constexpr int HP_RD = 272, HP_TR = 320;
constexpr int HL_QT = 0, HL_KH = HL_QT + 64 * HP_RD, HL_KD = HL_KH + 64 * HP_RD, HL_VT = HL_KD + 64 * HP_TR, HL_SB = HL_VT + 64 * HP_TR, HL_DEC = HL_SB + 128 * HP_TR, HL_SEG = HL_DEC + 512, HL_END = HL_SEG + 4 * 128 * 4;
static_assert(HL_END <= LDS_SCRATCH, "HGRN LDS map");
__device__ __forceinline__ void hgrn_unit(const bf16_t* HQ, const bf16_t* HK, const float* LOGF, const bf16_t* HV, float* ORAW, int bh, LAS unsigned char* lds, int tid, int lane, int wid) {
    const int b = bh >> 2, hh = bh & 3, r32 = lane & 31, hi = lane >> 5, tb = wid >> 2, vj = wid & 3;
    const size_t row0 = (size_t)b * SEQ; const int cb = hh * HGD;
    const int kc = tid & 127, seg = tid >> 7;
    const int vr = tid >> 3, vp8 = tid & 7;
    for (int i = tid; i < 128 * HP_TR / 16; i += NTHREADS) *(LAS u32x4*)(lds + HL_SB + i * 16) = (u32x4){0u, 0u, 0u, 0u};
    f32x16 S0 = {}, S1 = {};
    float lf[16]; unsigned short qv[16], kv[16]; u32x4 vv0, vv1;
#define HG_LOAD(c) do { const size_t base_ = (row0 + (size_t)(c) * 64 + 16 * seg) * HGW + cb + kc; \
        _Pragma("unroll") for (int i = 0; i < 16; ++i) { lf[i] = LOGF[base_ + (size_t)i * HGW]; qv[i] = HQ[base_ + (size_t)i * HGW]; kv[i] = HK[base_ + (size_t)i * HGW]; } \
        const bf16_t* vsrc_ = HV + (row0 + (size_t)(c) * 64 + vr) * HGW + cb + vp8 * 16; vv0 = *(const u32x4*)vsrc_; vv1 = *(const u32x4*)(vsrc_ + 8); } while (0)
    HG_LOAD(0);
    for (int c = 0; c < SEQ / 64; ++c) {
        float cs[16]; { float a = 0.f;
#pragma unroll
            for (int i = 0; i < 16; ++i) { a += lf[i]; cs[i] = a; } }
        ((LAS float*)(lds + HL_SEG))[seg * 128 + kc] = cs[15];
        *(LAS u32x4*)(lds + HL_VT + vr * HP_TR + vp8 * 32) = vv0; *(LAS u32x4*)(lds + HL_VT + vr * HP_TR + vp8 * 32 + 16) = vv1;
        __syncthreads();
        { const LAS float* sg = (const LAS float*)(lds + HL_SEG); const float t0 = sg[kc], t1 = sg[128 + kc], t2 = sg[256 + kc], t3 = sg[384 + kc];
          const float pre = (seg > 0 ? t0 : 0.f) + (seg > 1 ? t1 : 0.f) + (seg > 2 ? t2 : 0.f), bl = (t0 + t1) + (t2 + t3);
          if (seg == 0) ((LAS float*)(lds + HL_DEC))[kc] = __builtin_amdgcn_exp2f(bl * LOG2E);
#pragma unroll
          for (int i = 0; i < 16; ++i) { const float bb = (pre + cs[i]) * LOG2E, q = bf2f(qv[i]), k = bf2f(kv[i]); const int t = 16 * seg + i;
              *(LAS unsigned short*)(lds + HL_QT + t * HP_RD + kc * 2) = (unsigned short)f2bf(q * __builtin_amdgcn_exp2f(fmaxf(bb, -120.f)));
              *(LAS unsigned short*)(lds + HL_KH + t * HP_RD + kc * 2) = (unsigned short)f2bf(k * __builtin_amdgcn_exp2f(fminf(-bb, 120.f)));
              *(LAS unsigned short*)(lds + HL_KD + t * HP_TR + kc * 2) = (unsigned short)f2bf(k * __builtin_amdgcn_exp2f(bl * LOG2E - bb)); } }
        if (c + 1 < SEQ / 64) HG_LOAD(c + 1);
        __syncthreads();
        f32x16 oacc = {};
        bf16x8 pa[2][2];
#pragma unroll
        for (int a = 0; a < 2; ++a) if (a <= tb) {
            f32x16 x = {};
#pragma unroll
            for (int ks = 0; ks < 8; ++ks) {
                const bf16x8 af = *(const LAS bf16x8*)(lds + HL_KH + (32 * a + r32) * HP_RD + (16 * ks + 8 * hi) * 2);
                const bf16x8 bfr = *(const LAS bf16x8*)(lds + HL_QT + (32 * tb + r32) * HP_RD + (16 * ks + 8 * hi) * 2);
                x = __builtin_amdgcn_mfma_f32_32x32x16_bf16(af, bfr, x, 0, 0, 0);
            }
            if (a == tb) {
#pragma unroll
                for (int r = 0; r < 16; ++r) if (crow(r, hi) > r32) x[r] = 0.f;
            }
            pa[a][0] = pack8(x, 0); pa[a][1] = pack8(x, 8);
        }
#pragma unroll
        for (int ks = 0; ks < 8; ++ks) {
            const bf16x8 af = *(const LAS bf16x8*)(lds + HL_QT + (32 * tb + r32) * HP_RD + (16 * ks + 8 * hi) * 2);
            const LAS unsigned char* sp = lds + HL_SB + (16 * ks + 8 * hi + ((lane & 15) >> 2)) * HP_TR + (32 * vj + 16 * ((lane >> 4) & 1) + 4 * (lane & 3)) * 2;
            oacc = __builtin_amdgcn_mfma_f32_32x32x16_bf16(af, cat8(tr16(sp), tr16(sp + 4 * HP_TR)), oacc, 0, 0, 0);
        }
#pragma unroll
        for (int a = 0; a < 2; ++a) if (a <= tb) {
#pragma unroll
            for (int s2 = 0; s2 < 2; ++s2) {
                const LAS unsigned char* vp = lds + HL_VT + (32 * a + 16 * s2 + 4 * hi + ((lane & 15) >> 2)) * HP_TR + (32 * vj + 16 * ((lane >> 4) & 1) + 4 * (lane & 3)) * 2;
                oacc = __builtin_amdgcn_mfma_f32_32x32x16_bf16(pa[a][s2], cat8(tr16(vp), tr16(vp + 8 * HP_TR)), oacc, 0, 0, 0);
            }
        }
#pragma unroll
        for (int u = 0; u < 2; ++u) {
            f32x16 Sx = u ? S1 : S0; const int kt = 2 * tb + u;
            const LAS float* dec = (const LAS float*)(lds + HL_DEC) + 32 * kt;
#pragma unroll
            for (int r = 0; r < 16; ++r) Sx[r] *= dec[crow(r, hi)];
#pragma unroll
            for (int ks = 0; ks < 4; ++ks) {
                const int srow = 16 * ks + 8 * hi + ((lane & 15) >> 2), cq = 16 * ((lane >> 4) & 1) + 4 * (lane & 3);
                const LAS unsigned char* ap = lds + HL_KD + srow * HP_TR + (32 * kt + cq) * 2;
                const LAS unsigned char* bp = lds + HL_VT + srow * HP_TR + (32 * vj + cq) * 2;
                Sx = __builtin_amdgcn_mfma_f32_32x32x16_bf16(cat8(tr16(ap), tr16(ap + 4 * HP_TR)), cat8(tr16(bp), tr16(bp + 4 * HP_TR)), Sx, 0, 0, 0);
            }
            if (u) S1 = Sx; else S0 = Sx;
        }
        { float* op = ORAW + (row0 + (size_t)c * 64 + 32 * tb) * HGW + cb + 32 * vj + r32;
#pragma unroll
          for (int r = 0; r < 16; ++r) op[(size_t)crow(r, hi) * HGW] = oacc[r]; }
        __syncthreads();
#pragma unroll
        for (int u = 0; u < 2; ++u) { const f32x16 Sx = u ? S1 : S0; const int kt = 2 * tb + u;
#pragma unroll
            for (int r = 0; r < 16; ++r) *(LAS unsigned short*)(lds + HL_SB + (32 * kt + crow(r, hi)) * HP_TR + (32 * vj + r32) * 2) = (unsigned short)f2bf(Sx[r]); }
    }
#undef HG_LOAD
    __syncthreads();
}

constexpr int TROW = 2064;
constexpr int L_TILE = 0, L_LOGITS = 64 * TROW, L_TOPI = L_LOGITS + 64 * 32 * 4, L_HIST = L_TOPI + 1024, L_SLOT = L_HIST + 128, L_TOT = L_SLOT + 1024, L_BEF = L_TOT + 128, L_PAD = L_BEF + 128, L_PART = L_PAD + 256, L_END5 = L_PART + 2 * 16 * 32 * 4;
static_assert(L_END5 <= LDS_SCRATCH, "P5/P6 LDS map");
__device__ __forceinline__ void phase_ln1_router(const Args& A, LAS unsigned char* lds, int vb, int tid, int lane, int wave) {
    unsigned char* ws = A.ws;
    const float* PRE = (const float*)(ws + WS_PRE); float* H = (float*)(ws + WS_H); const float* g = A.in[7]; const float* bta = A.in[8];
    LAS int* HIST = (LAS int*)(lds + L_HIST);
    if (tid < NEXP) HIST[tid] = 0;
    for (int rr = 0; rr < 8; ++rr) {
        const int rl = wave * 8 + rr, row = vb * 64 + rl;
        f32x4 v[4]; float s = 0.f;
#pragma unroll
        for (int j = 0; j < 4; ++j) { v[j] = *(const f32x4*)(PRE + (size_t)row * DM + lane * 4 + 256 * j); s += (v[j][0] + v[j][1]) + (v[j][2] + v[j][3]); }
        const float mean = wave_sum(s) * (1.0f / DM); float s2 = 0.f;
#pragma unroll
        for (int j = 0; j < 4; ++j) { v[j] = v[j] - mean; s2 += (v[j][0] * v[j][0] + v[j][1] * v[j][1]) + (v[j][2] * v[j][2] + v[j][3] * v[j][3]); }
        const float rstd = 1.0f / sqrtf(wave_sum(s2) * (1.0f / DM) + LN_EPS);
#pragma unroll
        for (int j = 0; j < 4; ++j) { const int c = lane * 4 + 256 * j; const f32x4 hv = v[j] * rstd * *(const f32x4*)(g + c) + *(const f32x4*)(bta + c);
            *(f32x4*)(H + (size_t)row * DM + c) = hv;
            u32x2 w; w.x = pk2(hv[0], hv[1]); w.y = pk2(hv[2], hv[3]); *(LAS u32x2*)(lds + L_TILE + rl * TROW + c * 2) = w; }
    }
    __syncthreads();
    {
        const int rt = wave & 1, kq = wave >> 1, r = lane & 31, hh = lane >> 5;
        const bf16_t* RWT = (const bf16_t*)(ws + WS_RWT);
        f32x16 acc = {};
#pragma unroll 4
        for (int ks = 0; ks < 16; ++ks) {
            const int k = 256 * kq + 16 * ks + 8 * hh;
            const bf16x8 af = *(const LAS bf16x8*)(lds + L_TILE + (32 * rt + r) * TROW + k * 2);
            const bf16x8 bf = *(const bf16x8*)(RWT + (size_t)r * DM + k);
            acc = __builtin_amdgcn_mfma_f32_32x32x16_bf16(af, bf, acc, 0, 0, 0);
        }
        LAS float* LG = (LAS float*)(lds + L_LOGITS);
        for (int q = 0; q < 4; ++q) {
            if (kq == q) {
#pragma unroll
                for (int i = 0; i < 16; ++i) { const int rowl = 32 * rt + (i & 3) + 8 * (i >> 2) + 4 * hh; LAS float* p = LG + rowl * 32 + r; if (q == 0) *p = acc[i]; else *p += acc[i]; }
            }
            __syncthreads();
        }
    }
    {
        const float* rb = A.in[10]; float* TOPG = (float*)(ws + WS_TOPG); LAS int* TOPI = (LAS int*)(lds + L_TOPI); const LAS float* LG = (const LAS float*)(lds + L_LOGITS);
        const int e = lane & 31, half = lane >> 5;
        for (int it = 0; it < 4; ++it) {
            const int rl = wave * 8 + it * 2 + half;
            float val = LG[rl * 32 + e] + rb[e]; int idx = e; float tv[4]; int ti[4];
#pragma unroll
            for (int rnk = 0; rnk < 4; ++rnk) {
                float bv = val; int bi = idx;
#pragma unroll
                for (int off = 16; off >= 1; off >>= 1) { const float ov = __shfl_xor(bv, off); const int oi = __shfl_xor(bi, off); if (ov > bv || (ov == bv && oi < bi)) { bv = ov; bi = oi; } }
                tv[rnk] = bv; ti[rnk] = bi; if (e == bi) val = -INFINITY;
            }
            if (e == 0) {
                const float e1 = expf(tv[1] - tv[0]), e2 = expf(tv[2] - tv[0]), e3 = expf(tv[3] - tv[0]), inv = 1.0f / (1.0f + e1 + e2 + e3);
                *(float4*)(TOPG + (size_t)(vb * 64 + rl) * 4) = make_float4(inv, e1 * inv, e2 * inv, e3 * inv);
#pragma unroll
                for (int k = 0; k < 4; ++k) { TOPI[rl * 4 + k] = ti[k]; __hip_atomic_fetch_add(&HIST[ti[k]], 1, __ATOMIC_RELAXED, __HIP_MEMORY_SCOPE_WORKGROUP); }
            }
        }
    }
    __syncthreads();
    if (tid < NEXP) ((int*)(ws + WS_CNTM))[vb * NEXP + tid] = HIST[tid];
}
__device__ __forceinline__ void phase_assign(const Args& A, LAS unsigned char* lds, int vb, int G, int tid, int lane, int wave) {
    unsigned char* ws = A.ws; const int* CNTM = (const int*)(ws + WS_CNTM); int* ctl = (int*)(ws + WS_CTL);
    LAS int* PART = (LAS int*)(lds + L_PART); LAS int* TOT = (LAS int*)(lds + L_TOT); LAS int* BEF = (LAS int*)(lds + L_BEF); LAS int* PAD = (LAS int*)(lds + L_PAD);
    LAS int* TOPI = (LAS int*)(lds + L_TOPI); LAS int* SLOT = (LAS int*)(lds + L_SLOT);
    { const int e = tid & 31, part = tid >> 5; int tot = 0, bef = 0;
      for (int b2 = part * 16; b2 < part * 16 + 16; ++b2) { const int c = (b2 < G) ? CNTM[b2 * NEXP + e] : 0; tot += c; if (b2 < vb) bef += c; }
      PART[part * 32 + e] = tot; PART[512 + part * 32 + e] = bef; }
    __syncthreads();
    if (tid < NEXP) { int tot = 0, bef = 0;
#pragma unroll
        for (int p = 0; p < 16; ++p) { tot += PART[p * 32 + tid]; bef += PART[512 + p * 32 + tid]; }
        TOT[tid] = tot; BEF[tid] = bef; }
    __syncthreads();
    if (tid == 0) { int ps = 0, nt = 0;
        for (int e = 0; e < NEXP; ++e) { PAD[e] = ps; const int te = (TOT[e] + SLOT_PAD - 1) / SLOT_PAD; if (vb == 0) for (int i = 0; i < te; ++i) ctl[CW_TILEEXP + nt + i] = e; nt += te; ps += te * SLOT_PAD; }
        if (vb == 0) ctl[CW_NTILES] = nt; }
    __syncthreads();
    if (tid < 256) { const int e = TOPI[tid]; int rank = 0; for (int j = 0; j < tid; ++j) rank += (TOPI[j] == e) ? 1 : 0;
        const int slot = PAD[e] + BEF[e] + rank; SLOT[tid] = slot; ((int*)(ws + WS_DEST))[vb * 256 + tid] = slot; }
    __syncthreads();
    bf16_t* XS = (bf16_t*)(ws + WS_XS);
    for (int i = wave * 32; i < wave * 32 + 32; ++i) {
        const int slot = SLOT[i]; const LAS unsigned char* src = lds + L_TILE + (i >> 2) * TROW; unsigned char* dst = (unsigned char*)(XS + (size_t)slot * DM);
        const u32x4 a = *(const LAS u32x4*)(src + lane * 16), b = *(const LAS u32x4*)(src + 1024 + lane * 16);
        *(u32x4*)(dst + lane * 16) = a; *(u32x4*)(dst + 1024 + lane * 16) = b;
    }
}
__device__ __forceinline__ void combine_row(const Args& A, int row, int lane) {
    unsigned char* ws = A.ws; const float* H = (const float*)(ws + WS_H); const bf16_t* Y = (const bf16_t*)(ws + WS_Y);
    const int4 d = *(const int4*)((const int*)(ws + WS_DEST) + row * 4); const float4 gt = *(const float4*)((const float*)(ws + WS_TOPG) + row * 4);
    const int ds[4] = {d.x, d.y, d.z, d.w}; const float gs[4] = {gt.x, gt.y, gt.z, gt.w};
    f32x4 v[4]; float s = 0.f;
#pragma unroll
    for (int j = 0; j < 4; ++j) { const int c = lane * 4 + 256 * j; f32x4 a = *(const f32x4*)(H + (size_t)row * DM + c) * DN_ALPHA;
#pragma unroll
        for (int k = 0; k < 4; ++k) { const u32x2 y = *(const u32x2*)(Y + (size_t)ds[k] * DM + c);
            a[0] += gs[k] * bflo(y.x); a[1] += gs[k] * bfhi(y.x); a[2] += gs[k] * bflo(y.y); a[3] += gs[k] * bfhi(y.y); }
        v[j] = a; s += (a[0] + a[1]) + (a[2] + a[3]); }
    const float mean = wave_sum(s) * (1.0f / DM); float s2 = 0.f;
#pragma unroll
    for (int j = 0; j < 4; ++j) { v[j] = v[j] - mean; s2 += (v[j][0] * v[j][0] + v[j][1] * v[j][1]) + (v[j][2] * v[j][2] + v[j][3] * v[j][3]); }
    const float rstd = 1.0f / sqrtf(wave_sum(s2) * (1.0f / DM) + LN_EPS);
#pragma unroll
    for (int j = 0; j < 4; ++j) { const int c = lane * 4 + 256 * j; *(f32x4*)(A.out + (size_t)row * DM + c) = v[j] * rstd * *(const f32x4*)(A.in[15] + c) + *(const f32x4*)(A.in[16] + c); }
}

template <int LO, int HI> __global__ void __launch_bounds__(NTHREADS, 2) mk_fwd(Args args) {
    extern __shared__ __attribute__((aligned(16))) unsigned char lds_raw[];
    LAS unsigned char* lds = (LAS unsigned char*)lds_raw;
    volatile LAS unsigned* MISC = (volatile LAS unsigned*)(lds + MISC_OFF);
    const int tid = threadIdx.x, lane = tid & 63, wave = __builtin_amdgcn_readfirstlane(tid >> 6);
    const int G = gridDim.x, bx = blockIdx.x, vcu = (G % 8 == 0) ? (bx % 8) * (G / 8) + bx / 8 : bx;
    const int gw = vcu * NWAVES + wave, NGW = G * NWAVES;
    unsigned char* ws = args.ws;
    for (int u = tid; u < (LDS_BYTES - LDSCTL_OFF) / 4; u += NTHREADS) ((LAS unsigned*)(lds + LDSCTL_OFF))[u] = 0u;
    __syncthreads();
    XcdBarrier bar = xcd_barrier_post((unsigned*)(ws + WS_CTL) + CW_BAR + args.li * XCD_BAR_WORDS, MISC + 8);
#define IN(k) (LO <= (k) && (k) < HI)
#define SEAM(k) do { if constexpr (IN(k) && IN((k) + 1)) xcd_barrier(bar); } while (0)
    InProjOut ip; ip.Q = (bf16_t*)(ws + WS_Q); ip.K = (bf16_t*)(ws + WS_K); ip.V = (bf16_t*)(ws + WS_V); ip.HQ = (bf16_t*)(ws + WS_HQ); ip.HK = (bf16_t*)(ws + WS_HK); ip.HV = (bf16_t*)(ws + WS_HV);
    ip.HG = (bf16_t*)(ws + WS_HG); ip.GS = (bf16_t*)(ws + WS_GS); ip.GH = (bf16_t*)(ws + WS_GH); ip.LOGF = (float*)(ws + WS_LOGF); ip.lb = (const float*)(ws + WS_LB);

    if constexpr (IN(0)) phase_prologue(args, lds, gw, NGW, lane, wave);
    SEAM(0);
    if constexpr (IN(1)) { pg8::Gemm g{DM}; pg8::DenseSched S; S.o.init(NTOK / 256, INW / 256, G, bx); S.A = (const char*)(ws + WS_XB); S.Bt = (const char*)(ws + WS_WINT); S.tstep = (size_t)256 * DM * 2;
      pg8::EpiInProj E{ip};
      pg8::gemm_phase<pg8::EpiInProj, pg8::DenseSched, MK_P1_ALIGN, MK_P1_SP2>(lds, g, S, E); }
    SEAM(1);
    if constexpr (IN(2)) {
#if MK_NAIVE_MIX
    { const int u = gw; if (u < 2048) attn_naive_unit(ip.Q, ip.K, ip.V, (bf16_t*)(ws + WS_OSB), u & 63, 31 - (u >> 6), lane); }
    __syncthreads();
    if (vcu < 8) hgrn_naive_block(ip.HQ, ip.HK, ip.LOGF, ip.HV, (float*)(ws + WS_ORAW), lds, vcu, tid);
#else
    if (vcu < 32) hgrn_unit(ip.HQ, ip.HK, ip.LOGF, ip.HV, (float*)(ws + WS_ORAW), vcu, lds, tid, lane, wave);
    for (;;) {
        if (tid == 0) *(LAS int*)(lds + AT_Q) = __hip_atomic_fetch_add((int*)(ws + WS_CTL) + CW_ATTNQ, 1, __ATOMIC_RELAXED, __HIP_MEMORY_SCOPE_AGENT);
        __syncthreads();
        const int u = __builtin_amdgcn_readfirstlane(*(LAS int*)(lds + AT_Q));
        __syncthreads();
        if (u >= 512) break;
        attn_unit(ip.Q, ip.K, ip.V, (bf16_t*)(ws + WS_OSB), u & 63, 7 - (u >> 6), lds, lane, wave);
    }
#endif
    }
    SEAM(2);
    if constexpr (IN(3)) for (int it = gw; it < NTOK * HGH; it += NGW) hgrn_post_item((const float*)(ws + WS_ORAW), ip.HG, args.in[3], (bf16_t*)(ws + WS_OHG), it, lane);
    SEAM(3);
    if constexpr (IN(4)) { pg8::Gemm g{SBW}; pg8::BranchSched S; S.o.init(NTOK / 256, DM / 256, G, bx); S.A0 = (const char*)(ws + WS_OSB); S.B0 = (const char*)(ws + WS_WBST); S.A1 = (const char*)(ws + WS_OHG); S.B1 = (const char*)(ws + WS_WBHT); S.tstep = (size_t)256 * SBW * 2;
      pg8::EpiBranch E{ip.GS, ip.GH, (bf16_t*)(ws + WS_MERGED)};
      pg8::gemm_phase<pg8::EpiBranch, pg8::BranchSched, true, true>(lds, g, S, E); }
    SEAM(4);
    if constexpr (IN(5)) { pg8::Gemm g{DM}; pg8::DenseSched S; S.o.init(NTOK / 256, DM / 256, G, bx); S.A = (const char*)(ws + WS_MERGED); S.Bt = (const char*)(ws + WS_WOT); S.tstep = (size_t)256 * DM * 2;
      pg8::EpiOut E{args.in[0], (float*)(ws + WS_PRE)};
      pg8::gemm_phase<pg8::EpiOut, pg8::DenseSched, true, true>(lds, g, S, E); }
    SEAM(5);
    if constexpr (IN(6)) phase_ln1_router(args, lds, bx, tid, lane, wave);
    SEAM(6);
    if constexpr (IN(7)) phase_assign(args, lds, bx, G, tid, lane, wave);
    SEAM(7);
    int ntiles = 0; if constexpr (IN(8) || IN(9)) ntiles = __builtin_amdgcn_readfirstlane(__hip_atomic_load((const int*)(ws + WS_CTL) + CW_NTILES, __ATOMIC_RELAXED, __HIP_MEMORY_SCOPE_AGENT)); const int* tile_exp = (const int*)(ws + WS_CTL) + CW_TILEEXP;
    if constexpr (IN(8)) { pg8::Gemm g{DM}; pg8::MoeSched S; S.o.init(ntiles, UPW / 256, G, bx); S.A = (const char*)(ws + WS_XS); S.W = (const char*)(ws + WS_WUPT); S.tile_exp = tile_exp; S.tstep = (size_t)256 * DM * 2; S.estep = (size_t)UPW * DM * 2;
      pg8::EpiUp E{args.in[12], (bf16_t*)(ws + WS_ACT)};
      pg8::gemm_phase<pg8::EpiUp, pg8::MoeSched, true, true>(lds, g, S, E); }
    SEAM(8);
    if constexpr (IN(9)) { pg8::Gemm g{DFF}; pg8::MoeSched S; S.o.init(ntiles, DM / 256, G, bx); S.A = (const char*)(ws + WS_ACT); S.W = (const char*)(ws + WS_WDNT); S.tile_exp = tile_exp; S.tstep = (size_t)256 * DFF * 2; S.estep = (size_t)DM * DFF * 2;
      pg8::EpiDown E{args.in[14], (bf16_t*)(ws + WS_Y)};
      pg8::gemm_phase<pg8::EpiDown, pg8::MoeSched, true, true>(lds, g, S, E); }
    SEAM(9);
    if constexpr (IN(10)) for (int row = gw; row < NTOK; row += NGW) combine_row(args, row, lane);
}


#if MK_MODE == 2
namespace v1 {
constexpr int CW_CNT = 60000, CW_CUR = 60064, CW_PADSTART = 60128, CW_NTILES = 60192, CW_TILEEXP = 60256;
__device__ __forceinline__ float sigmoidf_(float v) { return 1.0f / (1.0f + expf(-v)); }
__global__ __launch_bounds__(256) void k_transpose_bf16(const float* __restrict__ W, bf16_t* __restrict__ WT, int K, int N) {
    __shared__ float tile[64][65];
    const size_t g = blockIdx.z; W += g * (size_t)K * N; WT += g * (size_t)K * N;
    const int k0 = blockIdx.y * 64, n0 = blockIdx.x * 64, tx = threadIdx.x & 63, ty = threadIdx.x >> 6;
    for (int i = ty; i < 64; i += 4) tile[i][tx] = W[(size_t)(k0 + i) * N + n0 + tx];
    __syncthreads();
    for (int i = ty; i < 64; i += 4) WT[(size_t)(n0 + i) * K + k0 + tx] = (bf16_t)f2bf(tile[tx][i]);
}
__global__ __launch_bounds__(256) void k_convert_x(const float* __restrict__ x, bf16_t* __restrict__ xb, const float* __restrict__ lbl, float* __restrict__ lb) {
    const size_t i = (size_t)blockIdx.x * 256 + threadIdx.x;
    const f32x4 v = ((const f32x4*)x)[i];
    uint2 o; o.x = f2bf(v[0]) | (f2bf(v[1]) << 16); o.y = f2bf(v[2]) | (f2bf(v[3]) << 16);
    ((uint2*)xb)[i] = o;
    if (blockIdx.x == 0) for (int c = threadIdx.x; c < HGW; c += 256) { const float l0 = lbl[c], l1 = lbl[HGW + c]; lb[c] = 1.0f / (1.0f + expf(l1 - l0)); }
}

constexpr int G_BM = 128, G_BK = 32, G_HTB = G_BM * G_BK * 2;
__device__ __forceinline__ void g128_loop(f32x4 (&acc)[4][4], const bf16_t* a0, const bf16_t* a1, const bf16_t* b0, const bf16_t* b1, int K, LAS unsigned char* shm) {
    const int tid = threadIdx.x, wid = tid >> 6, lane = tid & 63, wr = wid >> 1, wc = wid & 1, fr = lane & 15, fq = lane >> 4;
    LAS unsigned char* SA = shm; LAS unsigned char* SB = shm + G_HTB;
    for (int t = 0; t < K / G_BK; ++t) {
        __builtin_amdgcn_global_load_lds((const unsigned*)(a0 + t * G_BK), (LAS unsigned*)(SA + tid * 16), 16, 0, 0);
        __builtin_amdgcn_global_load_lds((const unsigned*)(a1 + t * G_BK), (LAS unsigned*)(SA + tid * 16 + 4096), 16, 0, 0);
        __builtin_amdgcn_global_load_lds((const unsigned*)(b0 + t * G_BK), (LAS unsigned*)(SB + tid * 16), 16, 0, 0);
        __builtin_amdgcn_global_load_lds((const unsigned*)(b1 + t * G_BK), (LAS unsigned*)(SB + tid * 16 + 4096), 16, 0, 0);
        asm volatile("s_waitcnt vmcnt(0)" ::: "memory"); __syncthreads();
        bf16x8 At[4], Bt[4];
#pragma unroll
        for (int m = 0; m < 4; ++m) { At[m] = *(const LAS bf16x8*)(SA + (wr * 64 + m * 16 + fr) * (G_BK * 2) + fq * 16); Bt[m] = *(const LAS bf16x8*)(SB + (wc * 64 + m * 16 + fr) * (G_BK * 2) + fq * 16); }
        asm volatile("s_waitcnt lgkmcnt(0)" ::: "memory"); __builtin_amdgcn_sched_barrier(0);
#pragma unroll
        for (int m = 0; m < 4; ++m)
#pragma unroll
            for (int n = 0; n < 4; ++n) acc[m][n] = __builtin_amdgcn_mfma_f32_16x16x32_bf16(At[m], Bt[n], acc[m][n], 0, 0, 0);
        __syncthreads();
    }
}
#define G128_ZERO(acc) _Pragma("unroll") for (int m_ = 0; m_ < 4; ++m_) _Pragma("unroll") for (int n_ = 0; n_ < 4; ++n_) acc[m_][n_] = (f32x4){0.f, 0.f, 0.f, 0.f}
#define G128_FOREACH(...) do { const int wid_ = threadIdx.x >> 6, lane_ = threadIdx.x & 63, wr_ = wid_ >> 1, wc_ = wid_ & 1, fr_ = lane_ & 15, fq_ = lane_ >> 4; \
    _Pragma("unroll") for (int m_ = 0; m_ < 4; ++m_) _Pragma("unroll") for (int n_ = 0; n_ < 4; ++n_) _Pragma("unroll") for (int j_ = 0; j_ < 4; ++j_) { \
        const int trow = wr_ * 64 + m_ * 16 + fq_ * 4 + j_, tcol = wc_ * 64 + n_ * 16 + fr_; __VA_ARGS__ } } while (0)


__global__ __launch_bounds__(256) void k_inproj(const bf16_t* __restrict__ XB, const bf16_t* __restrict__ WinT, InProjOut o) {
    __shared__ __attribute__((aligned(16))) unsigned char shm[2 * G_HTB];
    const int bcol = blockIdx.x * G_BM, brow = blockIdx.y * G_BM, tid = threadIdx.x, r0 = tid >> 2, c = (tid & 3) * 8;
    f32x4 acc[4][4]; G128_ZERO(acc);
    g128_loop(acc, XB + (size_t)(brow + r0) * DM + c, XB + (size_t)(brow + r0 + 64) * DM + c, WinT + (size_t)(bcol + r0) * DM + c, WinT + (size_t)(bcol + r0 + 64) * DM + c, DM, (LAS unsigned char*)shm);
    const int seg = bcol / 512;
    G128_FOREACH({
        const int row = brow + trow, col = bcol + tcol; const float v = acc[m_][n_][j_];
        if (seg == 0) o.Q[(size_t)row * 512 + col] = (bf16_t)f2bf(v * 0.125f);
        else if (seg == 1) o.K[(size_t)row * 512 + (col - 512)] = (bf16_t)f2bf(v);
        else if (seg == 2) o.V[(size_t)row * 512 + (col - 1024)] = (bf16_t)f2bf(v);
        else if (seg == 3) o.HQ[(size_t)row * 512 + (col - 1536)] = (bf16_t)f2bf(v * sigmoidf_(v));
        else if (seg == 4) { const int cc = col - 2048; const float l = o.lb[cc], f = l + (1.0f - l) * sigmoidf_(v);
            o.HK[(size_t)row * 512 + cc] = (bf16_t)f2bf(1.0f - f); o.LOGF[(size_t)row * 512 + cc] = logf(f); }
        else if (seg == 5) o.HV[(size_t)row * 512 + (col - 2560)] = (bf16_t)f2bf(v);
        else if (seg == 6) o.HG[(size_t)row * 512 + (col - 3072)] = (bf16_t)f2bf(sigmoidf_(v));
        else if (seg < 9) o.GS[(size_t)row * 1024 + (col - 3584)] = (bf16_t)f2bf(sigmoidf_(v));
        else o.GH[(size_t)row * 1024 + (col - 4608)] = (bf16_t)f2bf(sigmoidf_(v));
    });
}

__global__ __launch_bounds__(256) void k_branch(const bf16_t* __restrict__ OSB, const bf16_t* __restrict__ OHG, const bf16_t* __restrict__ WbsT, const bf16_t* __restrict__ WbhT,
                                                const bf16_t* __restrict__ GS, const bf16_t* __restrict__ GH, bf16_t* __restrict__ MERGED) {
    __shared__ __attribute__((aligned(16))) unsigned char shm[2 * G_HTB];
    const int bcol = blockIdx.x * G_BM, brow = blockIdx.y * G_BM, tid = threadIdx.x, r0 = tid >> 2, c = (tid & 3) * 8;
    f32x4 accA[4][4], accB[4][4]; G128_ZERO(accA); G128_ZERO(accB);
    g128_loop(accA, OSB + (size_t)(brow + r0) * SBW + c, OSB + (size_t)(brow + r0 + 64) * SBW + c, WbsT + (size_t)(bcol + r0) * SBW + c, WbsT + (size_t)(bcol + r0 + 64) * SBW + c, SBW, (LAS unsigned char*)shm);
    g128_loop(accB, OHG + (size_t)(brow + r0) * HGW + c, OHG + (size_t)(brow + r0 + 64) * HGW + c, WbhT + (size_t)(bcol + r0) * HGW + c, WbhT + (size_t)(bcol + r0 + 64) * HGW + c, HGW, (LAS unsigned char*)shm);
    G128_FOREACH({
        const size_t idx = (size_t)(brow + trow) * DM + bcol + tcol;
        MERGED[idx] = (bf16_t)f2bf(bf2f(GS[idx]) * accA[m_][n_][j_] + bf2f(GH[idx]) * accB[m_][n_][j_]);
    });
}

__global__ __launch_bounds__(256) void k_outproj(const bf16_t* __restrict__ MERGED, const bf16_t* __restrict__ WoT, const float* __restrict__ x, float* __restrict__ PRE) {
    __shared__ __attribute__((aligned(16))) unsigned char shm[2 * G_HTB];
    const int bcol = blockIdx.x * G_BM, brow = blockIdx.y * G_BM, tid = threadIdx.x, r0 = tid >> 2, c = (tid & 3) * 8;
    f32x4 acc[4][4]; G128_ZERO(acc);
    g128_loop(acc, MERGED + (size_t)(brow + r0) * DM + c, MERGED + (size_t)(brow + r0 + 64) * DM + c, WoT + (size_t)(bcol + r0) * DM + c, WoT + (size_t)(bcol + r0 + 64) * DM + c, DM, (LAS unsigned char*)shm);
    G128_FOREACH({ const size_t idx = (size_t)(brow + trow) * DM + bcol + tcol; PRE[idx] = DN_ALPHA * x[idx] + acc[m_][n_][j_]; });
}

__global__ __launch_bounds__(256) void k_moe_up(const bf16_t* __restrict__ HB, const bf16_t* __restrict__ WupT, const float* __restrict__ b_up, const int* __restrict__ ctl,
                                                const int* __restrict__ slot_tok, bf16_t* __restrict__ ACT) {
    __shared__ __attribute__((aligned(16))) unsigned char shm[2 * G_HTB];
    const int rt = blockIdx.y; if (rt >= 2 * ctl[CW_NTILES]) return;
    const int e = ctl[CW_TILEEXP + (rt >> 1)];
    const int bcol = blockIdx.x * G_BM, brow = rt * G_BM, tid = threadIdx.x, r0 = tid >> 2, c = (tid & 3) * 8;
    int t0 = slot_tok[brow + r0], t1 = slot_tok[brow + r0 + 64]; if (t0 < 0) t0 = 0; if (t1 < 0) t1 = 0;
    const bf16_t* W = WupT + (size_t)e * UPW * DM;
    f32x4 acc[4][4]; G128_ZERO(acc);
    g128_loop(acc, HB + (size_t)t0 * DM + c, HB + (size_t)t1 * DM + c, W + (size_t)(bcol + r0) * DM + c, W + (size_t)(bcol + r0 + 64) * DM + c, DM, (LAS unsigned char*)shm);
    G128_FOREACH({
        const int col = bcol + tcol; const float v = acc[m_][n_][j_] + b_up[e * UPW + col];
        const float other = __shfl_xor(v, 1);
        if ((col & 1) == 0) { const float g = fminf(v, SW_LIMIT), l = fminf(fmaxf(other, -SW_LIMIT), SW_LIMIT);
            ACT[(size_t)(brow + trow) * DFF + (col >> 1)] = (bf16_t)f2bf(g * sigmoidf_(SW_ALPHA * g) * (l + 1.0f)); }
    });
}
__global__ __launch_bounds__(256) void k_moe_down(const bf16_t* __restrict__ ACT, const bf16_t* __restrict__ WdnT, const float* __restrict__ b_dn, const int* __restrict__ ctl, bf16_t* __restrict__ Y) {
    __shared__ __attribute__((aligned(16))) unsigned char shm[2 * G_HTB];
    const int rt = blockIdx.y; if (rt >= 2 * ctl[CW_NTILES]) return;
    const int e = ctl[CW_TILEEXP + (rt >> 1)];
    const int bcol = blockIdx.x * G_BM, brow = rt * G_BM, tid = threadIdx.x, r0 = tid >> 2, c = (tid & 3) * 8;
    const bf16_t* W = WdnT + (size_t)e * DM * DFF;
    f32x4 acc[4][4]; G128_ZERO(acc);
    g128_loop(acc, ACT + (size_t)(brow + r0) * DFF + c, ACT + (size_t)(brow + r0 + 64) * DFF + c, W + (size_t)(bcol + r0) * DFF + c, W + (size_t)(bcol + r0 + 64) * DFF + c, DFF, (LAS unsigned char*)shm);
    G128_FOREACH({ const int col = bcol + tcol; Y[(size_t)(brow + trow) * DM + col] = (bf16_t)f2bf(acc[m_][n_][j_] + b_dn[e * DM + col]); });
}

__global__ __launch_bounds__(64) void k_attn_naive(const bf16_t* __restrict__ Q, const bf16_t* __restrict__ K, const bf16_t* __restrict__ V, bf16_t* __restrict__ O) {
    const int qb = 31 - (int)blockIdx.x, bh = blockIdx.y, b = bh >> 3, h = bh & 7;
    const int t = qb * 64 + threadIdx.x; const size_t rowbase = (size_t)b * SEQ;
    float q[64], o[64];
    { const bf16_t* qp = Q + (rowbase + t) * SBW + h * SBD;
#pragma unroll
      for (int d = 0; d < 64; ++d) { q[d] = bf2f(qp[d]); o[d] = 0.f; } }
    float R = 1.0f;
    for (int s = qb * 64 + 63; s >= 0; --s) {
        const bf16_t* kr = K + (rowbase + s) * SBW + h * SBD; const bf16_t* vr = V + (rowbase + s) * SBW + h * SBD;
        float z = 0.f;
#pragma unroll
        for (int d = 0; d < 64; ++d) z += q[d] * bf2f(kr[d]);
        const bool valid = s < t;
        const float ez = expf(fminf(z, 60.0f)), keep = 1.0f / (1.0f + ez);
        const float a = valid ? ez * keep * R : 0.f;
        R = valid ? R * keep : R;
#pragma unroll
        for (int d = 0; d < 64; ++d) o[d] += a * bf2f(vr[d]);
    }
    bf16_t* op = O + (rowbase + t) * SBW + h * SBD;
#pragma unroll
    for (int d = 0; d < 64; ++d) op[d] = (bf16_t)f2bf(o[d]);
}

__global__ __launch_bounds__(128) void k_hgrn_naive(const bf16_t* __restrict__ HQ, const bf16_t* __restrict__ HK, const float* __restrict__ LOGF, const bf16_t* __restrict__ HV, float* __restrict__ ORAW) {
    __shared__ __attribute__((aligned(16))) float sf[128], sk[128], sq[128];
    const int bh = blockIdx.x, b = bh >> 2, hh = bh & 3, v = threadIdx.x;
    float S[128];
#pragma unroll
    for (int k = 0; k < 128; ++k) S[k] = 0.f;
    for (int t = 0; t < SEQ; ++t) {
        const size_t base = ((size_t)b * SEQ + t) * HGW + hh * HGD;
        sf[v] = expf(LOGF[base + v]); sk[v] = bf2f(HK[base + v]); sq[v] = bf2f(HQ[base + v]);
        const float vv = bf2f(HV[base + v]);
        __syncthreads();
        float o = 0.f;
#pragma unroll
        for (int k = 0; k < 128; ++k) { S[k] = sf[k] * S[k] + sk[k] * vv; o += sq[k] * S[k]; }
        ORAW[base + v] = o;
        __syncthreads();
    }
}
__global__ __launch_bounds__(256) void k_hgrn_post(const float* __restrict__ ORAW, const bf16_t* __restrict__ HG, const float* __restrict__ norm_g, bf16_t* __restrict__ OHG) {
    const int gw = blockIdx.x * 4 + (threadIdx.x >> 6), lane = threadIdx.x & 63;
    const size_t base = (size_t)gw * HGD; const int c0 = (gw & 3) * HGD;
    const float x0 = ORAW[base + lane], x1 = ORAW[base + 64 + lane];
    const float r = 1.0f / sqrtf(wave_sum(x0 * x0 + x1 * x1) * (1.0f / HGD) + RMS_EPS);
    OHG[base + lane] = (bf16_t)f2bf(x0 * r * norm_g[c0 + lane] * bf2f(HG[base + lane]));
    OHG[base + 64 + lane] = (bf16_t)f2bf(x1 * r * norm_g[c0 + 64 + lane] * bf2f(HG[base + 64 + lane]));
}

__global__ __launch_bounds__(256) void k_ln1_router(const float* __restrict__ PRE, const float* __restrict__ g, const float* __restrict__ bta, const float* __restrict__ rw, const float* __restrict__ rb,
                                                    float* __restrict__ H, bf16_t* __restrict__ HB, int* __restrict__ TOPI, float* __restrict__ TOPG) {
    __shared__ __attribute__((aligned(16))) float hs[4][DM];
    const int w = threadIdx.x >> 6, lane = threadIdx.x & 63, row = blockIdx.x * 4 + w;
    f32x4 v[4]; float s = 0.f;
#pragma unroll
    for (int j = 0; j < 4; ++j) { v[j] = *(const f32x4*)(PRE + (size_t)row * DM + lane * 4 + 256 * j); s += (v[j][0] + v[j][1]) + (v[j][2] + v[j][3]); }
    const float mean = wave_sum(s) * (1.0f / DM); float s2 = 0.f;
#pragma unroll
    for (int j = 0; j < 4; ++j) { v[j] = v[j] - mean; s2 += (v[j][0] * v[j][0] + v[j][1] * v[j][1]) + (v[j][2] * v[j][2] + v[j][3] * v[j][3]); }
    const float rstd = 1.0f / sqrtf(wave_sum(s2) * (1.0f / DM) + LN_EPS);
#pragma unroll
    for (int j = 0; j < 4; ++j) { const int c = lane * 4 + 256 * j; const f32x4 gg = *(const f32x4*)(g + c), bb = *(const f32x4*)(bta + c);
        f32x4 hv = v[j] * rstd * gg + bb; *(f32x4*)(H + (size_t)row * DM + c) = hv; *(f32x4*)(&hs[w][c]) = hv;
        uint2 o; o.x = f2bf(hv[0]) | (f2bf(hv[1]) << 16); o.y = f2bf(hv[2]) | (f2bf(hv[3]) << 16); *(uint2*)(HB + (size_t)row * DM + c) = o; }
    __syncthreads();
    const int e = lane & 31, half = lane >> 5; float a = 0.f;
    for (int c = half * 512; c < half * 512 + 512; ++c) a += hs[w][c] * rw[c * NEXP + e];
    a += __shfl_xor(a, 32);
    float val = (lane < 32) ? a + rb[e] : -INFINITY; int idx = e;
    float tv[4]; int ti[4];
#pragma unroll
    for (int r = 0; r < 4; ++r) {
        float bv = val; int bi = idx;
#pragma unroll
        for (int off = 32; off >= 1; off >>= 1) { const float ov = __shfl_xor(bv, off); const int oi = __shfl_xor(bi, off); if (ov > bv || (ov == bv && oi < bi)) { bv = ov; bi = oi; } }
        tv[r] = bv; ti[r] = bi; if (lane < 32 && e == bi) val = -INFINITY;
    }
    if (lane == 0) { const float e1 = expf(tv[1] - tv[0]), e2 = expf(tv[2] - tv[0]), e3 = expf(tv[3] - tv[0]), inv = 1.0f / (1.0f + e1 + e2 + e3);
        *(int4*)(TOPI + row * 4) = make_int4(ti[0], ti[1], ti[2], ti[3]); *(float4*)(TOPG + row * 4) = make_float4(inv, e1 * inv, e2 * inv, e3 * inv); }
}

__global__ __launch_bounds__(256) void k_count(const int* __restrict__ TOPI, int* __restrict__ ctl, int* __restrict__ slot_tok) {
    __shared__ int hist[NEXP];
    if (threadIdx.x < NEXP) hist[threadIdx.x] = 0;
    __syncthreads();
    const int i = blockIdx.x * 256 + threadIdx.x;
    atomicAdd(&hist[TOPI[i]], 1);
    __syncthreads();
    if (threadIdx.x < NEXP) atomicAdd(&ctl[CW_CNT + threadIdx.x], hist[threadIdx.x]);
    for (int s = i; s < NSLOT_MAX; s += NASSIGN) slot_tok[s] = -1;
}
__global__ __launch_bounds__(64) void k_plan(int* __restrict__ ctl) {
    if (threadIdx.x == 0) { int ps = 0, nt = 0;
        for (int e = 0; e < NEXP; ++e) { ctl[CW_PADSTART + e] = ps; const int te = (ctl[CW_CNT + e] + SLOT_PAD - 1) / SLOT_PAD; for (int i = 0; i < te; ++i) ctl[CW_TILEEXP + nt++] = e; ps += te * SLOT_PAD; }
        ctl[CW_PADSTART + NEXP] = ps; ctl[CW_NTILES] = nt; }
}
__global__ __launch_bounds__(256) void k_assign(const int* __restrict__ TOPI, int* __restrict__ ctl, int* __restrict__ slot_tok, int* __restrict__ DEST) {
    const int i = blockIdx.x * 256 + threadIdx.x, e = TOPI[i];
    const int slot = ctl[CW_PADSTART + e] + atomicAdd(&ctl[CW_CUR + e], 1);
    slot_tok[slot] = i >> 2; DEST[i] = slot;
}
__global__ __launch_bounds__(256) void k_combine_ln2(const float* __restrict__ H, const bf16_t* __restrict__ Y, const int* __restrict__ DEST, const float* __restrict__ TOPG,
                                                     const float* __restrict__ g, const float* __restrict__ bta, float* __restrict__ out) {
    const int lane = threadIdx.x & 63, row = blockIdx.x * 4 + (threadIdx.x >> 6);
    const int4 d = *(const int4*)(DEST + row * 4); const float4 gt = *(const float4*)(TOPG + row * 4);
    const int ds[4] = {d.x, d.y, d.z, d.w}; const float gs[4] = {gt.x, gt.y, gt.z, gt.w};
    f32x4 v[4]; float s = 0.f;
#pragma unroll
    for (int j = 0; j < 4; ++j) { const int c = lane * 4 + 256 * j; f32x4 a = *(const f32x4*)(H + (size_t)row * DM + c) * DN_ALPHA;
#pragma unroll
        for (int k = 0; k < 4; ++k) { const uint2 y = *(const uint2*)(Y + (size_t)ds[k] * DM + c);
            a[0] += gs[k] * bf2f(y.x & 0xffff); a[1] += gs[k] * bf2f(y.x >> 16); a[2] += gs[k] * bf2f(y.y & 0xffff); a[3] += gs[k] * bf2f(y.y >> 16); }
        v[j] = a; s += (a[0] + a[1]) + (a[2] + a[3]); }
    const float mean = wave_sum(s) * (1.0f / DM); float s2 = 0.f;
#pragma unroll
    for (int j = 0; j < 4; ++j) { v[j] = v[j] - mean; s2 += (v[j][0] * v[j][0] + v[j][1] * v[j][1]) + (v[j][2] * v[j][2] + v[j][3] * v[j][3]); }
    const float rstd = 1.0f / sqrtf(wave_sum(s2) * (1.0f / DM) + LN_EPS);
#pragma unroll
    for (int j = 0; j < 4; ++j) { const int c = lane * 4 + 256 * j; *(f32x4*)(out + (size_t)row * DM + c) = v[j] * rstd * *(const f32x4*)(g + c) + *(const f32x4*)(bta + c); }
}

}
#endif
extern "C" void kernel_launch(void* const* d_in, const int* in_sizes, int n_in, void* d_out, int out_size, void* d_ws, size_t ws_size, hipStream_t stream) {
    static int grid = 0;
    if (grid == 0) {
        if (n_in != 17 || ws_size < WS_END) { fprintf(stderr, "kernel_launch: unexpected n_in %d or ws_size %zu (< %zu)\n", n_in, ws_size, (size_t)WS_END); grid = -1; return; }
        int dev = 0, cus = 0;
        if (hipGetDevice(&dev) != hipSuccess || hipDeviceGetAttribute(&cus, hipDeviceAttributeMultiprocessorCount, dev) != hipSuccess) { grid = -1; return; }
#define MK_ATTR(LO_, HI_) if (hipFuncSetAttribute((const void*)mk_fwd<LO_, HI_>, hipFuncAttributeMaxDynamicSharedMemorySize, LDS_BYTES) != hipSuccess) { fprintf(stderr, "kernel_launch: hipFuncSetAttribute failed\n"); grid = -1; return; }
#if MK_MODE == 0
        MK_ATTR(0, 11)
#elif MK_MODE == 2
        MK_ATTR(0, 1) MK_ATTR(1, 2) MK_ATTR(2, 3) MK_ATTR(3, 4) MK_ATTR(4, 5) MK_ATTR(5, 6)
#else
        MK_ATTR(0, 1) MK_ATTR(1, 2) MK_ATTR(2, 3) MK_ATTR(3, 4) MK_ATTR(4, 5) MK_ATTR(5, 6) MK_ATTR(6, 8) MK_ATTR(8, 9) MK_ATTR(9, 10) MK_ATTR(10, 11)
#endif
        grid = cus;
        if (grid != 256) fprintf(stderr, "kernel_launch: %d CUs (built for 256)\n", grid);
    }
    if (grid < 0) return;
    (void)hipMemsetAsync((char*)d_ws + WS_CTL, 0, CTL_ZERO_BYTES, stream);
    Args a{};
    for (int i = 0; i < 17; ++i) a.in[i] = (const float*)d_in[i];
    a.out = (float*)d_out; a.ws = (unsigned char*)d_ws;
#define MK_LAUNCH(LO_, HI_, LI_) do { a.ph_lo = LO_; a.ph_hi = HI_; a.li = LI_; hipLaunchKernelGGL((mk_fwd<LO_, HI_>), dim3(grid), dim3(NTHREADS), LDS_BYTES, stream, a); } while (0)
#if MK_MODE == 0
    MK_LAUNCH(0, 11, 0);
#elif MK_MODE == 2
    { unsigned char* ws = (unsigned char*)d_ws;
      InProjOut ip{}; ip.Q = (bf16_t*)(ws + WS_Q); ip.K = (bf16_t*)(ws + WS_K); ip.V = (bf16_t*)(ws + WS_V); ip.HQ = (bf16_t*)(ws + WS_HQ); ip.HK = (bf16_t*)(ws + WS_HK); ip.HV = (bf16_t*)(ws + WS_HV);
      ip.HG = (bf16_t*)(ws + WS_HG); ip.GS = (bf16_t*)(ws + WS_GS); ip.GH = (bf16_t*)(ws + WS_GH); ip.LOGF = (float*)(ws + WS_LOGF); ip.lb = (const float*)(ws + WS_LB);
#if MK_HEAD_V1 >= 1
      v1::k_convert_x<<<NTOK * DM / 4 / 256, 256, 0, stream>>>(a.in[0], (bf16_t*)(ws + WS_XB), a.in[2], (float*)(ws + WS_LB));
      v1::k_transpose_bf16<<<dim3(INW / 64, DM / 64, 1), 256, 0, stream>>>(a.in[1], (bf16_t*)(ws + WS_WINT), DM, INW);
      v1::k_transpose_bf16<<<dim3(DM / 64, SBW / 64, 1), 256, 0, stream>>>(a.in[4], (bf16_t*)(ws + WS_WBST), SBW, DM);
      v1::k_transpose_bf16<<<dim3(DM / 64, HGW / 64, 1), 256, 0, stream>>>(a.in[5], (bf16_t*)(ws + WS_WBHT), HGW, DM);
      v1::k_transpose_bf16<<<dim3(DM / 64, DM / 64, 1), 256, 0, stream>>>(a.in[6], (bf16_t*)(ws + WS_WOT), DM, DM);
      v1::k_transpose_bf16<<<dim3(UPW / 64, DM / 64, NEXP), 256, 0, stream>>>(a.in[11], (bf16_t*)(ws + WS_WUPT), DM, UPW);
      v1::k_transpose_bf16<<<dim3(DM / 64, DFF / 64, NEXP), 256, 0, stream>>>(a.in[13], (bf16_t*)(ws + WS_WDNT), DFF, DM);
#else
      MK_LAUNCH(0, 1, 0);
#endif
#if MK_HEAD_V1 >= 2
      v1::k_inproj<<<dim3(INW / v1::G_BM, NTOK / v1::G_BM), 256, 0, stream>>>((const bf16_t*)(ws + WS_XB), (const bf16_t*)(ws + WS_WINT), ip);
#else
      MK_LAUNCH(1, 2, 1);
#endif
      MK_LAUNCH(2, 3, 2); MK_LAUNCH(3, 4, 3); MK_LAUNCH(4, 5, 4); MK_LAUNCH(5, 6, 5); }
    { unsigned char* ws = (unsigned char*)d_ws; int* ctl = (int*)(ws + WS_CTL); bf16_t* HB = (bf16_t*)(ws + WS_XS); int* TOPI = (int*)(ws + WS_XS + 32 * MiB); int* SLOTTOK = (int*)(ws + WS_XS + 33 * MiB);
      float* TOPG = (float*)(ws + WS_TOPG); int* DEST = (int*)(ws + WS_DEST); float* H = (float*)(ws + WS_H); bf16_t* ACT = (bf16_t*)(ws + WS_ACT); bf16_t* Y = (bf16_t*)(ws + WS_Y);
      v1::k_ln1_router<<<NTOK / 4, 256, 0, stream>>>((const float*)(ws + WS_PRE), a.in[7], a.in[8], a.in[9], a.in[10], H, HB, TOPI, TOPG);
      v1::k_count<<<NASSIGN / 256, 256, 0, stream>>>(TOPI, ctl, SLOTTOK);
      v1::k_plan<<<1, 64, 0, stream>>>(ctl);
      v1::k_assign<<<NASSIGN / 256, 256, 0, stream>>>(TOPI, ctl, SLOTTOK, DEST);
      v1::k_moe_up<<<dim3(UPW / v1::G_BM, NSLOT_MAX / v1::G_BM), 256, 0, stream>>>(HB, (const bf16_t*)(ws + WS_WUPT), a.in[12], ctl, SLOTTOK, ACT);
      v1::k_moe_down<<<dim3(DM / v1::G_BM, NSLOT_MAX / v1::G_BM), 256, 0, stream>>>(ACT, (const bf16_t*)(ws + WS_WDNT), a.in[14], ctl, Y);
      v1::k_combine_ln2<<<NTOK / 4, 256, 0, stream>>>(H, Y, DEST, TOPG, a.in[15], a.in[16], (float*)d_out); }
#else
    MK_LAUNCH(0, 1, 0); MK_LAUNCH(1, 2, 1); MK_LAUNCH(2, 3, 2); MK_LAUNCH(3, 4, 3); MK_LAUNCH(4, 5, 4); MK_LAUNCH(5, 6, 5); MK_LAUNCH(6, 8, 6); MK_LAUNCH(8, 9, 7); MK_LAUNCH(9, 10, 8); MK_LAUNCH(10, 11, 9);
#endif
}
```

```cpp
#include <hip/hip_runtime.h>
#include <stdint.h>
#include <cstdio>

#define LAS __attribute__((address_space(3)))
#define GAS __attribute__((address_space(1)))
typedef unsigned short bf16_t;
typedef short bf16x8 __attribute__((ext_vector_type(8)));
typedef float f32x4 __attribute__((ext_vector_type(4)));
typedef float f32x16 __attribute__((ext_vector_type(16)));
typedef unsigned u32x4 __attribute__((ext_vector_type(4)));
typedef unsigned u32x2 __attribute__((ext_vector_type(2)));
typedef float f32x2_t __attribute__((ext_vector_type(2)));

constexpr int NTOK = 16384, DM = 1024, INW = 5632, SBW = 512, HGW = 512, NEXP = 32, TOPK = 4, DFF = 1024, UPW = 2048;
constexpr int SEQ = 2048, SBH = 8, SBD = 64, HGH = 4, HGD = 128;
constexpr int NASSIGN = NTOK * TOPK;
constexpr int SLOT_PAD = 256;
constexpr int NSLOT_MAX = NASSIGN + NEXP * SLOT_PAD;
constexpr int NTILE_MAX = NSLOT_MAX / SLOT_PAD;
constexpr float LN_EPS = 1e-5f, RMS_EPS = 1e-6f, DN_ALPHA = 1.189207115002721f, SW_ALPHA = 1.702f, SW_LIMIT = 7.0f, LOG2E = 1.4426950408889634f, LN2 = 0.6931471805599453f;
constexpr int NWAVES = 8, NTHREADS = 512;
constexpr float W8_SCALE = 32.0f; constexpr int W8_E8M0 = 0x7a7a7a7a;
#ifndef MK_Y8
#define MK_Y8 1
#endif
constexpr float Y8_SCALE = 16.0f;
constexpr float ACT8_SCALE = 4.0f; constexpr int ACT8_E8M0 = 0x7d7d7d7d;
#ifndef MK_DUP_P1
#define MK_DUP_P1 1
#endif
#ifndef MK_DUP_HGA
#define MK_DUP_HGA 1
#endif
#ifndef MK_DUP_HGB
#define MK_DUP_HGB 1
#endif
#ifndef MK_DUP_P45
#define MK_DUP_P45 1
#endif
#ifndef MK_BG_WAVES
#define MK_BG_WAVES 3
#endif
#ifndef MK_BG_SEAMS
#define MK_BG_SEAMS 0xFE
#endif
#ifndef MK_PROBE_CONV
#define MK_PROBE_CONV 0
#endif
#ifndef MK_PROBE_BAR
#define MK_PROBE_BAR 0
#endif
#ifndef MK_LOOP_P2
#define MK_LOOP_P2 1
#endif
#ifndef MK_DUP_TAIL
#define MK_DUP_TAIL 0
#endif
#ifndef MK_FP8_GATES
#define MK_FP8_GATES 1
#endif
#ifndef MK_FP8_DN
#define MK_FP8_DN 1
#endif
#ifndef MK_FP8_UP
#define MK_FP8_UP 1
#endif
#ifndef MK_BG
#define MK_BG 1
#endif
#ifndef MK_DUP_P2
#define MK_DUP_P2 1
#define MK_DUP_WHAT 0
#endif
#ifndef MK_PROBE
#define MK_PROBE 0
#endif
#define MK_PROBE_UNUSED 0
#ifndef MK_P0_ROWS
#define MK_P0_ROWS 2
#endif
#ifndef MK_PB_GROWS
#define MK_PB_GROWS 16
#endif
#ifndef MK_P10_ROWS
#define MK_P10_ROWS 4
#endif
#ifndef MK_WGM_P1A
#define MK_WGM_P1A 4
#define MK_WGM_P1B 4
#define MK_WGM_P4 8
#define MK_WGM_P5 8
#endif
#ifndef MK_WGM_DN
#define MK_WGM_DN 4
#endif
#ifndef MK_WGM_UP
#define MK_WGM_UP 4
#endif
#ifndef MK_GATHER_A
#define MK_GATHER_A 1
#endif
#ifndef MK_BR_BATCH
#define MK_BR_BATCH 3
#endif
#ifndef MK_PA0
#define MK_PA0 0
#define MK_PA1 1
#define MK_PB0 1
#define MK_PB1 2
#endif
#ifndef MK_NAIVE_MIX
#define MK_NAIVE_MIX 0
#endif
#ifndef MK_MODE
#ifndef MK_P1_ALIGN
#define MK_P1_ALIGN true
#endif
#ifndef MK_P1_SP2
#define MK_P1_SP2 true
#endif
#ifndef MK_HEAD_V1
#define MK_HEAD_V1 0
#endif
#define MK_MODE 0
#endif

constexpr size_t MiB = 1u << 20;
constexpr size_t WS_SLOTTOK = 262144;
constexpr size_t WS_CTL = 0, CTL_ZERO_BYTES = 262144 + 73728 * 4;
constexpr size_t WS_LB = 1 * MiB;
constexpr size_t WS_CNTM = WS_LB + 4096;
constexpr size_t WS_TOPG = WS_CNTM + 32768;
constexpr size_t WS_DEST = WS_TOPG + 262144;
constexpr size_t WS_RWT = WS_DEST + 262144;
constexpr size_t WS_XB = 3 * MiB;
constexpr size_t WS_WINT = WS_XB + 32 * MiB;
constexpr size_t WS_WBST = WS_WINT + 12 * MiB;
constexpr size_t WS_WBHT = WS_WBST + 1 * MiB;
constexpr size_t WS_WOT = WS_WBHT + 1 * MiB;
constexpr size_t WS_WUPT = WS_WOT + 2 * MiB;
constexpr size_t WS_WDNT = WS_WUPT + 128 * MiB;
constexpr size_t WS_Q = WS_WDNT + 64 * MiB;
constexpr size_t WS_K = WS_Q + 16 * MiB;
constexpr size_t WS_V = WS_K + 16 * MiB;
constexpr size_t WS_HQ = WS_V + 16 * MiB;
constexpr size_t WS_HK = WS_HQ + 16 * MiB;
constexpr size_t WS_HV = WS_HK + 16 * MiB;
constexpr size_t WS_HG = WS_HV + 16 * MiB;
constexpr size_t WS_LOGF = WS_HG + 16 * MiB;
constexpr size_t WS_GS = WS_LOGF + 32 * MiB;
constexpr size_t WS_GH = WS_GS + 32 * MiB;
constexpr size_t WS_OSB = WS_GH + 32 * MiB;
constexpr size_t WS_OHG = WS_OSB + 16 * MiB;
constexpr size_t WS_ORAW = WS_OHG + 16 * MiB;
constexpr size_t WS_MERGED = WS_ORAW + 32 * MiB;
constexpr size_t WS_H = WS_MERGED + 32 * MiB;
constexpr size_t WS_XS = WS_H + 64 * MiB;
constexpr size_t WS_ACT = WS_XS + 144 * MiB;
constexpr size_t WS_QC = WS_ACT + 144 * MiB;
constexpr size_t WS_DS = WS_QC + 16 * MiB;
constexpr size_t WS_DG = WS_DS + 16 * MiB;
constexpr size_t WS_XB8 = WS_DG + 1 * MiB;
constexpr size_t WS_WINT8 = WS_XB8 + 16 * MiB;
constexpr size_t WS_END = WS_WINT8 + 3 * MiB;
constexpr size_t WS_PRE = WS_Q;
constexpr size_t WS_Y = WS_HK;
static_assert(WS_Y + 144 * MiB <= WS_OSB && WS_PRE + 64 * MiB <= WS_HK, "overlays");
static_assert(WS_END <= 1020 * MiB, "ws budget");
constexpr int CW_NTILES = 16;
constexpr int CW_ATTNQ = 32;
constexpr int CW_BGQ = 48;
constexpr int CW_TILEEXP = 64;
constexpr int CW_BAR = 1024;
constexpr int LDS_SCRATCH = 147456;
constexpr int LDSCTL_OFF = LDS_SCRATCH, LDS_BYTES = LDS_SCRATCH + 512;
constexpr int LDS_IDX = 131072 + 1280;
constexpr int LDS_TILEEXP = 131072;
constexpr int MISC_OFF = LDSCTL_OFF;

__device__ __forceinline__ unsigned f2bf(float f) { unsigned u = __builtin_bit_cast(unsigned, f); return (u + 0x7fffu + ((u >> 16) & 1u)) >> 16; }
__device__ __forceinline__ unsigned pk2(float lo, float hi) { return f2bf(lo) | (f2bf(hi) << 16); }
__device__ __forceinline__ float bf2f(unsigned short b) { return __builtin_bit_cast(float, (unsigned)b << 16); }
__device__ __forceinline__ float bflo(unsigned w) { return __builtin_bit_cast(float, w << 16); }
__device__ __forceinline__ float bfhi(unsigned w) { return __builtin_bit_cast(float, w & 0xffff0000u); }
__device__ __forceinline__ float fsigmoid(float v) { return __builtin_amdgcn_rcpf(1.0f + __builtin_amdgcn_exp2f(-v * LOG2E)); }
__device__ __forceinline__ f32x4 fsigmoid4(f32x4 v) { const f32x4 x = v * (f32x4){-LOG2E, -LOG2E, -LOG2E, -LOG2E};
    const f32x4 d = (f32x4){__builtin_amdgcn_exp2f(x[0]), __builtin_amdgcn_exp2f(x[1]), __builtin_amdgcn_exp2f(x[2]), __builtin_amdgcn_exp2f(x[3])} + (f32x4){1.0f, 1.0f, 1.0f, 1.0f};
    return (f32x4){__builtin_amdgcn_rcpf(d[0]), __builtin_amdgcn_rcpf(d[1]), __builtin_amdgcn_rcpf(d[2]), __builtin_amdgcn_rcpf(d[3])}; }
template <int CTRL> __device__ __forceinline__ float dpp_f(float v) { return __builtin_bit_cast(float, __builtin_amdgcn_update_dpp(0, __builtin_bit_cast(int, v), CTRL, 0xF, 0xF, false)); }
__device__ __forceinline__ float row16_sum(float v) { v += dpp_f<0xB1>(v); v += dpp_f<0x4E>(v); v += dpp_f<0x141>(v); v += dpp_f<0x140>(v); return v; }
__device__ __forceinline__ float wave_sum(float v) {
    v = row16_sum(v);
    const float r0 = __builtin_bit_cast(float, __builtin_amdgcn_readlane(__builtin_bit_cast(int, v), 0)), r1 = __builtin_bit_cast(float, __builtin_amdgcn_readlane(__builtin_bit_cast(int, v), 16));
    const float r2 = __builtin_bit_cast(float, __builtin_amdgcn_readlane(__builtin_bit_cast(int, v), 32)), r3 = __builtin_bit_cast(float, __builtin_amdgcn_readlane(__builtin_bit_cast(int, v), 48));
    return (r0 + r1) + (r2 + r3);
}
__device__ __forceinline__ unsigned pk4_fp8(float a, float b, float c, float d) { int w = 0; w = __builtin_amdgcn_cvt_pk_fp8_f32(a, b, w, false); w = __builtin_amdgcn_cvt_pk_fp8_f32(c, d, w, true); return (unsigned)w; }
#define LDS_WAIT() asm volatile("s_waitcnt lgkmcnt(0)" ::: "memory")
#define VM_WAIT() asm volatile("s_waitcnt vmcnt(0)" ::: "memory")

struct InProjOut { bf16_t *Q, *K, *V, *HQ, *HK, *HV, *HG, *GS, *GH; float* LOGF; const float* lb; };

namespace pg8 {
#define PG8_LAS __attribute__((address_space(3)))
constexpr int BM = 256, BK = 64, HALF = 128, HTB = HALF * BK * 2  , STAGE_BYTES = 8 * HTB, NXCD = 8, WGM = 8;
__host__ __device__ __forceinline__ int lds_byte(int r, int c) { const int st = (r >> 4) * 2 + (c >> 5), rr = r & 15, cc = c & 31, ob = rr * 64 + cc * 2; return st * 1024 + (ob ^ (((ob >> 9) & 1) << 5)); }
__host__ __device__ __forceinline__ void stage_rc(int b, int& R, int& C) { const int st = b / 1024, sb = b % 1024, swz = sb ^ (((sb >> 9) & 1) << 5); R = (st >> 1) * 16 + swz / 64; C = (st & 1) * 32 + (swz % 64) / 2; }
__host__ __device__ __forceinline__ int perm32(int rho) { const int n = rho >> 4, i = rho & 15; return 8 * (i >> 2) + 4 * n + (i & 3); }

struct Unit { int pm, pn, aux; const char* a; const char* b; };
struct Gemm { int K; int scale_a = 0x7f7f7f7f, scale_b = 0x7f7f7f7f; };
struct TileOrder {
    int nM, nN, nwg, G, c, wgm;
    __device__ void init(int nM_, int nN_, int G_, int c_, int wgm_ = WGM) { nM = nM_; nN = nN_; nwg = nM * nN; G = G_; c = c_; wgm = wgm_; }
    __device__ bool tile(int i, int& pm, int& pn) const {
        const long L = (long)i * G + c; if (L >= nwg) return false;
        int wgid = (int)L; { const int q = nwg / NXCD, r = nwg % NXCD, xcd = wgid % NXCD, off = wgid / NXCD; wgid = (xcd < r ? xcd * (q + 1) : r * (q + 1) + (xcd - r) * q) + off; }
        const int nig = wgm * nN, gid = wgid / nig, fm = gid * wgm, gsz = (nM - fm) < wgm ? (nM - fm) : wgm;
        pm = fm + ((wgid % nig) % gsz); pn = (wgid % nig) / gsz; return true;
    }
};
struct DenseSched { static constexpr bool GATHER_A = false; TileOrder o; const char* A; const char* Bt; size_t tstep;
    __device__ __forceinline__ bool next(int i, Unit& u) const { if (!o.tile(i, u.pm, u.pn)) return false; u.aux = 0; u.a = A + (size_t)u.pm * tstep; u.b = Bt + (size_t)u.pn * tstep; return true; }
    __device__ __forceinline__ void a_ready(const Unit&) const {}
    __device__ __forceinline__ void done(const Unit&) const {} };
struct BranchSched { static constexpr bool GATHER_A = false; TileOrder o; const char *A0, *B0, *A1, *B1; size_t tstep;
    __device__ __forceinline__ bool next(int i, Unit& u) const { if (!o.tile(i >> 1, u.pm, u.pn)) return false; u.aux = i & 1; u.a = ((i & 1) ? A1 : A0) + (size_t)u.pm * tstep; u.b = ((i & 1) ? B1 : B0) + (size_t)u.pn * tstep; return true; }
    __device__ __forceinline__ void a_ready(const Unit&) const {}
    __device__ __forceinline__ void done(const Unit&) const {} };
struct MoeSched { static constexpr bool GATHER_A = false; TileOrder o; const char* A; const char* W; const LAS int* tile_exp; size_t tstep, estep;
    __device__ __forceinline__ bool next(int i, Unit& u) const { if (!o.tile(i, u.pm, u.pn)) return false; const int e = __builtin_amdgcn_readfirstlane(tile_exp[u.pm]); u.aux = e; u.a = A + (size_t)u.pm * tstep; u.b = W + (size_t)e * estep + (size_t)u.pn * tstep; return true; }
    __device__ __forceinline__ void a_ready(const Unit&) const {}
    __device__ __forceinline__ void done(const Unit&) const {} };

struct MoeGatherSched : MoeSched { static constexpr bool GATHER_A = true; const int* slot_tok;
    __device__ __forceinline__ bool next(int i, Unit& u) const { if (!MoeSched::next(i, u)) return false; u.a = A; return true; }
    __device__ __forceinline__ const int* idx(const Unit& u) const { return slot_tok + u.pm * BM; } };
typedef __bf16 bf16x2_t __attribute__((ext_vector_type(2)));
__device__ __forceinline__ unsigned cvt_pk_bf16(float lo, float hi) { f32x2_t v = {lo, hi}; bf16x2_t b = __builtin_convertvector(v, bf16x2_t); return __builtin_bit_cast(unsigned, b); }
template <int MODE> __device__ __forceinline__ void inproj_store(const f32x4 (&acc)[2][2][4][2], bf16_t* dst, int ld, int row0, int col0, float scale, const float* lb, float* logf_out) {
    f32x4 lbq[2][2];
    if (MODE == 2) {
#pragma unroll
        for (int bj = 0; bj < 2; ++bj) { lbq[bj][0] = *(const f32x4*)(lb + col0 + bj * HALF); lbq[bj][1] = *(const f32x4*)(lb + col0 + bj * HALF + 4); } }
#pragma unroll
    for (int ai = 0; ai < 2; ++ai)
#pragma unroll
        for (int m = 0; m < 4; ++m)
#pragma unroll
            for (int bj = 0; bj < 2; ++bj) {
                const size_t off = (size_t)(row0 + ai * HALF + m * 16) * ld + col0 + bj * HALF;
                f32x4 v[2] = {acc[ai][bj][m][0], acc[ai][bj][m][1]};
                if (MODE == 0) { v[0] = v[0] * scale; v[1] = v[1] * scale; }
                if (MODE == 1) { v[0] = v[0] * fsigmoid4(v[0]); v[1] = v[1] * fsigmoid4(v[1]); }
                if (MODE == 3) { v[0] = fsigmoid4(v[0]); v[1] = fsigmoid4(v[1]); }
                if (MODE == 2) {
                    f32x4 lg[2]; const f32x4 lbv[2] = {lbq[bj][0], lbq[bj][1]};
#pragma unroll
                    for (int n = 0; n < 2; ++n) { const f32x4 one = {1.0f, 1.0f, 1.0f, 1.0f}, l = lbv[n], f = l + (one - l) * fsigmoid4(v[n]); v[n] = one - f;
                        lg[n] = (f32x4){__builtin_amdgcn_logf(f[0]), __builtin_amdgcn_logf(f[1]), __builtin_amdgcn_logf(f[2]), __builtin_amdgcn_logf(f[3])} * (f32x4){LN2, LN2, LN2, LN2}; }
                    *(f32x4*)(logf_out + off) = lg[0]; *(f32x4*)(logf_out + off + 4) = lg[1];
                }
                u32x4 w; w.x = cvt_pk_bf16(v[0][0], v[0][1]); w.y = cvt_pk_bf16(v[0][2], v[0][3]); w.z = cvt_pk_bf16(v[1][0], v[1][1]); w.w = cvt_pk_bf16(v[1][2], v[1][3]);
                *(u32x4*)(dst + off) = w;
            }
}
template <int PN0> struct EpiInProjT { static constexpr bool PERM = true, AFTER_DRAIN = false, ACC_CHAIN = false; static constexpr int INIT = 0; InProjOut o;
    __device__ __forceinline__ void operator()(f32x4 (&acc)[2][2][4][2], const Unit& u, int wr, int wc, int fr, int fq) const {
        const int row0 = u.pm * BM + wr * 64 + fr, pn = u.pn + PN0;
        int seg, cb, ld;
        if (pn < 14) { seg = pn >> 1; cb = (pn & 1) * 256; ld = 512; } else if (pn < 18) { seg = 7; cb = (pn - 14) * 256; ld = 1024; } else { seg = 8; cb = (pn - 18) * 256; ld = 1024; }
        const int col0 = cb + wc * 32 + 8 * fq;
        if constexpr (PN0 != 0) { const size_t off = seg == 6 ? (size_t)(WS_HG - WS_HG) : (seg == 7 ? (size_t)(WS_GS - WS_HG) : (size_t)(WS_GH - WS_HG));
            inproj_store<3>(acc, (bf16_t*)((unsigned char*)o.HG + off), ld, row0, col0, 1.0f, nullptr, nullptr); return; }
        switch (seg) {
            case 0: inproj_store<0>(acc, o.Q, ld, row0, col0, 0.125f * LOG2E, nullptr, nullptr); break;
            case 1: inproj_store<0>(acc, o.K, ld, row0, col0, 1.0f, nullptr, nullptr); break;
            case 2: inproj_store<0>(acc, o.V, ld, row0, col0, 1.0f, nullptr, nullptr); break;
            case 3: inproj_store<1>(acc, o.HQ, ld, row0, col0, 1.0f, nullptr, nullptr); break;
            case 4: inproj_store<2>(acc, o.HK, ld, row0, col0, 1.0f, o.lb, o.LOGF); break;
            case 5: inproj_store<0>(acc, o.HV, ld, row0, col0, 1.0f, nullptr, nullptr); break;
            case 6: inproj_store<3>(acc, o.HG, ld, row0, col0, 1.0f, nullptr, nullptr); break;
            case 7: inproj_store<3>(acc, o.GS, ld, row0, col0, 1.0f, nullptr, nullptr); break;
            default: inproj_store<3>(acc, o.GH, ld, row0, col0, 1.0f, nullptr, nullptr); break;
        }
    }
};
struct EpiBranch { static constexpr bool PERM = true, AFTER_DRAIN = false, ACC_CHAIN = true; static constexpr int INIT = 0; const bf16_t* GS; const bf16_t* GH; bf16_t* MERGED;
    __device__ __forceinline__ void operator()(f32x4 (&acc)[2][2][4][2], const Unit& u, int wr, int wc, int fr, int fq) const {
        const int row0 = u.pm * BM + wr * 64 + fr, col0 = u.pn * BM + wc * 32 + 8 * fq;
        u32x4 ghq[MK_BR_BATCH + 1];
#pragma unroll
        for (int it = 0; it < MK_BR_BATCH; ++it) ghq[it] = *(const u32x4*)(GH + (size_t)(row0 + (it >> 3) * HALF + ((it >> 1) & 3) * 16) * DM + col0 + (it & 1) * HALF);
#pragma unroll
        for (int it = 0; it < 16; ++it) { const int ai = it >> 3, m = (it >> 1) & 3, bj = it & 1;
                    const size_t off = (size_t)(row0 + ai * HALF + m * 16) * DM + col0 + bj * HALF;
                    if (it + MK_BR_BATCH < 16) { const int i2 = it + MK_BR_BATCH; ghq[i2 % (MK_BR_BATCH + 1)] = *(const u32x4*)(GH + (size_t)(row0 + (i2 >> 3) * HALF + ((i2 >> 1) & 3) * 16) * DM + col0 + (i2 & 1) * HALF); }
                    const u32x4 gh = ghq[it % (MK_BR_BATCH + 1)];
                    const float h[8] = {bflo(gh.x), bfhi(gh.x), bflo(gh.y), bfhi(gh.y), bflo(gh.z), bfhi(gh.z), bflo(gh.w), bfhi(gh.w)};
                    if (u.aux == 0) {
                        const u32x4 gs = *(const u32x4*)(GS + off);
                        const float s[8] = {bflo(gs.x), bfhi(gs.x), bflo(gs.y), bfhi(gs.y), bflo(gs.z), bfhi(gs.z), bflo(gs.w), bfhi(gs.w)};
#pragma unroll
                        for (int n = 0; n < 2; ++n)
#pragma unroll
                            for (int j = 0; j < 4; ++j) acc[ai][bj][m][n][j] *= s[4 * n + j] * __builtin_amdgcn_rcpf(h[4 * n + j]);
                    } else {
                        float r[8];
#pragma unroll
                        for (int n = 0; n < 2; ++n)
#pragma unroll
                            for (int j = 0; j < 4; ++j) { r[4 * n + j] = acc[ai][bj][m][n][j] * h[4 * n + j]; acc[ai][bj][m][n][j] = 0.f; }
                        u32x4 w; w.x = cvt_pk_bf16(r[0], r[1]); w.y = cvt_pk_bf16(r[2], r[3]); w.z = cvt_pk_bf16(r[4], r[5]); w.w = cvt_pk_bf16(r[6], r[7]);
                        *(u32x4*)(MERGED + off) = w;
                    }
        }
    }
};
struct EpiOut { static constexpr bool PERM = true, AFTER_DRAIN = false, ACC_CHAIN = false; static constexpr int INIT = 2;     const bf16_t* xb; bf16_t* PRE;
    __device__ __forceinline__ void tile_init(f32x4 (&acc)[2][2][4][2], const Unit& u, int wr, int wc, int fr, int fq) const {
        const int row0 = u.pm * BM + wr * 64 + fr, col0 = u.pn * BM + wc * 32 + 8 * fq;
#pragma unroll
        for (int ai = 0; ai < 2; ++ai)
#pragma unroll
            for (int m = 0; m < 4; ++m)
#pragma unroll
                for (int bj = 0; bj < 2; ++bj) { const size_t off = (size_t)(row0 + ai * HALF + m * 16) * DM + col0 + bj * HALF;
                    const u32x4 xv = *(const u32x4*)(xb + off);
                    acc[ai][bj][m][0] = (f32x4){bflo(xv.x), bfhi(xv.x), bflo(xv.y), bfhi(xv.y)} * DN_ALPHA; acc[ai][bj][m][1] = (f32x4){bflo(xv.z), bfhi(xv.z), bflo(xv.w), bfhi(xv.w)} * DN_ALPHA; }
    }
    __device__ __forceinline__ void operator()(f32x4 (&acc)[2][2][4][2], const Unit& u, int wr, int wc, int fr, int fq) const {
        const int row0 = u.pm * BM + wr * 64 + fr, col0 = u.pn * BM + wc * 32 + 8 * fq;
#pragma unroll
        for (int ai = 0; ai < 2; ++ai)
#pragma unroll
            for (int m = 0; m < 4; ++m)
#pragma unroll
                for (int bj = 0; bj < 2; ++bj) { const size_t off = (size_t)(row0 + ai * HALF + m * 16) * DM + col0 + bj * HALF;
                    const f32x4 v0 = acc[ai][bj][m][0], v1 = acc[ai][bj][m][1];
                    u32x4 w; w.x = cvt_pk_bf16(v0[0], v0[1]); w.y = cvt_pk_bf16(v0[2], v0[3]); w.z = cvt_pk_bf16(v1[0], v1[1]); w.w = cvt_pk_bf16(v1[2], v1[3]);
                    *(u32x4*)(PRE + off) = w; }
    }
};
template <bool F8OUT> struct EpiUpT { static constexpr bool PERM = true, AFTER_DRAIN = false, ACC_CHAIN = false; static constexpr int INIT = 1;     const float* b_up; bf16_t* ACT;
    __device__ __forceinline__ void bias_load(f32x4 (&bv)[2][2], const Unit& u, int wc, int fq) const { const float* bias = b_up + (size_t)u.aux * UPW + u.pn * BM + wc * 32 + 8 * fq;
#pragma unroll
        for (int bj = 0; bj < 2; ++bj)
#pragma unroll
            for (int n = 0; n < 2; ++n) bv[bj][n] = *(const f32x4*)(bias + bj * HALF + 4 * n); }
    __device__ __forceinline__ void operator()(f32x4 (&acc)[2][2][4][2], const Unit& u, int wr, int wc, int fr, int fq) const {
        const int row0 = u.pm * BM + wr * 64 + fr, col0 = u.pn * BM + wc * 32 + 8 * fq;
        constexpr float OS = F8OUT ? ACT8_SCALE : 1.0f;
#pragma unroll
        for (int ai = 0; ai < 2; ++ai)
#pragma unroll
            for (int bj = 0; bj < 2; ++bj) {
                unsigned d[4]; u32x2 wb[4];
#pragma unroll
                for (int m = 0; m < 4; ++m) {
                    const f32x4 v0 = acc[ai][bj][m][0], v1 = acc[ai][bj][m][1];
                    const float gl[4] = {v0[0], v0[2], v1[0], v1[2]}, li[4] = {v0[1], v0[3], v1[1], v1[3]}; float a[4];
#pragma unroll
                    for (int p = 0; p < 4; p += 2) {
                        const f32x2_t g2 = {__builtin_amdgcn_fmed3f(gl[p], -INFINITY, SW_LIMIT), __builtin_amdgcn_fmed3f(gl[p + 1], -INFINITY, SW_LIMIT)}, l2 = {__builtin_amdgcn_fmed3f(li[p], -SW_LIMIT, SW_LIMIT), __builtin_amdgcn_fmed3f(li[p + 1], -SW_LIMIT, SW_LIMIT)};
                        const f32x2_t x2 = g2 * (f32x2_t){-SW_ALPHA * LOG2E, -SW_ALPHA * LOG2E};
                        const f32x2_t d2 = (f32x2_t){__builtin_amdgcn_exp2f(x2[0]), __builtin_amdgcn_exp2f(x2[1])} + (f32x2_t){1.0f, 1.0f};
                        const f32x2_t r2 = {__builtin_amdgcn_rcpf(d2[0]), __builtin_amdgcn_rcpf(d2[1])};
                        const f32x2_t u2 = l2 * (f32x2_t){OS, OS} + (f32x2_t){OS, OS};
                        const f32x2_t a2 = (g2 * r2) * u2;
                        a[p] = a2[0]; a[p + 1] = a2[1]; }
                    if constexpr (F8OUT) d[m] = pk4_fp8(a[0], a[1], a[2], a[3]);
                    else { wb[m].x = cvt_pk_bf16(a[0], a[1]); wb[m].y = cvt_pk_bf16(a[2], a[3]); }
                }
                if constexpr (F8OUT) {
                    auto r = __builtin_amdgcn_permlane16_swap(d[0], d[1], false, false); d[0] = r[0]; d[1] = r[1];
                    r = __builtin_amdgcn_permlane16_swap(d[2], d[3], false, false); d[2] = r[0]; d[3] = r[1];
                    r = __builtin_amdgcn_permlane32_swap(d[0], d[2], false, false); d[0] = r[0]; d[2] = r[1];
                    r = __builtin_amdgcn_permlane32_swap(d[1], d[3], false, false); d[1] = r[0]; d[3] = r[1];
                    *(u32x4*)((unsigned char*)ACT + (size_t)(row0 + ai * HALF + 16 * fq) * DFF + (u.pn * (BM / 2) + wc * 16 + bj * (HALF / 2))) = (u32x4){d[0], d[1], d[2], d[3]};
                } else {
#pragma unroll
                    for (int m = 0; m < 4; ++m) *(u32x2*)(ACT + (size_t)(row0 + ai * HALF + m * 16) * DFF + ((col0 + bj * HALF) >> 1)) = wb[m];
                }
            }
    }
};
struct EpiDown { static constexpr bool PERM = true, AFTER_DRAIN = false, ACC_CHAIN = false; static constexpr int INIT = 1; const float* b_dn; bf16_t* Y;
    __device__ __forceinline__ void bias_load(f32x4 (&bv)[2][2], const Unit& u, int wc, int fq) const { const float* bias = b_dn + (size_t)u.aux * DM + u.pn * BM + wc * 32 + 8 * fq;
#pragma unroll
        for (int bj = 0; bj < 2; ++bj)
#pragma unroll
            for (int n = 0; n < 2; ++n) bv[bj][n] = *(const f32x4*)(bias + bj * HALF + 4 * n); }
    __device__ __forceinline__ void operator()(f32x4 (&acc)[2][2][4][2], const Unit& u, int wr, int wc, int fr, int fq) const {
        const int row0 = u.pm * BM + wr * 64 + fr, col0 = u.pn * BM + wc * 32 + 8 * fq;
#if MK_Y8
#pragma unroll
        for (int ai = 0; ai < 2; ++ai)
#pragma unroll
            for (int bj = 0; bj < 2; ++bj)
#pragma unroll
                for (int mp = 0; mp < 4; mp += 2) {
                    u32x2 w[2];
#pragma unroll
                    for (int q = 0; q < 2; ++q) { const f32x4 v0 = acc[ai][bj][mp + q][0], v1 = acc[ai][bj][mp + q][1];
                        w[q].x = pk4_fp8(v0[0] * Y8_SCALE, v0[1] * Y8_SCALE, v0[2] * Y8_SCALE, v0[3] * Y8_SCALE); w[q].y = pk4_fp8(v1[0] * Y8_SCALE, v1[1] * Y8_SCALE, v1[2] * Y8_SCALE, v1[3] * Y8_SCALE); }
                    auto r = __builtin_amdgcn_permlane16_swap(w[0].x, w[1].x, false, false); w[0].x = r[0]; w[1].x = r[1];
                    r = __builtin_amdgcn_permlane16_swap(w[0].y, w[1].y, false, false); w[0].y = r[0]; w[1].y = r[1];
                    *(u32x4*)((unsigned char*)Y + (size_t)(row0 + ai * HALF + (mp + (fq & 1)) * 16) * DM + (u.pn * BM + wc * 32 + 8 * (fq & 2) + bj * HALF)) = (u32x4){w[0].x, w[0].y, w[1].x, w[1].y};
                }
#else
#pragma unroll
        for (int ai = 0; ai < 2; ++ai)
#pragma unroll
            for (int m = 0; m < 4; ++m)
#pragma unroll
                for (int bj = 0; bj < 2; ++bj) {
                    const f32x4 v0 = acc[ai][bj][m][0], v1 = acc[ai][bj][m][1];
                    u32x4 w; w.x = cvt_pk_bf16(v0[0], v0[1]); w.y = cvt_pk_bf16(v0[2], v0[3]); w.z = cvt_pk_bf16(v1[0], v1[1]); w.w = cvt_pk_bf16(v1[2], v1[3]);
                    *(u32x4*)(Y + (size_t)(row0 + ai * HALF + m * 16) * DM + col0 + bj * HALF) = w;
                }
#endif
    }
};

template <class Epi, class Sched, bool ALIGN_EPI = false, bool SP2 = false>
__device__ __forceinline__ void gemm_phase(PG8_LAS unsigned char* lds, const Gemm g, const Sched& S, const Epi& E) {
    int tid = threadIdx.x; asm volatile("" : "+v"(tid));
    const int wid = __builtin_amdgcn_readfirstlane(tid >> 6), lane = tid & 63, wr = wid >> 2, wc = wid & 3, fr = lane & 15, fq = lane >> 4;
    const int K = g.K, nt = K / BK;
    unsigned voffA[2], voffB[2];
#pragma unroll
    for (int i = 0; i < 2; ++i) { int R, C; stage_rc(tid * 16 + i * 8192, R, C); const int Rb = Epi::PERM ? ((R & ~31) + perm32(R & 31)) : R;
        voffA[i] = (unsigned)(R * K + C) * 2u; voffB[i] = (unsigned)(Rb * K + C) * 2u; }
    const size_t kstep = (size_t)(BK * 2);
    const size_t hstep = (size_t)HALF * K * 2;
    const unsigned ldsw = (unsigned)wid * 1024u;
    const int aoff = lds_byte(wr * 64 + fr, fq * 8), boff = lds_byte(wc * 32 + fr, fq * 8);
#define PG8_SA(b, h) (((b) * 2 + (h)) * HTB)
#define PG8_SB(b, h) ((4 + (b) * 2 + (h)) * HTB)
#define PG8_STAGE(bufoff, gbase, voff) do { _Pragma("unroll") for (int _i = 0; _i < 2; ++_i) \
        __builtin_amdgcn_global_load_lds((const unsigned*)((const char*)(gbase) + (voff)[_i]), (PG8_LAS unsigned*)(lds + (bufoff) + ldsw + _i * 8192), 16, 0, 0); } while (0)
#define PG8_LDA(dst, b, h) do { _Pragma("unroll") for (int m = 0; m < 4; ++m) _Pragma("unroll") for (int k = 0; k < 2; ++k) dst[m][k] = *(const PG8_LAS bf16x8*)(lds + PG8_SA(b, h) + aoff + m * 2048 + k * 1024); } while (0)
#define PG8_LDB(dst, b, h) do { _Pragma("unroll") for (int n = 0; n < 2; ++n) _Pragma("unroll") for (int k = 0; k < 2; ++k) dst[n][k] = *(const PG8_LAS bf16x8*)(lds + PG8_SB(b, h) + boff + n * 2048 + k * 1024); } while (0)
#define PG8_MMA(ai, bj, At, Bt) do { __builtin_amdgcn_s_setprio(1); _Pragma("unroll") for (int m = 0; m < 4; ++m) _Pragma("unroll") for (int n = 0; n < 2; ++n) _Pragma("unroll") for (int k = 0; k < 2; ++k) \
        acc[ai][bj][m][n] = __builtin_amdgcn_mfma_f32_16x16x32_bf16(Bt[n][k], At[m][k], acc[ai][bj][m][n], 0, 0, 0); __builtin_amdgcn_s_setprio(0); } while (0)
#define PG8_WAIT_V(n) asm volatile("s_waitcnt vmcnt(" #n ")" ::: "memory")
#define PG8_WAIT_L(n) asm volatile("s_waitcnt lgkmcnt(" #n ")" ::: "memory")
#define PG8_BAR __builtin_amdgcn_s_barrier()
#define PG8_SCHED __builtin_amdgcn_sched_barrier(0)
    Unit cur, nxt; int ui = 0;
    if (!S.next(0, cur)) return;
    f32x4 acc[2][2][4][2];
    f32x4 bv0[2][2];
    if constexpr (Epi::INIT == 1) E.bias_load(bv0, cur, wc, fq);
#pragma unroll
    for (int a = 0; a < 2; ++a)
#pragma unroll
        for (int b = 0; b < 2; ++b)
#pragma unroll
            for (int m = 0; m < 4; ++m)
#pragma unroll
                for (int n = 0; n < 2; ++n) { if constexpr (Epi::INIT == 1) acc[a][b][m][n] = bv0[b][n]; else acc[a][b][m][n] = (f32x4){0.f, 0.f, 0.f, 0.f}; }
    if constexpr (Epi::INIT == 2) E.tile_init(acc, cur, wr, wc, fr, fq);
    bf16x8 At[4][2], B0[2][2], B1[2][2];
    const char* cA = cur.a; const char* cB = cur.b;
    S.a_ready(cur);
    if constexpr (SP2) {
        PG8_STAGE(PG8_SB(0, 0), cB, voffB); PG8_STAGE(PG8_SB(0, 1), cB + hstep, voffB); PG8_STAGE(PG8_SA(0, 0), cA, voffA); PG8_STAGE(PG8_SA(0, 1), cA + hstep, voffA);
        if (wr == 1) PG8_BAR;
        PG8_WAIT_V(2); PG8_BAR;
        PG8_STAGE(PG8_SB(1, 0), cB + kstep, voffB); PG8_STAGE(PG8_SA(1, 0), cA + kstep, voffA); PG8_STAGE(PG8_SB(1, 1), cB + hstep + kstep, voffB);
        PG8_WAIT_V(6); PG8_BAR;
    } else {
        PG8_STAGE(PG8_SB(0, 0), cB, voffB); PG8_STAGE(PG8_SA(0, 0), cA, voffA); PG8_STAGE(PG8_SB(0, 1), cB + hstep, voffB); PG8_STAGE(PG8_SA(0, 1), cA + hstep, voffA);
        if (wr == 1) PG8_BAR;
        PG8_WAIT_V(4); PG8_BAR;
        PG8_STAGE(PG8_SB(1, 0), cB + kstep, voffB); PG8_STAGE(PG8_SA(1, 0), cA + kstep, voffA); PG8_STAGE(PG8_SB(1, 1), cB + hstep + kstep, voffB);
        PG8_WAIT_V(6); PG8_BAR;
    }
    for (;;) {
        const bool has_next = S.next(ui + 1, nxt);
        const char* nA = has_next ? nxt.a : cA; const char* nB = has_next ? nxt.b : cB;
        for (int t = 0; t < nt; t += 2) {
            const bool last = (t == nt - 2);
            const char* a1 = cA + (size_t)(t + 1) * kstep;
            const char* a2 = last ? nA : cA + (size_t)(t + 2) * kstep; const char* b2 = last ? nB : cB + (size_t)(t + 2) * kstep;
            const char* a3 = a2 + kstep; const char* b3 = b2 + kstep;
            if (last && has_next) S.a_ready(nxt);
            if constexpr (SP2) {
            PG8_LDB(B0, 0, 0); PG8_LDB(B1, 0, 1); PG8_SCHED; PG8_LDA(At, 0, 0); PG8_STAGE(PG8_SA(1, 1), a1 + hstep, voffA);
            PG8_WAIT_V(8); PG8_WAIT_L(0); PG8_BAR; PG8_MMA(0, 0, At, B0); PG8_MMA(0, 1, At, B1); PG8_BAR; PG8_SCHED;
            PG8_LDA(At, 0, 1); PG8_STAGE(PG8_SB(0, 0), b2, voffB); PG8_STAGE(PG8_SB(0, 1), b2 + hstep, voffB); PG8_STAGE(PG8_SA(0, 0), a2, voffA);
            PG8_WAIT_V(8); PG8_WAIT_L(0); PG8_BAR; PG8_MMA(1, 0, At, B0); PG8_MMA(1, 1, At, B1); PG8_BAR; PG8_SCHED;
            PG8_LDB(B0, 1, 0); PG8_LDB(B1, 1, 1); PG8_SCHED; PG8_LDA(At, 1, 0); PG8_STAGE(PG8_SA(0, 1), a2 + hstep, voffA);
            PG8_WAIT_V(8); PG8_WAIT_L(0); PG8_BAR; PG8_MMA(0, 0, At, B0); PG8_MMA(0, 1, At, B1); PG8_BAR; PG8_SCHED;
            PG8_LDA(At, 1, 1); PG8_STAGE(PG8_SB(1, 0), b3, voffB); PG8_STAGE(PG8_SB(1, 1), b3 + hstep, voffB); PG8_STAGE(PG8_SA(1, 0), a3, voffA);
            PG8_WAIT_V(8); PG8_WAIT_L(0); PG8_BAR; PG8_MMA(1, 0, At, B0); PG8_MMA(1, 1, At, B1); PG8_BAR; PG8_SCHED;
            } else {
            PG8_LDB(B0, 0, 0); PG8_SCHED; PG8_LDA(At, 0, 0); PG8_STAGE(PG8_SA(1, 1), a1 + hstep, voffA);
            PG8_WAIT_L(8); PG8_BAR; PG8_WAIT_L(0); PG8_MMA(0, 0, At, B0); PG8_BAR; PG8_SCHED;
            PG8_LDB(B1, 0, 1); PG8_STAGE(PG8_SB(0, 0), b2, voffB);
            PG8_BAR; PG8_WAIT_L(0); PG8_MMA(0, 1, At, B1); PG8_BAR;
            PG8_LDA(At, 0, 1); PG8_STAGE(PG8_SA(0, 0), a2, voffA);
            PG8_BAR; PG8_WAIT_L(0); PG8_MMA(1, 0, At, B0); PG8_BAR; PG8_SCHED;
            PG8_STAGE(PG8_SB(0, 1), b2 + hstep, voffB);
            PG8_WAIT_V(6); PG8_BAR; PG8_MMA(1, 1, At, B1); PG8_BAR;
            PG8_LDB(B0, 1, 0); PG8_SCHED; PG8_LDA(At, 1, 0); PG8_STAGE(PG8_SA(0, 1), a2 + hstep, voffA);
            PG8_WAIT_L(8); PG8_BAR; PG8_WAIT_L(0); PG8_MMA(0, 0, At, B0); PG8_BAR; PG8_SCHED;
            PG8_LDB(B1, 1, 1); PG8_STAGE(PG8_SB(1, 0), b3, voffB);
            PG8_BAR; PG8_WAIT_L(0); PG8_MMA(0, 1, At, B1); PG8_BAR;
            PG8_LDA(At, 1, 1); PG8_STAGE(PG8_SA(1, 0), a3, voffA);
            PG8_BAR; PG8_WAIT_L(0); PG8_MMA(1, 0, At, B0); PG8_BAR; PG8_SCHED;
            PG8_STAGE(PG8_SB(1, 1), b3 + hstep, voffB);
            PG8_WAIT_V(6); PG8_BAR; PG8_MMA(1, 1, At, B1); PG8_BAR;
            }
        }
        if constexpr (ALIGN_EPI) { if (wr == 0) PG8_BAR; }
        f32x4 bvn[2][2]; if constexpr (Epi::INIT == 1) { if (has_next) E.bias_load(bvn, nxt, wc, fq); }
        if constexpr (!Epi::AFTER_DRAIN) { E(acc, cur, wr, wc, fr, fq); S.done(cur); }
        if (!has_next) break;
        if constexpr (!Epi::ACC_CHAIN) {
#pragma unroll
        for (int a = 0; a < 2; ++a)
#pragma unroll
            for (int b = 0; b < 2; ++b)
#pragma unroll
                for (int m = 0; m < 4; ++m)
#pragma unroll
                    for (int n = 0; n < 2; ++n) { if constexpr (Epi::INIT == 1) acc[a][b][m][n] = bvn[b][n]; else acc[a][b][m][n] = (f32x4){0.f, 0.f, 0.f, 0.f}; }
        if constexpr (Epi::INIT == 2) E.tile_init(acc, nxt, wr, wc, fr, fq);
        }
        cur = nxt; cA = nA; cB = nB; ++ui;
        if constexpr (ALIGN_EPI) { if (wr == 1) PG8_BAR; }
    }
    PG8_WAIT_V(0);
    if constexpr (!ALIGN_EPI) { if (wr == 0) PG8_BAR; }
    PG8_BAR;
    if constexpr (Epi::AFTER_DRAIN) { E.fused(acc, cur, wr, wc, fr, fq, lds, wid, lane); S.done(cur); }
#undef PG8_SA
#undef PG8_SB
#undef PG8_STAGE
#undef PG8_LDA
#undef PG8_LDB
#undef PG8_MMA
#undef PG8_WAIT_V
#undef PG8_WAIT_L
#undef PG8_BAR
#undef PG8_SCHED
}
typedef int v8i_t __attribute__((ext_vector_type(8)));
template <class Epi, class Sched, bool ALIGN_EPI = false, bool SP2 = false>
__device__ __forceinline__ void gemm_phase_f8(PG8_LAS unsigned char* lds, const Gemm g, const Sched& S, const Epi& E) {
    int tid = threadIdx.x; asm volatile("" : "+v"(tid));
    const int wid = __builtin_amdgcn_readfirstlane(tid >> 6), lane = tid & 63, wr = wid >> 2, wc = wid & 3, fr = lane & 15, fq = lane >> 4;
    const int K = g.K, nt = K / BK;
    unsigned voffA[2], voffB[2];
#pragma unroll
    for (int i = 0; i < 2; ++i) { int R, C; stage_rc(tid * 16 + i * 8192, R, C); const int Rb = Epi::PERM ? ((R & ~31) + perm32(R & 31)) : R;
        voffA[i] = (unsigned)(R * K + C) * 2u; voffB[i] = (unsigned)(Rb * K + C) * 2u; }
    const size_t kstep = (size_t)(BK * 2);
    const size_t hstep = (size_t)HALF * K * 2;
    const unsigned ldsw = (unsigned)wid * 1024u;
    const int aoff = lds_byte(wr * 64 + fr, fq * 16), boff = lds_byte(wc * 32 + fr, fq * 16);
#define PG8_SA(b, h) (((b) * 2 + (h)) * HTB)
#define PG8_SB(b, h) ((4 + (b) * 2 + (h)) * HTB)
#define PG8_STAGE(bufoff, gbase, voff) do { _Pragma("unroll") for (int _i = 0; _i < 2; ++_i) \
        __builtin_amdgcn_global_load_lds((const unsigned*)((const char*)(gbase) + (voff)[_i]), (PG8_LAS unsigned*)(lds + (bufoff) + ldsw + _i * 8192), 16, 0, 0); } while (0)
#define PG8_STAGE_A(bufoff, gbase, h) do { if constexpr (Sched::GATHER_A) { PG8_STAGE(bufoff, gbase, goff[h]); } else { PG8_STAGE(bufoff, (gbase) + (size_t)(h) * hstep, voffA); } } while (0)
#define PG8_LDA(dst, b, h) do { _Pragma("unroll") for (int m = 0; m < 4; ++m) dst[m] = *(const PG8_LAS v8i_t*)(lds + PG8_SA(b, h) + aoff + m * 2048); } while (0)
#define PG8_LDB(dst, b, h) do { _Pragma("unroll") for (int n = 0; n < 2; ++n) dst[n] = *(const PG8_LAS v8i_t*)(lds + PG8_SB(b, h) + boff + n * 2048); } while (0)
#define PG8_F8(x) (x)
#define PG8_MMA(ai, bj, At, Bt) do { __builtin_amdgcn_s_setprio(1); _Pragma("unroll") for (int m = 0; m < 4; ++m) _Pragma("unroll") for (int n = 0; n < 2; ++n) \
        asm volatile("v_mfma_scale_f32_16x16x128_f8f6f4 %0, %1, %2, %0, %3, %4 op_sel_hi:[0,0,0]" : "+v"(acc[ai][bj][m][n]) : "v"(Bt[n]), "v"(At[m]), "v"(sc_w), "v"(sc_x)); __builtin_amdgcn_s_setprio(0); } while (0)
#define PG8_WAIT_V(n) asm volatile("s_waitcnt vmcnt(" #n ")" ::: "memory")
#define PG8_WAIT_L(n) asm volatile("s_waitcnt lgkmcnt(" #n ")" ::: "memory")
#define PG8_BAR __builtin_amdgcn_s_barrier()
#define PG8_SCHED __builtin_amdgcn_sched_barrier(0)
    const int sc_w = g.scale_b, sc_x = g.scale_a;
    Unit cur, nxt; int ui = 0;
    if (!S.next(0, cur)) return;
    f32x4 acc[2][2][4][2];
    f32x4 bv0[2][2];
    if constexpr (Epi::INIT == 1) E.bias_load(bv0, cur, wc, fq);
#pragma unroll
    for (int a = 0; a < 2; ++a)
#pragma unroll
        for (int b = 0; b < 2; ++b)
#pragma unroll
            for (int m = 0; m < 4; ++m)
#pragma unroll
                for (int n = 0; n < 2; ++n) { if constexpr (Epi::INIT == 1) acc[a][b][m][n] = bv0[b][n]; else acc[a][b][m][n] = (f32x4){0.f, 0.f, 0.f, 0.f}; }
    if constexpr (Epi::INIT == 2) E.tile_init(acc, cur, wr, wc, fr, fq);
    v8i_t At[4], B0[2], B1[2];
    const char* cA = cur.a; const char* cB = cur.b;
    unsigned goff[2][2]; int Rg[2], Cg[2];
    if constexpr (Sched::GATHER_A) {
#pragma unroll
        for (int i = 0; i < 2; ++i) { stage_rc(tid * 16 + i * 8192, Rg[i], Cg[i]); }
        const int* ix = S.idx(cur);
#pragma unroll
        for (int h = 0; h < 2; ++h)
#pragma unroll
            for (int i = 0; i < 2; ++i) goff[h][i] = (unsigned)ix[h * HALF + Rg[i]] * (unsigned)(K * 2) + (unsigned)(Cg[i] * 2);
    }
#define PG8_VA(h) goff[h]
#define PG8_AH(h) (Sched::GATHER_A ? (size_t)0 : (size_t)(h) * hstep)
    S.a_ready(cur);
    if constexpr (SP2) {
        PG8_STAGE(PG8_SB(0, 0), cB, voffB); PG8_STAGE(PG8_SB(0, 1), cB + hstep, voffB); PG8_STAGE_A(PG8_SA(0, 0), cA, 0); PG8_STAGE_A(PG8_SA(0, 1), cA, 1);
        if (wr == 1) PG8_BAR;
        PG8_WAIT_V(2); PG8_BAR;
        PG8_STAGE(PG8_SB(1, 0), cB + kstep, voffB); PG8_STAGE_A(PG8_SA(1, 0), cA + kstep, 0); PG8_STAGE(PG8_SB(1, 1), cB + hstep + kstep, voffB);
        PG8_WAIT_V(6); PG8_BAR;
    } else {
        PG8_STAGE(PG8_SB(0, 0), cB, voffB); PG8_STAGE_A(PG8_SA(0, 0), cA, 0); PG8_STAGE(PG8_SB(0, 1), cB + hstep, voffB); PG8_STAGE_A(PG8_SA(0, 1), cA, 1);
        if (wr == 1) PG8_BAR;
        PG8_WAIT_V(4); PG8_BAR;
        PG8_STAGE(PG8_SB(1, 0), cB + kstep, voffB); PG8_STAGE_A(PG8_SA(1, 0), cA + kstep, 0); PG8_STAGE(PG8_SB(1, 1), cB + hstep + kstep, voffB);
        PG8_WAIT_V(6); PG8_BAR;
    }
    for (;;) {
        const bool has_next = S.next(ui + 1, nxt);
        if constexpr (Sched::GATHER_A) { if (has_next && wid < 4) __builtin_amdgcn_global_load_lds((const unsigned*)(S.idx(nxt) + wid * 64 + lane), (PG8_LAS unsigned*)(lds + LDS_IDX + wid * 256), 4, 0, 0); }
        const char* nA = has_next ? nxt.a : cA; const char* nB = has_next ? nxt.b : cB;
#pragma unroll 1
        for (int t = 0; t < nt; t += 2) {
            const bool last = (t == nt - 2);
            const char* a1 = cA + (size_t)(t + 1) * kstep;
            const char* a2 = last ? nA : cA + (size_t)(t + 2) * kstep; const char* b2 = last ? nB : cB + (size_t)(t + 2) * kstep;
            const char* a3 = a2 + kstep; const char* b3 = b2 + kstep;
            if (last && has_next) S.a_ready(nxt);
            if constexpr (SP2) {
            PG8_LDB(B0, 0, 0); PG8_LDB(B1, 0, 1); PG8_SCHED; PG8_LDA(At, 0, 0); PG8_STAGE_A(PG8_SA(1, 1), a1, 1);
            if constexpr (Sched::GATHER_A) { if (last && has_next) {
                const PG8_LAS int* ixl = (const PG8_LAS int*)(lds + LDS_IDX);
#pragma unroll
                for (int h = 0; h < 2; ++h)
#pragma unroll
                    for (int i = 0; i < 2; ++i) goff[h][i] = (unsigned)ixl[h * HALF + Rg[i]] * (unsigned)(K * 2) + (unsigned)(Cg[i] * 2); } }
            PG8_WAIT_V(8); PG8_WAIT_L(0); PG8_BAR; PG8_MMA(0, 0, At, B0); PG8_MMA(0, 1, At, B1); PG8_BAR; PG8_SCHED;
            PG8_LDA(At, 0, 1); PG8_STAGE(PG8_SB(0, 0), b2, voffB); PG8_STAGE(PG8_SB(0, 1), b2 + hstep, voffB); PG8_STAGE_A(PG8_SA(0, 0), a2, 0);
            PG8_WAIT_V(8); PG8_WAIT_L(0); PG8_BAR; PG8_MMA(1, 0, At, B0); PG8_MMA(1, 1, At, B1); PG8_BAR; PG8_SCHED;
            PG8_LDB(B0, 1, 0); PG8_LDB(B1, 1, 1); PG8_SCHED; PG8_LDA(At, 1, 0); PG8_STAGE_A(PG8_SA(0, 1), a2, 1);
            PG8_WAIT_V(8); PG8_WAIT_L(0); PG8_BAR; PG8_MMA(0, 0, At, B0); PG8_MMA(0, 1, At, B1); PG8_BAR; PG8_SCHED;
            PG8_LDA(At, 1, 1); PG8_STAGE(PG8_SB(1, 0), b3, voffB); PG8_STAGE(PG8_SB(1, 1), b3 + hstep, voffB); PG8_STAGE_A(PG8_SA(1, 0), a3, 0);
            PG8_WAIT_V(8); PG8_WAIT_L(0); PG8_BAR; PG8_MMA(1, 0, At, B0); PG8_MMA(1, 1, At, B1); PG8_BAR; PG8_SCHED;
            } else {
            PG8_LDB(B0, 0, 0); PG8_SCHED; PG8_LDA(At, 0, 0); PG8_STAGE_A(PG8_SA(1, 1), a1, 1);
            PG8_WAIT_L(8); PG8_BAR; PG8_WAIT_L(0); PG8_MMA(0, 0, At, B0); PG8_BAR; PG8_SCHED;
            PG8_LDB(B1, 0, 1); PG8_STAGE(PG8_SB(0, 0), b2, voffB);
            PG8_BAR; PG8_WAIT_L(0); PG8_MMA(0, 1, At, B1); PG8_BAR;
            PG8_LDA(At, 0, 1); PG8_STAGE_A(PG8_SA(0, 0), a2, 0);
            PG8_BAR; PG8_WAIT_L(0); PG8_MMA(1, 0, At, B0); PG8_BAR; PG8_SCHED;
            PG8_STAGE(PG8_SB(0, 1), b2 + hstep, voffB);
            PG8_WAIT_V(6); PG8_BAR; PG8_MMA(1, 1, At, B1); PG8_BAR;
            PG8_LDB(B0, 1, 0); PG8_SCHED; PG8_LDA(At, 1, 0); PG8_STAGE_A(PG8_SA(0, 1), a2, 1);
            PG8_WAIT_L(8); PG8_BAR; PG8_WAIT_L(0); PG8_MMA(0, 0, At, B0); PG8_BAR; PG8_SCHED;
            PG8_LDB(B1, 1, 1); PG8_STAGE(PG8_SB(1, 0), b3, voffB);
            PG8_BAR; PG8_WAIT_L(0); PG8_MMA(0, 1, At, B1); PG8_BAR;
            PG8_LDA(At, 1, 1); PG8_STAGE_A(PG8_SA(1, 0), a3, 0);
            PG8_BAR; PG8_WAIT_L(0); PG8_MMA(1, 0, At, B0); PG8_BAR; PG8_SCHED;
            PG8_STAGE(PG8_SB(1, 1), b3 + hstep, voffB);
            PG8_WAIT_V(6); PG8_BAR; PG8_MMA(1, 1, At, B1); PG8_BAR;
            }
        }
        if constexpr (ALIGN_EPI) { if (wr == 0) PG8_BAR; }
        asm volatile("s_nop 15\n\ts_nop 7" ::: "memory"); __builtin_amdgcn_sched_barrier(0);
        f32x4 bvn[2][2]; if constexpr (Epi::INIT == 1) { if (has_next) E.bias_load(bvn, nxt, wc, fq); }
        if constexpr (!Epi::AFTER_DRAIN) { E(acc, cur, wr, wc, fr, fq); S.done(cur); }
        if (!has_next) break;
        if constexpr (!Epi::ACC_CHAIN) {
#pragma unroll
        for (int a = 0; a < 2; ++a)
#pragma unroll
            for (int b = 0; b < 2; ++b)
#pragma unroll
                for (int m = 0; m < 4; ++m)
#pragma unroll
                    for (int n = 0; n < 2; ++n) { if constexpr (Epi::INIT == 1) acc[a][b][m][n] = bvn[b][n]; else acc[a][b][m][n] = (f32x4){0.f, 0.f, 0.f, 0.f}; }
        if constexpr (Epi::INIT == 2) E.tile_init(acc, nxt, wr, wc, fr, fq);
        }
        cur = nxt; cA = nA; cB = nB; ++ui;
        if constexpr (ALIGN_EPI) { if (wr == 1) PG8_BAR; }
    }
    PG8_WAIT_V(0);
    if constexpr (!ALIGN_EPI) { if (wr == 0) PG8_BAR; }
    PG8_BAR;
    if constexpr (Epi::AFTER_DRAIN) { E.fused(acc, cur, wr, wc, fr, fq, lds, wid, lane); S.done(cur); }
#undef PG8_SA
#undef PG8_SB
#undef PG8_STAGE
#undef PG8_STAGE_A
#undef PG8_VA
#undef PG8_AH
#undef PG8_LDA
#undef PG8_LDB
#undef PG8_MMA
#undef PG8_F8
#undef PG8_WAIT_V
#undef PG8_WAIT_L
#undef PG8_BAR
#undef PG8_SCHED
}
}

typedef GAS unsigned gu32;
#define RLX_AGENT __ATOMIC_RELAXED, __HIP_MEMORY_SCOPE_AGENT
#define XB_TMO      128
#define XB_XCNT(j)  (256  + 64 * (j))
#define XB_XSUB(j)  (1280 + 64 * (j))
#define XB_XGEN(j)  (2304 + 64 * (j))
#define XB_TOP      3328
#define XB_TOPGEN   3392
#define XCD_BAR_WORDS 3456
#define XB_SPIN_CAP (1u << 26)

__device__ __forceinline__ unsigned xb_ld(unsigned* p)              { return __hip_atomic_load(p, __ATOMIC_RELAXED, __HIP_MEMORY_SCOPE_AGENT); }
__device__ __forceinline__ unsigned xb_add(unsigned* p, unsigned v) { return __hip_atomic_fetch_add(p, v, __ATOMIC_RELAXED, __HIP_MEMORY_SCOPE_AGENT); }
__device__ __forceinline__ unsigned xb_xcc_id() { return (unsigned)__builtin_amdgcn_s_getreg((3 << 11) | 20) & 0xFu; }
#define XB_SPIN(cond, bar) do { unsigned _sp = 0; while (cond) { __builtin_amdgcn_s_sleep(1); \
    if ((++_sp & 255u) == 0u) { if (xb_ld(&(bar)[XB_TMO])) break; if (_sp > XB_SPIN_CAP) { atomicAdd(&(bar)[XB_TMO], 1u); break; } } } } while (0)

struct XcdBarrier {
    unsigned* bar; unsigned x;
    volatile LAS unsigned* st;
};

__device__ __forceinline__ XcdBarrier xcd_barrier_post(unsigned* bar, volatile LAS unsigned* st) {
    XcdBarrier b; b.bar = bar; b.x = xb_xcc_id(); b.st = st;
    if (threadIdx.x == 0) (void)xb_add(&bar[XB_XCNT(b.x)], 1u);
    return b;
}
__device__ __forceinline__ void xcd_barrier_complete(unsigned* bar, unsigned x, unsigned& nloc, unsigned& nx) {
    const unsigned G = gridDim.x * gridDim.y * gridDim.z;
    unsigned sum, cnt, mine, sp = 0u;
    for (;;) {
        sum = 0u; cnt = 0u; mine = 0u;
#pragma unroll
        for (unsigned j = 0; j < 16; ++j) { const unsigned c = xb_ld(&bar[XB_XCNT(j)]); sum += c; cnt += (c > 0u) ? 1u : 0u; mine = (j == x) ? c : mine; }
        if (sum == G) break;
        __builtin_amdgcn_s_sleep(1);
        if ((++sp & 255u) == 0u) { if (xb_ld(&bar[XB_TMO])) break; if (sp > XB_SPIN_CAP) { atomicAdd(&bar[XB_TMO], 1u); break; } }
    }
    nloc = mine > 0u ? mine : 1u; nx = cnt > 0u ? cnt : 1u;
}

__device__ __forceinline__ void xcd_barrier(const XcdBarrier& b) {
    asm volatile("s_waitcnt vmcnt(0)" ::: "memory");
    __syncthreads();
    if (threadIdx.x == 0) {
        unsigned* bar = b.bar;
        __builtin_amdgcn_s_waitcnt(0);
        unsigned nloc = b.st[0], nx = b.st[1];
        if (nloc == 0u) { xcd_barrier_complete(bar, b.x, nloc, nx); b.st[0] = nloc; b.st[1] = nx; }
        const unsigned old = xb_add(&bar[XB_XSUB(b.x)], 1u);
        const unsigned gen = old / nloc;
        if (old + 1u == (gen + 1u) * nloc) {
            __builtin_amdgcn_fence(__ATOMIC_RELEASE, "agent");
            asm volatile("s_waitcnt vmcnt(0)" ::: "memory");
            const unsigned og = xb_add(&bar[XB_TOP], 1u);
            const unsigned tg = og / nx;
            if (og + 1u == (tg + 1u) * nx) xb_add(&bar[XB_TOPGEN], 1u);
            else XB_SPIN(xb_ld(&bar[XB_TOPGEN]) == tg, bar);
            __builtin_amdgcn_fence(__ATOMIC_ACQUIRE, "");
            xb_add(&bar[XB_XGEN(b.x)], 1u);
            asm volatile("s_waitcnt vmcnt(0)" ::: "memory");
        } else {
            XB_SPIN(xb_ld(&bar[XB_XGEN(b.x)]) == gen, bar);
            __builtin_amdgcn_fence(__ATOMIC_ACQUIRE, "");
            asm volatile("s_waitcnt vmcnt(0)" ::: "memory");
        }
    }
    __syncthreads();
}


template <bool BG, class ArgsT> __device__ __forceinline__ void xcd_barrier_bg(const XcdBarrier& b, const ArgsT& A, LAS unsigned char* lds, volatile LAS unsigned* MISC);
__device__ __forceinline__ int fresh_tid() { int t = threadIdx.x; asm volatile("" : "+v"(t)); return t; }
#define FRESH_IDS() const int tid = fresh_tid(), lane = tid & 63, wave = __builtin_amdgcn_readfirstlane(tid >> 6); (void)tid; (void)lane; (void)wave
struct Args { const float* in[17]; float* out; unsigned char* ws; int ph_lo, ph_hi, li, pad; };

__device__ __forceinline__ void p0_transpose_item(const float* W, int K, int N, bf16_t* WT, LAS float* scr, int item, int lane) {
    (void)scr;
    const int nblk = N / 32, kb = item / nblk, nb = item % nblk, k0 = 64 * kb + 8 * (lane >> 3), n0 = 32 * nb + 4 * (lane & 7);
    f32x4 v[8];
#pragma unroll
    for (int j2 = 0; j2 < 8; ++j2) v[j2] = *(const GAS f32x4*)(W + (size_t)(k0 + j2) * N + n0);
#pragma unroll
    for (int i2 = 0; i2 < 4; ++i2) { u32x4 o; o.x = pk2(v[0][i2], v[1][i2]); o.y = pk2(v[2][i2], v[3][i2]); o.z = pk2(v[4][i2], v[5][i2]); o.w = pk2(v[6][i2], v[7][i2]);
        *(GAS u32x4*)(WT + (size_t)(n0 + i2) * K + k0) = o; }
}
__device__ __forceinline__ void p0_transpose_item_f8(const float* W, int K, int N, unsigned char* WT8, LAS float* scr, int item, int lane, float wscale, int nblk_sub = 0) {
    (void)scr;
    const int nblk = nblk_sub ? nblk_sub : N / 32, kb = (item / (2 * nblk)) * 2 + (item & 1), nb = (item >> 1) % nblk, k0 = 64 * kb + 8 * (lane >> 3), n0 = 32 * nb + 4 * (lane & 7);
    f32x4 v[8];
#pragma unroll
    for (int j2 = 0; j2 < 8; ++j2) v[j2] = *(const GAS f32x4*)(W + (size_t)(k0 + j2) * N + n0);
#pragma unroll
    for (int i = 0; i < 4; ++i) { u32x2 o; o.x = pk4_fp8(v[0][i] * wscale, v[1][i] * wscale, v[2][i] * wscale, v[3][i] * wscale); o.y = pk4_fp8(v[4][i] * wscale, v[5][i] * wscale, v[6][i] * wscale, v[7][i] * wscale);
        *(GAS u32x2*)(WT8 + (size_t)(n0 + i) * K + k0) = o; }
}
constexpr int BG_BATCH = 8, BG_I_UP1 = (DM / 64) * (UPW / 32), BG_I_DN1 = (DFF / 64) * (DM / 32), BG_I_UP = NEXP * BG_I_UP1, BG_TOTAL = BG_I_UP + NEXP * BG_I_DN1;
static_assert(BG_I_UP % BG_BATCH == 0 && BG_TOTAL % BG_BATCH == 0, "batches do not straddle the up/down boundary");
__device__ __forceinline__ void bg_item(const Args& A, int it, LAS float* scr, int lane) {
    if (it < BG_I_UP) { const int e = it / BG_I_UP1;
#if MK_FP8_UP
        p0_transpose_item_f8(A.in[11] + (size_t)e * DM * UPW, DM, UPW, (unsigned char*)(A.ws + WS_WUPT) + (size_t)e * DM * UPW, scr, it % BG_I_UP1, lane, W8_SCALE);
#else
        p0_transpose_item(A.in[11] + (size_t)e * DM * UPW, DM, UPW, (bf16_t*)(A.ws + WS_WUPT) + (size_t)e * DM * UPW, scr, it % BG_I_UP1, lane);
#endif
    }
    else { const int r = it - BG_I_UP, e = r / BG_I_DN1;
#if MK_FP8_DN
        p0_transpose_item_f8(A.in[13] + (size_t)e * DFF * DM, DFF, DM, (unsigned char*)(A.ws + WS_WDNT) + (size_t)e * DFF * DM, scr, r % BG_I_DN1, lane, W8_SCALE);
#else
        p0_transpose_item(A.in[13] + (size_t)e * DFF * DM, DFF, DM, (bf16_t*)(A.ws + WS_WDNT) + (size_t)e * DFF * DM, scr, r % BG_I_DN1, lane);
#endif
    }
}
__device__ __forceinline__ bool bg_step(const Args& A, volatile LAS int* st, LAS float* scr, int lane, int limit) {
    int cur = st[0], end = st[1];
    if (cur >= end) {
        if (cur >= BG_TOTAL) return false;
        int start = 0; if (lane == 0) start = __hip_atomic_fetch_add((int*)(A.ws + WS_CTL) + CW_BGQ, BG_BATCH, __ATOMIC_RELAXED, __HIP_MEMORY_SCOPE_AGENT);
        start = __builtin_amdgcn_readfirstlane(start);
        if (start >= BG_TOTAL) { if (lane == 0) { st[0] = BG_TOTAL; st[1] = BG_TOTAL; } return false; }
        cur = start; end = start + BG_BATCH; if (lane == 0) { st[0] = cur; st[1] = end; }
    }
    if (cur >= limit) return false;
    bg_item(A, cur, scr, lane);
    if (lane == 0) st[0] = cur + 1;
    return true;
}
__device__ __forceinline__ void phase_prologue(const Args& A, LAS unsigned char* lds, int gw, int NGW, int lane, int wave) {
    unsigned char* ws = A.ws;
    LAS float* scr = (LAS float*)(lds + wave * 16384);
    constexpr int I_IN = (DM / 64) * (INW / 32), I_BS = (SBW / 64) * (DM / 32), I_WO = (DM / 64) * (DM / 32), I_RW = (DM / 64) * (NEXP / 32);
    constexpr int I_UP1 = (DM / 64) * (UPW / 32), I_DN1 = (DFF / 64) * (DM / 32), I_UP = NEXP * I_UP1, I_DN = NEXP * I_DN1;
    constexpr int NITEMS = I_IN + 2 * I_BS + I_WO + I_RW + (MK_BG ? 0 : I_UP + I_DN);
    for (int it = gw; it < NITEMS; it += NGW) {
        int r = it;
#if MK_FP8_GATES
        if (r < I_IN) { constexpr int NB16 = 3072 / 32, NB8 = (INW - 3072) / 32, I16 = (DM / 64) * NB16;
            if (r < I16) { const int kb = r / NB16, nb = r % NB16; p0_transpose_item(A.in[1], DM, INW, (bf16_t*)(ws + WS_WINT), scr, kb * (INW / 32) + nb, lane); }
            else p0_transpose_item_f8(A.in[1] + 3072, DM, INW, (unsigned char*)(ws + WS_WINT8), scr, r - I16, lane, W8_SCALE, NB8);
            continue; } r -= I_IN;
#else
        if (r < I_IN) { p0_transpose_item(A.in[1], DM, INW, (bf16_t*)(ws + WS_WINT), scr, r, lane); continue; } r -= I_IN;
#endif
        if (r < I_BS) { p0_transpose_item(A.in[4], SBW, DM, (bf16_t*)(ws + WS_WBST), scr, r, lane); continue; } r -= I_BS;
        if (r < I_BS) { p0_transpose_item(A.in[5], HGW, DM, (bf16_t*)(ws + WS_WBHT), scr, r, lane); continue; } r -= I_BS;
        if (r < I_WO) { p0_transpose_item(A.in[6], DM, DM, (bf16_t*)(ws + WS_WOT), scr, r, lane); continue; } r -= I_WO;
        if (r < I_RW) { p0_transpose_item(A.in[9], DM, NEXP, (bf16_t*)(ws + WS_RWT), scr, r, lane); continue; } r -= I_RW;
        if (r < I_UP) { const int e = r / I_UP1; p0_transpose_item(A.in[11] + (size_t)e * DM * UPW, DM, UPW, (bf16_t*)(ws + WS_WUPT) + (size_t)e * DM * UPW, scr, r % I_UP1, lane); continue; } r -= I_UP;
        { const int e = r / I_DN1; p0_transpose_item(A.in[13] + (size_t)e * DFF * DM, DFF, DM, (bf16_t*)(ws + WS_WDNT) + (size_t)e * DFF * DM, scr, r % I_DN1, lane); }
    }
    bf16_t* XB = (bf16_t*)(ws + WS_XB);
    for (int m0 = gw; m0 < NTOK; m0 += MK_P0_ROWS * NGW) {
        f32x4 xv[MK_P0_ROWS][4];
#pragma unroll
        for (int q = 0; q < MK_P0_ROWS; ++q) { const int m = m0 + q * NGW; const GAS f32x4* xr = (const GAS f32x4*)(A.in[0] + (size_t)(m < NTOK ? m : m0) * DM) + lane;
#pragma unroll
            for (int j = 0; j < 4; ++j) xv[q][j] = xr[64 * j]; }
#pragma unroll
        for (int q = 0; q < MK_P0_ROWS; ++q) { const int m = m0 + q * NGW; if (m < NTOK) { GAS u32x2* o8 = (GAS u32x2*)(XB + (size_t)m * DM) + lane;
#pragma unroll
            for (int j = 0; j < 4; ++j) { const f32x4 v = xv[q][j]; u32x2 w; w.x = pk2(v[0], v[1]); w.y = pk2(v[2], v[3]); o8[64 * j] = w;
#if MK_FP8_GATES
                ((GAS unsigned*)((unsigned char*)(ws + WS_XB8) + (size_t)m * DM))[lane + 64 * j] = pk4_fp8(v[0], v[1], v[2], v[3]);
#endif
            } } }
    }
    if (gw < 8) { const int c = gw * 64 + lane; const float l0 = A.in[2][c], l1 = A.in[2][HGW + c]; ((float*)(ws + WS_LB))[c] = 1.0f / (1.0f + expf(l1 - l0)); }
}

__device__ __forceinline__ void attn_naive_unit(const bf16_t* __restrict__ Q, const bf16_t* __restrict__ K, const bf16_t* __restrict__ V, bf16_t* __restrict__ O, int bh, int qb, int lane) {
    const int b = bh >> 3, h = bh & 7, t = qb * 64 + lane; const size_t rowbase = (size_t)b * SEQ;
    float q[64], o[64];
    { const bf16_t* qp = Q + (rowbase + t) * SBW + h * SBD;
#pragma unroll
      for (int d = 0; d < 64; ++d) { q[d] = bf2f(qp[d]); o[d] = 0.f; } }
    float R = 1.0f;
    for (int s = qb * 64 + 63; s >= 0; --s) {
        const bf16_t* kr = K + (rowbase + s) * SBW + h * SBD; const bf16_t* vr = V + (rowbase + s) * SBW + h * SBD;
        float z = 0.f;
#pragma unroll
        for (int d = 0; d < 64; ++d) z += q[d] * bf2f(kr[d]);
        const bool valid = s < t;
        const float ez = expf(fminf(z, 60.0f)), keep = 1.0f / (1.0f + ez);
        const float a = valid ? ez * keep * R : 0.f;
        R = valid ? R * keep : R;
#pragma unroll
        for (int d = 0; d < 64; ++d) o[d] += a * bf2f(vr[d]);
    }
    bf16_t* op = O + (rowbase + t) * SBW + h * SBD;
#pragma unroll
    for (int d = 0; d < 64; ++d) op[d] = (bf16_t)f2bf(o[d]);
}
__device__ __forceinline__ void hgrn_naive_block(const bf16_t* __restrict__ HQ, const bf16_t* __restrict__ HK, const float* __restrict__ LOGF, const bf16_t* __restrict__ HV, float* __restrict__ ORAW,
                                                 LAS unsigned char* lds, int blk, int tid) {
    const int grp = tid >> 7, v = tid & 127, bh = blk * 4 + grp, b = bh >> 2, hh = bh & 3;
    LAS float* sf = (LAS float*)lds + grp * 384; LAS float* sk = sf + 128; LAS float* sq = sf + 256;
    float S[128];
#pragma unroll
    for (int k = 0; k < 128; ++k) S[k] = 0.f;
    for (int t = 0; t < SEQ; ++t) {
        const size_t base = ((size_t)b * SEQ + t) * HGW + hh * HGD;
        sf[v] = expf(LOGF[base + v]); sk[v] = bf2f(HK[base + v]); sq[v] = bf2f(HQ[base + v]);
        const float vv = bf2f(HV[base + v]);
        __syncthreads();
        float o = 0.f;
#pragma unroll
        for (int k = 0; k < 128; ++k) { S[k] = sf[k] * S[k] + sk[k] * vv; o += sq[k] * S[k]; }
        ORAW[base + v] = o;
        __syncthreads();
    }
}
__device__ __forceinline__ void hgrn_post_item(const float* __restrict__ ORAW, const bf16_t* __restrict__ HG, const float* __restrict__ norm_g, bf16_t* __restrict__ OHG, int item, int lane) {
    const size_t base = (size_t)item * HGD; const int c0 = (item & 3) * HGD;
    const float x0 = ORAW[base + lane], x1 = ORAW[base + 64 + lane];
    const float r = 1.0f / sqrtf(wave_sum(x0 * x0 + x1 * x1) * (1.0f / HGD) + RMS_EPS);
    OHG[base + lane] = (bf16_t)f2bf(x0 * r * norm_g[c0 + lane] * bf2f(HG[base + lane]));
    OHG[base + 64 + lane] = (bf16_t)f2bf(x1 * r * norm_g[c0 + 64 + lane] * bf2f(HG[base + 64 + lane]));
}

__device__ __forceinline__ int crow(int r, int hi) { return (r & 3) + 8 * (r >> 2) + 4 * hi; }
typedef short v4i16_t __attribute__((ext_vector_type(4)));
__device__ __forceinline__ v4i16_t tr16(LAS const unsigned char* p) { return __builtin_amdgcn_ds_read_tr16_b64_v4i16((LAS v4i16_t*)p); }
__device__ __forceinline__ bf16x8 cat8(v4i16_t lo, v4i16_t hi) { return (bf16x8){lo[0], lo[1], lo[2], lo[3], hi[0], hi[1], hi[2], hi[3]}; }
__device__ __forceinline__ bf16x8 pack8(const f32x16& p, int base) {
    u32x4 w; w.x = pg8::cvt_pk_bf16(p[base + 0], p[base + 1]); w.y = pg8::cvt_pk_bf16(p[base + 2], p[base + 3]); w.z = pg8::cvt_pk_bf16(p[base + 4], p[base + 5]); w.w = pg8::cvt_pk_bf16(p[base + 6], p[base + 7]);
    return __builtin_bit_cast(bf16x8, w);
}
__device__ __forceinline__ float xhalf(float v) {
    auto rr = __builtin_amdgcn_permlane32_swap(__float_as_uint(v), __float_as_uint(v), false, false);
    return __uint_as_float((threadIdx.x & 32) ? rr[0] : rr[1]);
}
#define WAIT_ALL_BAR() asm volatile("s_waitcnt vmcnt(0) lgkmcnt(0)\n\ts_barrier" ::: "memory")

constexpr int AT_K = 0, AT_V = 16384, AT_OST = 32768, AT_Q = 65536, AT_FLAG = 65600;
__device__ __forceinline__ void attn_unit(const bf16_t* Q, const bf16_t* K, const bf16_t* V, bf16_t* O, int bh, int qb, LAS unsigned char* lds, int lane, int wid) {
    const int b = bh >> 3, h = bh & 7, r32 = lane & 31, hi = lane >> 5;
    const size_t rowbase = (size_t)b * SEQ; const int q0 = qb * 256, qw0 = q0 + wid * 32;
    bf16x8 qr[4];
    { const bf16_t* qp = Q + (rowbase + qw0 + r32) * SBW + h * SBD + hi * 8;
#pragma unroll
      for (int d0 = 0; d0 < 4; ++d0) qr[d0] = *(const bf16x8*)(qp + d0 * 16); }
    f32x16 o0 = {}, o1 = {}; float R = 1.0f;
    const int NT = 4 * qb + 4;
    const bf16_t* ksrc = K + (rowbase + lane) * SBW + h * SBD + wid * 8;
    const bf16_t* vsrc = V + (rowbase + 16 * (wid & 3) + (lane >> 2)) * SBW + h * SBD + (wid >> 2) * 32 + (lane & 3) * 8;
    LAS unsigned char* kdst = lds + AT_K + wid * 1024; LAS unsigned char* vdst = lds + AT_V + wid * 1024;
    const int vb = ((lane >> 4) & 1) * 32 + (lane & 3) * 8 + (4 * hi + ((lane & 15) >> 2)) * 64;
    { const size_t go = (size_t)(NT - 1) * 64 * SBW;
      __builtin_amdgcn_global_load_lds((const unsigned*)(ksrc + go), (LAS unsigned*)kdst, 16, 0, 0);
      __builtin_amdgcn_global_load_lds((const unsigned*)(vsrc + go), (LAS unsigned*)vdst, 16, 0, 0); }
    if (lane == 0) *(LAS int*)(lds + AT_FLAG + wid * 4) = 0;
    for (int it = 0; it < NT; ++it) {
        const int kt = NT - 1 - it, slot = (it & 1) * 8192, k0 = kt * 64;
        WAIT_ALL_BAR();
        { const u32x4 f0 = *(const LAS u32x4*)(lds + AT_FLAG), f1 = *(const LAS u32x4*)(lds + AT_FLAG + 16);
          if (__builtin_amdgcn_readfirstlane((f0.x & f0.y & f0.z & f0.w & f1.x & f1.y & f1.z & f1.w) != 0u)) break; }
        if (it + 1 < NT) { const size_t go = (size_t)(kt - 1) * 64 * SBW;
            __builtin_amdgcn_global_load_lds((const unsigned*)(ksrc + go), (LAS unsigned*)(kdst + (slot ^ 8192)), 16, 0, 0);
            __builtin_amdgcn_global_load_lds((const unsigned*)(vsrc + go), (LAS unsigned*)(vdst + (slot ^ 8192)), 16, 0, 0); }
        if (k0 < qw0 + 31) {
            f32x16 p0 = {}, p1 = {};
            const LAS unsigned char* kb = lds + AT_K + slot + hi * 1024 + r32 * 16;
#pragma unroll
            for (int d0 = 0; d0 < 4; ++d0) {
                const bf16x8 a0 = *(const LAS bf16x8*)(kb + d0 * 2048), a1 = *(const LAS bf16x8*)(kb + d0 * 2048 + 512);
                p0 = __builtin_amdgcn_mfma_f32_32x32x16_bf16(a0, qr[d0], p0, 0, 0, 0);
                p1 = __builtin_amdgcn_mfma_f32_32x32x16_bf16(a1, qr[d0], p1, 0, 0, 0);
            }
#pragma unroll
            for (int r = 0; r < 16; ++r) { p0[r] = __builtin_amdgcn_rcpf(1.0f + __builtin_amdgcn_exp2f(p0[r])); p1[r] = __builtin_amdgcn_rcpf(1.0f + __builtin_amdgcn_exp2f(p1[r])); }
            if (k0 + 63 >= qw0) {
                const int tq = qw0 + r32 - k0 - 4 * hi;
#pragma unroll
                for (int r = 0; r < 16; ++r) { const int kv = (r & 3) + 8 * (r >> 2); if (kv >= tq) p0[r] = 1.0f; if (kv + 32 >= tq) p1[r] = 1.0f; }
            }
            float gm[8], gp[8];
#pragma unroll
            for (int i = 0; i < 4; ++i) { gm[i] = (p0[4 * i] * p0[4 * i + 1]) * (p0[4 * i + 2] * p0[4 * i + 3]); gm[4 + i] = (p1[4 * i] * p1[4 * i + 1]) * (p1[4 * i + 2] * p1[4 * i + 3]); }
#pragma unroll
            for (int i = 0; i < 8; ++i) gp[i] = xhalf(gm[i]);
            float run = R, E[8];
#pragma unroll
            for (int i = 7; i >= 0; --i) {
                const float pre = hi ? 1.0f : gp[i], post = hi ? gp[i] : 1.0f;
                run *= pre; E[i] = run; run *= gm[i]; run *= post;
            }
            R = run;
#pragma unroll
            for (int i = 0; i < 4; ++i) {
                { float X = E[i];
#pragma unroll
                  for (int j = 3; j >= 0; --j) { const float s = p0[4 * i + j] * X; p0[4 * i + j] = X - s; X = s; } }
                { float X = E[4 + i];
#pragma unroll
                  for (int j = 3; j >= 0; --j) { const float s = p1[4 * i + j] * X; p1[4 * i + j] = X - s; X = s; } }
            }
            const bf16x8 pa0 = pack8(p0, 0), pa1 = pack8(p0, 8), pa2 = pack8(p1, 0), pa3 = pack8(p1, 8);
            const LAS unsigned char* vp = lds + AT_V + slot + vb;
#pragma unroll
            for (int d0 = 0; d0 < 2; ++d0) {
                f32x16 acc = d0 ? o1 : o0;
                acc = __builtin_amdgcn_mfma_f32_32x32x16_bf16(pa0, cat8(tr16(vp + d0 * 4096), tr16(vp + d0 * 4096 + 512)), acc, 0, 0, 0);
                acc = __builtin_amdgcn_mfma_f32_32x32x16_bf16(pa1, cat8(tr16(vp + d0 * 4096 + 1024), tr16(vp + d0 * 4096 + 1024 + 512)), acc, 0, 0, 0);
                acc = __builtin_amdgcn_mfma_f32_32x32x16_bf16(pa2, cat8(tr16(vp + d0 * 4096 + 2048), tr16(vp + d0 * 4096 + 2048 + 512)), acc, 0, 0, 0);
                acc = __builtin_amdgcn_mfma_f32_32x32x16_bf16(pa3, cat8(tr16(vp + d0 * 4096 + 3072), tr16(vp + d0 * 4096 + 3072 + 512)), acc, 0, 0, 0);
                if (d0) o1 = acc; else o0 = acc;
            }
            { const int allz = __all(R == 0.0f) ? 1 : 0; if (lane == 0) *(LAS int*)(lds + AT_FLAG + wid * 4) = allz; }
        }
    }
    { LAS unsigned short* stg = (LAS unsigned short*)(lds + AT_OST + wid * 4096);
#pragma unroll
      for (int r = 0; r < 16; ++r) { const int orow = crow(r, hi); stg[orow * 64 + r32] = (unsigned short)f2bf(o0[r]); stg[orow * 64 + 32 + r32] = (unsigned short)f2bf(o1[r]); }
      LDS_WAIT();
      bf16_t* Ow = O + (rowbase + qw0) * SBW + h * SBD;
#pragma unroll
      for (int i = 0; i < 4; ++i) { const int row = i * 8 + (lane >> 3), ch = lane & 7; const u32x4 v = *(const LAS u32x4*)((LAS unsigned char*)stg + row * 128 + ch * 16); *(u32x4*)(Ow + (size_t)row * SBW + ch * 8) = v; } }
}

constexpr int HP_RD = 272, HP_TR = 320;
constexpr int HL_QT = 0, HL_KH = HL_QT + 64 * HP_RD, HL_KD = HL_KH + 64 * HP_RD, HL_VT = HL_KD + 64 * HP_TR, HL_SB = HL_VT + 64 * HP_TR, HL_DEC = HL_SB + 128 * HP_TR, HL_SEG = HL_DEC + 512, HL_END = HL_SEG + 8 * 128 * 4;
static_assert(HL_END <= LDS_SCRATCH, "HGRN LDS map");
constexpr int HG_GROUPS = 8, HG_CHUNKS = SEQ / 64 / HG_GROUPS;
#define LDS_BAR() asm volatile("s_waitcnt lgkmcnt(0)\n\ts_barrier" ::: "memory")
__device__ __forceinline__ void hgrn_unit_a(const bf16_t* HQ, const bf16_t* HK, const float* LOGF, const bf16_t* HV, float* ORAW, bf16_t* QC, float* DS, float* DG, int unit, LAS unsigned char* lds, int tid, int lane, int wid) {
    const int bh = unit >> 3, g = unit & 7, b = bh >> 2, hh = bh & 3, r32 = lane & 31, hi = lane >> 5, tb = wid >> 2, vj = wid & 3;
    const size_t row0 = (size_t)b * SEQ + (size_t)g * (SEQ / HG_GROUPS); const int cb = hh * HGD;
    const int kp = lane, seg = wid;
    const int vr = tid >> 3, vp8 = tid & 7;
    for (int i = tid; i < 128 * HP_TR / 16; i += NTHREADS) *(LAS u32x4*)(lds + HL_SB + i * 16) = (u32x4){0u, 0u, 0u, 0u};
    f32x16 S0 = {}, S1 = {};
    float gb0 = 0.f, gb1 = 0.f;
    f32x2_t lf[8]; unsigned qv[8], kv[8]; u32x4 vv0, vv1;
#define HG_LOAD(c) do { const size_t base_ = (row0 + (size_t)(c) * 64 + 8 * seg) * HGW + cb + 2 * kp; \
        _Pragma("unroll") for (int i = 0; i < 8; ++i) { lf[i] = *(const f32x2_t*)(LOGF + base_ + (size_t)i * HGW); qv[i] = *(const unsigned*)(HQ + base_ + (size_t)i * HGW); kv[i] = *(const unsigned*)(HK + base_ + (size_t)i * HGW); } \
        const bf16_t* vsrc_ = HV + (row0 + (size_t)(c) * 64 + vr) * HGW + cb + vp8 * 16; vv0 = *(const u32x4*)vsrc_; vv1 = *(const u32x4*)(vsrc_ + 8); } while (0)
    HG_LOAD(0);
    for (int c = 0; c < HG_CHUNKS; ++c) {
        float cs0[8], cs1[8]; { float a0 = 0.f, a1 = 0.f;
#pragma unroll
            for (int i = 0; i < 8; ++i) { a0 += lf[i].x; a1 += lf[i].y; cs0[i] = a0; cs1[i] = a1; } }
        *(LAS f32x2_t*)(lds + HL_SEG + (seg * 128 + 2 * kp) * 4) = (f32x2_t){cs0[7], cs1[7]};
        *(LAS u32x4*)(lds + HL_VT + vr * HP_TR + vp8 * 32) = vv0; *(LAS u32x4*)(lds + HL_VT + vr * HP_TR + vp8 * 32 + 16) = vv1;
        LDS_BAR();
        { float pre0 = 0.f, pre1 = 0.f, bl0 = 0.f, bl1 = 0.f;
#pragma unroll
          for (int s2 = 0; s2 < 8; ++s2) { const f32x2_t t = *(const LAS f32x2_t*)(lds + HL_SEG + (s2 * 128 + 2 * kp) * 4); if (s2 < seg) { pre0 += t.x; pre1 += t.y; } bl0 += t.x; bl1 += t.y; }
          if (seg == 0) *(LAS f32x2_t*)(lds + HL_DEC + 2 * kp * 4) = (f32x2_t){__builtin_amdgcn_exp2f(bl0 * LOG2E), __builtin_amdgcn_exp2f(bl1 * LOG2E)};
          const size_t qcb = (row0 + (size_t)c * 64 + 8 * seg) * HGW + cb + 2 * kp;
          const float eB0 = __builtin_amdgcn_exp2f(bl0 * LOG2E), eB1 = __builtin_amdgcn_exp2f(bl1 * LOG2E), eG0 = __builtin_amdgcn_exp2f(fmaxf(gb0 * LOG2E, -120.f)), eG1 = __builtin_amdgcn_exp2f(fmaxf(gb1 * LOG2E, -120.f));
#pragma unroll
          for (int i = 0; i < 8; ++i) { const int t = 8 * seg + i;
              const f32x2_t bb = ((f32x2_t){pre0, pre1} + (f32x2_t){cs0[i], cs1[i]}) * (f32x2_t){LOG2E, LOG2E};
              const f32x2_t qe = (f32x2_t){bflo(qv[i]), bfhi(qv[i])} * (f32x2_t){__builtin_amdgcn_exp2f(__builtin_amdgcn_fmed3f(bb[0], -120.f, INFINITY)), __builtin_amdgcn_exp2f(__builtin_amdgcn_fmed3f(bb[1], -120.f, INFINITY))};
              const f32x2_t ke = (f32x2_t){bflo(kv[i]), bfhi(kv[i])} * (f32x2_t){__builtin_amdgcn_exp2f(__builtin_amdgcn_fmed3f(-bb[0], -INFINITY, 120.f)), __builtin_amdgcn_exp2f(__builtin_amdgcn_fmed3f(-bb[1], -INFINITY, 120.f))};
              const f32x2_t kd = ke * (f32x2_t){eB0, eB1}, qc = qe * (f32x2_t){eG0, eG1};
              *(LAS unsigned*)(lds + HL_QT + t * HP_RD + kp * 4) = pg8::cvt_pk_bf16(qe[0], qe[1]);
              *(LAS unsigned*)(lds + HL_KH + t * HP_RD + kp * 4) = pg8::cvt_pk_bf16(ke[0], ke[1]);
              *(LAS unsigned*)(lds + HL_KD + t * HP_TR + kp * 4) = pg8::cvt_pk_bf16(kd[0], kd[1]);
              if (g > 0) *(unsigned*)(QC + qcb + (size_t)i * HGW) = pg8::cvt_pk_bf16(qc[0], qc[1]); }
          gb0 += bl0; gb1 += bl1; }
        if (c + 1 < HG_CHUNKS) HG_LOAD(c + 1);
        LDS_BAR();
        f32x16 oacc = {};
        bf16x8 pa[2][2];
#pragma unroll
        for (int a = 0; a < 2; ++a) if (a <= tb) {
            f32x16 x = {};
#pragma unroll
            for (int ks = 0; ks < 8; ++ks) {
                const bf16x8 af = *(const LAS bf16x8*)(lds + HL_KH + (32 * a + r32) * HP_RD + (16 * ks + 8 * hi) * 2);
                const bf16x8 bfr = *(const LAS bf16x8*)(lds + HL_QT + (32 * tb + r32) * HP_RD + (16 * ks + 8 * hi) * 2);
                x = __builtin_amdgcn_mfma_f32_32x32x16_bf16(af, bfr, x, 0, 0, 0);
            }
            if (a == tb) {
#pragma unroll
                for (int r = 0; r < 16; ++r) if (crow(r, hi) > r32) x[r] = 0.f;
            }
            pa[a][0] = pack8(x, 0); pa[a][1] = pack8(x, 8);
        }
#pragma unroll
        for (int ks = 0; ks < 8; ++ks) {
            const bf16x8 af = *(const LAS bf16x8*)(lds + HL_QT + (32 * tb + r32) * HP_RD + (16 * ks + 8 * hi) * 2);
            const LAS unsigned char* sp = lds + HL_SB + (16 * ks + 8 * hi + ((lane & 15) >> 2)) * HP_TR + (32 * vj + 16 * ((lane >> 4) & 1) + 4 * (lane & 3)) * 2;
            oacc = __builtin_amdgcn_mfma_f32_32x32x16_bf16(af, cat8(tr16(sp), tr16(sp + 4 * HP_TR)), oacc, 0, 0, 0);
        }
#pragma unroll
        for (int a = 0; a < 2; ++a) if (a <= tb) {
#pragma unroll
            for (int s2 = 0; s2 < 2; ++s2) {
                const LAS unsigned char* vp = lds + HL_VT + (32 * a + 16 * s2 + 4 * hi + ((lane & 15) >> 2)) * HP_TR + (32 * vj + 16 * ((lane >> 4) & 1) + 4 * (lane & 3)) * 2;
                oacc = __builtin_amdgcn_mfma_f32_32x32x16_bf16(pa[a][s2], cat8(tr16(vp), tr16(vp + 8 * HP_TR)), oacc, 0, 0, 0);
            }
        }
#pragma unroll
        for (int u = 0; u < 2; ++u) {
            f32x16 Sx = u ? S1 : S0; const int kt = 2 * tb + u;
            const LAS float* dec = (const LAS float*)(lds + HL_DEC) + 32 * kt;
#pragma unroll
            for (int r = 0; r < 16; ++r) Sx[r] *= dec[crow(r, hi)];
#pragma unroll
            for (int ks = 0; ks < 4; ++ks) {
                const int srow = 16 * ks + 8 * hi + ((lane & 15) >> 2), cq = 16 * ((lane >> 4) & 1) + 4 * (lane & 3);
                const LAS unsigned char* ap = lds + HL_KD + srow * HP_TR + (32 * kt + cq) * 2;
                const LAS unsigned char* bp = lds + HL_VT + srow * HP_TR + (32 * vj + cq) * 2;
                Sx = __builtin_amdgcn_mfma_f32_32x32x16_bf16(cat8(tr16(ap), tr16(ap + 4 * HP_TR)), cat8(tr16(bp), tr16(bp + 4 * HP_TR)), Sx, 0, 0, 0);
            }
            if (u) S1 = Sx; else S0 = Sx;
        }
        { float* op = ORAW + (row0 + (size_t)c * 64 + 32 * tb) * HGW + cb + 32 * vj + r32;
#pragma unroll
          for (int r = 0; r < 16; ++r) op[(size_t)crow(r, hi) * HGW] = oacc[r]; }
        LDS_BAR();
        if (c + 1 < HG_CHUNKS) {
#pragma unroll
            for (int u = 0; u < 2; ++u) { const f32x16 Sx = u ? S1 : S0; const int kt = 2 * tb + u;
#pragma unroll
                for (int r = 0; r < 16; ++r) *(LAS unsigned short*)(lds + HL_SB + (32 * kt + crow(r, hi)) * HP_TR + (32 * vj + r32) * 2) = (unsigned short)f2bf(Sx[r]); }
        }
    }
#undef HG_LOAD
    if (g + 1 < HG_GROUPS) {
        float* ds = DS + (size_t)unit * (HGD * HGD);
#pragma unroll
        for (int u = 0; u < 2; ++u) { const f32x16 Sx = u ? S1 : S0; const int kt = 2 * tb + u;
#pragma unroll
            for (int r = 0; r < 16; ++r) ds[(32 * kt + crow(r, hi)) * HGD + 32 * vj + r32] = Sx[r]; }
        if (seg == 0) *(f32x2_t*)(DG + (size_t)unit * HGD + 2 * kp) = (f32x2_t){__builtin_amdgcn_exp2f(gb0 * LOG2E), __builtin_amdgcn_exp2f(gb1 * LOG2E)};
    }
    LDS_BAR();
}
__device__ __forceinline__ void hgrn_unit_b(const float* ORAW, const bf16_t* QC, const float* DS, const float* DG, const bf16_t* HG, const float* norm_g, bf16_t* OHG, int unit, LAS unsigned char* lds, int tid, int lane, int wid) {
    const int bh = unit >> 3, g = unit & 7, b = bh >> 2, hh = bh & 3, r32 = lane & 31, hi = lane >> 5;
    const size_t tok0 = (size_t)b * SEQ + (size_t)g * (SEQ / HG_GROUPS) + 32 * wid; const int cb = hh * HGD;
    if (g > 0) {
        { float S[32];
#pragma unroll
          for (int i = 0; i < 32; ++i) S[i] = 0.f;
          const int k = tid >> 2;
          for (int g2 = 0; g2 < g; ++g2) { const float* ds = DS + (size_t)(bh * 8 + g2) * (HGD * HGD) + tid * 32; const float d = DG[(size_t)(bh * 8 + g2) * HGD + k];
#pragma unroll
              for (int j = 0; j < 8; ++j) { const f32x4 x = *(const f32x4*)(ds + 4 * j);
#pragma unroll
                  for (int t = 0; t < 4; ++t) S[4 * j + t] = d * S[4 * j + t] + x[t]; } }
#pragma unroll
          for (int j = 0; j < 4; ++j) { u32x4 w; w.x = pg8::cvt_pk_bf16(S[8 * j], S[8 * j + 1]); w.y = pg8::cvt_pk_bf16(S[8 * j + 2], S[8 * j + 3]); w.z = pg8::cvt_pk_bf16(S[8 * j + 4], S[8 * j + 5]); w.w = pg8::cvt_pk_bf16(S[8 * j + 6], S[8 * j + 7]);
              *(LAS u32x4*)(lds + HL_SB + k * HP_TR + (tid & 3) * 64 + j * 16) = w; } }
        LDS_BAR();
    }
    asm volatile("" ::: "memory");
    f32x16 acc[4];
#pragma unroll
    for (int vj = 0; vj < 4; ++vj)
#pragma unroll
        for (int r = 0; r < 16; ++r) acc[vj][r] = ORAW[(tok0 + crow(r, hi)) * HGW + cb + 32 * vj + r32];
    if (g > 0) {
#pragma unroll
        for (int ks = 0; ks < 8; ++ks) {
            const bf16x8 af = *(const bf16x8*)(QC + (tok0 + r32) * HGW + cb + 16 * ks + 8 * hi);
#pragma unroll
            for (int vj = 0; vj < 4; ++vj) {
                const LAS unsigned char* sp = lds + HL_SB + (16 * ks + 8 * hi + ((lane & 15) >> 2)) * HP_TR + (32 * vj + 16 * ((lane >> 4) & 1) + 4 * (lane & 3)) * 2;
                acc[vj] = __builtin_amdgcn_mfma_f32_32x32x16_bf16(af, cat8(tr16(sp), tr16(sp + 4 * HP_TR)), acc[vj], 0, 0, 0);
            }
        }
    }
    float ng[4];
#pragma unroll
    for (int vj = 0; vj < 4; ++vj) ng[vj] = norm_g[cb + 32 * vj + r32];
#pragma unroll
    for (int rb = 0; rb < 16; rb += MK_PB_GROWS) {
        bf16_t hgv[MK_PB_GROWS][4];
#pragma unroll
        for (int r2 = 0; r2 < MK_PB_GROWS; ++r2) { const size_t ro = (tok0 + crow(rb + r2, hi)) * HGW + cb + r32;
#pragma unroll
            for (int vj = 0; vj < 4; ++vj) hgv[r2][vj] = HG[ro + 32 * vj]; }
#pragma unroll
        for (int r2 = 0; r2 < MK_PB_GROWS; ++r2) { const int r = rb + r2;
            float ss = (acc[0][r] * acc[0][r] + acc[1][r] * acc[1][r]) + (acc[2][r] * acc[2][r] + acc[3][r] * acc[3][r]);
            ss = row16_sum(ss); ss += __shfl_xor(ss, 16);
            const float rs = __builtin_amdgcn_rsqf(ss * (1.0f / HGD) + RMS_EPS);
            const size_t ro = (tok0 + crow(r, hi)) * HGW + cb + r32;
#pragma unroll
            for (int vj = 0; vj < 4; ++vj) OHG[ro + 32 * vj] = (bf16_t)f2bf(acc[vj][r] * rs * ng[vj] * bf2f(hgv[r2][vj]));
        }
        asm volatile("" ::: "memory");
    }
    LDS_BAR();
}

constexpr int TROW = 2064;
constexpr int L_TILE = 0, L_LOGITS = 64 * TROW, L_TOPI = L_LOGITS + 64 * 32 * 4, L_HIST = L_TOPI + 1024, L_SLOT = L_HIST + 128, L_TOT = L_SLOT + 1024, L_BEF = L_TOT + 128, L_PAD = L_BEF + 128, L_PART = L_PAD + 256, L_END5 = L_PART + 2 * 16 * 32 * 4;
static_assert(L_END5 <= LDS_SCRATCH, "P5/P6 LDS map");
__device__ __forceinline__ void phase_ln1_router(const Args& A, LAS unsigned char* lds, int vb, int tid, int lane, int wave) {
    unsigned char* ws = A.ws;
    const bf16_t* PRE = (const bf16_t*)(ws + WS_PRE); float* STATS = (float*)(ws + WS_H); const float* g = A.in[7]; const float* bta = A.in[8];
    LAS int* HIST = (LAS int*)(lds + L_HIST);
    if (tid < NEXP) HIST[tid] = 0;
    u32x2 pp[8][4];
#pragma unroll
    for (int rr = 0; rr < 8; ++rr)
#pragma unroll
        for (int j = 0; j < 4; ++j) pp[rr][j] = *(const u32x2*)(PRE + (size_t)(vb * 64 + wave * 8 + rr) * DM + lane * 4 + 256 * j);
    f32x4 gq[4], bq[4];
#pragma unroll
    for (int j = 0; j < 4; ++j) { gq[j] = *(const f32x4*)(g + lane * 4 + 256 * j); bq[j] = *(const f32x4*)(bta + lane * 4 + 256 * j); }
    bf16x8 rwf[16];
    { const bf16_t* RWT = (const bf16_t*)(ws + WS_RWT); const int kq = wave >> 1, r = lane & 31, hh = lane >> 5;
#pragma unroll
      for (int ks = 0; ks < 16; ++ks) rwf[ks] = *(const bf16x8*)(RWT + (size_t)r * DM + 256 * kq + 16 * ks + 8 * hh); }
#pragma unroll
    for (int rr = 0; rr < 8; ++rr) {
        const int rl = wave * 8 + rr, row = vb * 64 + rl;
        f32x4 v[4]; float s = 0.f;
#pragma unroll
        for (int j = 0; j < 4; ++j) { const u32x2 p = pp[rr][j]; v[j] = (f32x4){bflo(p.x), bfhi(p.x), bflo(p.y), bfhi(p.y)}; s += (v[j][0] + v[j][1]) + (v[j][2] + v[j][3]); }
        const float mean = wave_sum(s) * (1.0f / DM); float s2 = 0.f;
#pragma unroll
        for (int j = 0; j < 4; ++j) { v[j] = v[j] - mean; s2 += (v[j][0] * v[j][0] + v[j][1] * v[j][1]) + (v[j][2] * v[j][2] + v[j][3] * v[j][3]); }
        const float rstd = __builtin_amdgcn_rsqf(wave_sum(s2) * (1.0f / DM) + LN_EPS);
        if (lane == 0) *(f32x2_t*)(STATS + (size_t)row * 2) = (f32x2_t){mean, rstd};
#pragma unroll
        for (int j = 0; j < 4; ++j) { const int c = lane * 4 + 256 * j; const f32x4 hv = v[j] * rstd * gq[j] + bq[j];
            u32x2 w; w.x = pk2(hv[0], hv[1]); w.y = pk2(hv[2], hv[3]); *(LAS u32x2*)(lds + L_TILE + rl * TROW + c * 2) = w; }
    }
    LDS_BAR();
    {
        const int rt = wave & 1, kq = wave >> 1, r = lane & 31, hh = lane >> 5;
        const bf16_t* RWT = (const bf16_t*)(ws + WS_RWT);
        f32x16 acc = {};
#pragma unroll
        for (int ks = 0; ks < 16; ++ks) {
            const int k = 256 * kq + 16 * ks + 8 * hh;
            const bf16x8 af = *(const LAS bf16x8*)(lds + L_TILE + (32 * rt + r) * TROW + k * 2);
            acc = __builtin_amdgcn_mfma_f32_32x32x16_bf16(af, rwf[ks], acc, 0, 0, 0);
        }
        (void)RWT;
        LAS float* LG = (LAS float*)(lds + L_LOGITS);
        for (int q = 0; q < 4; ++q) {
            if (kq == q) {
#pragma unroll
                for (int i = 0; i < 16; ++i) { const int rowl = 32 * rt + (i & 3) + 8 * (i >> 2) + 4 * hh; LAS float* p = LG + rowl * 32 + r; if (q == 0) *p = acc[i]; else *p += acc[i]; }
            }
            LDS_BAR();
        }
    }
    {
        const float* rb = A.in[10]; float* TOPG = (float*)(ws + WS_TOPG); LAS int* TOPI = (LAS int*)(lds + L_TOPI); const LAS float* LG = (const LAS float*)(lds + L_LOGITS);
        const int e = lane & 31, half = lane >> 5;
        for (int it = 0; it < 4; ++it) {
            const int rl = wave * 8 + it * 2 + half;
            float val = LG[rl * 32 + e] + rb[e]; int idx = e; float tv[4]; int ti[4];
#pragma unroll
            for (int rnk = 0; rnk < 4; ++rnk) {
                float bv = val; int bi = idx;
#define TOPK_STEP(OV, OI) do { const float ov = (OV); const int oi = (OI); if (ov > bv || (ov == bv && oi < bi)) { bv = ov; bi = oi; } } while (0)
                TOPK_STEP(dpp_f<0xB1>(bv), __builtin_amdgcn_update_dpp(0, bi, 0xB1, 0xF, 0xF, false)); TOPK_STEP(dpp_f<0x4E>(bv), __builtin_amdgcn_update_dpp(0, bi, 0x4E, 0xF, 0xF, false));
                TOPK_STEP(dpp_f<0x141>(bv), __builtin_amdgcn_update_dpp(0, bi, 0x141, 0xF, 0xF, false)); TOPK_STEP(dpp_f<0x140>(bv), __builtin_amdgcn_update_dpp(0, bi, 0x140, 0xF, 0xF, false));
                TOPK_STEP(__shfl_xor(bv, 16), __shfl_xor(bi, 16));
#undef TOPK_STEP
                tv[rnk] = bv; ti[rnk] = bi; if (e == bi) val = -INFINITY;
            }
            if (e == 0) {
                const float e1 = expf(tv[1] - tv[0]), e2 = expf(tv[2] - tv[0]), e3 = expf(tv[3] - tv[0]), inv = 1.0f / (1.0f + e1 + e2 + e3);
                *(float4*)(TOPG + (size_t)(vb * 64 + rl) * 4) = make_float4(inv, e1 * inv, e2 * inv, e3 * inv);
#pragma unroll
                for (int k = 0; k < 4; ++k) { TOPI[rl * 4 + k] = ti[k]; __hip_atomic_fetch_add(&HIST[ti[k]], 1, __ATOMIC_RELAXED, __HIP_MEMORY_SCOPE_WORKGROUP); }
            }
        }
    }
    LDS_BAR();
    if (tid < NEXP) ((int*)(ws + WS_CNTM))[vb * NEXP + tid] = HIST[tid];
}
__device__ __forceinline__ void phase_assign(const Args& A, LAS unsigned char* lds, int vb, int G, int tid, int lane, int wave) {
    unsigned char* ws = A.ws; const int* CNTM = (const int*)(ws + WS_CNTM); int* ctl = (int*)(ws + WS_CTL);
    LAS int* PART = (LAS int*)(lds + L_PART); LAS int* TOT = (LAS int*)(lds + L_TOT); LAS int* BEF = (LAS int*)(lds + L_BEF); LAS int* PAD = (LAS int*)(lds + L_PAD);
    LAS int* TOPI = (LAS int*)(lds + L_TOPI); LAS int* SLOT = (LAS int*)(lds + L_SLOT);
    { const int e = tid & 31, part = tid >> 5; int tot = 0, bef = 0;
      int cv[16];
#pragma unroll
      for (int q = 0; q < 16; ++q) { const int b2 = part * 16 + q; cv[q] = CNTM[(b2 < G ? b2 : G - 1) * NEXP + e]; }
#pragma unroll
      for (int q = 0; q < 16; ++q) { const int b2 = part * 16 + q; const int c = (b2 < G) ? cv[q] : 0; tot += c; if (b2 < vb) bef += c; }
      PART[part * 32 + e] = tot; PART[512 + part * 32 + e] = bef; }
    LDS_BAR();
    if (tid < NEXP) { int tot = 0, bef = 0;
#pragma unroll
        for (int p = 0; p < 16; ++p) { tot += PART[p * 32 + tid]; bef += PART[512 + p * 32 + tid]; }
        TOT[tid] = tot; BEF[tid] = bef; }
    LDS_BAR();
    if (tid < 64) {
        const int te = (tid < NEXP) ? (TOT[tid & 31] + SLOT_PAD - 1) / SLOT_PAD : 0; int inc = te;
#pragma unroll
        for (int d = 1; d < 32; d <<= 1) { const int o = __shfl_up(inc, d); if ((tid & 63) >= d) inc += o; }
        const int tb = inc - te;
        if (tid < NEXP) { PAD[tid] = tb * SLOT_PAD; if (vb == 0) for (int i = 0; i < te; ++i) ctl[CW_TILEEXP + tb + i] = tid; }
        if (vb == 0 && tid == NEXP - 1) ctl[CW_NTILES] = inc; }
    LDS_BAR();
    if (tid < 256) { const int e = TOPI[tid]; int rank = 0; for (int j = 0; j < tid; ++j) rank += (TOPI[j] == e) ? 1 : 0;
        const int slot = PAD[e] + BEF[e] + rank; SLOT[tid] = slot; ((int*)(ws + WS_DEST))[vb * 256 + tid] = slot;
#if MK_GATHER_A
        ((int*)(ws + WS_SLOTTOK))[slot] = vb * 64 + (tid >> 2);
#endif
    }
    LDS_BAR();
    bf16_t* XS = (bf16_t*)(ws + WS_XS);
#if MK_GATHER_A
#pragma unroll
    for (int rq = 0; rq < 8; ++rq) { const int r = wave * 8 + rq;
        const int i = 4 * r; const int slot = vb * 64 + r; const LAS unsigned char* src = lds + L_TILE + (i >> 2) * TROW; unsigned char* dst = (unsigned char*)(XS + (size_t)slot * DM);
#else
    for (int i = wave * 32; i < wave * 32 + 32; ++i) {
        const int slot = SLOT[i]; const LAS unsigned char* src = lds + L_TILE + (i >> 2) * TROW; unsigned char* dst = (unsigned char*)(XS + (size_t)slot * DM);
#endif
#if MK_FP8_UP
        { const u32x4 a = *(const LAS u32x4*)(src + lane * 32), b = *(const LAS u32x4*)(src + lane * 32 + 16); u32x4 o;
          o.x = pk4_fp8(bflo(a.x), bfhi(a.x), bflo(a.y), bfhi(a.y)); o.y = pk4_fp8(bflo(a.z), bfhi(a.z), bflo(a.w), bfhi(a.w)); o.z = pk4_fp8(bflo(b.x), bfhi(b.x), bflo(b.y), bfhi(b.y)); o.w = pk4_fp8(bflo(b.z), bfhi(b.z), bflo(b.w), bfhi(b.w));
          *(u32x4*)((unsigned char*)(ws + WS_XS) + (size_t)slot * DM + lane * 16) = o; (void)dst; }
#else
        const u32x4 a = *(const LAS u32x4*)(src + lane * 16), b = *(const LAS u32x4*)(src + 1024 + lane * 16);
        *(u32x4*)(dst + lane * 16) = a; *(u32x4*)(dst + 1024 + lane * 16) = b;
#endif
    }
}
template <int NR> __device__ __forceinline__ void combine_rows(const Args& A, int row0, int rstep, int lane, const f32x4 (&g1)[4], const f32x4 (&b1)[4], const f32x4 (&g2)[4], const f32x4 (&b2)[4]) {
    unsigned char* ws = A.ws; const bf16_t* PRE = (const bf16_t*)(ws + WS_PRE); const unsigned char* Y = (const unsigned char*)(ws + WS_Y);
    f32x2_t st[NR]; int4 d[NR]; float4 gt[NR]; u32x2 p[NR][4]; unsigned y[NR][4][4];
#pragma unroll
    for (int q = 0; q < NR; ++q) { const int row = row0 + q * rstep; st[q] = *(const f32x2_t*)((const float*)(ws + WS_H) + (size_t)row * 2); d[q] = *(const int4*)((const int*)(ws + WS_DEST) + row * 4); gt[q] = *(const float4*)((const float*)(ws + WS_TOPG) + row * 4);
#pragma unroll
        for (int j = 0; j < 4; ++j) p[q][j] = *(const u32x2*)(PRE + (size_t)row * DM + lane * 4 + 256 * j); }
#pragma unroll
    for (int q = 0; q < NR; ++q) { const int ds[4] = {d[q].x, d[q].y, d[q].z, d[q].w};
#pragma unroll
        for (int j = 0; j < 4; ++j)
#pragma unroll
            for (int k = 0; k < 4; ++k) y[q][j][k] = *(const unsigned*)(Y + (size_t)ds[k] * DM + lane * 4 + 256 * j); }
#pragma unroll
    for (int q = 0; q < NR; ++q) { const int row = row0 + q * rstep;
        const float gs[4] = {gt[q].x * (1.0f / Y8_SCALE), gt[q].y * (1.0f / Y8_SCALE), gt[q].z * (1.0f / Y8_SCALE), gt[q].w * (1.0f / Y8_SCALE)};
        f32x4 v[4]; float s = 0.f;
#pragma unroll
        for (int j = 0; j < 4; ++j) {
            f32x4 a = (((f32x4){bflo(p[q][j].x), bfhi(p[q][j].x), bflo(p[q][j].y), bfhi(p[q][j].y)} - st[q][0]) * st[q][1] * g1[j] + b1[j]) * DN_ALPHA;
#pragma unroll
            for (int k = 0; k < 4; ++k) { const f32x2_t y01 = __builtin_amdgcn_cvt_pk_f32_fp8(y[q][j][k], false), y23 = __builtin_amdgcn_cvt_pk_f32_fp8(y[q][j][k], true);
                a[0] += gs[k] * y01[0]; a[1] += gs[k] * y01[1]; a[2] += gs[k] * y23[0]; a[3] += gs[k] * y23[1]; }
            v[j] = a; s += (a[0] + a[1]) + (a[2] + a[3]); }
        const float mean = wave_sum(s) * (1.0f / DM); float s2 = 0.f;
#pragma unroll
        for (int j = 0; j < 4; ++j) { v[j] = v[j] - mean; s2 += (v[j][0] * v[j][0] + v[j][1] * v[j][1]) + (v[j][2] * v[j][2] + v[j][3] * v[j][3]); }
        const float rstd = __builtin_amdgcn_rsqf(wave_sum(s2) * (1.0f / DM) + LN_EPS);
#pragma unroll
        for (int j = 0; j < 4; ++j) { const int c = lane * 4 + 256 * j; *(f32x4*)(A.out + (size_t)row * DM + c) = v[j] * rstd * g2[j] + b2[j]; }
    }
}

template <bool BG, class ArgsT> __device__ __forceinline__ void xcd_barrier_bg(const XcdBarrier& b, const ArgsT& A, LAS unsigned char* lds, volatile LAS unsigned* MISC) {
    const int wave = __builtin_amdgcn_readfirstlane(threadIdx.x >> 6), lane = threadIdx.x & 63;
    const unsigned e0 = MISC[10];
    asm volatile("s_waitcnt vmcnt(0)" ::: "memory");
    __syncthreads();
    if (wave == 0) {
        if (threadIdx.x == 0) {
            unsigned* bar = b.bar;
            __builtin_amdgcn_s_waitcnt(0);
            unsigned nloc = b.st[0], nx = b.st[1];
            if (nloc == 0u) { xcd_barrier_complete(bar, b.x, nloc, nx); b.st[0] = nloc; b.st[1] = nx; }
            const unsigned old = xb_add(&bar[XB_XSUB(b.x)], 1u);
            const unsigned gen = old / nloc;
            if (old + 1u == (gen + 1u) * nloc) {
                __builtin_amdgcn_fence(__ATOMIC_RELEASE, "agent");
                asm volatile("s_waitcnt vmcnt(0)" ::: "memory");
                const unsigned og = xb_add(&bar[XB_TOP], 1u);
                const unsigned tg = og / nx;
                if (og + 1u == (tg + 1u) * nx) xb_add(&bar[XB_TOPGEN], 1u);
                else XB_SPIN(xb_ld(&bar[XB_TOPGEN]) == tg, bar);
                __builtin_amdgcn_fence(__ATOMIC_ACQUIRE, "");
                xb_add(&bar[XB_XGEN(b.x)], 1u);
                asm volatile("s_waitcnt vmcnt(0)" ::: "memory");
            } else {
                XB_SPIN(xb_ld(&bar[XB_XGEN(b.x)]) == gen, bar);
                __builtin_amdgcn_fence(__ATOMIC_ACQUIRE, "");
                asm volatile("s_waitcnt vmcnt(0)" ::: "memory");
            }
            MISC[10] = e0 + 1u;
        }
    } else if (BG && wave <= MK_BG_WAVES) {
        volatile LAS int* st = (volatile LAS int*)(MISC + 16 + 2 * wave);
        LAS float* scr = (LAS float*)(lds + wave * 16384);
        while (MISC[10] == e0) { if (!bg_step(A, st, scr, lane, BG_TOTAL)) __builtin_amdgcn_s_sleep(16); }
    }
    __syncthreads();
}
__device__ __forceinline__ void bg_drain(const Args& A, LAS unsigned char* lds, volatile LAS unsigned* MISC, int limit) {
    const int wave = __builtin_amdgcn_readfirstlane(threadIdx.x >> 6), lane = threadIdx.x & 63;
    volatile LAS int* st = (volatile LAS int*)(MISC + 16 + 2 * wave);
    while (bg_step(A, st, (LAS float*)(lds + wave * 16384), lane, limit)) {}
}
template <int LO, int HI> __global__ void __launch_bounds__(NTHREADS, 2) mk_fwd(Args args) {
    extern __shared__ __attribute__((aligned(16))) unsigned char lds_raw[];
    LAS unsigned char* lds = (LAS unsigned char*)lds_raw;
    volatile LAS unsigned* MISC = (volatile LAS unsigned*)(lds + MISC_OFF);
    const int G = gridDim.x, bx = blockIdx.x, vcu = (G % 8 == 0) ? (bx % 8) * (G / 8) + bx / 8 : bx;
    const int NGW = G * NWAVES;
#define GW (vcu * NWAVES + wave)
    unsigned char* ws = args.ws;
    for (int u = threadIdx.x; u < (LDS_BYTES - LDSCTL_OFF) / 4; u += NTHREADS) ((LAS unsigned*)(lds + LDSCTL_OFF))[u] = 0u;
    __syncthreads();
    XcdBarrier bar = xcd_barrier_post((unsigned*)(ws + WS_CTL) + CW_BAR + args.li * XCD_BAR_WORDS, MISC + 8);
#define IN(k) (LO <= (k) && (k) < HI)
#if MK_PROBE
    unsigned long long ts[16]; ts[0] = __builtin_amdgcn_s_memrealtime();
#define TS(i) ts[i] = __builtin_amdgcn_s_memrealtime()
#else
#define TS(i) do { } while (0)
#endif
#if 1
#if MK_BG
#define SEAM(k) do { if constexpr (IN(k) && IN((k) + 1)) { \
        if constexpr ((k) == 7) { __syncthreads(); bg_drain(args, lds, MISC, BG_I_UP); } \
        if constexpr ((k) == 8) { TS(13); bg_drain(args, lds, MISC, BG_TOTAL); TS(14); } \
        if constexpr (((MK_BG_SEAMS) >> (k)) & 1) xcd_barrier_bg<true>(bar, args, lds, MISC); else xcd_barrier_bg<false>(bar, args, lds, MISC); } } while (0)
#else
#define SEAM(k) do { if constexpr (IN(k) && IN((k) + 1)) xcd_barrier(bar); } while (0)
#endif
#endif
    InProjOut ip; ip.Q = (bf16_t*)(ws + WS_Q); ip.K = (bf16_t*)(ws + WS_K); ip.V = (bf16_t*)(ws + WS_V); ip.HQ = (bf16_t*)(ws + WS_HQ); ip.HK = (bf16_t*)(ws + WS_HK); ip.HV = (bf16_t*)(ws + WS_HV);
    ip.HG = (bf16_t*)(ws + WS_HG); ip.GS = (bf16_t*)(ws + WS_GS); ip.GH = (bf16_t*)(ws + WS_GH); ip.LOGF = (float*)(ws + WS_LOGF); ip.lb = (const float*)(ws + WS_LB);

    if constexpr (IN(0)) { FRESH_IDS(); phase_prologue(args, lds, GW, NGW, lane, wave); }
#if MK_PROBE_CONV
    bg_drain(args, lds, MISC, BG_TOTAL);
#if MK_PROBE_CONV > 1
    xcd_barrier(bar);
    if (threadIdx.x == 0) __hip_atomic_store((int*)(ws + WS_CTL) + CW_BGQ, 0, __ATOMIC_RELAXED, __HIP_MEMORY_SCOPE_AGENT);
    { const int w_ = __builtin_amdgcn_readfirstlane(threadIdx.x >> 6); if ((threadIdx.x & 63) == 0) { MISC[16 + 2 * w_] = 0; MISC[17 + 2 * w_] = 0; } }
    xcd_barrier(bar);
    bg_drain(args, lds, MISC, BG_TOTAL);
#endif
#endif
    SEAM(0); TS(1);
    if constexpr (IN(1)) {
#if MK_FP8_GATES
      { pg8::Gemm g{DM}; pg8::DenseSched S; S.o.init(NTOK / 256, 12, G, bx, MK_WGM_P1A); S.A = (const char*)(ws + WS_XB); S.Bt = (const char*)(ws + WS_WINT); S.tstep = (size_t)256 * DM * 2;
        pg8::EpiInProjT<0> E{ip};
        pg8::gemm_phase<pg8::EpiInProjT<0>, pg8::DenseSched, true, true>(lds, g, S, E); }
      { pg8::Gemm g{DM / 2, 0x7f7f7f7f, W8_E8M0}; pg8::DenseSched S; S.o.init(NTOK / 256, 10, G, G - 1 - bx, MK_WGM_P1B); S.A = (const char*)(ws + WS_XB8);     S.Bt = (const char*)(ws + WS_WINT8); S.tstep = (size_t)256 * DM;
        pg8::EpiInProjT<12> E{ip};
        pg8::gemm_phase_f8<pg8::EpiInProjT<12>, pg8::DenseSched, true, true>(lds, g, S, E); }
#else
      { pg8::Gemm g{DM}; pg8::DenseSched S; S.o.init(NTOK / 256, INW / 256, G, bx); S.A = (const char*)(ws + WS_XB); S.Bt = (const char*)(ws + WS_WINT); S.tstep = (size_t)256 * DM * 2;
        pg8::EpiInProjT<0> E{ip};
        pg8::gemm_phase<pg8::EpiInProjT<0>, pg8::DenseSched, true, true>(lds, g, S, E); }
#endif
    }
    SEAM(1); TS(2);
    if constexpr (IN(2)) { _Pragma("unroll 1") for (int rp2_ = 0; rp2_ < MK_LOOP_P2; ++rp2_) { if (rp2_) xcd_barrier(bar); FRESH_IDS(); const int gw = GW; (void)gw; const int qw_ = rp2_;
#if MK_NAIVE_MIX
    { const int u = gw; if (u < 2048) attn_naive_unit(ip.Q, ip.K, ip.V, (bf16_t*)(ws + WS_OSB), u & 63, 31 - (u >> 6), lane); }
    __syncthreads();
    if (vcu < 8) hgrn_naive_block(ip.HQ, ip.HK, ip.LOGF, ip.HV, (float*)(ws + WS_ORAW), lds, vcu, tid);
#else
#define MK_P2_BODY(QW) \
    hgrn_unit_a(ip.HQ, ip.HK, ip.LOGF, ip.HV, (float*)(ws + WS_ORAW), (bf16_t*)(ws + WS_QC), (float*)(ws + WS_DS), (float*)(ws + WS_DG), vcu, lds, tid, lane, wave); TS(12); \
    for (;;) { \
        if (tid == 0) *(LAS int*)(lds + AT_Q) = __hip_atomic_fetch_add((int*)(ws + WS_CTL) + CW_ATTNQ + (QW), 1, __ATOMIC_RELAXED, __HIP_MEMORY_SCOPE_AGENT); \
        LDS_BAR(); \
        const int u = __builtin_amdgcn_readfirstlane(*(LAS int*)(lds + AT_Q)); \
        LDS_BAR(); \
        if (u >= 512) break; \
        attn_unit(ip.Q, ip.K, ip.V, (bf16_t*)(ws + WS_OSB), u & 63, 7 - (u >> 6), lds, lane, wave); \
    }
    MK_P2_BODY(qw_)
#if MK_DUP_P2 > 1
    xcd_barrier(bar);
#if MK_DUP_WHAT == 1
    hgrn_unit_a(ip.HQ, ip.HK, ip.LOGF, ip.HV, (float*)(ws + WS_ORAW), (bf16_t*)(ws + WS_QC), (float*)(ws + WS_DS), (float*)(ws + WS_DG), vcu, lds, tid, lane, wave);
#elif MK_DUP_WHAT == 2
    for (;;) {
        if (tid == 0) *(LAS int*)(lds + AT_Q) = __hip_atomic_fetch_add((int*)(ws + WS_CTL) + CW_ATTNQ + 1, 1, __ATOMIC_RELAXED, __HIP_MEMORY_SCOPE_AGENT);
        __syncthreads();
        const int u = __builtin_amdgcn_readfirstlane(*(LAS int*)(lds + AT_Q));
        __syncthreads();
        if (u >= 512) break;
        attn_unit(ip.Q, ip.K, ip.V, (bf16_t*)(ws + WS_OSB), u & 63, 7 - (u >> 6), lds, lane, wave);
    }
#else
    MK_P2_BODY(1)
#endif
#endif
#if 0
    for (;;) {
        if (tid == 0) {
        __syncthreads();
        const int u = __builtin_amdgcn_readfirstlane(*(LAS int*)(lds + AT_Q));
        __syncthreads();
        if (u >= 512) break;
        attn_unit(ip.Q, ip.K, ip.V, (bf16_t*)(ws + WS_OSB), u & 63, 7 - (u >> 6), lds, lane, wave);
    }
#endif
#endif
    } }
    SEAM(2); TS(3);
#if MK_NAIVE_MIX
    if constexpr (IN(3)) { FRESH_IDS(); const int gw = GW; for (int it = gw; it < NTOK * HGH; it += NGW) hgrn_post_item((const float*)(ws + WS_ORAW), ip.HG, args.in[3], (bf16_t*)(ws + WS_OHG), it, lane); }
#else
    if constexpr (IN(3)) { _Pragma("unroll 1") for (int rb_ = 0; rb_ < MK_DUP_HGB; ++rb_) { if (rb_) xcd_barrier(bar); FRESH_IDS(); hgrn_unit_b((const float*)(ws + WS_ORAW), (const bf16_t*)(ws + WS_QC), (const float*)(ws + WS_DS), (const float*)(ws + WS_DG), ip.HG, args.in[3], (bf16_t*)(ws + WS_OHG), vcu, lds, tid, lane, wave); } }
#endif
    SEAM(3); TS(4);
#if MK_PROBE_BAR
    for (int rb2_ = 0; rb2_ < MK_PROBE_BAR; ++rb2_) xcd_barrier(bar);
#endif
#pragma unroll 1
    for (int rep4_ = 0; rep4_ < MK_DUP_P45; ++rep4_) { if (rep4_) xcd_barrier(bar);
    if constexpr (IN(4)) { pg8::Gemm g{SBW}; pg8::BranchSched S; S.o.init(NTOK / 256, DM / 256, G, bx, MK_WGM_P4); S.A0 = (const char*)(ws + WS_OSB); S.B0 = (const char*)(ws + WS_WBST); S.A1 = (const char*)(ws + WS_OHG); S.B1 = (const char*)(ws + WS_WBHT); S.tstep = (size_t)256 * SBW * 2;
      pg8::EpiBranch E{ip.GS, ip.GH, (bf16_t*)(ws + WS_MERGED)};
      pg8::gemm_phase<pg8::EpiBranch, pg8::BranchSched, true, true>(lds, g, S, E); }
    SEAM(4); TS(5);
    if constexpr (IN(5)) { pg8::Gemm g{DM}; pg8::DenseSched S; S.o.init(NTOK / 256, DM / 256, G, bx, MK_WGM_P5); S.A = (const char*)(ws + WS_MERGED); S.Bt = (const char*)(ws + WS_WOT); S.tstep = (size_t)256 * DM * 2;
      pg8::EpiOut E{(const bf16_t*)(ws + WS_XB), (bf16_t*)(ws + WS_PRE)};
      pg8::gemm_phase<pg8::EpiOut, pg8::DenseSched, true, true>(lds, g, S, E); }
    }
    SEAM(5); TS(6);
#if MK_DUP_TAIL & 1
    { FRESH_IDS(); phase_ln1_router(args, lds, bx, tid, lane, wave); } xcd_barrier(bar);
    { FRESH_IDS(); phase_assign(args, lds, bx, G, tid, lane, wave); } xcd_barrier(bar);
#endif
    if constexpr (IN(6)) { FRESH_IDS(); phase_ln1_router(args, lds, bx, tid, lane, wave); }
    SEAM(6); TS(7);
    if constexpr (IN(7)) { FRESH_IDS(); phase_assign(args, lds, bx, G, tid, lane, wave); }
    SEAM(7); TS(8);
    int ntiles = 0; if constexpr (IN(8) || IN(9)) ntiles = __builtin_amdgcn_readfirstlane(__hip_atomic_load((const int*)(ws + WS_CTL) + CW_NTILES, __ATOMIC_RELAXED, __HIP_MEMORY_SCOPE_AGENT)); const LAS int* tile_exp = (const LAS int*)(lds + LDS_TILEEXP);
    if constexpr (IN(8) || IN(9)) { for (int i = threadIdx.x; i < ntiles; i += NTHREADS) ((LAS int*)(lds + LDS_TILEEXP))[i] = __hip_atomic_load((const int*)(ws + WS_CTL) + CW_TILEEXP + i, __ATOMIC_RELAXED, __HIP_MEMORY_SCOPE_AGENT); __syncthreads(); }
#if MK_FP8_UP
#if MK_GATHER_A
    if constexpr (IN(8)) { pg8::Gemm g{DM / 2, 0x7f7f7f7f, W8_E8M0}; pg8::MoeGatherSched S; S.o.init(ntiles, UPW / 256, G, bx, MK_WGM_UP); S.A = (const char*)(ws + WS_XS); S.W = (const char*)(ws + WS_WUPT); S.tile_exp = tile_exp; S.tstep = (size_t)256 * DM; S.estep = (size_t)UPW * DM; S.slot_tok = (const int*)(ws + WS_SLOTTOK);
      pg8::EpiUpT<MK_FP8_DN != 0> E{args.in[12], (bf16_t*)(ws + WS_ACT)};
      pg8::gemm_phase_f8<pg8::EpiUpT<MK_FP8_DN != 0>, pg8::MoeGatherSched, true, true>(lds, g, S, E); }
#else
    if constexpr (IN(8)) { pg8::Gemm g{DM / 2, 0x7f7f7f7f, W8_E8M0}; pg8::MoeSched S; S.o.init(ntiles, UPW / 256, G, bx); S.A = (const char*)(ws + WS_XS); S.W = (const char*)(ws + WS_WUPT); S.tile_exp = tile_exp; S.tstep = (size_t)256 * DM; S.estep = (size_t)UPW * DM;
      pg8::EpiUpT<MK_FP8_DN != 0> E{args.in[12], (bf16_t*)(ws + WS_ACT)};
      pg8::gemm_phase_f8<pg8::EpiUpT<MK_FP8_DN != 0>, pg8::MoeSched, true, true>(lds, g, S, E); }
#endif
#else
    if constexpr (IN(8)) { pg8::Gemm g{DM}; pg8::MoeSched S; S.o.init(ntiles, UPW / 256, G, bx); S.A = (const char*)(ws + WS_XS); S.W = (const char*)(ws + WS_WUPT); S.tile_exp = tile_exp; S.tstep = (size_t)256 * DM * 2; S.estep = (size_t)UPW * DM * 2;
      pg8::EpiUpT<MK_FP8_DN != 0> E{args.in[12], (bf16_t*)(ws + WS_ACT)};
      pg8::gemm_phase<pg8::EpiUpT<MK_FP8_DN != 0>, pg8::MoeSched, true, true>(lds, g, S, E); }
#endif
    SEAM(8); TS(9);
#if MK_FP8_DN
    if constexpr (IN(9)) { pg8::Gemm g{DFF / 2, ACT8_E8M0, W8_E8M0}; pg8::MoeSched S; S.o.init(ntiles, DM / 256, G, bx, MK_WGM_DN); S.A = (const char*)(ws + WS_ACT); S.W = (const char*)(ws + WS_WDNT); S.tile_exp = tile_exp; S.tstep = (size_t)256 * DFF; S.estep = (size_t)DM * DFF;
      pg8::EpiDown E{args.in[14], (bf16_t*)(ws + WS_Y)};
      pg8::gemm_phase_f8<pg8::EpiDown, pg8::MoeSched, true, true>(lds, g, S, E); }
#else
    if constexpr (IN(9)) { pg8::Gemm g{DFF}; pg8::MoeSched S; S.o.init(ntiles, DM / 256, G, bx); S.A = (const char*)(ws + WS_ACT); S.W = (const char*)(ws + WS_WDNT); S.tile_exp = tile_exp; S.tstep = (size_t)256 * DFF * 2; S.estep = (size_t)DM * DFF * 2;
      pg8::EpiDown E{args.in[14], (bf16_t*)(ws + WS_Y)};
      pg8::gemm_phase<pg8::EpiDown, pg8::MoeSched, true, true>(lds, g, S, E); }
#endif
    SEAM(9); TS(10);
    if constexpr (IN(10)) { FRESH_IDS(); f32x4 g1[4], b1[4], g2[4], b2[4];
#pragma unroll
        for (int j = 0; j < 4; ++j) { const int c = lane * 4 + 256 * j; g1[j] = *(const f32x4*)(args.in[7] + c); b1[j] = *(const f32x4*)(args.in[8] + c); g2[j] = *(const f32x4*)(args.in[15] + c); b2[j] = *(const f32x4*)(args.in[16] + c); }
        int row = GW;
        for (; row + (MK_P10_ROWS - 1) * NGW < NTOK; row += MK_P10_ROWS * NGW) combine_rows<MK_P10_ROWS>(args, row, NGW, lane, g1, b1, g2, b2);
        for (; row < NTOK; row += NGW) combine_rows<1>(args, row, NGW, lane, g1, b1, g2, b2); }
#if MK_PROBE
    xcd_barrier(bar); TS(11);
    if (bx == 0 && threadIdx.x == 0) { unsigned* mk = (unsigned*)(ws + WS_LB + 3072); const bool warm = __hip_atomic_load(mk, __ATOMIC_RELAXED, __HIP_MEMORY_SCOPE_AGENT) == 0x51a7e5u; __hip_atomic_store(mk, 0x51a7e5u, __ATOMIC_RELAXED, __HIP_MEMORY_SCOPE_AGENT);
        const float dA = (float)(ts[MK_PA1] - ts[MK_PA0]) * 0.01f;
        __hip_atomic_store((float*)(ws + WS_CTL) + 40, warm ? dA * (1.0f / 500.0f) : 0.f, __ATOMIC_RELAXED, __HIP_MEMORY_SCOPE_AGENT); }
    xcd_barrier(bar);
    { FRESH_IDS(); const float eps = __hip_atomic_load((float*)(ws + WS_CTL) + 40, __ATOMIC_RELAXED, __HIP_MEMORY_SCOPE_AGENT);
      for (int row = GW; row < NTOK; row += NGW) for (int j2 = 0; j2 < 4; ++j2) { f32x4* p = (f32x4*)(args.out + (size_t)row * DM + lane * 4 + 256 * j2); *p = *p * (1.0f + eps); } }
#endif
}


#if MK_MODE == 2
namespace v1 {
constexpr int CW_CNT = 60000, CW_CUR = 60064, CW_PADSTART = 60128, CW_NTILES = 60192, CW_TILEEXP = 60256;
__device__ __forceinline__ float sigmoidf_(float v) { return 1.0f / (1.0f + expf(-v)); }
__global__ __launch_bounds__(256) void k_transpose_bf16(const float* __restrict__ W, bf16_t* __restrict__ WT, int K, int N) {
    __shared__ float tile[64][65];
    const size_t g = blockIdx.z; W += g * (size_t)K * N; WT += g * (size_t)K * N;
    const int k0 = blockIdx.y * 64, n0 = blockIdx.x * 64, tx = threadIdx.x & 63, ty = threadIdx.x >> 6;
    for (int i = ty; i < 64; i += 4) tile[i][tx] = W[(size_t)(k0 + i) * N + n0 + tx];
    __syncthreads();
    for (int i = ty; i < 64; i += 4) WT[(size_t)(n0 + i) * K + k0 + tx] = (bf16_t)f2bf(tile[tx][i]);
}
__global__ __launch_bounds__(256) void k_convert_x(const float* __restrict__ x, bf16_t* __restrict__ xb, const float* __restrict__ lbl, float* __restrict__ lb) {
    const size_t i = (size_t)blockIdx.x * 256 + threadIdx.x;
    const f32x4 v = ((const f32x4*)x)[i];
    uint2 o; o.x = f2bf(v[0]) | (f2bf(v[1]) << 16); o.y = f2bf(v[2]) | (f2bf(v[3]) << 16);
    ((uint2*)xb)[i] = o;
    if (blockIdx.x == 0) for (int c = threadIdx.x; c < HGW; c += 256) { const float l0 = lbl[c], l1 = lbl[HGW + c]; lb[c] = 1.0f / (1.0f + expf(l1 - l0)); }
}

constexpr int G_BM = 128, G_BK = 32, G_HTB = G_BM * G_BK * 2;
__device__ __forceinline__ void g128_loop(f32x4 (&acc)[4][4], const bf16_t* a0, const bf16_t* a1, const bf16_t* b0, const bf16_t* b1, int K, LAS unsigned char* shm) {
    const int tid = threadIdx.x, wid = tid >> 6, lane = tid & 63, wr = wid >> 1, wc = wid & 1, fr = lane & 15, fq = lane >> 4;
    LAS unsigned char* SA = shm; LAS unsigned char* SB = shm + G_HTB;
    for (int t = 0; t < K / G_BK; ++t) {
        __builtin_amdgcn_global_load_lds((const unsigned*)(a0 + t * G_BK), (LAS unsigned*)(SA + tid * 16), 16, 0, 0);
        __builtin_amdgcn_global_load_lds((const unsigned*)(a1 + t * G_BK), (LAS unsigned*)(SA + tid * 16 + 4096), 16, 0, 0);
        __builtin_amdgcn_global_load_lds((const unsigned*)(b0 + t * G_BK), (LAS unsigned*)(SB + tid * 16), 16, 0, 0);
        __builtin_amdgcn_global_load_lds((const unsigned*)(b1 + t * G_BK), (LAS unsigned*)(SB + tid * 16 + 4096), 16, 0, 0);
        asm volatile("s_waitcnt vmcnt(0)" ::: "memory"); __syncthreads();
        bf16x8 At[4], Bt[4];
#pragma unroll
        for (int m = 0; m < 4; ++m) { At[m] = *(const LAS bf16x8*)(SA + (wr * 64 + m * 16 + fr) * (G_BK * 2) + fq * 16); Bt[m] = *(const LAS bf16x8*)(SB + (wc * 64 + m * 16 + fr) * (G_BK * 2) + fq * 16); }
        asm volatile("s_waitcnt lgkmcnt(0)" ::: "memory"); __builtin_amdgcn_sched_barrier(0);
#pragma unroll
        for (int m = 0; m < 4; ++m)
#pragma unroll
            for (int n = 0; n < 4; ++n) acc[m][n] = __builtin_amdgcn_mfma_f32_16x16x32_bf16(At[m], Bt[n], acc[m][n], 0, 0, 0);
        __syncthreads();
    }
}
#define G128_ZERO(acc) _Pragma("unroll") for (int m_ = 0; m_ < 4; ++m_) _Pragma("unroll") for (int n_ = 0; n_ < 4; ++n_) acc[m_][n_] = (f32x4){0.f, 0.f, 0.f, 0.f}
#define G128_FOREACH(...) do { const int wid_ = threadIdx.x >> 6, lane_ = threadIdx.x & 63, wr_ = wid_ >> 1, wc_ = wid_ & 1, fr_ = lane_ & 15, fq_ = lane_ >> 4; \
    _Pragma("unroll") for (int m_ = 0; m_ < 4; ++m_) _Pragma("unroll") for (int n_ = 0; n_ < 4; ++n_) _Pragma("unroll") for (int j_ = 0; j_ < 4; ++j_) { \
        const int trow = wr_ * 64 + m_ * 16 + fq_ * 4 + j_, tcol = wc_ * 64 + n_ * 16 + fr_; __VA_ARGS__ } } while (0)


__global__ __launch_bounds__(256) void k_inproj(const bf16_t* __restrict__ XB, const bf16_t* __restrict__ WinT, InProjOut o) {
    __shared__ __attribute__((aligned(16))) unsigned char shm[2 * G_HTB];
    const int bcol = blockIdx.x * G_BM, brow = blockIdx.y * G_BM, tid = threadIdx.x, r0 = tid >> 2, c = (tid & 3) * 8;
    f32x4 acc[4][4]; G128_ZERO(acc);
    g128_loop(acc, XB + (size_t)(brow + r0) * DM + c, XB + (size_t)(brow + r0 + 64) * DM + c, WinT + (size_t)(bcol + r0) * DM + c, WinT + (size_t)(bcol + r0 + 64) * DM + c, DM, (LAS unsigned char*)shm);
    const int seg = bcol / 512;
    G128_FOREACH({
        const int row = brow + trow, col = bcol + tcol; const float v = acc[m_][n_][j_];
        if (seg == 0) o.Q[(size_t)row * 512 + col] = (bf16_t)f2bf(v * 0.125f);
        else if (seg == 1) o.K[(size_t)row * 512 + (col - 512)] = (bf16_t)f2bf(v);
        else if (seg == 2) o.V[(size_t)row * 512 + (col - 1024)] = (bf16_t)f2bf(v);
        else if (seg == 3) o.HQ[(size_t)row * 512 + (col - 1536)] = (bf16_t)f2bf(v * sigmoidf_(v));
        else if (seg == 4) { const int cc = col - 2048; const float l = o.lb[cc], f = l + (1.0f - l) * sigmoidf_(v);
            o.HK[(size_t)row * 512 + cc] = (bf16_t)f2bf(1.0f - f); o.LOGF[(size_t)row * 512 + cc] = logf(f); }
        else if (seg == 5) o.HV[(size_t)row * 512 + (col - 2560)] = (bf16_t)f2bf(v);
        else if (seg == 6) o.HG[(size_t)row * 512 + (col - 3072)] = (bf16_t)f2bf(sigmoidf_(v));
        else if (seg < 9) o.GS[(size_t)row * 1024 + (col - 3584)] = (bf16_t)f2bf(sigmoidf_(v));
        else o.GH[(size_t)row * 1024 + (col - 4608)] = (bf16_t)f2bf(sigmoidf_(v));
    });
}

__global__ __launch_bounds__(256) void k_branch(const bf16_t* __restrict__ OSB, const bf16_t* __restrict__ OHG, const bf16_t* __restrict__ WbsT, const bf16_t* __restrict__ WbhT,
                                                const bf16_t* __restrict__ GS, const bf16_t* __restrict__ GH, bf16_t* __restrict__ MERGED) {
    __shared__ __attribute__((aligned(16))) unsigned char shm[2 * G_HTB];
    const int bcol = blockIdx.x * G_BM, brow = blockIdx.y * G_BM, tid = threadIdx.x, r0 = tid >> 2, c = (tid & 3) * 8;
    f32x4 accA[4][4], accB[4][4]; G128_ZERO(accA); G128_ZERO(accB);
    g128_loop(accA, OSB + (size_t)(brow + r0) * SBW + c, OSB + (size_t)(brow + r0 + 64) * SBW + c, WbsT + (size_t)(bcol + r0) * SBW + c, WbsT + (size_t)(bcol + r0 + 64) * SBW + c, SBW, (LAS unsigned char*)shm);
    g128_loop(accB, OHG + (size_t)(brow + r0) * HGW + c, OHG + (size_t)(brow + r0 + 64) * HGW + c, WbhT + (size_t)(bcol + r0) * HGW + c, WbhT + (size_t)(bcol + r0 + 64) * HGW + c, HGW, (LAS unsigned char*)shm);
    G128_FOREACH({
        const size_t idx = (size_t)(brow + trow) * DM + bcol + tcol;
        MERGED[idx] = (bf16_t)f2bf(bf2f(GS[idx]) * accA[m_][n_][j_] + bf2f(GH[idx]) * accB[m_][n_][j_]);
    });
}

__global__ __launch_bounds__(256) void k_outproj(const bf16_t* __restrict__ MERGED, const bf16_t* __restrict__ WoT, const float* __restrict__ x, float* __restrict__ PRE) {
    __shared__ __attribute__((aligned(16))) unsigned char shm[2 * G_HTB];
    const int bcol = blockIdx.x * G_BM, brow = blockIdx.y * G_BM, tid = threadIdx.x, r0 = tid >> 2, c = (tid & 3) * 8;
    f32x4 acc[4][4]; G128_ZERO(acc);
    g128_loop(acc, MERGED + (size_t)(brow + r0) * DM + c, MERGED + (size_t)(brow + r0 + 64) * DM + c, WoT + (size_t)(bcol + r0) * DM + c, WoT + (size_t)(bcol + r0 + 64) * DM + c, DM, (LAS unsigned char*)shm);
    G128_FOREACH({ const size_t idx = (size_t)(brow + trow) * DM + bcol + tcol; PRE[idx] = DN_ALPHA * x[idx] + acc[m_][n_][j_]; });
}

__global__ __launch_bounds__(256) void k_moe_up(const bf16_t* __restrict__ HB, const bf16_t* __restrict__ WupT, const float* __restrict__ b_up, const int* __restrict__ ctl,
                                                const int* __restrict__ slot_tok, bf16_t* __restrict__ ACT) {
    __shared__ __attribute__((aligned(16))) unsigned char shm[2 * G_HTB];
    const int rt = blockIdx.y; if (rt >= 2 * ctl[CW_NTILES]) return;
    const int e = ctl[CW_TILEEXP + (rt >> 1)];
    const int bcol = blockIdx.x * G_BM, brow = rt * G_BM, tid = threadIdx.x, r0 = tid >> 2, c = (tid & 3) * 8;
    int t0 = slot_tok[brow + r0], t1 = slot_tok[brow + r0 + 64]; if (t0 < 0) t0 = 0; if (t1 < 0) t1 = 0;
    const bf16_t* W = WupT + (size_t)e * UPW * DM;
    f32x4 acc[4][4]; G128_ZERO(acc);
    g128_loop(acc, HB + (size_t)t0 * DM + c, HB + (size_t)t1 * DM + c, W + (size_t)(bcol + r0) * DM + c, W + (size_t)(bcol + r0 + 64) * DM + c, DM, (LAS unsigned char*)shm);
    G128_FOREACH({
        const int col = bcol + tcol; const float v = acc[m_][n_][j_] + b_up[e * UPW + col];
        const float other = __shfl_xor(v, 1);
        if ((col & 1) == 0) { const float g = fminf(v, SW_LIMIT), l = fminf(fmaxf(other, -SW_LIMIT), SW_LIMIT);
            ACT[(size_t)(brow + trow) * DFF + (col >> 1)] = (bf16_t)f2bf(g * sigmoidf_(SW_ALPHA * g) * (l + 1.0f)); }
    });
}
__global__ __launch_bounds__(256) void k_moe_down(const bf16_t* __restrict__ ACT, const bf16_t* __restrict__ WdnT, const float* __restrict__ b_dn, const int* __restrict__ ctl, bf16_t* __restrict__ Y) {
    __shared__ __attribute__((aligned(16))) unsigned char shm[2 * G_HTB];
    const int rt = blockIdx.y; if (rt >= 2 * ctl[CW_NTILES]) return;
    const int e = ctl[CW_TILEEXP + (rt >> 1)];
    const int bcol = blockIdx.x * G_BM, brow = rt * G_BM, tid = threadIdx.x, r0 = tid >> 2, c = (tid & 3) * 8;
    const bf16_t* W = WdnT + (size_t)e * DM * DFF;
    f32x4 acc[4][4]; G128_ZERO(acc);
    g128_loop(acc, ACT + (size_t)(brow + r0) * DFF + c, ACT + (size_t)(brow + r0 + 64) * DFF + c, W + (size_t)(bcol + r0) * DFF + c, W + (size_t)(bcol + r0 + 64) * DFF + c, DFF, (LAS unsigned char*)shm);
    G128_FOREACH({ const int col = bcol + tcol; Y[(size_t)(brow + trow) * DM + col] = (bf16_t)f2bf(acc[m_][n_][j_] + b_dn[e * DM + col]); });
}

__global__ __launch_bounds__(64) void k_attn_naive(const bf16_t* __restrict__ Q, const bf16_t* __restrict__ K, const bf16_t* __restrict__ V, bf16_t* __restrict__ O) {
    const int qb = 31 - (int)blockIdx.x, bh = blockIdx.y, b = bh >> 3, h = bh & 7;
    const int t = qb * 64 + threadIdx.x; const size_t rowbase = (size_t)b * SEQ;
    float q[64], o[64];
    { const bf16_t* qp = Q + (rowbase + t) * SBW + h * SBD;
#pragma unroll
      for (int d = 0; d < 64; ++d) { q[d] = bf2f(qp[d]); o[d] = 0.f; } }
    float R = 1.0f;
    for (int s = qb * 64 + 63; s >= 0; --s) {
        const bf16_t* kr = K + (rowbase + s) * SBW + h * SBD; const bf16_t* vr = V + (rowbase + s) * SBW + h * SBD;
        float z = 0.f;
#pragma unroll
        for (int d = 0; d < 64; ++d) z += q[d] * bf2f(kr[d]);
        const bool valid = s < t;
        const float ez = expf(fminf(z, 60.0f)), keep = 1.0f / (1.0f + ez);
        const float a = valid ? ez * keep * R : 0.f;
        R = valid ? R * keep : R;
#pragma unroll
        for (int d = 0; d < 64; ++d) o[d] += a * bf2f(vr[d]);
    }
    bf16_t* op = O + (rowbase + t) * SBW + h * SBD;
#pragma unroll
    for (int d = 0; d < 64; ++d) op[d] = (bf16_t)f2bf(o[d]);
}

__global__ __launch_bounds__(128) void k_hgrn_naive(const bf16_t* __restrict__ HQ, const bf16_t* __restrict__ HK, const float* __restrict__ LOGF, const bf16_t* __restrict__ HV, float* __restrict__ ORAW) {
    __shared__ __attribute__((aligned(16))) float sf[128], sk[128], sq[128];
    const int bh = blockIdx.x, b = bh >> 2, hh = bh & 3, v = threadIdx.x;
    float S[128];
#pragma unroll
    for (int k = 0; k < 128; ++k) S[k] = 0.f;
    for (int t = 0; t < SEQ; ++t) {
        const size_t base = ((size_t)b * SEQ + t) * HGW + hh * HGD;
        sf[v] = expf(LOGF[base + v]); sk[v] = bf2f(HK[base + v]); sq[v] = bf2f(HQ[base + v]);
        const float vv = bf2f(HV[base + v]);
        __syncthreads();
        float o = 0.f;
#pragma unroll
        for (int k = 0; k < 128; ++k) { S[k] = sf[k] * S[k] + sk[k] * vv; o += sq[k] * S[k]; }
        ORAW[base + v] = o;
        __syncthreads();
    }
}
__global__ __launch_bounds__(256) void k_hgrn_post(const float* __restrict__ ORAW, const bf16_t* __restrict__ HG, const float* __restrict__ norm_g, bf16_t* __restrict__ OHG) {
    const int gw = blockIdx.x * 4 + (threadIdx.x >> 6), lane = threadIdx.x & 63;
    const size_t base = (size_t)gw * HGD; const int c0 = (gw & 3) * HGD;
    const float x0 = ORAW[base + lane], x1 = ORAW[base + 64 + lane];
    const float r = 1.0f / sqrtf(wave_sum(x0 * x0 + x1 * x1) * (1.0f / HGD) + RMS_EPS);
    OHG[base + lane] = (bf16_t)f2bf(x0 * r * norm_g[c0 + lane] * bf2f(HG[base + lane]));
    OHG[base + 64 + lane] = (bf16_t)f2bf(x1 * r * norm_g[c0 + 64 + lane] * bf2f(HG[base + 64 + lane]));
}

__global__ __launch_bounds__(256) void k_ln1_router(const float* __restrict__ PRE, const float* __restrict__ g, const float* __restrict__ bta, const float* __restrict__ rw, const float* __restrict__ rb,
                                                    float* __restrict__ H, bf16_t* __restrict__ HB, int* __restrict__ TOPI, float* __restrict__ TOPG) {
    __shared__ __attribute__((aligned(16))) float hs[4][DM];
    const int w = threadIdx.x >> 6, lane = threadIdx.x & 63, row = blockIdx.x * 4 + w;
    f32x4 v[4]; float s = 0.f;
#pragma unroll
    for (int j = 0; j < 4; ++j) { v[j] = *(const f32x4*)(PRE + (size_t)row * DM + lane * 4 + 256 * j); s += (v[j][0] + v[j][1]) + (v[j][2] + v[j][3]); }
    const float mean = wave_sum(s) * (1.0f / DM); float s2 = 0.f;
#pragma unroll
    for (int j = 0; j < 4; ++j) { v[j] = v[j] - mean; s2 += (v[j][0] * v[j][0] + v[j][1] * v[j][1]) + (v[j][2] * v[j][2] + v[j][3] * v[j][3]); }
    const float rstd = 1.0f / sqrtf(wave_sum(s2) * (1.0f / DM) + LN_EPS);
#pragma unroll
    for (int j = 0; j < 4; ++j) { const int c = lane * 4 + 256 * j; const f32x4 gg = *(const f32x4*)(g + c), bb = *(const f32x4*)(bta + c);
        f32x4 hv = v[j] * rstd * gg + bb; *(f32x4*)(H + (size_t)row * DM + c) = hv; *(f32x4*)(&hs[w][c]) = hv;
        uint2 o; o.x = f2bf(hv[0]) | (f2bf(hv[1]) << 16); o.y = f2bf(hv[2]) | (f2bf(hv[3]) << 16); *(uint2*)(HB + (size_t)row * DM + c) = o; }
    __syncthreads();
    const int e = lane & 31, half = lane >> 5; float a = 0.f;
    for (int c = half * 512; c < half * 512 + 512; ++c) a += hs[w][c] * rw[c * NEXP + e];
    a += __shfl_xor(a, 32);
    float val = (lane < 32) ? a + rb[e] : -INFINITY; int idx = e;
    float tv[4]; int ti[4];
#pragma unroll
    for (int r = 0; r < 4; ++r) {
        float bv = val; int bi = idx;
#pragma unroll
        for (int off = 32; off >= 1; off >>= 1) { const float ov = __shfl_xor(bv, off); const int oi = __shfl_xor(bi, off); if (ov > bv || (ov == bv && oi < bi)) { bv = ov; bi = oi; } }
        tv[r] = bv; ti[r] = bi; if (lane < 32 && e == bi) val = -INFINITY;
    }
    if (lane == 0) { const float e1 = expf(tv[1] - tv[0]), e2 = expf(tv[2] - tv[0]), e3 = expf(tv[3] - tv[0]), inv = 1.0f / (1.0f + e1 + e2 + e3);
        *(int4*)(TOPI + row * 4) = make_int4(ti[0], ti[1], ti[2], ti[3]); *(float4*)(TOPG + row * 4) = make_float4(inv, e1 * inv, e2 * inv, e3 * inv); }
}

__global__ __launch_bounds__(256) void k_count(const int* __restrict__ TOPI, int* __restrict__ ctl, int* __restrict__ slot_tok) {
    __shared__ int hist[NEXP];
    if (threadIdx.x < NEXP) hist[threadIdx.x] = 0;
    __syncthreads();
    const int i = blockIdx.x * 256 + threadIdx.x;
    atomicAdd(&hist[TOPI[i]], 1);
    __syncthreads();
    if (threadIdx.x < NEXP) atomicAdd(&ctl[CW_CNT + threadIdx.x], hist[threadIdx.x]);
    for (int s = i; s < NSLOT_MAX; s += NASSIGN) slot_tok[s] = -1;
}
__global__ __launch_bounds__(64) void k_plan(int* __restrict__ ctl) {
    if (threadIdx.x == 0) { int ps = 0, nt = 0;
        for (int e = 0; e < NEXP; ++e) { ctl[CW_PADSTART + e] = ps; const int te = (ctl[CW_CNT + e] + SLOT_PAD - 1) / SLOT_PAD; for (int i = 0; i < te; ++i) ctl[CW_TILEEXP + nt++] = e; ps += te * SLOT_PAD; }
        ctl[CW_PADSTART + NEXP] = ps; ctl[CW_NTILES] = nt; }
}
__global__ __launch_bounds__(256) void k_assign(const int* __restrict__ TOPI, int* __restrict__ ctl, int* __restrict__ slot_tok, int* __restrict__ DEST) {
    const int i = blockIdx.x * 256 + threadIdx.x, e = TOPI[i];
    const int slot = ctl[CW_PADSTART + e] + atomicAdd(&ctl[CW_CUR + e], 1);
    slot_tok[slot] = i >> 2; DEST[i] = slot;
}
__global__ __launch_bounds__(256) void k_combine_ln2(const float* __restrict__ H, const bf16_t* __restrict__ Y, const int* __restrict__ DEST, const float* __restrict__ TOPG,
                                                     const float* __restrict__ g, const float* __restrict__ bta, float* __restrict__ out) {
    const int lane = threadIdx.x & 63, row = blockIdx.x * 4 + (threadIdx.x >> 6);
    const int4 d = *(const int4*)(DEST + row * 4); const float4 gt = *(const float4*)(TOPG + row * 4);
    const int ds[4] = {d.x, d.y, d.z, d.w}; const float gs[4] = {gt.x, gt.y, gt.z, gt.w};
    f32x4 v[4]; float s = 0.f;
#pragma unroll
    for (int j = 0; j < 4; ++j) { const int c = lane * 4 + 256 * j; f32x4 a = *(const f32x4*)(H + (size_t)row * DM + c) * DN_ALPHA;
#pragma unroll
        for (int k = 0; k < 4; ++k) { const uint2 y = *(const uint2*)(Y + (size_t)ds[k] * DM + c);
            a[0] += gs[k] * bf2f(y.x & 0xffff); a[1] += gs[k] * bf2f(y.x >> 16); a[2] += gs[k] * bf2f(y.y & 0xffff); a[3] += gs[k] * bf2f(y.y >> 16); }
        v[j] = a; s += (a[0] + a[1]) + (a[2] + a[3]); }
    const float mean = wave_sum(s) * (1.0f / DM); float s2 = 0.f;
#pragma unroll
    for (int j = 0; j < 4; ++j) { v[j] = v[j] - mean; s2 += (v[j][0] * v[j][0] + v[j][1] * v[j][1]) + (v[j][2] * v[j][2] + v[j][3] * v[j][3]); }
    const float rstd = 1.0f / sqrtf(wave_sum(s2) * (1.0f / DM) + LN_EPS);
#pragma unroll
    for (int j = 0; j < 4; ++j) { const int c = lane * 4 + 256 * j; *(f32x4*)(out + (size_t)row * DM + c) = v[j] * rstd * *(const f32x4*)(g + c) + *(const f32x4*)(bta + c); }
}

}
#endif
extern "C" void kernel_launch(void* const* d_in, const int* in_sizes, int n_in, void* d_out, int out_size, void* d_ws, size_t ws_size, hipStream_t stream) {
    static int grid = 0;
    if (grid == 0) {
        if (n_in != 17 || ws_size < WS_END) { fprintf(stderr, "kernel_launch: unexpected n_in %d or ws_size %zu (< %zu)\n", n_in, ws_size, (size_t)WS_END); grid = -1; return; }
        int dev = 0, cus = 0;
        if (hipGetDevice(&dev) != hipSuccess || hipDeviceGetAttribute(&cus, hipDeviceAttributeMultiprocessorCount, dev) != hipSuccess) { grid = -1; return; }
#define MK_ATTR(LO_, HI_) if (hipFuncSetAttribute((const void*)mk_fwd<LO_, HI_>, hipFuncAttributeMaxDynamicSharedMemorySize, LDS_BYTES) != hipSuccess) { fprintf(stderr, "kernel_launch: hipFuncSetAttribute failed\n"); grid = -1; return; }
#if MK_MODE == 0
        MK_ATTR(0, 11)
#elif MK_MODE == 2
        MK_ATTR(0, 1) MK_ATTR(1, 2) MK_ATTR(2, 3) MK_ATTR(3, 4) MK_ATTR(4, 5) MK_ATTR(5, 6)
#else
        MK_ATTR(0, 1) MK_ATTR(1, 2) MK_ATTR(2, 3) MK_ATTR(3, 4) MK_ATTR(4, 5) MK_ATTR(5, 6) MK_ATTR(6, 8) MK_ATTR(8, 9) MK_ATTR(9, 10) MK_ATTR(10, 11)
#endif
        grid = cus;
        if (grid != 256) fprintf(stderr, "kernel_launch: %d CUs (built for 256)\n", grid);
    }
    if (grid < 0) return;
    (void)hipMemsetAsync((char*)d_ws + WS_CTL, 0, CTL_ZERO_BYTES, stream);
    Args a{};
    for (int i = 0; i < 17; ++i) a.in[i] = (const float*)d_in[i];
    a.out = (float*)d_out; a.ws = (unsigned char*)d_ws;
#define MK_LAUNCH(LO_, HI_, LI_) do { a.ph_lo = LO_; a.ph_hi = HI_; a.li = LI_; hipLaunchKernelGGL((mk_fwd<LO_, HI_>), dim3(grid), dim3(NTHREADS), LDS_BYTES, stream, a); } while (0)
#if MK_MODE == 0
    MK_LAUNCH(0, 11, 0);
#elif MK_MODE == 2
    { unsigned char* ws = (unsigned char*)d_ws;
      InProjOut ip{}; ip.Q = (bf16_t*)(ws + WS_Q); ip.K = (bf16_t*)(ws + WS_K); ip.V = (bf16_t*)(ws + WS_V); ip.HQ = (bf16_t*)(ws + WS_HQ); ip.HK = (bf16_t*)(ws + WS_HK); ip.HV = (bf16_t*)(ws + WS_HV);
      ip.HG = (bf16_t*)(ws + WS_HG); ip.GS = (bf16_t*)(ws + WS_GS); ip.GH = (bf16_t*)(ws + WS_GH); ip.LOGF = (float*)(ws + WS_LOGF); ip.lb = (const float*)(ws + WS_LB);
#if MK_HEAD_V1 >= 1
      v1::k_convert_x<<<NTOK * DM / 4 / 256, 256, 0, stream>>>(a.in[0], (bf16_t*)(ws + WS_XB), a.in[2], (float*)(ws + WS_LB));
      v1::k_transpose_bf16<<<dim3(INW / 64, DM / 64, 1), 256, 0, stream>>>(a.in[1], (bf16_t*)(ws + WS_WINT), DM, INW);
      v1::k_transpose_bf16<<<dim3(DM / 64, SBW / 64, 1), 256, 0, stream>>>(a.in[4], (bf16_t*)(ws + WS_WBST), SBW, DM);
      v1::k_transpose_bf16<<<dim3(DM / 64, HGW / 64, 1), 256, 0, stream>>>(a.in[5], (bf16_t*)(ws + WS_WBHT), HGW, DM);
      v1::k_transpose_bf16<<<dim3(DM / 64, DM / 64, 1), 256, 0, stream>>>(a.in[6], (bf16_t*)(ws + WS_WOT), DM, DM);
      v1::k_transpose_bf16<<<dim3(UPW / 64, DM / 64, NEXP), 256, 0, stream>>>(a.in[11], (bf16_t*)(ws + WS_WUPT), DM, UPW);
      v1::k_transpose_bf16<<<dim3(DM / 64, DFF / 64, NEXP), 256, 0, stream>>>(a.in[13], (bf16_t*)(ws + WS_WDNT), DFF, DM);
#else
      MK_LAUNCH(0, 1, 0);
#endif
#if MK_HEAD_V1 >= 2
      v1::k_inproj<<<dim3(INW / v1::G_BM, NTOK / v1::G_BM), 256, 0, stream>>>((const bf16_t*)(ws + WS_XB), (const bf16_t*)(ws + WS_WINT), ip);
#else
      MK_LAUNCH(1, 2, 1);
#endif
      MK_LAUNCH(2, 3, 2); MK_LAUNCH(3, 4, 3); MK_LAUNCH(4, 5, 4); MK_LAUNCH(5, 6, 5); }
    { unsigned char* ws = (unsigned char*)d_ws; int* ctl = (int*)(ws + WS_CTL); bf16_t* HB = (bf16_t*)(ws + WS_XS); int* TOPI = (int*)(ws + WS_XS + 32 * MiB); int* SLOTTOK = (int*)(ws + WS_XS + 33 * MiB);
      float* TOPG = (float*)(ws + WS_TOPG); int* DEST = (int*)(ws + WS_DEST); float* H = (float*)(ws + WS_H); bf16_t* ACT = (bf16_t*)(ws + WS_ACT); bf16_t* Y = (bf16_t*)(ws + WS_Y);
      v1::k_ln1_router<<<NTOK / 4, 256, 0, stream>>>((const float*)(ws + WS_PRE), a.in[7], a.in[8], a.in[9], a.in[10], H, HB, TOPI, TOPG);
      v1::k_count<<<NASSIGN / 256, 256, 0, stream>>>(TOPI, ctl, SLOTTOK);
      v1::k_plan<<<1, 64, 0, stream>>>(ctl);
      v1::k_assign<<<NASSIGN / 256, 256, 0, stream>>>(TOPI, ctl, SLOTTOK, DEST);
      v1::k_moe_up<<<dim3(UPW / v1::G_BM, NSLOT_MAX / v1::G_BM), 256, 0, stream>>>(HB, (const bf16_t*)(ws + WS_WUPT), a.in[12], ctl, SLOTTOK, ACT);
      v1::k_moe_down<<<dim3(DM / v1::G_BM, NSLOT_MAX / v1::G_BM), 256, 0, stream>>>(ACT, (const bf16_t*)(ws + WS_WDNT), a.in[14], ctl, Y);
      v1::k_combine_ln2<<<NTOK / 4, 256, 0, stream>>>(H, Y, DEST, TOPG, a.in[15], a.in[16], (float*)d_out); }
#else
    MK_LAUNCH(0, 1, 0); MK_LAUNCH(1, 2, 1); MK_LAUNCH(2, 3, 2); MK_LAUNCH(3, 4, 3); MK_LAUNCH(4, 5, 4); MK_LAUNCH(5, 6, 5); MK_LAUNCH(6, 8, 6); MK_LAUNCH(8, 9, 7); MK_LAUNCH(9, 10, 8); MK_LAUNCH(10, 11, 9);
#endif
}
```

```cpp
#include <hip/hip_runtime.h>
#include <stdint.h>
#include <cstdio>

#define LAS __attribute__((address_space(3)))
#define GAS __attribute__((address_space(1)))
typedef unsigned short bf16_t;
typedef short bf16x8 __attribute__((ext_vector_type(8)));
typedef float f32x4 __attribute__((ext_vector_type(4)));
typedef float f32x16 __attribute__((ext_vector_type(16)));
typedef unsigned u32x4 __attribute__((ext_vector_type(4)));
typedef unsigned u32x2 __attribute__((ext_vector_type(2)));
typedef float f32x2_t __attribute__((ext_vector_type(2)));

constexpr int NTOK = 16384, DM = 1024, INW = 5632, SBW = 512, HGW = 512, NEXP = 32, TOPK = 4, DFF = 1024, UPW = 2048;
constexpr int SEQ = 2048, SBH = 8, SBD = 64, HGH = 4, HGD = 128;
constexpr int NASSIGN = NTOK * TOPK;
constexpr int SLOT_PAD = 256;
constexpr int NSLOT_MAX = NASSIGN + NEXP * SLOT_PAD;
constexpr int NTILE_MAX = NSLOT_MAX / SLOT_PAD;
constexpr float LN_EPS = 1e-5f, RMS_EPS = 1e-6f, DN_ALPHA = 1.189207115002721f, SW_ALPHA = 1.702f, SW_LIMIT = 7.0f, LOG2E = 1.4426950408889634f, LN2 = 0.6931471805599453f;
constexpr int NWAVES = 8, NTHREADS = 512;
constexpr float W8_SCALE = 32.0f; constexpr int W8_E8M0 = 0x7a7a7a7a;
#ifndef MK_Y8
#define MK_Y8 1
#endif
constexpr float Y8_SCALE = 16.0f;
constexpr float ACT8_SCALE = 4.0f; constexpr int ACT8_E8M0 = 0x7d7d7d7d;
#ifndef MK_DUP_P1
#define MK_DUP_P1 1
#endif
#ifndef MK_DUP_HGA
#define MK_DUP_HGA 1
#endif
#ifndef MK_DUP_HGB
#define MK_DUP_HGB 1
#endif
#ifndef MK_DUP_P45
#define MK_DUP_P45 1
#endif
#ifndef MK_BG_WAVES
#define MK_BG_WAVES 3
#endif
#ifndef MK_BG_SEAMS
#define MK_BG_SEAMS 0xFE
#endif
#ifndef MK_PROBE_CONV
#define MK_PROBE_CONV 0
#endif
#ifndef MK_PROBE_BAR
#define MK_PROBE_BAR 0
#endif
#ifndef MK_LOOP_P2
#define MK_LOOP_P2 1
#endif
#ifndef MK_DUP_TAIL
#define MK_DUP_TAIL 0
#endif
#ifndef MK_FP8_GATES
#define MK_FP8_GATES 1
#endif
#ifndef MK_FP8_DN
#define MK_FP8_DN 1
#endif
#ifndef MK_FP8_UP
#define MK_FP8_UP 1
#endif
#ifndef MK_BG
#define MK_BG 1
#endif
#ifndef MK_DUP_P2
#define MK_DUP_P2 1
#define MK_DUP_WHAT 0
#endif
#ifndef MK_PROBE
#define MK_PROBE 0
#endif
#define MK_PROBE_UNUSED 0
#ifndef MK_P0_ROWS
#define MK_P0_ROWS 2
#endif
#ifndef MK_PB_GROWS
#define MK_PB_GROWS 16
#endif
#ifndef MK_P10_ROWS
#define MK_P10_ROWS 4
#endif
#ifndef MK_WGM_P1A
#define MK_WGM_P1A 4
#define MK_WGM_P1B 4
#define MK_WGM_P4 8
#define MK_WGM_P5 8
#endif
#ifndef MK_WGM_DN
#define MK_WGM_DN 4
#endif
#ifndef MK_WGM_UP
#define MK_WGM_UP 4
#endif
#ifndef MK_GATHER_A
#define MK_GATHER_A 1
#endif
#ifndef MK_BR_BATCH
#define MK_BR_BATCH 3
#endif
#ifndef MK_PA0
#define MK_PA0 0
#define MK_PA1 1
#define MK_PB0 1
#define MK_PB1 2
#endif
#ifndef MK_NAIVE_MIX
#define MK_NAIVE_MIX 0
#endif
#ifndef MK_MODE
#ifndef MK_P1_ALIGN
#define MK_P1_ALIGN true
#endif
#ifndef MK_P1_SP2
#define MK_P1_SP2 true
#endif
#ifndef MK_HEAD_V1
#define MK_HEAD_V1 0
#endif
#define MK_MODE 0
#endif

constexpr size_t MiB = 1u << 20;
constexpr size_t WS_SLOTTOK = 262144;
constexpr size_t WS_CTL = 0, CTL_ZERO_BYTES = 262144 + 73728 * 4;
constexpr size_t WS_LB = 1 * MiB;
constexpr size_t WS_CNTM = WS_LB + 4096;
constexpr size_t WS_TOPG = WS_CNTM + 32768;
constexpr size_t WS_DEST = WS_TOPG + 262144;
constexpr size_t WS_RWT = WS_DEST + 262144;
constexpr size_t WS_XB = 3 * MiB;
constexpr size_t WS_WINT = WS_XB + 32 * MiB;
constexpr size_t WS_WBST = WS_WINT + 12 * MiB;
constexpr size_t WS_WBHT = WS_WBST + 1 * MiB;
constexpr size_t WS_WOT = WS_WBHT + 1 * MiB;
constexpr size_t WS_WUPT = WS_WOT + 2 * MiB;
constexpr size_t WS_WDNT = WS_WUPT + 128 * MiB;
constexpr size_t WS_Q = WS_WDNT + 64 * MiB;
constexpr size_t WS_K = WS_Q + 16 * MiB;
constexpr size_t WS_V = WS_K + 16 * MiB;
constexpr size_t WS_HQ = WS_V + 16 * MiB;
constexpr size_t WS_HK = WS_HQ + 16 * MiB;
constexpr size_t WS_HV = WS_HK + 16 * MiB;
constexpr size_t WS_HG = WS_HV + 16 * MiB;
constexpr size_t WS_LOGF = WS_HG + 16 * MiB;
constexpr size_t WS_GS = WS_LOGF + 32 * MiB;
constexpr size_t WS_GH = WS_GS + 32 * MiB;
constexpr size_t WS_OSB = WS_GH + 32 * MiB;
constexpr size_t WS_OHG = WS_OSB + 16 * MiB;
constexpr size_t WS_ORAW = WS_OHG + 16 * MiB;
constexpr size_t WS_MERGED = WS_ORAW + 32 * MiB;
constexpr size_t WS_H = WS_MERGED + 32 * MiB;
constexpr size_t WS_XS = WS_H + 64 * MiB;
constexpr size_t WS_ACT = WS_XS + 144 * MiB;
constexpr size_t WS_QC = WS_ACT + 144 * MiB;
constexpr size_t WS_DS = WS_QC + 16 * MiB;
constexpr size_t WS_DG = WS_DS + 16 * MiB;
constexpr size_t WS_XB8 = WS_DG + 1 * MiB;
constexpr size_t WS_WINT8 = WS_XB8 + 16 * MiB;
constexpr size_t WS_END = WS_WINT8 + 3 * MiB;
constexpr size_t WS_PRE = WS_Q;
constexpr size_t WS_Y = WS_HK;
static_assert(WS_Y + 144 * MiB <= WS_OSB && WS_PRE + 64 * MiB <= WS_HK, "overlays");
static_assert(WS_END <= 1020 * MiB, "ws budget");
constexpr int CW_NTILES = 16;
constexpr int CW_ATTNQ = 32;
constexpr int CW_BGQ = 48;
constexpr int CW_TILEEXP = 64;
constexpr int CW_BAR = 1024;
constexpr int LDS_SCRATCH = 147456;
constexpr int LDSCTL_OFF = LDS_SCRATCH, LDS_BYTES = LDS_SCRATCH + 512;
constexpr int LDS_IDX = 131072 + 1280;
constexpr int LDS_TILEEXP = 131072;
constexpr int MISC_OFF = LDSCTL_OFF;

__device__ __forceinline__ unsigned f2bf(float f) { unsigned u = __builtin_bit_cast(unsigned, f); return (u + 0x7fffu + ((u >> 16) & 1u)) >> 16; }
__device__ __forceinline__ unsigned pk2(float lo, float hi) { return f2bf(lo) | (f2bf(hi) << 16); }
__device__ __forceinline__ float bf2f(unsigned short b) { return __builtin_bit_cast(float, (unsigned)b << 16); }
__device__ __forceinline__ float bflo(unsigned w) { return __builtin_bit_cast(float, w << 16); }
__device__ __forceinline__ float bfhi(unsigned w) { return __builtin_bit_cast(float, w & 0xffff0000u); }
__device__ __forceinline__ float fsigmoid(float v) { return __builtin_amdgcn_rcpf(1.0f + __builtin_amdgcn_exp2f(-v * LOG2E)); }
__device__ __forceinline__ f32x4 fsigmoid4(f32x4 v) { const f32x4 x = v * (f32x4){-LOG2E, -LOG2E, -LOG2E, -LOG2E};
    const f32x4 d = (f32x4){__builtin_amdgcn_exp2f(x[0]), __builtin_amdgcn_exp2f(x[1]), __builtin_amdgcn_exp2f(x[2]), __builtin_amdgcn_exp2f(x[3])} + (f32x4){1.0f, 1.0f, 1.0f, 1.0f};
    return (f32x4){__builtin_amdgcn_rcpf(d[0]), __builtin_amdgcn_rcpf(d[1]), __builtin_amdgcn_rcpf(d[2]), __builtin_amdgcn_rcpf(d[3])}; }
template <int CTRL> __device__ __forceinline__ float dpp_f(float v) { return __builtin_bit_cast(float, __builtin_amdgcn_update_dpp(0, __builtin_bit_cast(int, v), CTRL, 0xF, 0xF, false)); }
__device__ __forceinline__ float row16_sum(float v) { v += dpp_f<0xB1>(v); v += dpp_f<0x4E>(v); v += dpp_f<0x141>(v); v += dpp_f<0x140>(v); return v; }
__device__ __forceinline__ float wave_sum(float v) {
    v = row16_sum(v);
    const float r0 = __builtin_bit_cast(float, __builtin_amdgcn_readlane(__builtin_bit_cast(int, v), 0)), r1 = __builtin_bit_cast(float, __builtin_amdgcn_readlane(__builtin_bit_cast(int, v), 16));
    const float r2 = __builtin_bit_cast(float, __builtin_amdgcn_readlane(__builtin_bit_cast(int, v), 32)), r3 = __builtin_bit_cast(float, __builtin_amdgcn_readlane(__builtin_bit_cast(int, v), 48));
    return (r0 + r1) + (r2 + r3);
}
__device__ __forceinline__ unsigned pk4_fp8(float a, float b, float c, float d) { int w = 0; w = __builtin_amdgcn_cvt_pk_fp8_f32(a, b, w, false); w = __builtin_amdgcn_cvt_pk_fp8_f32(c, d, w, true); return (unsigned)w; }
#define LDS_WAIT() asm volatile("s_waitcnt lgkmcnt(0)" ::: "memory")
#define VM_WAIT() asm volatile("s_waitcnt vmcnt(0)" ::: "memory")

struct InProjOut { bf16_t *Q, *K, *V, *HQ, *HK, *HV, *HG, *GS, *GH; float* LOGF; const float* lb; };

namespace pg8 {
#define PG8_LAS __attribute__((address_space(3)))
constexpr int BM = 256, BK = 64, HALF = 128, HTB = HALF * BK * 2  , STAGE_BYTES = 8 * HTB, NXCD = 8, WGM = 8;
__host__ __device__ __forceinline__ int lds_byte(int r, int c) { const int st = (r >> 4) * 2 + (c >> 5), rr = r & 15, cc = c & 31, ob = rr * 64 + cc * 2; return st * 1024 + (ob ^ (((ob >> 9) & 1) << 5)); }
__host__ __device__ __forceinline__ void stage_rc(int b, int& R, int& C) { const int st = b / 1024, sb = b % 1024, swz = sb ^ (((sb >> 9) & 1) << 5); R = (st >> 1) * 16 + swz / 64; C = (st & 1) * 32 + (swz % 64) / 2; }
__host__ __device__ __forceinline__ int perm32(int rho) { const int n = rho >> 4, i = rho & 15; return 8 * (i >> 2) + 4 * n + (i & 3); }

struct Unit { int pm, pn, aux; const char* a; const char* b; };
struct Gemm { int K; int scale_a = 0x7f7f7f7f, scale_b = 0x7f7f7f7f; };
struct TileOrder {
    int nM, nN, nwg, G, c, wgm;
    __device__ void init(int nM_, int nN_, int G_, int c_, int wgm_ = WGM) { nM = nM_; nN = nN_; nwg = nM * nN; G = G_; c = c_; wgm = wgm_; }
    __device__ bool tile(int i, int& pm, int& pn) const {
        const long L = (long)i * G + c; if (L >= nwg) return false;
        int wgid = (int)L; { const int q = nwg / NXCD, r = nwg % NXCD, xcd = wgid % NXCD, off = wgid / NXCD; wgid = (xcd < r ? xcd * (q + 1) : r * (q + 1) + (xcd - r) * q) + off; }
        const int nig = wgm * nN, gid = wgid / nig, fm = gid * wgm, gsz = (nM - fm) < wgm ? (nM - fm) : wgm;
        pm = fm + ((wgid % nig) % gsz); pn = (wgid % nig) / gsz; return true;
    }
};
struct DenseSched { static constexpr bool GATHER_A = false; TileOrder o; const char* A; const char* Bt; size_t tstep;
    __device__ __forceinline__ bool next(int i, Unit& u) const { if (!o.tile(i, u.pm, u.pn)) return false; u.aux = 0; u.a = A + (size_t)u.pm * tstep; u.b = Bt + (size_t)u.pn * tstep; return true; }
    __device__ __forceinline__ void a_ready(const Unit&) const {}
    __device__ __forceinline__ void done(const Unit&) const {} };
struct BranchSched { static constexpr bool GATHER_A = false; TileOrder o; const char *A0, *B0, *A1, *B1; size_t tstep;
    __device__ __forceinline__ bool next(int i, Unit& u) const { if (!o.tile(i >> 1, u.pm, u.pn)) return false; u.aux = i & 1; u.a = ((i & 1) ? A1 : A0) + (size_t)u.pm * tstep; u.b = ((i & 1) ? B1 : B0) + (size_t)u.pn * tstep; return true; }
    __device__ __forceinline__ void a_ready(const Unit&) const {}
    __device__ __forceinline__ void done(const Unit&) const {} };
struct MoeSched { static constexpr bool GATHER_A = false; TileOrder o; const char* A; const char* W; const LAS int* tile_exp; size_t tstep, estep;
    __device__ __forceinline__ bool next(int i, Unit& u) const { if (!o.tile(i, u.pm, u.pn)) return false; const int e = __builtin_amdgcn_readfirstlane(tile_exp[u.pm]); u.aux = e; u.a = A + (size_t)u.pm * tstep; u.b = W + (size_t)e * estep + (size_t)u.pn * tstep; return true; }
    __device__ __forceinline__ void a_ready(const Unit&) const {}
    __device__ __forceinline__ void done(const Unit&) const {} };

struct MoeGatherSched : MoeSched { static constexpr bool GATHER_A = true; const int* slot_tok;
    __device__ __forceinline__ bool next(int i, Unit& u) const { if (!MoeSched::next(i, u)) return false; u.a = A; return true; }
    __device__ __forceinline__ const int* idx(const Unit& u) const { return slot_tok + u.pm * BM; } };
typedef __bf16 bf16x2_t __attribute__((ext_vector_type(2)));
__device__ __forceinline__ unsigned cvt_pk_bf16(float lo, float hi) { f32x2_t v = {lo, hi}; bf16x2_t b = __builtin_convertvector(v, bf16x2_t); return __builtin_bit_cast(unsigned, b); }
template <int MODE> __device__ __forceinline__ void inproj_store(const f32x4 (&acc)[2][2][4][2], bf16_t* dst, int ld, int row0, int col0, float scale, const float* lb, float* logf_out) {
    f32x4 lbq[2][2];
    if (MODE == 2) {
#pragma unroll
        for (int bj = 0; bj < 2; ++bj) { lbq[bj][0] = *(const f32x4*)(lb + col0 + bj * HALF); lbq[bj][1] = *(const f32x4*)(lb + col0 + bj * HALF + 4); } }
#pragma unroll
    for (int ai = 0; ai < 2; ++ai)
#pragma unroll
        for (int m = 0; m < 4; ++m)
#pragma unroll
            for (int bj = 0; bj < 2; ++bj) {
                const size_t off = (size_t)(row0 + ai * HALF + m * 16) * ld + col0 + bj * HALF;
                f32x4 v[2] = {acc[ai][bj][m][0], acc[ai][bj][m][1]};
                if (MODE == 0) { v[0] = v[0] * scale; v[1] = v[1] * scale; }
                if (MODE == 1) { v[0] = v[0] * fsigmoid4(v[0]); v[1] = v[1] * fsigmoid4(v[1]); }
                if (MODE == 3) { v[0] = fsigmoid4(v[0]); v[1] = fsigmoid4(v[1]); }
                if (MODE == 2) {
                    f32x4 lg[2]; const f32x4 lbv[2] = {lbq[bj][0], lbq[bj][1]};
#pragma unroll
                    for (int n = 0; n < 2; ++n) { const f32x4 one = {1.0f, 1.0f, 1.0f, 1.0f}, l = lbv[n], f = l + (one - l) * fsigmoid4(v[n]); v[n] = one - f;
                        lg[n] = (f32x4){__builtin_amdgcn_logf(f[0]), __builtin_amdgcn_logf(f[1]), __builtin_amdgcn_logf(f[2]), __builtin_amdgcn_logf(f[3])} * (f32x4){LN2, LN2, LN2, LN2}; }
                    *(f32x4*)(logf_out + off) = lg[0]; *(f32x4*)(logf_out + off + 4) = lg[1];
                }
                u32x4 w; w.x = cvt_pk_bf16(v[0][0], v[0][1]); w.y = cvt_pk_bf16(v[0][2], v[0][3]); w.z = cvt_pk_bf16(v[1][0], v[1][1]); w.w = cvt_pk_bf16(v[1][2], v[1][3]);
                *(u32x4*)(dst + off) = w;
            }
}
template <int PN0> struct EpiInProjT { static constexpr bool PERM = true, AFTER_DRAIN = false, ACC_CHAIN = false; static constexpr int INIT = 0; InProjOut o;
    __device__ __forceinline__ void operator()(f32x4 (&acc)[2][2][4][2], const Unit& u, int wr, int wc, int fr, int fq) const {
        const int row0 = u.pm * BM + wr * 64 + fr, pn = u.pn + PN0;
        int seg, cb, ld;
        if (pn < 14) { seg = pn >> 1; cb = (pn & 1) * 256; ld = 512; } else if (pn < 18) { seg = 7; cb = (pn - 14) * 256; ld = 1024; } else { seg = 8; cb = (pn - 18) * 256; ld = 1024; }
        const int col0 = cb + wc * 32 + 8 * fq;
        if constexpr (PN0 != 0) { const size_t off = seg == 6 ? (size_t)(WS_HG - WS_HG) : (seg == 7 ? (size_t)(WS_GS - WS_HG) : (size_t)(WS_GH - WS_HG));
            inproj_store<3>(acc, (bf16_t*)((unsigned char*)o.HG + off), ld, row0, col0, 1.0f, nullptr, nullptr); return; }
        switch (seg) {
            case 0: inproj_store<0>(acc, o.Q, ld, row0, col0, 0.125f * LOG2E, nullptr, nullptr); break;
            case 1: inproj_store<0>(acc, o.K, ld, row0, col0, 1.0f, nullptr, nullptr); break;
            case 2: inproj_store<0>(acc, o.V, ld, row0, col0, 1.0f, nullptr, nullptr); break;
            case 3: inproj_store<1>(acc, o.HQ, ld, row0, col0, 1.0f, nullptr, nullptr); break;
            case 4: inproj_store<2>(acc, o.HK, ld, row0, col0, 1.0f, o.lb, o.LOGF); break;
            case 5: inproj_store<0>(acc, o.HV, ld, row0, col0, 1.0f, nullptr, nullptr); break;
            case 6: inproj_store<3>(acc, o.HG, ld, row0, col0, 1.0f, nullptr, nullptr); break;
            case 7: inproj_store<3>(acc, o.GS, ld, row0, col0, 1.0f, nullptr, nullptr); break;
            default: inproj_store<3>(acc, o.GH, ld, row0, col0, 1.0f, nullptr, nullptr); break;
        }
    }
};
struct EpiBranch { static constexpr bool PERM = true, AFTER_DRAIN = false, ACC_CHAIN = true; static constexpr int INIT = 0; const bf16_t* GS; const bf16_t* GH; bf16_t* MERGED;
    __device__ __forceinline__ void operator()(f32x4 (&acc)[2][2][4][2], const Unit& u, int wr, int wc, int fr, int fq) const {
        const int row0 = u.pm * BM + wr * 64 + fr, col0 = u.pn * BM + wc * 32 + 8 * fq;
        u32x4 ghq[MK_BR_BATCH + 1];
#pragma unroll
        for (int it = 0; it < MK_BR_BATCH; ++it) ghq[it] = *(const u32x4*)(GH + (size_t)(row0 + (it >> 3) * HALF + ((it >> 1) & 3) * 16) * DM + col0 + (it & 1) * HALF);
#pragma unroll
        for (int it = 0; it < 16; ++it) { const int ai = it >> 3, m = (it >> 1) & 3, bj = it & 1;
                    const size_t off = (size_t)(row0 + ai * HALF + m * 16) * DM + col0 + bj * HALF;
                    if (it + MK_BR_BATCH < 16) { const int i2 = it + MK_BR_BATCH; ghq[i2 % (MK_BR_BATCH + 1)] = *(const u32x4*)(GH + (size_t)(row0 + (i2 >> 3) * HALF + ((i2 >> 1) & 3) * 16) * DM + col0 + (i2 & 1) * HALF); }
                    const u32x4 gh = ghq[it % (MK_BR_BATCH + 1)];
                    const float h[8] = {bflo(gh.x), bfhi(gh.x), bflo(gh.y), bfhi(gh.y), bflo(gh.z), bfhi(gh.z), bflo(gh.w), bfhi(gh.w)};
                    if (u.aux == 0) {
                        const u32x4 gs = *(const u32x4*)(GS + off);
                        const float s[8] = {bflo(gs.x), bfhi(gs.x), bflo(gs.y), bfhi(gs.y), bflo(gs.z), bfhi(gs.z), bflo(gs.w), bfhi(gs.w)};
#pragma unroll
                        for (int n = 0; n < 2; ++n)
#pragma unroll
                            for (int j = 0; j < 4; ++j) acc[ai][bj][m][n][j] *= s[4 * n + j] * __builtin_amdgcn_rcpf(h[4 * n + j]);
                    } else {
                        float r[8];
#pragma unroll
                        for (int n = 0; n < 2; ++n)
#pragma unroll
                            for (int j = 0; j < 4; ++j) { r[4 * n + j] = acc[ai][bj][m][n][j] * h[4 * n + j]; acc[ai][bj][m][n][j] = 0.f; }
                        u32x4 w; w.x = cvt_pk_bf16(r[0], r[1]); w.y = cvt_pk_bf16(r[2], r[3]); w.z = cvt_pk_bf16(r[4], r[5]); w.w = cvt_pk_bf16(r[6], r[7]);
                        *(u32x4*)(MERGED + off) = w;
                    }
        }
    }
};
struct EpiOut { static constexpr bool PERM = true, AFTER_DRAIN = false, ACC_CHAIN = false; static constexpr int INIT = 2;     const bf16_t* xb; bf16_t* PRE;
    __device__ __forceinline__ void tile_init(f32x4 (&acc)[2][2][4][2], const Unit& u, int wr, int wc, int fr, int fq) const {
        const int row0 = u.pm * BM + wr * 64 + fr, col0 = u.pn * BM + wc * 32 + 8 * fq;
#pragma unroll
        for (int ai = 0; ai < 2; ++ai)
#pragma unroll
            for (int m = 0; m < 4; ++m)
#pragma unroll
                for (int bj = 0; bj < 2; ++bj) { const size_t off = (size_t)(row0 + ai * HALF + m * 16) * DM + col0 + bj * HALF;
                    const u32x4 xv = *(const u32x4*)(xb + off);
                    acc[ai][bj][m][0] = (f32x4){bflo(xv.x), bfhi(xv.x), bflo(xv.y), bfhi(xv.y)} * DN_ALPHA; acc[ai][bj][m][1] = (f32x4){bflo(xv.z), bfhi(xv.z), bflo(xv.w), bfhi(xv.w)} * DN_ALPHA; }
    }
    __device__ __forceinline__ void operator()(f32x4 (&acc)[2][2][4][2], const Unit& u, int wr, int wc, int fr, int fq) const {
        const int row0 = u.pm * BM + wr * 64 + fr, col0 = u.pn * BM + wc * 32 + 8 * fq;
#pragma unroll
        for (int ai = 0; ai < 2; ++ai)
#pragma unroll
            for (int m = 0; m < 4; ++m)
#pragma unroll
                for (int bj = 0; bj < 2; ++bj) { const size_t off = (size_t)(row0 + ai * HALF + m * 16) * DM + col0 + bj * HALF;
                    const f32x4 v0 = acc[ai][bj][m][0], v1 = acc[ai][bj][m][1];
                    u32x4 w; w.x = cvt_pk_bf16(v0[0], v0[1]); w.y = cvt_pk_bf16(v0[2], v0[3]); w.z = cvt_pk_bf16(v1[0], v1[1]); w.w = cvt_pk_bf16(v1[2], v1[3]);
                    *(u32x4*)(PRE + off) = w; }
    }
};
template <bool F8OUT> struct EpiUpT { static constexpr bool PERM = true, AFTER_DRAIN = false, ACC_CHAIN = false; static constexpr int INIT = 1;     const float* b_up; bf16_t* ACT;
    __device__ __forceinline__ void bias_load(f32x4 (&bv)[2][2], const Unit& u, int wc, int fq) const { const float* bias = b_up + (size_t)u.aux * UPW + u.pn * BM + wc * 32 + 8 * fq;
#pragma unroll
        for (int bj = 0; bj < 2; ++bj)
#pragma unroll
            for (int n = 0; n < 2; ++n) bv[bj][n] = *(const f32x4*)(bias + bj * HALF + 4 * n); }
    __device__ __forceinline__ void operator()(f32x4 (&acc)[2][2][4][2], const Unit& u, int wr, int wc, int fr, int fq) const {
        const int row0 = u.pm * BM + wr * 64 + fr, col0 = u.pn * BM + wc * 32 + 8 * fq;
        constexpr float OS = F8OUT ? ACT8_SCALE : 1.0f;
#pragma unroll
        for (int ai = 0; ai < 2; ++ai)
#pragma unroll
            for (int bj = 0; bj < 2; ++bj) {
                unsigned d[4]; u32x2 wb[4];
#pragma unroll
                for (int m = 0; m < 4; ++m) {
                    const f32x4 v0 = acc[ai][bj][m][0], v1 = acc[ai][bj][m][1];
                    const float gl[4] = {v0[0], v0[2], v1[0], v1[2]}, li[4] = {v0[1], v0[3], v1[1], v1[3]}; float a[4];
#pragma unroll
                    for (int p = 0; p < 4; p += 2) {
                        const f32x2_t g2 = {__builtin_amdgcn_fmed3f(gl[p], -INFINITY, SW_LIMIT), __builtin_amdgcn_fmed3f(gl[p + 1], -INFINITY, SW_LIMIT)}, l2 = {__builtin_amdgcn_fmed3f(li[p], -SW_LIMIT, SW_LIMIT), __builtin_amdgcn_fmed3f(li[p + 1], -SW_LIMIT, SW_LIMIT)};
                        const f32x2_t x2 = g2 * (f32x2_t){-SW_ALPHA * LOG2E, -SW_ALPHA * LOG2E};
                        const f32x2_t d2 = (f32x2_t){__builtin_amdgcn_exp2f(x2[0]), __builtin_amdgcn_exp2f(x2[1])} + (f32x2_t){1.0f, 1.0f};
                        const f32x2_t r2 = {__builtin_amdgcn_rcpf(d2[0]), __builtin_amdgcn_rcpf(d2[1])};
                        const f32x2_t u2 = l2 * (f32x2_t){OS, OS} + (f32x2_t){OS, OS};
                        const f32x2_t a2 = (g2 * r2) * u2;
                        a[p] = a2[0]; a[p + 1] = a2[1]; }
                    if constexpr (F8OUT) d[m] = pk4_fp8(a[0], a[1], a[2], a[3]);
                    else { wb[m].x = cvt_pk_bf16(a[0], a[1]); wb[m].y = cvt_pk_bf16(a[2], a[3]); }
                }
                if constexpr (F8OUT) {
                    auto r = __builtin_amdgcn_permlane16_swap(d[0], d[1], false, false); d[0] = r[0]; d[1] = r[1];
                    r = __builtin_amdgcn_permlane16_swap(d[2], d[3], false, false); d[2] = r[0]; d[3] = r[1];
                    r = __builtin_amdgcn_permlane32_swap(d[0], d[2], false, false); d[0] = r[0]; d[2] = r[1];
                    r = __builtin_amdgcn_permlane32_swap(d[1], d[3], false, false); d[1] = r[0]; d[3] = r[1];
                    *(u32x4*)((unsigned char*)ACT + (size_t)(row0 + ai * HALF + 16 * fq) * DFF + (u.pn * (BM / 2) + wc * 16 + bj * (HALF / 2))) = (u32x4){d[0], d[1], d[2], d[3]};
                } else {
#pragma unroll
                    for (int m = 0; m < 4; ++m) *(u32x2*)(ACT + (size_t)(row0 + ai * HALF + m * 16) * DFF + ((col0 + bj * HALF) >> 1)) = wb[m];
                }
            }
    }
};
struct EpiDown { static constexpr bool PERM = true, AFTER_DRAIN = false, ACC_CHAIN = false; static constexpr int INIT = 1; const float* b_dn; bf16_t* Y;
    __device__ __forceinline__ void bias_load(f32x4 (&bv)[2][2], const Unit& u, int wc, int fq) const { const float* bias = b_dn + (size_t)u.aux * DM + u.pn * BM + wc * 32 + 8 * fq;
#pragma unroll
        for (int bj = 0; bj < 2; ++bj)
#pragma unroll
            for (int n = 0; n < 2; ++n) bv[bj][n] = *(const f32x4*)(bias + bj * HALF + 4 * n); }
    __device__ __forceinline__ void operator()(f32x4 (&acc)[2][2][4][2], const Unit& u, int wr, int wc, int fr, int fq) const {
        const int row0 = u.pm * BM + wr * 64 + fr, col0 = u.pn * BM + wc * 32 + 8 * fq;
#if MK_Y8
#pragma unroll
        for (int ai = 0; ai < 2; ++ai)
#pragma unroll
            for (int bj = 0; bj < 2; ++bj)
#pragma unroll
                for (int mp = 0; mp < 4; mp += 2) {
                    u32x2 w[2];
#pragma unroll
                    for (int q = 0; q < 2; ++q) { const f32x4 v0 = acc[ai][bj][mp + q][0], v1 = acc[ai][bj][mp + q][1];
                        w[q].x = pk4_fp8(v0[0] * Y8_SCALE, v0[1] * Y8_SCALE, v0[2] * Y8_SCALE, v0[3] * Y8_SCALE); w[q].y = pk4_fp8(v1[0] * Y8_SCALE, v1[1] * Y8_SCALE, v1[2] * Y8_SCALE, v1[3] * Y8_SCALE); }
                    auto r = __builtin_amdgcn_permlane16_swap(w[0].x, w[1].x, false, false); w[0].x = r[0]; w[1].x = r[1];
                    r = __builtin_amdgcn_permlane16_swap(w[0].y, w[1].y, false, false); w[0].y = r[0]; w[1].y = r[1];
                    *(u32x4*)((unsigned char*)Y + (size_t)(row0 + ai * HALF + (mp + (fq & 1)) * 16) * DM + (u.pn * BM + wc * 32 + 8 * (fq & 2) + bj * HALF)) = (u32x4){w[0].x, w[0].y, w[1].x, w[1].y};
                }
#else
#pragma unroll
        for (int ai = 0; ai < 2; ++ai)
#pragma unroll
            for (int m = 0; m < 4; ++m)
#pragma unroll
                for (int bj = 0; bj < 2; ++bj) {
                    const f32x4 v0 = acc[ai][bj][m][0], v1 = acc[ai][bj][m][1];
                    u32x4 w; w.x = cvt_pk_bf16(v0[0], v0[1]); w.y = cvt_pk_bf16(v0[2], v0[3]); w.z = cvt_pk_bf16(v1[0], v1[1]); w.w = cvt_pk_bf16(v1[2], v1[3]);
                    *(u32x4*)(Y + (size_t)(row0 + ai * HALF + m * 16) * DM + col0 + bj * HALF) = w;
                }
#endif
    }
};

template <class Epi, class Sched, bool ALIGN_EPI = false, bool SP2 = false>
__device__ __forceinline__ void gemm_phase(PG8_LAS unsigned char* lds, const Gemm g, const Sched& S, const Epi& E) {
    int tid = threadIdx.x; asm volatile("" : "+v"(tid));
    const int wid = __builtin_amdgcn_readfirstlane(tid >> 6), lane = tid & 63, wr = wid >> 2, wc = wid & 3, fr = lane & 15, fq = lane >> 4;
    const int K = g.K, nt = K / BK;
    unsigned voffA[2], voffB[2];
#pragma unroll
    for (int i = 0; i < 2; ++i) { int R, C; stage_rc(tid * 16 + i * 8192, R, C); const int Rb = Epi::PERM ? ((R & ~31) + perm32(R & 31)) : R;
        voffA[i] = (unsigned)(R * K + C) * 2u; voffB[i] = (unsigned)(Rb * K + C) * 2u; }
    const size_t kstep = (size_t)(BK * 2);
    const size_t hstep = (size_t)HALF * K * 2;
    const unsigned ldsw = (unsigned)wid * 1024u;
    const int aoff = lds_byte(wr * 64 + fr, fq * 8), boff = lds_byte(wc * 32 + fr, fq * 8);
#define PG8_SA(b, h) (((b) * 2 + (h)) * HTB)
#define PG8_SB(b, h) ((4 + (b) * 2 + (h)) * HTB)
#define PG8_STAGE(bufoff, gbase, voff) do { _Pragma("unroll") for (int _i = 0; _i < 2; ++_i) \
        __builtin_amdgcn_global_load_lds((const unsigned*)((const char*)(gbase) + (voff)[_i]), (PG8_LAS unsigned*)(lds + (bufoff) + ldsw + _i * 8192), 16, 0, 0); } while (0)
#define PG8_LDA(dst, b, h) do { _Pragma("unroll") for (int m = 0; m < 4; ++m) _Pragma("unroll") for (int k = 0; k < 2; ++k) dst[m][k] = *(const PG8_LAS bf16x8*)(lds + PG8_SA(b, h) + aoff + m * 2048 + k * 1024); } while (0)
#define PG8_LDB(dst, b, h) do { _Pragma("unroll") for (int n = 0; n < 2; ++n) _Pragma("unroll") for (int k = 0; k < 2; ++k) dst[n][k] = *(const PG8_LAS bf16x8*)(lds + PG8_SB(b, h) + boff + n * 2048 + k * 1024); } while (0)
#define PG8_MMA(ai, bj, At, Bt) do { __builtin_amdgcn_s_setprio(1); _Pragma("unroll") for (int m = 0; m < 4; ++m) _Pragma("unroll") for (int n = 0; n < 2; ++n) _Pragma("unroll") for (int k = 0; k < 2; ++k) \
        acc[ai][bj][m][n] = __builtin_amdgcn_mfma_f32_16x16x32_bf16(Bt[n][k], At[m][k], acc[ai][bj][m][n], 0, 0, 0); __builtin_amdgcn_s_setprio(0); } while (0)
#define PG8_WAIT_V(n) asm volatile("s_waitcnt vmcnt(" #n ")" ::: "memory")
#define PG8_WAIT_L(n) asm volatile("s_waitcnt lgkmcnt(" #n ")" ::: "memory")
#define PG8_BAR __builtin_amdgcn_s_barrier()
#define PG8_SCHED __builtin_amdgcn_sched_barrier(0)
    Unit cur, nxt; int ui = 0;
    if (!S.next(0, cur)) return;
    f32x4 acc[2][2][4][2];
    f32x4 bv0[2][2];
    if constexpr (Epi::INIT == 1) E.bias_load(bv0, cur, wc, fq);
#pragma unroll
    for (int a = 0; a < 2; ++a)
#pragma unroll
        for (int b = 0; b < 2; ++b)
#pragma unroll
            for (int m = 0; m < 4; ++m)
#pragma unroll
                for (int n = 0; n < 2; ++n) { if constexpr (Epi::INIT == 1) acc[a][b][m][n] = bv0[b][n]; else acc[a][b][m][n] = (f32x4){0.f, 0.f, 0.f, 0.f}; }
    if constexpr (Epi::INIT == 2) E.tile_init(acc, cur, wr, wc, fr, fq);
    bf16x8 At[4][2], B0[2][2], B1[2][2];
    const char* cA = cur.a; const char* cB = cur.b;
    S.a_ready(cur);
    if constexpr (SP2) {
        PG8_STAGE(PG8_SB(0, 0), cB, voffB); PG8_STAGE(PG8_SB(0, 1), cB + hstep, voffB); PG8_STAGE(PG8_SA(0, 0), cA, voffA); PG8_STAGE(PG8_SA(0, 1), cA + hstep, voffA);
        if (wr == 1) PG8_BAR;
        PG8_WAIT_V(2); PG8_BAR;
        PG8_STAGE(PG8_SB(1, 0), cB + kstep, voffB); PG8_STAGE(PG8_SA(1, 0), cA + kstep, voffA); PG8_STAGE(PG8_SB(1, 1), cB + hstep + kstep, voffB);
        PG8_WAIT_V(6); PG8_BAR;
    } else {
        PG8_STAGE(PG8_SB(0, 0), cB, voffB); PG8_STAGE(PG8_SA(0, 0), cA, voffA); PG8_STAGE(PG8_SB(0, 1), cB + hstep, voffB); PG8_STAGE(PG8_SA(0, 1), cA + hstep, voffA);
        if (wr == 1) PG8_BAR;
        PG8_WAIT_V(4); PG8_BAR;
        PG8_STAGE(PG8_SB(1, 0), cB + kstep, voffB); PG8_STAGE(PG8_SA(1, 0), cA + kstep, voffA); PG8_STAGE(PG8_SB(1, 1), cB + hstep + kstep, voffB);
        PG8_WAIT_V(6); PG8_BAR;
    }
    for (;;) {
        const bool has_next = S.next(ui + 1, nxt);
        const char* nA = has_next ? nxt.a : cA; const char* nB = has_next ? nxt.b : cB;
        for (int t = 0; t < nt; t += 2) {
            const bool last = (t == nt - 2);
            const char* a1 = cA + (size_t)(t + 1) * kstep;
            const char* a2 = last ? nA : cA + (size_t)(t + 2) * kstep; const char* b2 = last ? nB : cB + (size_t)(t + 2) * kstep;
            const char* a3 = a2 + kstep; const char* b3 = b2 + kstep;
            if (last && has_next) S.a_ready(nxt);
            if constexpr (SP2) {
            PG8_LDB(B0, 0, 0); PG8_LDB(B1, 0, 1); PG8_SCHED; PG8_LDA(At, 0, 0); PG8_STAGE(PG8_SA(1, 1), a1 + hstep, voffA);
            PG8_WAIT_V(8); PG8_WAIT_L(0); PG8_BAR; PG8_MMA(0, 0, At, B0); PG8_MMA(0, 1, At, B1); PG8_BAR; PG8_SCHED;
            PG8_LDA(At, 0, 1); PG8_STAGE(PG8_SB(0, 0), b2, voffB); PG8_STAGE(PG8_SB(0, 1), b2 + hstep, voffB); PG8_STAGE(PG8_SA(0, 0), a2, voffA);
            PG8_WAIT_V(8); PG8_WAIT_L(0); PG8_BAR; PG8_MMA(1, 0, At, B0); PG8_MMA(1, 1, At, B1); PG8_BAR; PG8_SCHED;
            PG8_LDB(B0, 1, 0); PG8_LDB(B1, 1, 1); PG8_SCHED; PG8_LDA(At, 1, 0); PG8_STAGE(PG8_SA(0, 1), a2 + hstep, voffA);
            PG8_WAIT_V(8); PG8_WAIT_L(0); PG8_BAR; PG8_MMA(0, 0, At, B0); PG8_MMA(0, 1, At, B1); PG8_BAR; PG8_SCHED;
            PG8_LDA(At, 1, 1); PG8_STAGE(PG8_SB(1, 0), b3, voffB); PG8_STAGE(PG8_SB(1, 1), b3 + hstep, voffB); PG8_STAGE(PG8_SA(1, 0), a3, voffA);
            PG8_WAIT_V(8); PG8_WAIT_L(0); PG8_BAR; PG8_MMA(1, 0, At, B0); PG8_MMA(1, 1, At, B1); PG8_BAR; PG8_SCHED;
            } else {
            PG8_LDB(B0, 0, 0); PG8_SCHED; PG8_LDA(At, 0, 0); PG8_STAGE(PG8_SA(1, 1), a1 + hstep, voffA);
            PG8_WAIT_L(8); PG8_BAR; PG8_WAIT_L(0); PG8_MMA(0, 0, At, B0); PG8_BAR; PG8_SCHED;
            PG8_LDB(B1, 0, 1); PG8_STAGE(PG8_SB(0, 0), b2, voffB);
            PG8_BAR; PG8_WAIT_L(0); PG8_MMA(0, 1, At, B1); PG8_BAR;
            PG8_LDA(At, 0, 1); PG8_STAGE(PG8_SA(0, 0), a2, voffA);
            PG8_BAR; PG8_WAIT_L(0); PG8_MMA(1, 0, At, B0); PG8_BAR; PG8_SCHED;
            PG8_STAGE(PG8_SB(0, 1), b2 + hstep, voffB);
            PG8_WAIT_V(6); PG8_BAR; PG8_MMA(1, 1, At, B1); PG8_BAR;
            PG8_LDB(B0, 1, 0); PG8_SCHED; PG8_LDA(At, 1, 0); PG8_STAGE(PG8_SA(0, 1), a2 + hstep, voffA);
            PG8_WAIT_L(8); PG8_BAR; PG8_WAIT_L(0); PG8_MMA(0, 0, At, B0); PG8_BAR; PG8_SCHED;
            PG8_LDB(B1, 1, 1); PG8_STAGE(PG8_SB(1, 0), b3, voffB);
            PG8_BAR; PG8_WAIT_L(0); PG8_MMA(0, 1, At, B1); PG8_BAR;
            PG8_LDA(At, 1, 1); PG8_STAGE(PG8_SA(1, 0), a3, voffA);
            PG8_BAR; PG8_WAIT_L(0); PG8_MMA(1, 0, At, B0); PG8_BAR; PG8_SCHED;
            PG8_STAGE(PG8_SB(1, 1), b3 + hstep, voffB);
            PG8_WAIT_V(6); PG8_BAR; PG8_MMA(1, 1, At, B1); PG8_BAR;
            }
        }
        if constexpr (ALIGN_EPI) { if (wr == 0) PG8_BAR; }
        f32x4 bvn[2][2]; if constexpr (Epi::INIT == 1) { if (has_next) E.bias_load(bvn, nxt, wc, fq); }
        if constexpr (!Epi::AFTER_DRAIN) { E(acc, cur, wr, wc, fr, fq); S.done(cur); }
        if (!has_next) break;
        if constexpr (!Epi::ACC_CHAIN) {
#pragma unroll
        for (int a = 0; a < 2; ++a)
#pragma unroll
            for (int b = 0; b < 2; ++b)
#pragma unroll
                for (int m = 0; m < 4; ++m)
#pragma unroll
                    for (int n = 0; n < 2; ++n) { if constexpr (Epi::INIT == 1) acc[a][b][m][n] = bvn[b][n]; else acc[a][b][m][n] = (f32x4){0.f, 0.f, 0.f, 0.f}; }
        if constexpr (Epi::INIT == 2) E.tile_init(acc, nxt, wr, wc, fr, fq);
        }
        cur = nxt; cA = nA; cB = nB; ++ui;
        if constexpr (ALIGN_EPI) { if (wr == 1) PG8_BAR; }
    }
    PG8_WAIT_V(0);
    if constexpr (!ALIGN_EPI) { if (wr == 0) PG8_BAR; }
    PG8_BAR;
    if constexpr (Epi::AFTER_DRAIN) { E.fused(acc, cur, wr, wc, fr, fq, lds, wid, lane); S.done(cur); }
#undef PG8_SA
#undef PG8_SB
#undef PG8_STAGE
#undef PG8_LDA
#undef PG8_LDB
#undef PG8_MMA
#undef PG8_WAIT_V
#undef PG8_WAIT_L
#undef PG8_BAR
#undef PG8_SCHED
}
typedef int v8i_t __attribute__((ext_vector_type(8)));
template <class Epi, class Sched, bool ALIGN_EPI = false, bool SP2 = false>
__device__ __forceinline__ void gemm_phase_f8(PG8_LAS unsigned char* lds, const Gemm g, const Sched& S, const Epi& E) {
    int tid = threadIdx.x; asm volatile("" : "+v"(tid));
    const int wid = __builtin_amdgcn_readfirstlane(tid >> 6), lane = tid & 63, wr = wid >> 2, wc = wid & 3, fr = lane & 15, fq = lane >> 4;
    const int K = g.K, nt = K / BK;
    unsigned voffA[2], voffB[2];
#pragma unroll
    for (int i = 0; i < 2; ++i) { int R, C; stage_rc(tid * 16 + i * 8192, R, C); const int Rb = Epi::PERM ? ((R & ~31) + perm32(R & 31)) : R;
        voffA[i] = (unsigned)(R * K + C) * 2u; voffB[i] = (unsigned)(Rb * K + C) * 2u; }
    const size_t kstep = (size_t)(BK * 2);
    const size_t hstep = (size_t)HALF * K * 2;
    const unsigned ldsw = (unsigned)wid * 1024u;
    const int aoff = lds_byte(wr * 64 + fr, fq * 16), boff = lds_byte(wc * 32 + fr, fq * 16);
#define PG8_SA(b, h) (((b) * 2 + (h)) * HTB)
#define PG8_SB(b, h) ((4 + (b) * 2 + (h)) * HTB)
#define PG8_STAGE(bufoff, gbase, voff) do { _Pragma("unroll") for (int _i = 0; _i < 2; ++_i) \
        __builtin_amdgcn_global_load_lds((const unsigned*)((const char*)(gbase) + (voff)[_i]), (PG8_LAS unsigned*)(lds + (bufoff) + ldsw + _i * 8192), 16, 0, 0); } while (0)
#define PG8_STAGE_A(bufoff, gbase, h) do { if constexpr (Sched::GATHER_A) { PG8_STAGE(bufoff, gbase, goff[h]); } else { PG8_STAGE(bufoff, (gbase) + (size_t)(h) * hstep, voffA); } } while (0)
#define PG8_LDA(dst, b, h) do { _Pragma("unroll") for (int m = 0; m < 4; ++m) dst[m] = *(const PG8_LAS v8i_t*)(lds + PG8_SA(b, h) + aoff + m * 2048); } while (0)
#define PG8_LDB(dst, b, h) do { _Pragma("unroll") for (int n = 0; n < 2; ++n) dst[n] = *(const PG8_LAS v8i_t*)(lds + PG8_SB(b, h) + boff + n * 2048); } while (0)
#define PG8_F8(x) (x)
#define PG8_MMA(ai, bj, At, Bt) do { __builtin_amdgcn_s_setprio(1); _Pragma("unroll") for (int m = 0; m < 4; ++m) _Pragma("unroll") for (int n = 0; n < 2; ++n) \
        asm volatile("v_mfma_scale_f32_16x16x128_f8f6f4 %0, %1, %2, %0, %3, %4 op_sel_hi:[0,0,0]" : "+v"(acc[ai][bj][m][n]) : "v"(Bt[n]), "v"(At[m]), "v"(sc_w), "v"(sc_x)); __builtin_amdgcn_s_setprio(0); } while (0)
#define PG8_WAIT_V(n) asm volatile("s_waitcnt vmcnt(" #n ")" ::: "memory")
#define PG8_WAIT_L(n) asm volatile("s_waitcnt lgkmcnt(" #n ")" ::: "memory")
#define PG8_BAR __builtin_amdgcn_s_barrier()
#define PG8_SCHED __builtin_amdgcn_sched_barrier(0)
    const int sc_w = g.scale_b, sc_x = g.scale_a;
    Unit cur, nxt; int ui = 0;
    if (!S.next(0, cur)) return;
    f32x4 acc[2][2][4][2];
    f32x4 bv0[2][2];
    if constexpr (Epi::INIT == 1) E.bias_load(bv0, cur, wc, fq);
#pragma unroll
    for (int a = 0; a < 2; ++a)
#pragma unroll
        for (int b = 0; b < 2; ++b)
#pragma unroll
            for (int m = 0; m < 4; ++m)
#pragma unroll
                for (int n = 0; n < 2; ++n) { if constexpr (Epi::INIT == 1) acc[a][b][m][n] = bv0[b][n]; else acc[a][b][m][n] = (f32x4){0.f, 0.f, 0.f, 0.f}; }
    if constexpr (Epi::INIT == 2) E.tile_init(acc, cur, wr, wc, fr, fq);
    v8i_t At[4], B0[2], B1[2];
    const char* cA = cur.a; const char* cB = cur.b;
    unsigned goff[2][2]; int Rg[2], Cg[2];
    if constexpr (Sched::GATHER_A) {
#pragma unroll
        for (int i = 0; i < 2; ++i) { stage_rc(tid * 16 + i * 8192, Rg[i], Cg[i]); }
        const int* ix = S.idx(cur);
#pragma unroll
        for (int h = 0; h < 2; ++h)
#pragma unroll
            for (int i = 0; i < 2; ++i) goff[h][i] = (unsigned)ix[h * HALF + Rg[i]] * (unsigned)(K * 2) + (unsigned)(Cg[i] * 2);
    }
#define PG8_VA(h) goff[h]
#define PG8_AH(h) (Sched::GATHER_A ? (size_t)0 : (size_t)(h) * hstep)
    S.a_ready(cur);
    if constexpr (SP2) {
        PG8_STAGE(PG8_SB(0, 0), cB, voffB); PG8_STAGE(PG8_SB(0, 1), cB + hstep, voffB); PG8_STAGE_A(PG8_SA(0, 0), cA, 0); PG8_STAGE_A(PG8_SA(0, 1), cA, 1);
        if (wr == 1) PG8_BAR;
        PG8_WAIT_V(2); PG8_BAR;
        PG8_STAGE(PG8_SB(1, 0), cB + kstep, voffB); PG8_STAGE_A(PG8_SA(1, 0), cA + kstep, 0); PG8_STAGE(PG8_SB(1, 1), cB + hstep + kstep, voffB);
        PG8_WAIT_V(6); PG8_BAR;
    } else {
        PG8_STAGE(PG8_SB(0, 0), cB, voffB); PG8_STAGE_A(PG8_SA(0, 0), cA, 0); PG8_STAGE(PG8_SB(0, 1), cB + hstep, voffB); PG8_STAGE_A(PG8_SA(0, 1), cA, 1);
        if (wr == 1) PG8_BAR;
        PG8_WAIT_V(4); PG8_BAR;
        PG8_STAGE(PG8_SB(1, 0), cB + kstep, voffB); PG8_STAGE_A(PG8_SA(1, 0), cA + kstep, 0); PG8_STAGE(PG8_SB(1, 1), cB + hstep + kstep, voffB);
        PG8_WAIT_V(6); PG8_BAR;
    }
    for (;;) {
        const bool has_next = S.next(ui + 1, nxt);
        if constexpr (Sched::GATHER_A) { if (has_next && wid < 4) __builtin_amdgcn_global_load_lds((const unsigned*)(S.idx(nxt) + wid * 64 + lane), (PG8_LAS unsigned*)(lds + LDS_IDX + wid * 256), 4, 0, 0); }
        const char* nA = has_next ? nxt.a : cA; const char* nB = has_next ? nxt.b : cB;
#pragma unroll 1
        for (int t = 0; t < nt; t += 2) {
            const bool last = (t == nt - 2);
            const char* a1 = cA + (size_t)(t + 1) * kstep;
            const char* a2 = last ? nA : cA + (size_t)(t + 2) * kstep; const char* b2 = last ? nB : cB + (size_t)(t + 2) * kstep;
            const char* a3 = a2 + kstep; const char* b3 = b2 + kstep;
            if (last && has_next) S.a_ready(nxt);
            if constexpr (SP2) {
            PG8_LDB(B0, 0, 0); PG8_LDB(B1, 0, 1); PG8_SCHED; PG8_LDA(At, 0, 0); PG8_STAGE_A(PG8_SA(1, 1), a1, 1);
            if constexpr (Sched::GATHER_A) { if (last && has_next) {
                const PG8_LAS int* ixl = (const PG8_LAS int*)(lds + LDS_IDX);
#pragma unroll
                for (int h = 0; h < 2; ++h)
#pragma unroll
                    for (int i = 0; i < 2; ++i) goff[h][i] = (unsigned)ixl[h * HALF + Rg[i]] * (unsigned)(K * 2) + (unsigned)(Cg[i] * 2); } }
            PG8_WAIT_V(8); PG8_WAIT_L(0); PG8_BAR; PG8_MMA(0, 0, At, B0); PG8_MMA(0, 1, At, B1); PG8_BAR; PG8_SCHED;
            PG8_LDA(At, 0, 1); PG8_STAGE(PG8_SB(0, 0), b2, voffB); PG8_STAGE(PG8_SB(0, 1), b2 + hstep, voffB); PG8_STAGE_A(PG8_SA(0, 0), a2, 0);
            PG8_WAIT_V(8); PG8_WAIT_L(0); PG8_BAR; PG8_MMA(1, 0, At, B0); PG8_MMA(1, 1, At, B1); PG8_BAR; PG8_SCHED;
            PG8_LDB(B0, 1, 0); PG8_LDB(B1, 1, 1); PG8_SCHED; PG8_LDA(At, 1, 0); PG8_STAGE_A(PG8_SA(0, 1), a2, 1);
            PG8_WAIT_V(8); PG8_WAIT_L(0); PG8_BAR; PG8_MMA(0, 0, At, B0); PG8_MMA(0, 1, At, B1); PG8_BAR; PG8_SCHED;
            PG8_LDA(At, 1, 1); PG8_STAGE(PG8_SB(1, 0), b3, voffB); PG8_STAGE(PG8_SB(1, 1), b3 + hstep, voffB); PG8_STAGE_A(PG8_SA(1, 0), a3, 0);
            PG8_WAIT_V(8); PG8_WAIT_L(0); PG8_BAR; PG8_MMA(1, 0, At, B0); PG8_MMA(1, 1, At, B1); PG8_BAR; PG8_SCHED;
            } else {
            PG8_LDB(B0, 0, 0); PG8_SCHED; PG8_LDA(At, 0, 0); PG8_STAGE_A(PG8_SA(1, 1), a1, 1);
            PG8_WAIT_L(8); PG8_BAR; PG8_WAIT_L(0); PG8_MMA(0, 0, At, B0); PG8_BAR; PG8_SCHED;
            PG8_LDB(B1, 0, 1); PG8_STAGE(PG8_SB(0, 0), b2, voffB);
            PG8_BAR; PG8_WAIT_L(0); PG8_MMA(0, 1, At, B1); PG8_BAR;
            PG8_LDA(At, 0, 1); PG8_STAGE_A(PG8_SA(0, 0), a2, 0);
            PG8_BAR; PG8_WAIT_L(0); PG8_MMA(1, 0, At, B0); PG8_BAR; PG8_SCHED;
            PG8_STAGE(PG8_SB(0, 1), b2 + hstep, voffB);
            PG8_WAIT_V(6); PG8_BAR; PG8_MMA(1, 1, At, B1); PG8_BAR;
            PG8_LDB(B0, 1, 0); PG8_SCHED; PG8_LDA(At, 1, 0); PG8_STAGE_A(PG8_SA(0, 1), a2, 1);
            PG8_WAIT_L(8); PG8_BAR; PG8_WAIT_L(0); PG8_MMA(0, 0, At, B0); PG8_BAR; PG8_SCHED;
            PG8_LDB(B1, 1, 1); PG8_STAGE(PG8_SB(1, 0), b3, voffB);
            PG8_BAR; PG8_WAIT_L(0); PG8_MMA(0, 1, At, B1); PG8_BAR;
            PG8_LDA(At, 1, 1); PG8_STAGE_A(PG8_SA(1, 0), a3, 0);
            PG8_BAR; PG8_WAIT_L(0); PG8_MMA(1, 0, At, B0); PG8_BAR; PG8_SCHED;
            PG8_STAGE(PG8_SB(1, 1), b3 + hstep, voffB);
            PG8_WAIT_V(6); PG8_BAR; PG8_MMA(1, 1, At, B1); PG8_BAR;
            }
        }
        if constexpr (ALIGN_EPI) { if (wr == 0) PG8_BAR; }
        asm volatile("s_nop 15\n\ts_nop 7" ::: "memory"); __builtin_amdgcn_sched_barrier(0);
        f32x4 bvn[2][2]; if constexpr (Epi::INIT == 1) { if (has_next) E.bias_load(bvn, nxt, wc, fq); }
        if constexpr (!Epi::AFTER_DRAIN) { E(acc, cur, wr, wc, fr, fq); S.done(cur); }
        if (!has_next) break;
        if constexpr (!Epi::ACC_CHAIN) {
#pragma unroll
        for (int a = 0; a < 2; ++a)
#pragma unroll
            for (int b = 0; b < 2; ++b)
#pragma unroll
                for (int m = 0; m < 4; ++m)
#pragma unroll
                    for (int n = 0; n < 2; ++n) { if constexpr (Epi::INIT == 1) acc[a][b][m][n] = bvn[b][n]; else acc[a][b][m][n] = (f32x4){0.f, 0.f, 0.f, 0.f}; }
        if constexpr (Epi::INIT == 2) E.tile_init(acc, nxt, wr, wc, fr, fq);
        }
        cur = nxt; cA = nA; cB = nB; ++ui;
        if constexpr (ALIGN_EPI) { if (wr == 1) PG8_BAR; }
    }
    PG8_WAIT_V(0);
    if constexpr (!ALIGN_EPI) { if (wr == 0) PG8_BAR; }
    PG8_BAR;
    if constexpr (Epi::AFTER_DRAIN) { E.fused(acc, cur, wr, wc, fr, fq, lds, wid, lane); S.done(cur); }
#undef PG8_SA
#undef PG8_SB
#undef PG8_STAGE
#undef PG8_STAGE_A
#undef PG8_VA
#undef PG8_AH
#undef PG8_LDA
#undef PG8_LDB
#undef PG8_MMA
#undef PG8_F8
#undef PG8_WAIT_V
#undef PG8_WAIT_L
#undef PG8_BAR
#undef PG8_SCHED
}
}

typedef GAS unsigned gu32;
#define RLX_AGENT __ATOMIC_RELAXED, __HIP_MEMORY_SCOPE_AGENT
#define XB_TMO      128
#define XB_XCNT(j)  (256  + 64 * (j))
#define XB_XSUB(j)  (1280 + 64 * (j))
#define XB_XGEN(j)  (2304 + 64 * (j))
#define XB_TOP      3328
#define XB_TOPGEN   3392
#define XCD_BAR_WORDS 3456
#define XB_SPIN_CAP (1u << 26)

__device__ __forceinline__ unsigned xb_ld(unsigned* p)              { return __hip_atomic_load(p, __ATOMIC_RELAXED, __HIP_MEMORY_SCOPE_AGENT); }
__device__ __forceinline__ unsigned xb_add(unsigned* p, unsigned v) { return __hip_atomic_fetch_add(p, v, __ATOMIC_RELAXED, __HIP_MEMORY_SCOPE_AGENT); }
__device__ __forceinline__ unsigned xb_xcc_id() { return (unsigned)__builtin_amdgcn_s_getreg((3 << 11) | 20) & 0xFu; }
#define XB_SPIN(cond, bar) do { unsigned _sp = 0; while (cond) { __builtin_amdgcn_s_sleep(1); \
    if ((++_sp & 255u) == 0u) { if (xb_ld(&(bar)[XB_TMO])) break; if (_sp > XB_SPIN_CAP) { atomicAdd(&(bar)[XB_TMO], 1u); break; } } } } while (0)

struct XcdBarrier {
    unsigned* bar; unsigned x;
    volatile LAS unsigned* st;
};

__device__ __forceinline__ XcdBarrier xcd_barrier_post(unsigned* bar, volatile LAS unsigned* st) {
    XcdBarrier b; b.bar = bar; b.x = xb_xcc_id(); b.st = st;
    if (threadIdx.x == 0) (void)xb_add(&bar[XB_XCNT(b.x)], 1u);
    return b;
}
__device__ __forceinline__ void xcd_barrier_complete(unsigned* bar, unsigned x, unsigned& nloc, unsigned& nx) {
    const unsigned G = gridDim.x * gridDim.y * gridDim.z;
    unsigned sum, cnt, mine, sp = 0u;
    for (;;) {
        sum = 0u; cnt = 0u; mine = 0u;
#pragma unroll
        for (unsigned j = 0; j < 16; ++j) { const unsigned c = xb_ld(&bar[XB_XCNT(j)]); sum += c; cnt += (c > 0u) ? 1u : 0u; mine = (j == x) ? c : mine; }
        if (sum == G) break;
        __builtin_amdgcn_s_sleep(1);
        if ((++sp & 255u) == 0u) { if (xb_ld(&bar[XB_TMO])) break; if (sp > XB_SPIN_CAP) { atomicAdd(&bar[XB_TMO], 1u); break; } }
    }
    nloc = mine > 0u ? mine : 1u; nx = cnt > 0u ? cnt : 1u;
}

__device__ __forceinline__ void xcd_barrier(const XcdBarrier& b) {
    asm volatile("s_waitcnt vmcnt(0)" ::: "memory");
    __syncthreads();
    if (threadIdx.x == 0) {
        unsigned* bar = b.bar;
        __builtin_amdgcn_s_waitcnt(0);
        unsigned nloc = b.st[0], nx = b.st[1];
        if (nloc == 0u) { xcd_barrier_complete(bar, b.x, nloc, nx); b.st[0] = nloc; b.st[1] = nx; }
        const unsigned old = xb_add(&bar[XB_XSUB(b.x)], 1u);
        const unsigned gen = old / nloc;
        if (old + 1u == (gen + 1u) * nloc) {
            __builtin_amdgcn_fence(__ATOMIC_RELEASE, "agent");
            asm volatile("s_waitcnt vmcnt(0)" ::: "memory");
            const unsigned og = xb_add(&bar[XB_TOP], 1u);
            const unsigned tg = og / nx;
            if (og + 1u == (tg + 1u) * nx) xb_add(&bar[XB_TOPGEN], 1u);
            else XB_SPIN(xb_ld(&bar[XB_TOPGEN]) == tg, bar);
            __builtin_amdgcn_fence(__ATOMIC_ACQUIRE, "");
            xb_add(&bar[XB_XGEN(b.x)], 1u);
            asm volatile("s_waitcnt vmcnt(0)" ::: "memory");
        } else {
            XB_SPIN(xb_ld(&bar[XB_XGEN(b.x)]) == gen, bar);
            __builtin_amdgcn_fence(__ATOMIC_ACQUIRE, "");
            asm volatile("s_waitcnt vmcnt(0)" ::: "memory");
        }
    }
    __syncthreads();
}


template <bool BG, class ArgsT> __device__ __forceinline__ void xcd_barrier_bg(const XcdBarrier& b, const ArgsT& A, LAS unsigned char* lds, volatile LAS unsigned* MISC);
__device__ __forceinline__ int fresh_tid() { int t = threadIdx.x; asm volatile("" : "+v"(t)); return t; }
#define FRESH_IDS() const int tid = fresh_tid(), lane = tid & 63, wave = __builtin_amdgcn_readfirstlane(tid >> 6); (void)tid; (void)lane; (void)wave
struct Args { const float* in[17]; float* out; unsigned char* ws; int ph_lo, ph_hi, li, pad; };

__device__ __forceinline__ void p0_transpose_item(const float* W, int K, int N, bf16_t* WT, LAS float* scr, int item, int lane) {
    (void)scr;
    const int nblk = N / 32, kb = item / nblk, nb = item % nblk, k0 = 64 * kb + 8 * (lane >> 3), n0 = 32 * nb + 4 * (lane & 7);
    f32x4 v[8];
#pragma unroll
    for (int j2 = 0; j2 < 8; ++j2) v[j2] = *(const GAS f32x4*)(W + (size_t)(k0 + j2) * N + n0);
#pragma unroll
    for (int i2 = 0; i2 < 4; ++i2) { u32x4 o; o.x = pk2(v[0][i2], v[1][i2]); o.y = pk2(v[2][i2], v[3][i2]); o.z = pk2(v[4][i2], v[5][i2]); o.w = pk2(v[6][i2], v[7][i2]);
        *(GAS u32x4*)(WT + (size_t)(n0 + i2) * K + k0) = o; }
}
__device__ __forceinline__ void p0_transpose_item_f8(const float* W, int K, int N, unsigned char* WT8, LAS float* scr, int item, int lane, float wscale, int nblk_sub = 0) {
    (void)scr;
    const int nblk = nblk_sub ? nblk_sub : N / 32, kb = (item / (2 * nblk)) * 2 + (item & 1), nb = (item >> 1) % nblk, k0 = 64 * kb + 8 * (lane >> 3), n0 = 32 * nb + 4 * (lane & 7);
    f32x4 v[8];
#pragma unroll
    for (int j2 = 0; j2 < 8; ++j2) v[j2] = *(const GAS f32x4*)(W + (size_t)(k0 + j2) * N + n0);
#pragma unroll
    for (int i = 0; i < 4; ++i) { u32x2 o; o.x = pk4_fp8(v[0][i] * wscale, v[1][i] * wscale, v[2][i] * wscale, v[3][i] * wscale); o.y = pk4_fp8(v[4][i] * wscale, v[5][i] * wscale, v[6][i] * wscale, v[7][i] * wscale);
        *(GAS u32x2*)(WT8 + (size_t)(n0 + i) * K + k0) = o; }
}
constexpr int BG_BATCH = 8, BG_I_UP1 = (DM / 64) * (UPW / 32), BG_I_DN1 = (DFF / 64) * (DM / 32), BG_I_UP = NEXP * BG_I_UP1, BG_TOTAL = BG_I_UP + NEXP * BG_I_DN1;
static_assert(BG_I_UP % BG_BATCH == 0 && BG_TOTAL % BG_BATCH == 0, "batches do not straddle the up/down boundary");
__device__ __forceinline__ void bg_item(const Args& A, int it, LAS float* scr, int lane) {
    if (it < BG_I_UP) { const int e = it / BG_I_UP1;
#if MK_FP8_UP
        p0_transpose_item_f8(A.in[11] + (size_t)e * DM * UPW, DM, UPW, (unsigned char*)(A.ws + WS_WUPT) + (size_t)e * DM * UPW, scr, it % BG_I_UP1, lane, W8_SCALE);
#else
        p0_transpose_item(A.in[11] + (size_t)e * DM * UPW, DM, UPW, (bf16_t*)(A.ws + WS_WUPT) + (size_t)e * DM * UPW, scr, it % BG_I_UP1, lane);
#endif
    }
    else { const int r = it - BG_I_UP, e = r / BG_I_DN1;
#if MK_FP8_DN
        p0_transpose_item_f8(A.in[13] + (size_t)e * DFF * DM, DFF, DM, (unsigned char*)(A.ws + WS_WDNT) + (size_t)e * DFF * DM, scr, r % BG_I_DN1, lane, W8_SCALE);
#else
        p0_transpose_item(A.in[13] + (size_t)e * DFF * DM, DFF, DM, (bf16_t*)(A.ws + WS_WDNT) + (size_t)e * DFF * DM, scr, r % BG_I_DN1, lane);
#endif
    }
}
__device__ __forceinline__ bool bg_step(const Args& A, volatile LAS int* st, LAS float* scr, int lane, int limit) {
    int cur = st[0], end = st[1];
    if (cur >= end) {
        if (cur >= BG_TOTAL) return false;
        int start = 0; if (lane == 0) start = __hip_atomic_fetch_add((int*)(A.ws + WS_CTL) + CW_BGQ, BG_BATCH, __ATOMIC_RELAXED, __HIP_MEMORY_SCOPE_AGENT);
        start = __builtin_amdgcn_readfirstlane(start);
        if (start >= BG_TOTAL) { if (lane == 0) { st[0] = BG_TOTAL; st[1] = BG_TOTAL; } return false; }
        cur = start; end = start + BG_BATCH; if (lane == 0) { st[0] = cur; st[1] = end; }
    }
    if (cur >= limit) return false;
    bg_item(A, cur, scr, lane);
    if (lane == 0) st[0] = cur + 1;
    return true;
}
__device__ __forceinline__ void phase_prologue(const Args& A, LAS unsigned char* lds, int gw, int NGW, int lane, int wave) {
    unsigned char* ws = A.ws;
    LAS float* scr = (LAS float*)(lds + wave * 16384);
    constexpr int I_IN = (DM / 64) * (INW / 32), I_BS = (SBW / 64) * (DM / 32), I_WO = (DM / 64) * (DM / 32), I_RW = (DM / 64) * (NEXP / 32);
    constexpr int I_UP1 = (DM / 64) * (UPW / 32), I_DN1 = (DFF / 64) * (DM / 32), I_UP = NEXP * I_UP1, I_DN = NEXP * I_DN1;
    constexpr int NITEMS = I_IN + 2 * I_BS + I_WO + I_RW + (MK_BG ? 0 : I_UP + I_DN);
    for (int it = gw; it < NITEMS; it += NGW) {
        int r = it;
#if MK_FP8_GATES
        if (r < I_IN) { constexpr int NB16 = 3072 / 32, NB8 = (INW - 3072) / 32, I16 = (DM / 64) * NB16;
            if (r < I16) { const int kb = r / NB16, nb = r % NB16; p0_transpose_item(A.in[1], DM, INW, (bf16_t*)(ws + WS_WINT), scr, kb * (INW / 32) + nb, lane); }
            else p0_transpose_item_f8(A.in[1] + 3072, DM, INW, (unsigned char*)(ws + WS_WINT8), scr, r - I16, lane, W8_SCALE, NB8);
            continue; } r -= I_IN;
#else
        if (r < I_IN) { p0_transpose_item(A.in[1], DM, INW, (bf16_t*)(ws + WS_WINT), scr, r, lane); continue; } r -= I_IN;
#endif
        if (r < I_BS) { p0_transpose_item(A.in[4], SBW, DM, (bf16_t*)(ws + WS_WBST), scr, r, lane); continue; } r -= I_BS;
        if (r < I_BS) { p0_transpose_item(A.in[5], HGW, DM, (bf16_t*)(ws + WS_WBHT), scr, r, lane); continue; } r -= I_BS;
        if (r < I_WO) { p0_transpose_item(A.in[6], DM, DM, (bf16_t*)(ws + WS_WOT), scr, r, lane); continue; } r -= I_WO;
        if (r < I_RW) { p0_transpose_item(A.in[9], DM, NEXP, (bf16_t*)(ws + WS_RWT), scr, r, lane); continue; } r -= I_RW;
        if (r < I_UP) { const int e = r / I_UP1; p0_transpose_item(A.in[11] + (size_t)e * DM * UPW, DM, UPW, (bf16_t*)(ws + WS_WUPT) + (size_t)e * DM * UPW, scr, r % I_UP1, lane); continue; } r -= I_UP;
        { const int e = r / I_DN1; p0_transpose_item(A.in[13] + (size_t)e * DFF * DM, DFF, DM, (bf16_t*)(ws + WS_WDNT) + (size_t)e * DFF * DM, scr, r % I_DN1, lane); }
    }
    bf16_t* XB = (bf16_t*)(ws + WS_XB);
    for (int m0 = gw; m0 < NTOK; m0 += MK_P0_ROWS * NGW) {
        f32x4 xv[MK_P0_ROWS][4];
#pragma unroll
        for (int q = 0; q < MK_P0_ROWS; ++q) { const int m = m0 + q * NGW; const GAS f32x4* xr = (const GAS f32x4*)(A.in[0] + (size_t)(m < NTOK ? m : m0) * DM) + lane;
#pragma unroll
            for (int j = 0; j < 4; ++j) xv[q][j] = xr[64 * j]; }
#pragma unroll
        for (int q = 0; q < MK_P0_ROWS; ++q) { const int m = m0 + q * NGW; if (m < NTOK) { GAS u32x2* o8 = (GAS u32x2*)(XB + (size_t)m * DM) + lane;
#pragma unroll
            for (int j = 0; j < 4; ++j) { const f32x4 v = xv[q][j]; u32x2 w; w.x = pk2(v[0], v[1]); w.y = pk2(v[2], v[3]); o8[64 * j] = w;
#if MK_FP8_GATES
                ((GAS unsigned*)((unsigned char*)(ws + WS_XB8) + (size_t)m * DM))[lane + 64 * j] = pk4_fp8(v[0], v[1], v[2], v[3]);
#endif
            } } }
    }
    if (gw < 8) { const int c = gw * 64 + lane; const float l0 = A.in[2][c], l1 = A.in[2][HGW + c]; ((float*)(ws + WS_LB))[c] = 1.0f / (1.0f + expf(l1 - l0)); }
}

__device__ __forceinline__ void attn_naive_unit(const bf16_t* __restrict__ Q, const bf16_t* __restrict__ K, const bf16_t* __restrict__ V, bf16_t* __restrict__ O, int bh, int qb, int lane) {
    const int b = bh >> 3, h = bh & 7, t = qb * 64 + lane; const size_t rowbase = (size_t)b * SEQ;
    float q[64], o[64];
    { const bf16_t* qp = Q + (rowbase + t) * SBW + h * SBD;
#pragma unroll
      for (int d = 0; d < 64; ++d) { q[d] = bf2f(qp[d]); o[d] = 0.f; } }
    float R = 1.0f;
    for (int s = qb * 64 + 63; s >= 0; --s) {
        const bf16_t* kr = K + (rowbase + s) * SBW + h * SBD; const bf16_t* vr = V + (rowbase + s) * SBW + h * SBD;
        float z = 0.f;
#pragma unroll
        for (int d = 0; d < 64; ++d) z += q[d] * bf2f(kr[d]);
        const bool valid = s < t;
        const float ez = expf(fminf(z, 60.0f)), keep = 1.0f / (1.0f + ez);
        const float a = valid ? ez * keep * R : 0.f;
        R = valid ? R * keep : R;
#pragma unroll
        for (int d = 0; d < 64; ++d) o[d] += a * bf2f(vr[d]);
    }
    bf16_t* op = O + (rowbase + t) * SBW + h * SBD;
#pragma unroll
    for (int d = 0; d < 64; ++d) op[d] = (bf16_t)f2bf(o[d]);
}
__device__ __forceinline__ void hgrn_naive_block(const bf16_t* __restrict__ HQ, const bf16_t* __restrict__ HK, const float* __restrict__ LOGF, const bf16_t* __restrict__ HV, float* __restrict__ ORAW,
                                                 LAS unsigned char* lds, int blk, int tid) {
    const int grp = tid >> 7, v = tid & 127, bh = blk * 4 + grp, b = bh >> 2, hh = bh & 3;
    LAS float* sf = (LAS float*)lds + grp * 384; LAS float* sk = sf + 128; LAS float* sq = sf + 256;
    float S[128];
#pragma unroll
    for (int k = 0; k < 128; ++k) S[k] = 0.f;
    for (int t = 0; t < SEQ; ++t) {
        const size_t base = ((size_t)b * SEQ + t) * HGW + hh * HGD;
        sf[v] = expf(LOGF[base + v]); sk[v] = bf2f(HK[base + v]); sq[v] = bf2f(HQ[base + v]);
        const float vv = bf2f(HV[base + v]);
        __syncthreads();
        float o = 0.f;
#pragma unroll
        for (int k = 0; k < 128; ++k) { S[k] = sf[k] * S[k] + sk[k] * vv; o += sq[k] * S[k]; }
        ORAW[base + v] = o;
        __syncthreads();
    }
}
__device__ __forceinline__ void hgrn_post_item(const float* __restrict__ ORAW, const bf16_t* __restrict__ HG, const float* __restrict__ norm_g, bf16_t* __restrict__ OHG, int item, int lane) {
    const size_t base = (size_t)item * HGD; const int c0 = (item & 3) * HGD;
    const float x0 = ORAW[base + lane], x1 = ORAW[base + 64 + lane];
    const float r = 1.0f / sqrtf(wave_sum(x0 * x0 + x1 * x1) * (1.0f / HGD) + RMS_EPS);
    OHG[base + lane] = (bf16_t)f2bf(x0 * r * norm_g[c0 + lane] * bf2f(HG[base + lane]));
    OHG[base + 64 + lane] = (bf16_t)f2bf(x1 * r * norm_g[c0 + 64 + lane] * bf2f(HG[base + 64 + lane]));
}

__device__ __forceinline__ int crow(int r, int hi) { return (r & 3) + 8 * (r >> 2) + 4 * hi; }
typedef short v4i16_t __attribute__((ext_vector_type(4)));
__device__ __forceinline__ v4i16_t tr16(LAS const unsigned char* p) { return __builtin_amdgcn_ds_read_tr16_b64_v4i16((LAS v4i16_t*)p); }
__device__ __forceinline__ bf16x8 cat8(v4i16_t lo, v4i16_t hi) { return (bf16x8){lo[0], lo[1], lo[2], lo[3], hi[0], hi[1], hi[2], hi[3]}; }
__device__ __forceinline__ bf16x8 pack8(const f32x16& p, int base) {
    u32x4 w; w.x = pg8::cvt_pk_bf16(p[base + 0], p[base + 1]); w.y = pg8::cvt_pk_bf16(p[base + 2], p[base + 3]); w.z = pg8::cvt_pk_bf16(p[base + 4], p[base + 5]); w.w = pg8::cvt_pk_bf16(p[base + 6], p[base + 7]);
    return __builtin_bit_cast(bf16x8, w);
}
__device__ __forceinline__ float xhalf(float v) {
    auto rr = __builtin_amdgcn_permlane32_swap(__float_as_uint(v), __float_as_uint(v), false, false);
    return __uint_as_float((threadIdx.x & 32) ? rr[0] : rr[1]);
}
#define WAIT_ALL_BAR() asm volatile("s_waitcnt vmcnt(0) lgkmcnt(0)\n\ts_barrier" ::: "memory")

constexpr int AT_K = 0, AT_V = 16384, AT_OST = 32768, AT_Q = 65536, AT_FLAG = 65600;
__device__ __forceinline__ void attn_unit(const bf16_t* Q, const bf16_t* K, const bf16_t* V, bf16_t* O, int bh, int qb, LAS unsigned char* lds, int lane, int wid) {
    const int b = bh >> 3, h = bh & 7, r32 = lane & 31, hi = lane >> 5;
    const size_t rowbase = (size_t)b * SEQ; const int q0 = qb * 256, qw0 = q0 + wid * 32;
    bf16x8 qr[4];
    { const bf16_t* qp = Q + (rowbase + qw0 + r32) * SBW + h * SBD + hi * 8;
#pragma unroll
      for (int d0 = 0; d0 < 4; ++d0) qr[d0] = *(const bf16x8*)(qp + d0 * 16); }
    f32x16 o0 = {}, o1 = {}; float R = 1.0f;
    const int NT = 4 * qb + 4;
    const bf16_t* ksrc = K + (rowbase + lane) * SBW + h * SBD + wid * 8;
    const bf16_t* vsrc = V + (rowbase + 16 * (wid & 3) + (lane >> 2)) * SBW + h * SBD + (wid >> 2) * 32 + (lane & 3) * 8;
    LAS unsigned char* kdst = lds + AT_K + wid * 1024; LAS unsigned char* vdst = lds + AT_V + wid * 1024;
    const int vb = ((lane >> 4) & 1) * 32 + (lane & 3) * 8 + (4 * hi + ((lane & 15) >> 2)) * 64;
    { const size_t go = (size_t)(NT - 1) * 64 * SBW;
      __builtin_amdgcn_global_load_lds((const unsigned*)(ksrc + go), (LAS unsigned*)kdst, 16, 0, 0);
      __builtin_amdgcn_global_load_lds((const unsigned*)(vsrc + go), (LAS unsigned*)vdst, 16, 0, 0); }
    if (lane == 0) *(LAS int*)(lds + AT_FLAG + wid * 4) = 0;
    bool wz = false;
    for (int it = 0; it < NT; ++it) {
        const int kt = NT - 1 - it, slot = (it & 1) * 8192, k0 = kt * 64;
        WAIT_ALL_BAR();
        { const u32x4 f0 = *(const LAS u32x4*)(lds + AT_FLAG), f1 = *(const LAS u32x4*)(lds + AT_FLAG + 16);
          if (__builtin_amdgcn_readfirstlane((f0.x & f0.y & f0.z & f0.w & f1.x & f1.y & f1.z & f1.w) != 0u)) break; }
        if (it + 1 < NT) { const size_t go = (size_t)(kt - 1) * 64 * SBW;
            __builtin_amdgcn_global_load_lds((const unsigned*)(ksrc + go), (LAS unsigned*)(kdst + (slot ^ 8192)), 16, 0, 0);
            __builtin_amdgcn_global_load_lds((const unsigned*)(vsrc + go), (LAS unsigned*)(vdst + (slot ^ 8192)), 16, 0, 0); }
        if (k0 < qw0 + 31 && !wz) {
            f32x16 p0 = {}, p1 = {};
            const LAS unsigned char* kb = lds + AT_K + slot + hi * 1024 + r32 * 16;
#pragma unroll
            for (int d0 = 0; d0 < 4; ++d0) {
                const bf16x8 a0 = *(const LAS bf16x8*)(kb + d0 * 2048), a1 = *(const LAS bf16x8*)(kb + d0 * 2048 + 512);
                p0 = __builtin_amdgcn_mfma_f32_32x32x16_bf16(a0, qr[d0], p0, 0, 0, 0);
                p1 = __builtin_amdgcn_mfma_f32_32x32x16_bf16(a1, qr[d0], p1, 0, 0, 0);
            }
#pragma unroll
            for (int r = 0; r < 16; ++r) { p0[r] = __builtin_amdgcn_rcpf(1.0f + __builtin_amdgcn_exp2f(p0[r])); p1[r] = __builtin_amdgcn_rcpf(1.0f + __builtin_amdgcn_exp2f(p1[r])); }
            if (k0 + 63 >= qw0) {
                const int tq = qw0 + r32 - k0 - 4 * hi;
#pragma unroll
                for (int r = 0; r < 16; ++r) { const int kv = (r & 3) + 8 * (r >> 2); if (kv >= tq) p0[r] = 1.0f; if (kv + 32 >= tq) p1[r] = 1.0f; }
            }
            float gm[8], gp[8];
#pragma unroll
            for (int i = 0; i < 4; ++i) { gm[i] = (p0[4 * i] * p0[4 * i + 1]) * (p0[4 * i + 2] * p0[4 * i + 3]); gm[4 + i] = (p1[4 * i] * p1[4 * i + 1]) * (p1[4 * i + 2] * p1[4 * i + 3]); }
#pragma unroll
            for (int i = 0; i < 8; ++i) gp[i] = xhalf(gm[i]);
            float run = R, E[8];
#pragma unroll
            for (int i = 7; i >= 0; --i) {
                const float pre = hi ? 1.0f : gp[i], post = hi ? gp[i] : 1.0f;
                run *= pre; E[i] = run; run *= gm[i]; run *= post;
            }
            R = run;
#pragma unroll
            for (int i = 0; i < 4; ++i) {
                { float X = E[i];
#pragma unroll
                  for (int j = 3; j >= 0; --j) { const float s = p0[4 * i + j] * X; p0[4 * i + j] = X - s; X = s; } }
                { float X = E[4 + i];
#pragma unroll
                  for (int j = 3; j >= 0; --j) { const float s = p1[4 * i + j] * X; p1[4 * i + j] = X - s; X = s; } }
            }
            const bf16x8 pa0 = pack8(p0, 0), pa1 = pack8(p0, 8), pa2 = pack8(p1, 0), pa3 = pack8(p1, 8);
            const LAS unsigned char* vp = lds + AT_V + slot + vb;
#pragma unroll
            for (int d0 = 0; d0 < 2; ++d0) {
                f32x16 acc = d0 ? o1 : o0;
                acc = __builtin_amdgcn_mfma_f32_32x32x16_bf16(pa0, cat8(tr16(vp + d0 * 4096), tr16(vp + d0 * 4096 + 512)), acc, 0, 0, 0);
                acc = __builtin_amdgcn_mfma_f32_32x32x16_bf16(pa1, cat8(tr16(vp + d0 * 4096 + 1024), tr16(vp + d0 * 4096 + 1024 + 512)), acc, 0, 0, 0);
                acc = __builtin_amdgcn_mfma_f32_32x32x16_bf16(pa2, cat8(tr16(vp + d0 * 4096 + 2048), tr16(vp + d0 * 4096 + 2048 + 512)), acc, 0, 0, 0);
                acc = __builtin_amdgcn_mfma_f32_32x32x16_bf16(pa3, cat8(tr16(vp + d0 * 4096 + 3072), tr16(vp + d0 * 4096 + 3072 + 512)), acc, 0, 0, 0);
                if (d0) o1 = acc; else o0 = acc;
            }
            { const int allz = __all(R == 0.0f) ? 1 : 0; if (lane == 0) *(LAS int*)(lds + AT_FLAG + wid * 4) = allz; wz = allz != 0; }
        }
    }
    { LAS unsigned short* stg = (LAS unsigned short*)(lds + AT_OST + wid * 4096);
#pragma unroll
      for (int r = 0; r < 16; ++r) { const int orow = crow(r, hi); stg[orow * 64 + r32] = (unsigned short)f2bf(o0[r]); stg[orow * 64 + 32 + r32] = (unsigned short)f2bf(o1[r]); }
      LDS_WAIT();
      bf16_t* Ow = O + (rowbase + qw0) * SBW + h * SBD;
#pragma unroll
      for (int i = 0; i < 4; ++i) { const int row = i * 8 + (lane >> 3), ch = lane & 7; const u32x4 v = *(const LAS u32x4*)((LAS unsigned char*)stg + row * 128 + ch * 16); *(u32x4*)(Ow + (size_t)row * SBW + ch * 8) = v; } }
}

constexpr int HP_RD = 272, HP_TR = 320;
constexpr int HL_QT = 0, HL_KH = HL_QT + 64 * HP_RD, HL_KD = HL_KH + 64 * HP_RD, HL_VT = HL_KD + 64 * HP_TR, HL_SB = HL_VT + 64 * HP_TR, HL_DEC = HL_SB + 128 * HP_TR, HL_SEG = HL_DEC + 512, HL_END = HL_SEG + 8 * 128 * 4;
static_assert(HL_END <= LDS_SCRATCH, "HGRN LDS map");
constexpr int HG_GROUPS = 8, HG_CHUNKS = SEQ / 64 / HG_GROUPS;
#define LDS_BAR() asm volatile("s_waitcnt lgkmcnt(0)\n\ts_barrier" ::: "memory")
__device__ __forceinline__ void hgrn_unit_a(const bf16_t* HQ, const bf16_t* HK, const float* LOGF, const bf16_t* HV, float* ORAW, bf16_t* QC, float* DS, float* DG, int unit, LAS unsigned char* lds, int tid, int lane, int wid) {
    const int bh = unit >> 3, g = unit & 7, b = bh >> 2, hh = bh & 3, r32 = lane & 31, hi = lane >> 5, tb = wid >> 2, vj = wid & 3;
    const size_t row0 = (size_t)b * SEQ + (size_t)g * (SEQ / HG_GROUPS); const int cb = hh * HGD;
    const int kp = lane, seg = wid;
    const int vr = tid >> 3, vp8 = tid & 7;
    for (int i = tid; i < 128 * HP_TR / 16; i += NTHREADS) *(LAS u32x4*)(lds + HL_SB + i * 16) = (u32x4){0u, 0u, 0u, 0u};
    f32x16 S0 = {}, S1 = {};
    float gb0 = 0.f, gb1 = 0.f;
    f32x2_t lf[8]; unsigned qv[8], kv[8]; u32x4 vv0, vv1;
#define HG_LOAD(c) do { const size_t base_ = (row0 + (size_t)(c) * 64 + 8 * seg) * HGW + cb + 2 * kp; \
        _Pragma("unroll") for (int i = 0; i < 8; ++i) { lf[i] = *(const f32x2_t*)(LOGF + base_ + (size_t)i * HGW); qv[i] = *(const unsigned*)(HQ + base_ + (size_t)i * HGW); kv[i] = *(const unsigned*)(HK + base_ + (size_t)i * HGW); } \
        const bf16_t* vsrc_ = HV + (row0 + (size_t)(c) * 64 + vr) * HGW + cb + vp8 * 16; vv0 = *(const u32x4*)vsrc_; vv1 = *(const u32x4*)(vsrc_ + 8); } while (0)
    HG_LOAD(0);
    for (int c = 0; c < HG_CHUNKS; ++c) {
        float cs0[8], cs1[8]; { float a0 = 0.f, a1 = 0.f;
#pragma unroll
            for (int i = 0; i < 8; ++i) { a0 += lf[i].x; a1 += lf[i].y; cs0[i] = a0; cs1[i] = a1; } }
        *(LAS f32x2_t*)(lds + HL_SEG + (seg * 128 + 2 * kp) * 4) = (f32x2_t){cs0[7], cs1[7]};
        *(LAS u32x4*)(lds + HL_VT + vr * HP_TR + vp8 * 32) = vv0; *(LAS u32x4*)(lds + HL_VT + vr * HP_TR + vp8 * 32 + 16) = vv1;
        LDS_BAR();
        { float pre0 = 0.f, pre1 = 0.f, bl0 = 0.f, bl1 = 0.f;
#pragma unroll
          for (int s2 = 0; s2 < 8; ++s2) { const f32x2_t t = *(const LAS f32x2_t*)(lds + HL_SEG + (s2 * 128 + 2 * kp) * 4); if (s2 < seg) { pre0 += t.x; pre1 += t.y; } bl0 += t.x; bl1 += t.y; }
          if (seg == 0) *(LAS f32x2_t*)(lds + HL_DEC + 2 * kp * 4) = (f32x2_t){__builtin_amdgcn_exp2f(bl0 * LOG2E), __builtin_amdgcn_exp2f(bl1 * LOG2E)};
          const size_t qcb = (row0 + (size_t)c * 64 + 8 * seg) * HGW + cb + 2 * kp;
          const float eB0 = __builtin_amdgcn_exp2f(bl0 * LOG2E), eB1 = __builtin_amdgcn_exp2f(bl1 * LOG2E), eG0 = __builtin_amdgcn_exp2f(fmaxf(gb0 * LOG2E, -120.f)), eG1 = __builtin_amdgcn_exp2f(fmaxf(gb1 * LOG2E, -120.f));
#pragma unroll
          for (int i = 0; i < 8; ++i) { const int t = 8 * seg + i;
              const float bb0 = (pre0 + cs0[i]) * LOG2E, bb1 = (pre1 + cs1[i]) * LOG2E, q0 = bflo(qv[i]), q1 = bfhi(qv[i]), k0 = bflo(kv[i]), k1 = bfhi(kv[i]);
              const float qe0 = q0 * __builtin_amdgcn_exp2f(fmaxf(bb0, -120.f)), qe1 = q1 * __builtin_amdgcn_exp2f(fmaxf(bb1, -120.f)), ke0 = k0 * __builtin_amdgcn_exp2f(fminf(-bb0, 120.f)), ke1 = k1 * __builtin_amdgcn_exp2f(fminf(-bb1, 120.f));
              *(LAS unsigned*)(lds + HL_QT + t * HP_RD + kp * 4) = pg8::cvt_pk_bf16(qe0, qe1);
              *(LAS unsigned*)(lds + HL_KH + t * HP_RD + kp * 4) = pg8::cvt_pk_bf16(ke0, ke1);
              *(LAS unsigned*)(lds + HL_KD + t * HP_TR + kp * 4) = pg8::cvt_pk_bf16(ke0 * eB0, ke1 * eB1);
              if (g > 0) *(unsigned*)(QC + qcb + (size_t)i * HGW) = pg8::cvt_pk_bf16(qe0 * eG0, qe1 * eG1); }
          gb0 += bl0; gb1 += bl1; }
        if (c + 1 < HG_CHUNKS) HG_LOAD(c + 1);
        LDS_BAR();
        f32x16 oacc = {};
        bf16x8 pa[2][2];
#pragma unroll
        for (int a = 0; a < 2; ++a) if (a <= tb) {
            f32x16 x = {};
#pragma unroll
            for (int ks = 0; ks < 8; ++ks) {
                const bf16x8 af = *(const LAS bf16x8*)(lds + HL_KH + (32 * a + r32) * HP_RD + (16 * ks + 8 * hi) * 2);
                const bf16x8 bfr = *(const LAS bf16x8*)(lds + HL_QT + (32 * tb + r32) * HP_RD + (16 * ks + 8 * hi) * 2);
                x = __builtin_amdgcn_mfma_f32_32x32x16_bf16(af, bfr, x, 0, 0, 0);
            }
            if (a == tb) {
#pragma unroll
                for (int r = 0; r < 16; ++r) if (crow(r, hi) > r32) x[r] = 0.f;
            }
            pa[a][0] = pack8(x, 0); pa[a][1] = pack8(x, 8);
        }
#pragma unroll
        for (int ks = 0; ks < 8; ++ks) {
            const bf16x8 af = *(const LAS bf16x8*)(lds + HL_QT + (32 * tb + r32) * HP_RD + (16 * ks + 8 * hi) * 2);
            const LAS unsigned char* sp = lds + HL_SB + (16 * ks + 8 * hi + ((lane & 15) >> 2)) * HP_TR + (32 * vj + 16 * ((lane >> 4) & 1) + 4 * (lane & 3)) * 2;
            oacc = __builtin_amdgcn_mfma_f32_32x32x16_bf16(af, cat8(tr16(sp), tr16(sp + 4 * HP_TR)), oacc, 0, 0, 0);
        }
#pragma unroll
        for (int a = 0; a < 2; ++a) if (a <= tb) {
#pragma unroll
            for (int s2 = 0; s2 < 2; ++s2) {
                const LAS unsigned char* vp = lds + HL_VT + (32 * a + 16 * s2 + 4 * hi + ((lane & 15) >> 2)) * HP_TR + (32 * vj + 16 * ((lane >> 4) & 1) + 4 * (lane & 3)) * 2;
                oacc = __builtin_amdgcn_mfma_f32_32x32x16_bf16(pa[a][s2], cat8(tr16(vp), tr16(vp + 8 * HP_TR)), oacc, 0, 0, 0);
            }
        }
#pragma unroll
        for (int u = 0; u < 2; ++u) {
            f32x16 Sx = u ? S1 : S0; const int kt = 2 * tb + u;
            const LAS float* dec = (const LAS float*)(lds + HL_DEC) + 32 * kt;
#pragma unroll
            for (int r = 0; r < 16; ++r) Sx[r] *= dec[crow(r, hi)];
#pragma unroll
            for (int ks = 0; ks < 4; ++ks) {
                const int srow = 16 * ks + 8 * hi + ((lane & 15) >> 2), cq = 16 * ((lane >> 4) & 1) + 4 * (lane & 3);
                const LAS unsigned char* ap = lds + HL_KD + srow * HP_TR + (32 * kt + cq) * 2;
                const LAS unsigned char* bp = lds + HL_VT + srow * HP_TR + (32 * vj + cq) * 2;
                Sx = __builtin_amdgcn_mfma_f32_32x32x16_bf16(cat8(tr16(ap), tr16(ap + 4 * HP_TR)), cat8(tr16(bp), tr16(bp + 4 * HP_TR)), Sx, 0, 0, 0);
            }
            if (u) S1 = Sx; else S0 = Sx;
        }
        { float* op = ORAW + (row0 + (size_t)c * 64 + 32 * tb) * HGW + cb + 32 * vj + r32;
#pragma unroll
          for (int r = 0; r < 16; ++r) op[(size_t)crow(r, hi) * HGW] = oacc[r]; }
        LDS_BAR();
        if (c + 1 < HG_CHUNKS) {
#pragma unroll
            for (int u = 0; u < 2; ++u) { const f32x16 Sx = u ? S1 : S0; const int kt = 2 * tb + u;
#pragma unroll
                for (int r = 0; r < 16; ++r) *(LAS unsigned short*)(lds + HL_SB + (32 * kt + crow(r, hi)) * HP_TR + (32 * vj + r32) * 2) = (unsigned short)f2bf(Sx[r]); }
        }
    }
#undef HG_LOAD
    if (g + 1 < HG_GROUPS) {
        float* ds = DS + (size_t)unit * (HGD * HGD);
#pragma unroll
        for (int u = 0; u < 2; ++u) { const f32x16 Sx = u ? S1 : S0; const int kt = 2 * tb + u;
#pragma unroll
            for (int r = 0; r < 16; ++r) ds[(32 * kt + crow(r, hi)) * HGD + 32 * vj + r32] = Sx[r]; }
        if (seg == 0) *(f32x2_t*)(DG + (size_t)unit * HGD + 2 * kp) = (f32x2_t){__builtin_amdgcn_exp2f(gb0 * LOG2E), __builtin_amdgcn_exp2f(gb1 * LOG2E)};
    }
    LDS_BAR();
}
__device__ __forceinline__ void hgrn_unit_b(const float* ORAW, const bf16_t* QC, const float* DS, const float* DG, const bf16_t* HG, const float* norm_g, bf16_t* OHG, int unit, LAS unsigned char* lds, int tid, int lane, int wid) {
    const int bh = unit >> 3, g = unit & 7, b = bh >> 2, hh = bh & 3, r32 = lane & 31, hi = lane >> 5;
    const size_t tok0 = (size_t)b * SEQ + (size_t)g * (SEQ / HG_GROUPS) + 32 * wid; const int cb = hh * HGD;
    if (g > 0) {
        { float S[32];
#pragma unroll
          for (int i = 0; i < 32; ++i) S[i] = 0.f;
          const int k = tid >> 2;
          for (int g2 = 0; g2 < g; ++g2) { const float* ds = DS + (size_t)(bh * 8 + g2) * (HGD * HGD) + tid * 32; const float d = DG[(size_t)(bh * 8 + g2) * HGD + k];
#pragma unroll
              for (int j = 0; j < 8; ++j) { const f32x4 x = *(const f32x4*)(ds + 4 * j);
#pragma unroll
                  for (int t = 0; t < 4; ++t) S[4 * j + t] = d * S[4 * j + t] + x[t]; } }
#pragma unroll
          for (int j = 0; j < 4; ++j) { u32x4 w; w.x = pg8::cvt_pk_bf16(S[8 * j], S[8 * j + 1]); w.y = pg8::cvt_pk_bf16(S[8 * j + 2], S[8 * j + 3]); w.z = pg8::cvt_pk_bf16(S[8 * j + 4], S[8 * j + 5]); w.w = pg8::cvt_pk_bf16(S[8 * j + 6], S[8 * j + 7]);
              *(LAS u32x4*)(lds + HL_SB + k * HP_TR + (tid & 3) * 64 + j * 16) = w; } }
        LDS_BAR();
    }
    asm volatile("" ::: "memory");
    f32x16 acc[4];
#pragma unroll
    for (int vj = 0; vj < 4; ++vj)
#pragma unroll
        for (int r = 0; r < 16; ++r) acc[vj][r] = ORAW[(tok0 + crow(r, hi)) * HGW + cb + 32 * vj + r32];
    if (g > 0) {
#pragma unroll
        for (int ks = 0; ks < 8; ++ks) {
            const bf16x8 af = *(const bf16x8*)(QC + (tok0 + r32) * HGW + cb + 16 * ks + 8 * hi);
#pragma unroll
            for (int vj = 0; vj < 4; ++vj) {
                const LAS unsigned char* sp = lds + HL_SB + (16 * ks + 8 * hi + ((lane & 15) >> 2)) * HP_TR + (32 * vj + 16 * ((lane >> 4) & 1) + 4 * (lane & 3)) * 2;
                acc[vj] = __builtin_amdgcn_mfma_f32_32x32x16_bf16(af, cat8(tr16(sp), tr16(sp + 4 * HP_TR)), acc[vj], 0, 0, 0);
            }
        }
    }
    float ng[4];
#pragma unroll
    for (int vj = 0; vj < 4; ++vj) ng[vj] = norm_g[cb + 32 * vj + r32];
#pragma unroll
    for (int rb = 0; rb < 16; rb += MK_PB_GROWS) {
        bf16_t hgv[MK_PB_GROWS][4];
#pragma unroll
        for (int r2 = 0; r2 < MK_PB_GROWS; ++r2) { const size_t ro = (tok0 + crow(rb + r2, hi)) * HGW + cb + r32;
#pragma unroll
            for (int vj = 0; vj < 4; ++vj) hgv[r2][vj] = HG[ro + 32 * vj]; }
#pragma unroll
        for (int r2 = 0; r2 < MK_PB_GROWS; ++r2) { const int r = rb + r2;
            float ss = (acc[0][r] * acc[0][r] + acc[1][r] * acc[1][r]) + (acc[2][r] * acc[2][r] + acc[3][r] * acc[3][r]);
            ss = row16_sum(ss); ss += __shfl_xor(ss, 16);
            const float rs = __builtin_amdgcn_rsqf(ss * (1.0f / HGD) + RMS_EPS);
            const size_t ro = (tok0 + crow(r, hi)) * HGW + cb + r32;
#pragma unroll
            for (int vj = 0; vj < 4; ++vj) OHG[ro + 32 * vj] = (bf16_t)f2bf(acc[vj][r] * rs * ng[vj] * bf2f(hgv[r2][vj]));
        }
        asm volatile("" ::: "memory");
    }
    LDS_BAR();
}

constexpr int TROW = 2064;
constexpr int L_TILE = 0, L_LOGITS = 64 * TROW, L_TOPI = L_LOGITS + 64 * 32 * 4, L_HIST = L_TOPI + 1024, L_SLOT = L_HIST + 128, L_TOT = L_SLOT + 1024, L_BEF = L_TOT + 128, L_PAD = L_BEF + 128, L_PART = L_PAD + 256, L_END5 = L_PART + 2 * 16 * 32 * 4;
static_assert(L_END5 <= LDS_SCRATCH, "P5/P6 LDS map");
__device__ __forceinline__ void phase_ln1_router(const Args& A, LAS unsigned char* lds, int vb, int tid, int lane, int wave) {
    unsigned char* ws = A.ws;
    const bf16_t* PRE = (const bf16_t*)(ws + WS_PRE); float* STATS = (float*)(ws + WS_H); const float* g = A.in[7]; const float* bta = A.in[8];
    LAS int* HIST = (LAS int*)(lds + L_HIST);
    if (tid < NEXP) HIST[tid] = 0;
    u32x2 pp[8][4];
#pragma unroll
    for (int rr = 0; rr < 8; ++rr)
#pragma unroll
        for (int j = 0; j < 4; ++j) pp[rr][j] = *(const u32x2*)(PRE + (size_t)(vb * 64 + wave * 8 + rr) * DM + lane * 4 + 256 * j);
    f32x4 gq[4], bq[4];
#pragma unroll
    for (int j = 0; j < 4; ++j) { gq[j] = *(const f32x4*)(g + lane * 4 + 256 * j); bq[j] = *(const f32x4*)(bta + lane * 4 + 256 * j); }
    bf16x8 rwf[16];
    { const bf16_t* RWT = (const bf16_t*)(ws + WS_RWT); const int kq = wave >> 1, r = lane & 31, hh = lane >> 5;
#pragma unroll
      for (int ks = 0; ks < 16; ++ks) rwf[ks] = *(const bf16x8*)(RWT + (size_t)r * DM + 256 * kq + 16 * ks + 8 * hh); }
#pragma unroll
    for (int rr = 0; rr < 8; ++rr) {
        const int rl = wave * 8 + rr, row = vb * 64 + rl;
        f32x4 v[4]; float s = 0.f;
#pragma unroll
        for (int j = 0; j < 4; ++j) { const u32x2 p = pp[rr][j]; v[j] = (f32x4){bflo(p.x), bfhi(p.x), bflo(p.y), bfhi(p.y)}; s += (v[j][0] + v[j][1]) + (v[j][2] + v[j][3]); }
        const float mean = wave_sum(s) * (1.0f / DM); float s2 = 0.f;
#pragma unroll
        for (int j = 0; j < 4; ++j) { v[j] = v[j] - mean; s2 += (v[j][0] * v[j][0] + v[j][1] * v[j][1]) + (v[j][2] * v[j][2] + v[j][3] * v[j][3]); }
        const float rstd = __builtin_amdgcn_rsqf(wave_sum(s2) * (1.0f / DM) + LN_EPS);
        if (lane == 0) *(f32x2_t*)(STATS + (size_t)row * 2) = (f32x2_t){mean, rstd};
#pragma unroll
        for (int j = 0; j < 4; ++j) { const int c = lane * 4 + 256 * j; const f32x4 hv = v[j] * rstd * gq[j] + bq[j];
            u32x2 w; w.x = pk2(hv[0], hv[1]); w.y = pk2(hv[2], hv[3]); *(LAS u32x2*)(lds + L_TILE + rl * TROW + c * 2) = w; }
    }
    LDS_BAR();
    {
        const int rt = wave & 1, kq = wave >> 1, r = lane & 31, hh = lane >> 5;
        const bf16_t* RWT = (const bf16_t*)(ws + WS_RWT);
        f32x16 acc = {};
#pragma unroll
        for (int ks = 0; ks < 16; ++ks) {
            const int k = 256 * kq + 16 * ks + 8 * hh;
            const bf16x8 af = *(const LAS bf16x8*)(lds + L_TILE + (32 * rt + r) * TROW + k * 2);
            acc = __builtin_amdgcn_mfma_f32_32x32x16_bf16(af, rwf[ks], acc, 0, 0, 0);
        }
        (void)RWT;
        LAS float* LG = (LAS float*)(lds + L_LOGITS);
        for (int q = 0; q < 4; ++q) {
            if (kq == q) {
#pragma unroll
                for (int i = 0; i < 16; ++i) { const int rowl = 32 * rt + (i & 3) + 8 * (i >> 2) + 4 * hh; LAS float* p = LG + rowl * 32 + r; if (q == 0) *p = acc[i]; else *p += acc[i]; }
            }
            LDS_BAR();
        }
    }
    {
        const float* rb = A.in[10]; float* TOPG = (float*)(ws + WS_TOPG); LAS int* TOPI = (LAS int*)(lds + L_TOPI); const LAS float* LG = (const LAS float*)(lds + L_LOGITS);
        const int e = lane & 31, half = lane >> 5;
        for (int it = 0; it < 4; ++it) {
            const int rl = wave * 8 + it * 2 + half;
            float val = LG[rl * 32 + e] + rb[e]; int idx = e; float tv[4]; int ti[4];
#pragma unroll
            for (int rnk = 0; rnk < 4; ++rnk) {
                float bv = val; int bi = idx;
#define TOPK_STEP(OV, OI) do { const float ov = (OV); const int oi = (OI); if (ov > bv || (ov == bv && oi < bi)) { bv = ov; bi = oi; } } while (0)
                TOPK_STEP(dpp_f<0xB1>(bv), __builtin_amdgcn_update_dpp(0, bi, 0xB1, 0xF, 0xF, false)); TOPK_STEP(dpp_f<0x4E>(bv), __builtin_amdgcn_update_dpp(0, bi, 0x4E, 0xF, 0xF, false));
                TOPK_STEP(dpp_f<0x141>(bv), __builtin_amdgcn_update_dpp(0, bi, 0x141, 0xF, 0xF, false)); TOPK_STEP(dpp_f<0x140>(bv), __builtin_amdgcn_update_dpp(0, bi, 0x140, 0xF, 0xF, false));
                TOPK_STEP(__shfl_xor(bv, 16), __shfl_xor(bi, 16));
#undef TOPK_STEP
                tv[rnk] = bv; ti[rnk] = bi; if (e == bi) val = -INFINITY;
            }
            if (e == 0) {
                const float e1 = expf(tv[1] - tv[0]), e2 = expf(tv[2] - tv[0]), e3 = expf(tv[3] - tv[0]), inv = 1.0f / (1.0f + e1 + e2 + e3);
                *(float4*)(TOPG + (size_t)(vb * 64 + rl) * 4) = make_float4(inv, e1 * inv, e2 * inv, e3 * inv);
#pragma unroll
                for (int k = 0; k < 4; ++k) { TOPI[rl * 4 + k] = ti[k]; __hip_atomic_fetch_add(&HIST[ti[k]], 1, __ATOMIC_RELAXED, __HIP_MEMORY_SCOPE_WORKGROUP); }
            }
        }
    }
    LDS_BAR();
    if (tid < NEXP) ((int*)(ws + WS_CNTM))[vb * NEXP + tid] = HIST[tid];
}
__device__ __forceinline__ void phase_assign(const Args& A, LAS unsigned char* lds, int vb, int G, int tid, int lane, int wave) {
    unsigned char* ws = A.ws; const int* CNTM = (const int*)(ws + WS_CNTM); int* ctl = (int*)(ws + WS_CTL);
    LAS int* PART = (LAS int*)(lds + L_PART); LAS int* TOT = (LAS int*)(lds + L_TOT); LAS int* BEF = (LAS int*)(lds + L_BEF); LAS int* PAD = (LAS int*)(lds + L_PAD);
    LAS int* TOPI = (LAS int*)(lds + L_TOPI); LAS int* SLOT = (LAS int*)(lds + L_SLOT);
    { const int e = tid & 31, part = tid >> 5; int tot = 0, bef = 0;
      int cv[16];
#pragma unroll
      for (int q = 0; q < 16; ++q) { const int b2 = part * 16 + q; cv[q] = CNTM[(b2 < G ? b2 : G - 1) * NEXP + e]; }
#pragma unroll
      for (int q = 0; q < 16; ++q) { const int b2 = part * 16 + q; const int c = (b2 < G) ? cv[q] : 0; tot += c; if (b2 < vb) bef += c; }
      PART[part * 32 + e] = tot; PART[512 + part * 32 + e] = bef; }
    LDS_BAR();
    if (tid < NEXP) { int tot = 0, bef = 0;
#pragma unroll
        for (int p = 0; p < 16; ++p) { tot += PART[p * 32 + tid]; bef += PART[512 + p * 32 + tid]; }
        TOT[tid] = tot; BEF[tid] = bef; }
    LDS_BAR();
    if (tid < 64) {
        const int te = (tid < NEXP) ? (TOT[tid & 31] + SLOT_PAD - 1) / SLOT_PAD : 0; int inc = te;
#pragma unroll
        for (int d = 1; d < 32; d <<= 1) { const int o = __shfl_up(inc, d); if ((tid & 63) >= d) inc += o; }
        const int tb = inc - te;
        if (tid < NEXP) { PAD[tid] = tb * SLOT_PAD; if (vb == 0) for (int i = 0; i < te; ++i) ctl[CW_TILEEXP + tb + i] = tid; }
        if (vb == 0 && tid == NEXP - 1) ctl[CW_NTILES] = inc; }
    LDS_BAR();
    if (tid < 256) { const int e = TOPI[tid]; int rank = 0; for (int j = 0; j < tid; ++j) rank += (TOPI[j] == e) ? 1 : 0;
        const int slot = PAD[e] + BEF[e] + rank; SLOT[tid] = slot; ((int*)(ws + WS_DEST))[vb * 256 + tid] = slot;
#if MK_GATHER_A
        ((int*)(ws + WS_SLOTTOK))[slot] = vb * 64 + (tid >> 2);
#endif
    }
    LDS_BAR();
    bf16_t* XS = (bf16_t*)(ws + WS_XS);
#if MK_GATHER_A
#pragma unroll
    for (int rq = 0; rq < 8; ++rq) { const int r = wave * 8 + rq;
        const int i = 4 * r; const int slot = vb * 64 + r; const LAS unsigned char* src = lds + L_TILE + (i >> 2) * TROW; unsigned char* dst = (unsigned char*)(XS + (size_t)slot * DM);
#else
    for (int i = wave * 32; i < wave * 32 + 32; ++i) {
        const int slot = SLOT[i]; const LAS unsigned char* src = lds + L_TILE + (i >> 2) * TROW; unsigned char* dst = (unsigned char*)(XS + (size_t)slot * DM);
#endif
#if MK_FP8_UP
        { const u32x4 a = *(const LAS u32x4*)(src + lane * 32), b = *(const LAS u32x4*)(src + lane * 32 + 16); u32x4 o;
          o.x = pk4_fp8(bflo(a.x), bfhi(a.x), bflo(a.y), bfhi(a.y)); o.y = pk4_fp8(bflo(a.z), bfhi(a.z), bflo(a.w), bfhi(a.w)); o.z = pk4_fp8(bflo(b.x), bfhi(b.x), bflo(b.y), bfhi(b.y)); o.w = pk4_fp8(bflo(b.z), bfhi(b.z), bflo(b.w), bfhi(b.w));
          *(u32x4*)((unsigned char*)(ws + WS_XS) + (size_t)slot * DM + lane * 16) = o; (void)dst; }
#else
        const u32x4 a = *(const LAS u32x4*)(src + lane * 16), b = *(const LAS u32x4*)(src + 1024 + lane * 16);
        *(u32x4*)(dst + lane * 16) = a; *(u32x4*)(dst + 1024 + lane * 16) = b;
#endif
    }
}
template <int NR> __device__ __forceinline__ void combine_rows(const Args& A, int row0, int rstep, int lane, const f32x4 (&g1)[4], const f32x4 (&b1)[4], const f32x4 (&g2)[4], const f32x4 (&b2)[4]) {
    unsigned char* ws = A.ws; const bf16_t* PRE = (const bf16_t*)(ws + WS_PRE); const unsigned char* Y = (const unsigned char*)(ws + WS_Y);
    f32x2_t st[NR]; int4 d[NR]; float4 gt[NR]; u32x2 p[NR][4]; unsigned y[NR][4][4];
#pragma unroll
    for (int q = 0; q < NR; ++q) { const int row = row0 + q * rstep; st[q] = *(const f32x2_t*)((const float*)(ws + WS_H) + (size_t)row * 2); d[q] = *(const int4*)((const int*)(ws + WS_DEST) + row * 4); gt[q] = *(const float4*)((const float*)(ws + WS_TOPG) + row * 4);
#pragma unroll
        for (int j = 0; j < 4; ++j) p[q][j] = *(const u32x2*)(PRE + (size_t)row * DM + lane * 4 + 256 * j); }
#pragma unroll
    for (int q = 0; q < NR; ++q) { const int ds[4] = {d[q].x, d[q].y, d[q].z, d[q].w};
#pragma unroll
        for (int j = 0; j < 4; ++j)
#pragma unroll
            for (int k = 0; k < 4; ++k) y[q][j][k] = *(const unsigned*)(Y + (size_t)ds[k] * DM + lane * 4 + 256 * j); }
#pragma unroll
    for (int q = 0; q < NR; ++q) { const int row = row0 + q * rstep;
        const float gs[4] = {gt[q].x * (1.0f / Y8_SCALE), gt[q].y * (1.0f / Y8_SCALE), gt[q].z * (1.0f / Y8_SCALE), gt[q].w * (1.0f / Y8_SCALE)};
        f32x4 v[4]; float s = 0.f;
#pragma unroll
        for (int j = 0; j < 4; ++j) {
            f32x4 a = (((f32x4){bflo(p[q][j].x), bfhi(p[q][j].x), bflo(p[q][j].y), bfhi(p[q][j].y)} - st[q][0]) * st[q][1] * g1[j] + b1[j]) * DN_ALPHA;
#pragma unroll
            for (int k = 0; k < 4; ++k) { const f32x2_t y01 = __builtin_amdgcn_cvt_pk_f32_fp8(y[q][j][k], false), y23 = __builtin_amdgcn_cvt_pk_f32_fp8(y[q][j][k], true);
                a[0] += gs[k] * y01[0]; a[1] += gs[k] * y01[1]; a[2] += gs[k] * y23[0]; a[3] += gs[k] * y23[1]; }
            v[j] = a; s += (a[0] + a[1]) + (a[2] + a[3]); }
        const float mean = wave_sum(s) * (1.0f / DM); float s2 = 0.f;
#pragma unroll
        for (int j = 0; j < 4; ++j) { v[j] = v[j] - mean; s2 += (v[j][0] * v[j][0] + v[j][1] * v[j][1]) + (v[j][2] * v[j][2] + v[j][3] * v[j][3]); }
        const float rstd = __builtin_amdgcn_rsqf(wave_sum(s2) * (1.0f / DM) + LN_EPS);
#pragma unroll
        for (int j = 0; j < 4; ++j) { const int c = lane * 4 + 256 * j; *(f32x4*)(A.out + (size_t)row * DM + c) = v[j] * rstd * g2[j] + b2[j]; }
    }
}

template <bool BG, class ArgsT> __device__ __forceinline__ void xcd_barrier_bg(const XcdBarrier& b, const ArgsT& A, LAS unsigned char* lds, volatile LAS unsigned* MISC) {
    const int wave = __builtin_amdgcn_readfirstlane(threadIdx.x >> 6), lane = threadIdx.x & 63;
    const unsigned e0 = MISC[10];
    asm volatile("s_waitcnt vmcnt(0)" ::: "memory");
    __syncthreads();
    if (wave == 0) {
        if (threadIdx.x == 0) {
            unsigned* bar = b.bar;
            __builtin_amdgcn_s_waitcnt(0);
            unsigned nloc = b.st[0], nx = b.st[1];
            if (nloc == 0u) { xcd_barrier_complete(bar, b.x, nloc, nx); b.st[0] = nloc; b.st[1] = nx; }
            const unsigned old = xb_add(&bar[XB_XSUB(b.x)], 1u);
            const unsigned gen = old / nloc;
            if (old + 1u == (gen + 1u) * nloc) {
                __builtin_amdgcn_fence(__ATOMIC_RELEASE, "agent");
                asm volatile("s_waitcnt vmcnt(0)" ::: "memory");
                const unsigned og = xb_add(&bar[XB_TOP], 1u);
                const unsigned tg = og / nx;
                if (og + 1u == (tg + 1u) * nx) xb_add(&bar[XB_TOPGEN], 1u);
                else XB_SPIN(xb_ld(&bar[XB_TOPGEN]) == tg, bar);
                __builtin_amdgcn_fence(__ATOMIC_ACQUIRE, "");
                xb_add(&bar[XB_XGEN(b.x)], 1u);
                asm volatile("s_waitcnt vmcnt(0)" ::: "memory");
            } else {
                XB_SPIN(xb_ld(&bar[XB_XGEN(b.x)]) == gen, bar);
                __builtin_amdgcn_fence(__ATOMIC_ACQUIRE, "");
                asm volatile("s_waitcnt vmcnt(0)" ::: "memory");
            }
            MISC[10] = e0 + 1u;
        }
    } else if (BG && wave <= MK_BG_WAVES) {
        volatile LAS int* st = (volatile LAS int*)(MISC + 16 + 2 * wave);
        LAS float* scr = (LAS float*)(lds + wave * 16384);
        while (MISC[10] == e0) { if (!bg_step(A, st, scr, lane, BG_TOTAL)) __builtin_amdgcn_s_sleep(16); }
    }
    __syncthreads();
}
__device__ __forceinline__ void bg_drain(const Args& A, LAS unsigned char* lds, volatile LAS unsigned* MISC, int limit) {
    const int wave = __builtin_amdgcn_readfirstlane(threadIdx.x >> 6), lane = threadIdx.x & 63;
    volatile LAS int* st = (volatile LAS int*)(MISC + 16 + 2 * wave);
    while (bg_step(A, st, (LAS float*)(lds + wave * 16384), lane, limit)) {}
}
template <int LO, int HI> __global__ void __launch_bounds__(NTHREADS, 2) mk_fwd(Args args) {
    extern __shared__ __attribute__((aligned(16))) unsigned char lds_raw[];
    LAS unsigned char* lds = (LAS unsigned char*)lds_raw;
    volatile LAS unsigned* MISC = (volatile LAS unsigned*)(lds + MISC_OFF);
    const int G = gridDim.x, bx = blockIdx.x, vcu = (G % 8 == 0) ? (bx % 8) * (G / 8) + bx / 8 : bx;
    const int NGW = G * NWAVES;
#define GW (vcu * NWAVES + wave)
    unsigned char* ws = args.ws;
    for (int u = threadIdx.x; u < (LDS_BYTES - LDSCTL_OFF) / 4; u += NTHREADS) ((LAS unsigned*)(lds + LDSCTL_OFF))[u] = 0u;
    __syncthreads();
    XcdBarrier bar = xcd_barrier_post((unsigned*)(ws + WS_CTL) + CW_BAR + args.li * XCD_BAR_WORDS, MISC + 8);
#define IN(k) (LO <= (k) && (k) < HI)
#if MK_PROBE
    unsigned long long ts[16]; ts[0] = __builtin_amdgcn_s_memrealtime();
#define TS(i) ts[i] = __builtin_amdgcn_s_memrealtime()
#else
#define TS(i) do { } while (0)
#endif
#if 1
#if MK_BG
#define SEAM(k) do { if constexpr (IN(k) && IN((k) + 1)) { \
        if constexpr ((k) == 7) { __syncthreads(); bg_drain(args, lds, MISC, BG_I_UP); } \
        if constexpr ((k) == 8) { TS(13); bg_drain(args, lds, MISC, BG_TOTAL); TS(14); } \
        if constexpr (((MK_BG_SEAMS) >> (k)) & 1) xcd_barrier_bg<true>(bar, args, lds, MISC); else xcd_barrier_bg<false>(bar, args, lds, MISC); } } while (0)
#else
#define SEAM(k) do { if constexpr (IN(k) && IN((k) + 1)) xcd_barrier(bar); } while (0)
#endif
#endif
    InProjOut ip; ip.Q = (bf16_t*)(ws + WS_Q); ip.K = (bf16_t*)(ws + WS_K); ip.V = (bf16_t*)(ws + WS_V); ip.HQ = (bf16_t*)(ws + WS_HQ); ip.HK = (bf16_t*)(ws + WS_HK); ip.HV = (bf16_t*)(ws + WS_HV);
    ip.HG = (bf16_t*)(ws + WS_HG); ip.GS = (bf16_t*)(ws + WS_GS); ip.GH = (bf16_t*)(ws + WS_GH); ip.LOGF = (float*)(ws + WS_LOGF); ip.lb = (const float*)(ws + WS_LB);

    if constexpr (IN(0)) { FRESH_IDS(); phase_prologue(args, lds, GW, NGW, lane, wave); }
#if MK_PROBE_CONV
    bg_drain(args, lds, MISC, BG_TOTAL);
#if MK_PROBE_CONV > 1
    xcd_barrier(bar);
    if (threadIdx.x == 0) __hip_atomic_store((int*)(ws + WS_CTL) + CW_BGQ, 0, __ATOMIC_RELAXED, __HIP_MEMORY_SCOPE_AGENT);
    { const int w_ = __builtin_amdgcn_readfirstlane(threadIdx.x >> 6); if ((threadIdx.x & 63) == 0) { MISC[16 + 2 * w_] = 0; MISC[17 + 2 * w_] = 0; } }
    xcd_barrier(bar);
    bg_drain(args, lds, MISC, BG_TOTAL);
#endif
#endif
    SEAM(0); TS(1);
    if constexpr (IN(1)) {
#if MK_FP8_GATES
      { pg8::Gemm g{DM}; pg8::DenseSched S; S.o.init(NTOK / 256, 12, G, bx, MK_WGM_P1A); S.A = (const char*)(ws + WS_XB); S.Bt = (const char*)(ws + WS_WINT); S.tstep = (size_t)256 * DM * 2;
        pg8::EpiInProjT<0> E{ip};
        pg8::gemm_phase<pg8::EpiInProjT<0>, pg8::DenseSched, true, true>(lds, g, S, E); }
      { pg8::Gemm g{DM / 2, 0x7f7f7f7f, W8_E8M0}; pg8::DenseSched S; S.o.init(NTOK / 256, 10, G, G - 1 - bx, MK_WGM_P1B); S.A = (const char*)(ws + WS_XB8);     S.Bt = (const char*)(ws + WS_WINT8); S.tstep = (size_t)256 * DM;
        pg8::EpiInProjT<12> E{ip};
        pg8::gemm_phase_f8<pg8::EpiInProjT<12>, pg8::DenseSched, true, true>(lds, g, S, E); }
#else
      { pg8::Gemm g{DM}; pg8::DenseSched S; S.o.init(NTOK / 256, INW / 256, G, bx); S.A = (const char*)(ws + WS_XB); S.Bt = (const char*)(ws + WS_WINT); S.tstep = (size_t)256 * DM * 2;
        pg8::EpiInProjT<0> E{ip};
        pg8::gemm_phase<pg8::EpiInProjT<0>, pg8::DenseSched, true, true>(lds, g, S, E); }
#endif
    }
    SEAM(1); TS(2);
    if constexpr (IN(2)) { _Pragma("unroll 1") for (int rp2_ = 0; rp2_ < MK_LOOP_P2; ++rp2_) { if (rp2_) xcd_barrier(bar); FRESH_IDS(); const int gw = GW; (void)gw; const int qw_ = rp2_;
#if MK_NAIVE_MIX
    { const int u = gw; if (u < 2048) attn_naive_unit(ip.Q, ip.K, ip.V, (bf16_t*)(ws + WS_OSB), u & 63, 31 - (u >> 6), lane); }
    __syncthreads();
    if (vcu < 8) hgrn_naive_block(ip.HQ, ip.HK, ip.LOGF, ip.HV, (float*)(ws + WS_ORAW), lds, vcu, tid);
#else
#define MK_P2_BODY(QW) \
    hgrn_unit_a(ip.HQ, ip.HK, ip.LOGF, ip.HV, (float*)(ws + WS_ORAW), (bf16_t*)(ws + WS_QC), (float*)(ws + WS_DS), (float*)(ws + WS_DG), vcu, lds, tid, lane, wave); TS(12); \
    for (;;) { \
        if (tid == 0) *(LAS int*)(lds + AT_Q) = __hip_atomic_fetch_add((int*)(ws + WS_CTL) + CW_ATTNQ + (QW), 1, __ATOMIC_RELAXED, __HIP_MEMORY_SCOPE_AGENT); \
        LDS_BAR(); \
        const int u = __builtin_amdgcn_readfirstlane(*(LAS int*)(lds + AT_Q)); \
        LDS_BAR(); \
        if (u >= 512) break; \
        attn_unit(ip.Q, ip.K, ip.V, (bf16_t*)(ws + WS_OSB), u & 63, 7 - (u >> 6), lds, lane, wave); \
    }
    MK_P2_BODY(qw_)
#if MK_DUP_P2 > 1
    xcd_barrier(bar);
#if MK_DUP_WHAT == 1
    hgrn_unit_a(ip.HQ, ip.HK, ip.LOGF, ip.HV, (float*)(ws + WS_ORAW), (bf16_t*)(ws + WS_QC), (float*)(ws + WS_DS), (float*)(ws + WS_DG), vcu, lds, tid, lane, wave);
#elif MK_DUP_WHAT == 2
    for (;;) {
        if (tid == 0) *(LAS int*)(lds + AT_Q) = __hip_atomic_fetch_add((int*)(ws + WS_CTL) + CW_ATTNQ + 1, 1, __ATOMIC_RELAXED, __HIP_MEMORY_SCOPE_AGENT);
        __syncthreads();
        const int u = __builtin_amdgcn_readfirstlane(*(LAS int*)(lds + AT_Q));
        __syncthreads();
        if (u >= 512) break;
        attn_unit(ip.Q, ip.K, ip.V, (bf16_t*)(ws + WS_OSB), u & 63, 7 - (u >> 6), lds, lane, wave);
    }
#else
    MK_P2_BODY(1)
#endif
#endif
#if 0
    for (;;) {
        if (tid == 0) {
        __syncthreads();
        const int u = __builtin_amdgcn_readfirstlane(*(LAS int*)(lds + AT_Q));
        __syncthreads();
        if (u >= 512) break;
        attn_unit(ip.Q, ip.K, ip.V, (bf16_t*)(ws + WS_OSB), u & 63, 7 - (u >> 6), lds, lane, wave);
    }
#endif
#endif
    } }
    SEAM(2); TS(3);
#if MK_NAIVE_MIX
    if constexpr (IN(3)) { FRESH_IDS(); const int gw = GW; for (int it = gw; it < NTOK * HGH; it += NGW) hgrn_post_item((const float*)(ws + WS_ORAW), ip.HG, args.in[3], (bf16_t*)(ws + WS_OHG), it, lane); }
#else
    if constexpr (IN(3)) { _Pragma("unroll 1") for (int rb_ = 0; rb_ < MK_DUP_HGB; ++rb_) { if (rb_) xcd_barrier(bar); FRESH_IDS(); hgrn_unit_b((const float*)(ws + WS_ORAW), (const bf16_t*)(ws + WS_QC), (const float*)(ws + WS_DS), (const float*)(ws + WS_DG), ip.HG, args.in[3], (bf16_t*)(ws + WS_OHG), vcu, lds, tid, lane, wave); } }
#endif
    SEAM(3); TS(4);
#if MK_PROBE_BAR
    for (int rb2_ = 0; rb2_ < MK_PROBE_BAR; ++rb2_) xcd_barrier(bar);
#endif
#pragma unroll 1
    for (int rep4_ = 0; rep4_ < MK_DUP_P45; ++rep4_) { if (rep4_) xcd_barrier(bar);
    if constexpr (IN(4)) { pg8::Gemm g{SBW}; pg8::BranchSched S; S.o.init(NTOK / 256, DM / 256, G, bx, MK_WGM_P4); S.A0 = (const char*)(ws + WS_OSB); S.B0 = (const char*)(ws + WS_WBST); S.A1 = (const char*)(ws + WS_OHG); S.B1 = (const char*)(ws + WS_WBHT); S.tstep = (size_t)256 * SBW * 2;
      pg8::EpiBranch E{ip.GS, ip.GH, (bf16_t*)(ws + WS_MERGED)};
      pg8::gemm_phase<pg8::EpiBranch, pg8::BranchSched, true, true>(lds, g, S, E); }
    SEAM(4); TS(5);
    if constexpr (IN(5)) { pg8::Gemm g{DM}; pg8::DenseSched S; S.o.init(NTOK / 256, DM / 256, G, bx, MK_WGM_P5); S.A = (const char*)(ws + WS_MERGED); S.Bt = (const char*)(ws + WS_WOT); S.tstep = (size_t)256 * DM * 2;
      pg8::EpiOut E{(const bf16_t*)(ws + WS_XB), (bf16_t*)(ws + WS_PRE)};
      pg8::gemm_phase<pg8::EpiOut, pg8::DenseSched, true, true>(lds, g, S, E); }
    }
    SEAM(5); TS(6);
#if MK_DUP_TAIL & 1
    { FRESH_IDS(); phase_ln1_router(args, lds, bx, tid, lane, wave); } xcd_barrier(bar);
    { FRESH_IDS(); phase_assign(args, lds, bx, G, tid, lane, wave); } xcd_barrier(bar);
#endif
    if constexpr (IN(6)) { FRESH_IDS(); phase_ln1_router(args, lds, bx, tid, lane, wave); }
    SEAM(6); TS(7);
    if constexpr (IN(7)) { FRESH_IDS(); phase_assign(args, lds, bx, G, tid, lane, wave); }
    SEAM(7); TS(8);
    int ntiles = 0; if constexpr (IN(8) || IN(9)) ntiles = __builtin_amdgcn_readfirstlane(__hip_atomic_load((const int*)(ws + WS_CTL) + CW_NTILES, __ATOMIC_RELAXED, __HIP_MEMORY_SCOPE_AGENT)); const LAS int* tile_exp = (const LAS int*)(lds + LDS_TILEEXP);
    if constexpr (IN(8) || IN(9)) { for (int i = threadIdx.x; i < ntiles; i += NTHREADS) ((LAS int*)(lds + LDS_TILEEXP))[i] = __hip_atomic_load((const int*)(ws + WS_CTL) + CW_TILEEXP + i, __ATOMIC_RELAXED, __HIP_MEMORY_SCOPE_AGENT); __syncthreads(); }
#if MK_FP8_UP
#if MK_GATHER_A
    if constexpr (IN(8)) { pg8::Gemm g{DM / 2, 0x7f7f7f7f, W8_E8M0}; pg8::MoeGatherSched S; S.o.init(ntiles, UPW / 256, G, bx, MK_WGM_UP); S.A = (const char*)(ws + WS_XS); S.W = (const char*)(ws + WS_WUPT); S.tile_exp = tile_exp; S.tstep = (size_t)256 * DM; S.estep = (size_t)UPW * DM; S.slot_tok = (const int*)(ws + WS_SLOTTOK);
      pg8::EpiUpT<MK_FP8_DN != 0> E{args.in[12], (bf16_t*)(ws + WS_ACT)};
      pg8::gemm_phase_f8<pg8::EpiUpT<MK_FP8_DN != 0>, pg8::MoeGatherSched, true, true>(lds, g, S, E); }
#else
    if constexpr (IN(8)) { pg8::Gemm g{DM / 2, 0x7f7f7f7f, W8_E8M0}; pg8::MoeSched S; S.o.init(ntiles, UPW / 256, G, bx); S.A = (const char*)(ws + WS_XS); S.W = (const char*)(ws + WS_WUPT); S.tile_exp = tile_exp; S.tstep = (size_t)256 * DM; S.estep = (size_t)UPW * DM;
      pg8::EpiUpT<MK_FP8_DN != 0> E{args.in[12], (bf16_t*)(ws + WS_ACT)};
      pg8::gemm_phase_f8<pg8::EpiUpT<MK_FP8_DN != 0>, pg8::MoeSched, true, true>(lds, g, S, E); }
#endif
#else
    if constexpr (IN(8)) { pg8::Gemm g{DM}; pg8::MoeSched S; S.o.init(ntiles, UPW / 256, G, bx); S.A = (const char*)(ws + WS_XS); S.W = (const char*)(ws + WS_WUPT); S.tile_exp = tile_exp; S.tstep = (size_t)256 * DM * 2; S.estep = (size_t)UPW * DM * 2;
      pg8::EpiUpT<MK_FP8_DN != 0> E{args.in[12], (bf16_t*)(ws + WS_ACT)};
      pg8::gemm_phase<pg8::EpiUpT<MK_FP8_DN != 0>, pg8::MoeSched, true, true>(lds, g, S, E); }
#endif
    SEAM(8); TS(9);
#if MK_FP8_DN
    if constexpr (IN(9)) { pg8::Gemm g{DFF / 2, ACT8_E8M0, W8_E8M0}; pg8::MoeSched S; S.o.init(ntiles, DM / 256, G, bx, MK_WGM_DN); S.A = (const char*)(ws + WS_ACT); S.W = (const char*)(ws + WS_WDNT); S.tile_exp = tile_exp; S.tstep = (size_t)256 * DFF; S.estep = (size_t)DM * DFF;
      pg8::EpiDown E{args.in[14], (bf16_t*)(ws + WS_Y)};
      pg8::gemm_phase_f8<pg8::EpiDown, pg8::MoeSched, true, true>(lds, g, S, E); }
#else
    if constexpr (IN(9)) { pg8::Gemm g{DFF}; pg8::MoeSched S; S.o.init(ntiles, DM / 256, G, bx); S.A = (const char*)(ws + WS_ACT); S.W = (const char*)(ws + WS_WDNT); S.tile_exp = tile_exp; S.tstep = (size_t)256 * DFF * 2; S.estep = (size_t)DM * DFF * 2;
      pg8::EpiDown E{args.in[14], (bf16_t*)(ws + WS_Y)};
      pg8::gemm_phase<pg8::EpiDown, pg8::MoeSched, true, true>(lds, g, S, E); }
#endif
    SEAM(9); TS(10);
    if constexpr (IN(10)) { FRESH_IDS(); f32x4 g1[4], b1[4], g2[4], b2[4];
#pragma unroll
        for (int j = 0; j < 4; ++j) { const int c = lane * 4 + 256 * j; g1[j] = *(const f32x4*)(args.in[7] + c); b1[j] = *(const f32x4*)(args.in[8] + c); g2[j] = *(const f32x4*)(args.in[15] + c); b2[j] = *(const f32x4*)(args.in[16] + c); }
        int row = GW;
        for (; row + (MK_P10_ROWS - 1) * NGW < NTOK; row += MK_P10_ROWS * NGW) combine_rows<MK_P10_ROWS>(args, row, NGW, lane, g1, b1, g2, b2);
        for (; row < NTOK; row += NGW) combine_rows<1>(args, row, NGW, lane, g1, b1, g2, b2); }
#if MK_PROBE
    xcd_barrier(bar); TS(11);
    if (bx == 0 && threadIdx.x == 0) { unsigned* mk = (unsigned*)(ws + WS_LB + 3072); const bool warm = __hip_atomic_load(mk, __ATOMIC_RELAXED, __HIP_MEMORY_SCOPE_AGENT) == 0x51a7e5u; __hip_atomic_store(mk, 0x51a7e5u, __ATOMIC_RELAXED, __HIP_MEMORY_SCOPE_AGENT);
        const float dA = (float)(ts[MK_PA1] - ts[MK_PA0]) * 0.01f;
        __hip_atomic_store((float*)(ws + WS_CTL) + 40, warm ? dA * (1.0f / 500.0f) : 0.f, __ATOMIC_RELAXED, __HIP_MEMORY_SCOPE_AGENT); }
    xcd_barrier(bar);
    { FRESH_IDS(); const float eps = __hip_atomic_load((float*)(ws + WS_CTL) + 40, __ATOMIC_RELAXED, __HIP_MEMORY_SCOPE_AGENT);
      for (int row = GW; row < NTOK; row += NGW) for (int j2 = 0; j2 < 4; ++j2) { f32x4* p = (f32x4*)(args.out + (size_t)row * DM + lane * 4 + 256 * j2); *p = *p * (1.0f + eps); } }
#endif
}


#if MK_MODE == 2
namespace v1 {
constexpr int CW_CNT = 60000, CW_CUR = 60064, CW_PADSTART = 60128, CW_NTILES = 60192, CW_TILEEXP = 60256;
__device__ __forceinline__ float sigmoidf_(float v) { return 1.0f / (1.0f + expf(-v)); }
__global__ __launch_bounds__(256) void k_transpose_bf16(const float* __restrict__ W, bf16_t* __restrict__ WT, int K, int N) {
    __shared__ float tile[64][65];
    const size_t g = blockIdx.z; W += g * (size_t)K * N; WT += g * (size_t)K * N;
    const int k0 = blockIdx.y * 64, n0 = blockIdx.x * 64, tx = threadIdx.x & 63, ty = threadIdx.x >> 6;
    for (int i = ty; i < 64; i += 4) tile[i][tx] = W[(size_t)(k0 + i) * N + n0 + tx];
    __syncthreads();
    for (int i = ty; i < 64; i += 4) WT[(size_t)(n0 + i) * K + k0 + tx] = (bf16_t)f2bf(tile[tx][i]);
}
__global__ __launch_bounds__(256) void k_convert_x(const float* __restrict__ x, bf16_t* __restrict__ xb, const float* __restrict__ lbl, float* __restrict__ lb) {
    const size_t i = (size_t)blockIdx.x * 256 + threadIdx.x;
    const f32x4 v = ((const f32x4*)x)[i];
    uint2 o; o.x = f2bf(v[0]) | (f2bf(v[1]) << 16); o.y = f2bf(v[2]) | (f2bf(v[3]) << 16);
    ((uint2*)xb)[i] = o;
    if (blockIdx.x == 0) for (int c = threadIdx.x; c < HGW; c += 256) { const float l0 = lbl[c], l1 = lbl[HGW + c]; lb[c] = 1.0f / (1.0f + expf(l1 - l0)); }
}

constexpr int G_BM = 128, G_BK = 32, G_HTB = G_BM * G_BK * 2;
__device__ __forceinline__ void g128_loop(f32x4 (&acc)[4][4], const bf16_t* a0, const bf16_t* a1, const bf16_t* b0, const bf16_t* b1, int K, LAS unsigned char* shm) {
    const int tid = threadIdx.x, wid = tid >> 6, lane = tid & 63, wr = wid >> 1, wc = wid & 1, fr = lane & 15, fq = lane >> 4;
    LAS unsigned char* SA = shm; LAS unsigned char* SB = shm + G_HTB;
    for (int t = 0; t < K / G_BK; ++t) {
        __builtin_amdgcn_global_load_lds((const unsigned*)(a0 + t * G_BK), (LAS unsigned*)(SA + tid * 16), 16, 0, 0);
        __builtin_amdgcn_global_load_lds((const unsigned*)(a1 + t * G_BK), (LAS unsigned*)(SA + tid * 16 + 4096), 16, 0, 0);
        __builtin_amdgcn_global_load_lds((const unsigned*)(b0 + t * G_BK), (LAS unsigned*)(SB + tid * 16), 16, 0, 0);
        __builtin_amdgcn_global_load_lds((const unsigned*)(b1 + t * G_BK), (LAS unsigned*)(SB + tid * 16 + 4096), 16, 0, 0);
        asm volatile("s_waitcnt vmcnt(0)" ::: "memory"); __syncthreads();
        bf16x8 At[4], Bt[4];
#pragma unroll
        for (int m = 0; m < 4; ++m) { At[m] = *(const LAS bf16x8*)(SA + (wr * 64 + m * 16 + fr) * (G_BK * 2) + fq * 16); Bt[m] = *(const LAS bf16x8*)(SB + (wc * 64 + m * 16 + fr) * (G_BK * 2) + fq * 16); }
        asm volatile("s_waitcnt lgkmcnt(0)" ::: "memory"); __builtin_amdgcn_sched_barrier(0);
#pragma unroll
        for (int m = 0; m < 4; ++m)
#pragma unroll
            for (int n = 0; n < 4; ++n) acc[m][n] = __builtin_amdgcn_mfma_f32_16x16x32_bf16(At[m], Bt[n], acc[m][n], 0, 0, 0);
        __syncthreads();
    }
}
#define G128_ZERO(acc) _Pragma("unroll") for (int m_ = 0; m_ < 4; ++m_) _Pragma("unroll") for (int n_ = 0; n_ < 4; ++n_) acc[m_][n_] = (f32x4){0.f, 0.f, 0.f, 0.f}
#define G128_FOREACH(...) do { const int wid_ = threadIdx.x >> 6, lane_ = threadIdx.x & 63, wr_ = wid_ >> 1, wc_ = wid_ & 1, fr_ = lane_ & 15, fq_ = lane_ >> 4; \
    _Pragma("unroll") for (int m_ = 0; m_ < 4; ++m_) _Pragma("unroll") for (int n_ = 0; n_ < 4; ++n_) _Pragma("unroll") for (int j_ = 0; j_ < 4; ++j_) { \
        const int trow = wr_ * 64 + m_ * 16 + fq_ * 4 + j_, tcol = wc_ * 64 + n_ * 16 + fr_; __VA_ARGS__ } } while (0)


__global__ __launch_bounds__(256) void k_inproj(const bf16_t* __restrict__ XB, const bf16_t* __restrict__ WinT, InProjOut o) {
    __shared__ __attribute__((aligned(16))) unsigned char shm[2 * G_HTB];
    const int bcol = blockIdx.x * G_BM, brow = blockIdx.y * G_BM, tid = threadIdx.x, r0 = tid >> 2, c = (tid & 3) * 8;
    f32x4 acc[4][4]; G128_ZERO(acc);
    g128_loop(acc, XB + (size_t)(brow + r0) * DM + c, XB + (size_t)(brow + r0 + 64) * DM + c, WinT + (size_t)(bcol + r0) * DM + c, WinT + (size_t)(bcol + r0 + 64) * DM + c, DM, (LAS unsigned char*)shm);
    const int seg = bcol / 512;
    G128_FOREACH({
        const int row = brow + trow, col = bcol + tcol; const float v = acc[m_][n_][j_];
        if (seg == 0) o.Q[(size_t)row * 512 + col] = (bf16_t)f2bf(v * 0.125f);
        else if (seg == 1) o.K[(size_t)row * 512 + (col - 512)] = (bf16_t)f2bf(v);
        else if (seg == 2) o.V[(size_t)row * 512 + (col - 1024)] = (bf16_t)f2bf(v);
        else if (seg == 3) o.HQ[(size_t)row * 512 + (col - 1536)] = (bf16_t)f2bf(v * sigmoidf_(v));
        else if (seg == 4) { const int cc = col - 2048; const float l = o.lb[cc], f = l + (1.0f - l) * sigmoidf_(v);
            o.HK[(size_t)row * 512 + cc] = (bf16_t)f2bf(1.0f - f); o.LOGF[(size_t)row * 512 + cc] = logf(f); }
        else if (seg == 5) o.HV[(size_t)row * 512 + (col - 2560)] = (bf16_t)f2bf(v);
        else if (seg == 6) o.HG[(size_t)row * 512 + (col - 3072)] = (bf16_t)f2bf(sigmoidf_(v));
        else if (seg < 9) o.GS[(size_t)row * 1024 + (col - 3584)] = (bf16_t)f2bf(sigmoidf_(v));
        else o.GH[(size_t)row * 1024 + (col - 4608)] = (bf16_t)f2bf(sigmoidf_(v));
    });
}

__global__ __launch_bounds__(256) void k_branch(const bf16_t* __restrict__ OSB, const bf16_t* __restrict__ OHG, const bf16_t* __restrict__ WbsT, const bf16_t* __restrict__ WbhT,
                                                const bf16_t* __restrict__ GS, const bf16_t* __restrict__ GH, bf16_t* __restrict__ MERGED) {
    __shared__ __attribute__((aligned(16))) unsigned char shm[2 * G_HTB];
    const int bcol = blockIdx.x * G_BM, brow = blockIdx.y * G_BM, tid = threadIdx.x, r0 = tid >> 2, c = (tid & 3) * 8;
    f32x4 accA[4][4], accB[4][4]; G128_ZERO(accA); G128_ZERO(accB);
    g128_loop(accA, OSB + (size_t)(brow + r0) * SBW + c, OSB + (size_t)(brow + r0 + 64) * SBW + c, WbsT + (size_t)(bcol + r0) * SBW + c, WbsT + (size_t)(bcol + r0 + 64) * SBW + c, SBW, (LAS unsigned char*)shm);
    g128_loop(accB, OHG + (size_t)(brow + r0) * HGW + c, OHG + (size_t)(brow + r0 + 64) * HGW + c, WbhT + (size_t)(bcol + r0) * HGW + c, WbhT + (size_t)(bcol + r0 + 64) * HGW + c, HGW, (LAS unsigned char*)shm);
    G128_FOREACH({
        const size_t idx = (size_t)(brow + trow) * DM + bcol + tcol;
        MERGED[idx] = (bf16_t)f2bf(bf2f(GS[idx]) * accA[m_][n_][j_] + bf2f(GH[idx]) * accB[m_][n_][j_]);
    });
}

__global__ __launch_bounds__(256) void k_outproj(const bf16_t* __restrict__ MERGED, const bf16_t* __restrict__ WoT, const float* __restrict__ x, float* __restrict__ PRE) {
    __shared__ __attribute__((aligned(16))) unsigned char shm[2 * G_HTB];
    const int bcol = blockIdx.x * G_BM, brow = blockIdx.y * G_BM, tid = threadIdx.x, r0 = tid >> 2, c = (tid & 3) * 8;
    f32x4 acc[4][4]; G128_ZERO(acc);
    g128_loop(acc, MERGED + (size_t)(brow + r0) * DM + c, MERGED + (size_t)(brow + r0 + 64) * DM + c, WoT + (size_t)(bcol + r0) * DM + c, WoT + (size_t)(bcol + r0 + 64) * DM + c, DM, (LAS unsigned char*)shm);
    G128_FOREACH({ const size_t idx = (size_t)(brow + trow) * DM + bcol + tcol; PRE[idx] = DN_ALPHA * x[idx] + acc[m_][n_][j_]; });
}

__global__ __launch_bounds__(256) void k_moe_up(const bf16_t* __restrict__ HB, const bf16_t* __restrict__ WupT, const float* __restrict__ b_up, const int* __restrict__ ctl,
                                                const int* __restrict__ slot_tok, bf16_t* __restrict__ ACT) {
    __shared__ __attribute__((aligned(16))) unsigned char shm[2 * G_HTB];
    const int rt = blockIdx.y; if (rt >= 2 * ctl[CW_NTILES]) return;
    const int e = ctl[CW_TILEEXP + (rt >> 1)];
    const int bcol = blockIdx.x * G_BM, brow = rt * G_BM, tid = threadIdx.x, r0 = tid >> 2, c = (tid & 3) * 8;
    int t0 = slot_tok[brow + r0], t1 = slot_tok[brow + r0 + 64]; if (t0 < 0) t0 = 0; if (t1 < 0) t1 = 0;
    const bf16_t* W = WupT + (size_t)e * UPW * DM;
    f32x4 acc[4][4]; G128_ZERO(acc);
    g128_loop(acc, HB + (size_t)t0 * DM + c, HB + (size_t)t1 * DM + c, W + (size_t)(bcol + r0) * DM + c, W + (size_t)(bcol + r0 + 64) * DM + c, DM, (LAS unsigned char*)shm);
    G128_FOREACH({
        const int col = bcol + tcol; const float v = acc[m_][n_][j_] + b_up[e * UPW + col];
        const float other = __shfl_xor(v, 1);
        if ((col & 1) == 0) { const float g = fminf(v, SW_LIMIT), l = fminf(fmaxf(other, -SW_LIMIT), SW_LIMIT);
            ACT[(size_t)(brow + trow) * DFF + (col >> 1)] = (bf16_t)f2bf(g * sigmoidf_(SW_ALPHA * g) * (l + 1.0f)); }
    });
}
__global__ __launch_bounds__(256) void k_moe_down(const bf16_t* __restrict__ ACT, const bf16_t* __restrict__ WdnT, const float* __restrict__ b_dn, const int* __restrict__ ctl, bf16_t* __restrict__ Y) {
    __shared__ __attribute__((aligned(16))) unsigned char shm[2 * G_HTB];
    const int rt = blockIdx.y; if (rt >= 2 * ctl[CW_NTILES]) return;
    const int e = ctl[CW_TILEEXP + (rt >> 1)];
    const int bcol = blockIdx.x * G_BM, brow = rt * G_BM, tid = threadIdx.x, r0 = tid >> 2, c = (tid & 3) * 8;
    const bf16_t* W = WdnT + (size_t)e * DM * DFF;
    f32x4 acc[4][4]; G128_ZERO(acc);
    g128_loop(acc, ACT + (size_t)(brow + r0) * DFF + c, ACT + (size_t)(brow + r0 + 64) * DFF + c, W + (size_t)(bcol + r0) * DFF + c, W + (size_t)(bcol + r0 + 64) * DFF + c, DFF, (LAS unsigned char*)shm);
    G128_FOREACH({ const int col = bcol + tcol; Y[(size_t)(brow + trow) * DM + col] = (bf16_t)f2bf(acc[m_][n_][j_] + b_dn[e * DM + col]); });
}

__global__ __launch_bounds__(64) void k_attn_naive(const bf16_t* __restrict__ Q, const bf16_t* __restrict__ K, const bf16_t* __restrict__ V, bf16_t* __restrict__ O) {
    const int qb = 31 - (int)blockIdx.x, bh = blockIdx.y, b = bh >> 3, h = bh & 7;
    const int t = qb * 64 + threadIdx.x; const size_t rowbase = (size_t)b * SEQ;
    float q[64], o[64];
    { const bf16_t* qp = Q + (rowbase + t) * SBW + h * SBD;
#pragma unroll
      for (int d = 0; d < 64; ++d) { q[d] = bf2f(qp[d]); o[d] = 0.f; } }
    float R = 1.0f;
    for (int s = qb * 64 + 63; s >= 0; --s) {
        const bf16_t* kr = K + (rowbase + s) * SBW + h * SBD; const bf16_t* vr = V + (rowbase + s) * SBW + h * SBD;
        float z = 0.f;
#pragma unroll
        for (int d = 0; d < 64; ++d) z += q[d] * bf2f(kr[d]);
        const bool valid = s < t;
        const float ez = expf(fminf(z, 60.0f)), keep = 1.0f / (1.0f + ez);
        const float a = valid ? ez * keep * R : 0.f;
        R = valid ? R * keep : R;
#pragma unroll
        for (int d = 0; d < 64; ++d) o[d] += a * bf2f(vr[d]);
    }
    bf16_t* op = O + (rowbase + t) * SBW + h * SBD;
#pragma unroll
    for (int d = 0; d < 64; ++d) op[d] = (bf16_t)f2bf(o[d]);
}

__global__ __launch_bounds__(128) void k_hgrn_naive(const bf16_t* __restrict__ HQ, const bf16_t* __restrict__ HK, const float* __restrict__ LOGF, const bf16_t* __restrict__ HV, float* __restrict__ ORAW) {
    __shared__ __attribute__((aligned(16))) float sf[128], sk[128], sq[128];
    const int bh = blockIdx.x, b = bh >> 2, hh = bh & 3, v = threadIdx.x;
    float S[128];
#pragma unroll
    for (int k = 0; k < 128; ++k) S[k] = 0.f;
    for (int t = 0; t < SEQ; ++t) {
        const size_t base = ((size_t)b * SEQ + t) * HGW + hh * HGD;
        sf[v] = expf(LOGF[base + v]); sk[v] = bf2f(HK[base + v]); sq[v] = bf2f(HQ[base + v]);
        const float vv = bf2f(HV[base + v]);
        __syncthreads();
        float o = 0.f;
#pragma unroll
        for (int k = 0; k < 128; ++k) { S[k] = sf[k] * S[k] + sk[k] * vv; o += sq[k] * S[k]; }
        ORAW[base + v] = o;
        __syncthreads();
    }
}
__global__ __launch_bounds__(256) void k_hgrn_post(const float* __restrict__ ORAW, const bf16_t* __restrict__ HG, const float* __restrict__ norm_g, bf16_t* __restrict__ OHG) {
    const int gw = blockIdx.x * 4 + (threadIdx.x >> 6), lane = threadIdx.x & 63;
    const size_t base = (size_t)gw * HGD; const int c0 = (gw & 3) * HGD;
    const float x0 = ORAW[base + lane], x1 = ORAW[base + 64 + lane];
    const float r = 1.0f / sqrtf(wave_sum(x0 * x0 + x1 * x1) * (1.0f / HGD) + RMS_EPS);
    OHG[base + lane] = (bf16_t)f2bf(x0 * r * norm_g[c0 + lane] * bf2f(HG[base + lane]));
    OHG[base + 64 + lane] = (bf16_t)f2bf(x1 * r * norm_g[c0 + 64 + lane] * bf2f(HG[base + 64 + lane]));
}

__global__ __launch_bounds__(256) void k_ln1_router(const float* __restrict__ PRE, const float* __restrict__ g, const float* __restrict__ bta, const float* __restrict__ rw, const float* __restrict__ rb,
                                                    float* __restrict__ H, bf16_t* __restrict__ HB, int* __restrict__ TOPI, float* __restrict__ TOPG) {
    __shared__ __attribute__((aligned(16))) float hs[4][DM];
    const int w = threadIdx.x >> 6, lane = threadIdx.x & 63, row = blockIdx.x * 4 + w;
    f32x4 v[4]; float s = 0.f;
#pragma unroll
    for (int j = 0; j < 4; ++j) { v[j] = *(const f32x4*)(PRE + (size_t)row * DM + lane * 4 + 256 * j); s += (v[j][0] + v[j][1]) + (v[j][2] + v[j][3]); }
    const float mean = wave_sum(s) * (1.0f / DM); float s2 = 0.f;
#pragma unroll
    for (int j = 0; j < 4; ++j) { v[j] = v[j] - mean; s2 += (v[j][0] * v[j][0] + v[j][1] * v[j][1]) + (v[j][2] * v[j][2] + v[j][3] * v[j][3]); }
    const float rstd = 1.0f / sqrtf(wave_sum(s2) * (1.0f / DM) + LN_EPS);
#pragma unroll
    for (int j = 0; j < 4; ++j) { const int c = lane * 4 + 256 * j; const f32x4 gg = *(const f32x4*)(g + c), bb = *(const f32x4*)(bta + c);
        f32x4 hv = v[j] * rstd * gg + bb; *(f32x4*)(H + (size_t)row * DM + c) = hv; *(f32x4*)(&hs[w][c]) = hv;
        uint2 o; o.x = f2bf(hv[0]) | (f2bf(hv[1]) << 16); o.y = f2bf(hv[2]) | (f2bf(hv[3]) << 16); *(uint2*)(HB + (size_t)row * DM + c) = o; }
    __syncthreads();
    const int e = lane & 31, half = lane >> 5; float a = 0.f;
    for (int c = half * 512; c < half * 512 + 512; ++c) a += hs[w][c] * rw[c * NEXP + e];
    a += __shfl_xor(a, 32);
    float val = (lane < 32) ? a + rb[e] : -INFINITY; int idx = e;
    float tv[4]; int ti[4];
#pragma unroll
    for (int r = 0; r < 4; ++r) {
        float bv = val; int bi = idx;
#pragma unroll
        for (int off = 32; off >= 1; off >>= 1) { const float ov = __shfl_xor(bv, off); const int oi = __shfl_xor(bi, off); if (ov > bv || (ov == bv && oi < bi)) { bv = ov; bi = oi; } }
        tv[r] = bv; ti[r] = bi; if (lane < 32 && e == bi) val = -INFINITY;
    }
    if (lane == 0) { const float e1 = expf(tv[1] - tv[0]), e2 = expf(tv[2] - tv[0]), e3 = expf(tv[3] - tv[0]), inv = 1.0f / (1.0f + e1 + e2 + e3);
        *(int4*)(TOPI + row * 4) = make_int4(ti[0], ti[1], ti[2], ti[3]); *(float4*)(TOPG + row * 4) = make_float4(inv, e1 * inv, e2 * inv, e3 * inv); }
}

__global__ __launch_bounds__(256) void k_count(const int* __restrict__ TOPI, int* __restrict__ ctl, int* __restrict__ slot_tok) {
    __shared__ int hist[NEXP];
    if (threadIdx.x < NEXP) hist[threadIdx.x] = 0;
    __syncthreads();
    const int i = blockIdx.x * 256 + threadIdx.x;
    atomicAdd(&hist[TOPI[i]], 1);
    __syncthreads();
    if (threadIdx.x < NEXP) atomicAdd(&ctl[CW_CNT + threadIdx.x], hist[threadIdx.x]);
    for (int s = i; s < NSLOT_MAX; s += NASSIGN) slot_tok[s] = -1;
}
__global__ __launch_bounds__(64) void k_plan(int* __restrict__ ctl) {
    if (threadIdx.x == 0) { int ps = 0, nt = 0;
        for (int e = 0; e < NEXP; ++e) { ctl[CW_PADSTART + e] = ps; const int te = (ctl[CW_CNT + e] + SLOT_PAD - 1) / SLOT_PAD; for (int i = 0; i < te; ++i) ctl[CW_TILEEXP + nt++] = e; ps += te * SLOT_PAD; }
        ctl[CW_PADSTART + NEXP] = ps; ctl[CW_NTILES] = nt; }
}
__global__ __launch_bounds__(256) void k_assign(const int* __restrict__ TOPI, int* __restrict__ ctl, int* __restrict__ slot_tok, int* __restrict__ DEST) {
    const int i = blockIdx.x * 256 + threadIdx.x, e = TOPI[i];
    const int slot = ctl[CW_PADSTART + e] + atomicAdd(&ctl[CW_CUR + e], 1);
    slot_tok[slot] = i >> 2; DEST[i] = slot;
}
__global__ __launch_bounds__(256) void k_combine_ln2(const float* __restrict__ H, const bf16_t* __restrict__ Y, const int* __restrict__ DEST, const float* __restrict__ TOPG,
                                                     const float* __restrict__ g, const float* __restrict__ bta, float* __restrict__ out) {
    const int lane = threadIdx.x & 63, row = blockIdx.x * 4 + (threadIdx.x >> 6);
    const int4 d = *(const int4*)(DEST + row * 4); const float4 gt = *(const float4*)(TOPG + row * 4);
    const int ds[4] = {d.x, d.y, d.z, d.w}; const float gs[4] = {gt.x, gt.y, gt.z, gt.w};
    f32x4 v[4]; float s = 0.f;
#pragma unroll
    for (int j = 0; j < 4; ++j) { const int c = lane * 4 + 256 * j; f32x4 a = *(const f32x4*)(H + (size_t)row * DM + c) * DN_ALPHA;
#pragma unroll
        for (int k = 0; k < 4; ++k) { const uint2 y = *(const uint2*)(Y + (size_t)ds[k] * DM + c);
            a[0] += gs[k] * bf2f(y.x & 0xffff); a[1] += gs[k] * bf2f(y.x >> 16); a[2] += gs[k] * bf2f(y.y & 0xffff); a[3] += gs[k] * bf2f(y.y >> 16); }
        v[j] = a; s += (a[0] + a[1]) + (a[2] + a[3]); }
    const float mean = wave_sum(s) * (1.0f / DM); float s2 = 0.f;
#pragma unroll
    for (int j = 0; j < 4; ++j) { v[j] = v[j] - mean; s2 += (v[j][0] * v[j][0] + v[j][1] * v[j][1]) + (v[j][2] * v[j][2] + v[j][3] * v[j][3]); }
    const float rstd = 1.0f / sqrtf(wave_sum(s2) * (1.0f / DM) + LN_EPS);
#pragma unroll
    for (int j = 0; j < 4; ++j) { const int c = lane * 4 + 256 * j; *(f32x4*)(out + (size_t)row * DM + c) = v[j] * rstd * *(const f32x4*)(g + c) + *(const f32x4*)(bta + c); }
}

}
#endif
extern "C" void kernel_launch(void* const* d_in, const int* in_sizes, int n_in, void* d_out, int out_size, void* d_ws, size_t ws_size, hipStream_t stream) {
    static int grid = 0;
    if (grid == 0) {
        if (n_in != 17 || ws_size < WS_END) { fprintf(stderr, "kernel_launch: unexpected n_in %d or ws_size %zu (< %zu)\n", n_in, ws_size, (size_t)WS_END); grid = -1; return; }
        int dev = 0, cus = 0;
        if (hipGetDevice(&dev) != hipSuccess || hipDeviceGetAttribute(&cus, hipDeviceAttributeMultiprocessorCount, dev) != hipSuccess) { grid = -1; return; }
#define MK_ATTR(LO_, HI_) if (hipFuncSetAttribute((const void*)mk_fwd<LO_, HI_>, hipFuncAttributeMaxDynamicSharedMemorySize, LDS_BYTES) != hipSuccess) { fprintf(stderr, "kernel_launch: hipFuncSetAttribute failed\n"); grid = -1; return; }
#if MK_MODE == 0
        MK_ATTR(0, 11)
#elif MK_MODE == 2
        MK_ATTR(0, 1) MK_ATTR(1, 2) MK_ATTR(2, 3) MK_ATTR(3, 4) MK_ATTR(4, 5) MK_ATTR(5, 6)
#else
        MK_ATTR(0, 1) MK_ATTR(1, 2) MK_ATTR(2, 3) MK_ATTR(3, 4) MK_ATTR(4, 5) MK_ATTR(5, 6) MK_ATTR(6, 8) MK_ATTR(8, 9) MK_ATTR(9, 10) MK_ATTR(10, 11)
#endif
        grid = cus;
        if (grid != 256) fprintf(stderr, "kernel_launch: %d CUs (built for 256)\n", grid);
    }
    if (grid < 0) return;
    (void)hipMemsetAsync((char*)d_ws + WS_CTL, 0, CTL_ZERO_BYTES, stream);
    Args a{};
    for (int i = 0; i < 17; ++i) a.in[i] = (const float*)d_in[i];
    a.out = (float*)d_out; a.ws = (unsigned char*)d_ws;
#define MK_LAUNCH(LO_, HI_, LI_) do { a.ph_lo = LO_; a.ph_hi = HI_; a.li = LI_; hipLaunchKernelGGL((mk_fwd<LO_, HI_>), dim3(grid), dim3(NTHREADS), LDS_BYTES, stream, a); } while (0)
#if MK_MODE == 0
    MK_LAUNCH(0, 11, 0);
#elif MK_MODE == 2
    { unsigned char* ws = (unsigned char*)d_ws;
      InProjOut ip{}; ip.Q = (bf16_t*)(ws + WS_Q); ip.K = (bf16_t*)(ws + WS_K); ip.V = (bf16_t*)(ws + WS_V); ip.HQ = (bf16_t*)(ws + WS_HQ); ip.HK = (bf16_t*)(ws + WS_HK); ip.HV = (bf16_t*)(ws + WS_HV);
      ip.HG = (bf16_t*)(ws + WS_HG); ip.GS = (bf16_t*)(ws + WS_GS); ip.GH = (bf16_t*)(ws + WS_GH); ip.LOGF = (float*)(ws + WS_LOGF); ip.lb = (const float*)(ws + WS_LB);
#if MK_HEAD_V1 >= 1
      v1::k_convert_x<<<NTOK * DM / 4 / 256, 256, 0, stream>>>(a.in[0], (bf16_t*)(ws + WS_XB), a.in[2], (float*)(ws + WS_LB));
      v1::k_transpose_bf16<<<dim3(INW / 64, DM / 64, 1), 256, 0, stream>>>(a.in[1], (bf16_t*)(ws + WS_WINT), DM, INW);
      v1::k_transpose_bf16<<<dim3(DM / 64, SBW / 64, 1), 256, 0, stream>>>(a.in[4], (bf16_t*)(ws + WS_WBST), SBW, DM);
      v1::k_transpose_bf16<<<dim3(DM / 64, HGW / 64, 1), 256, 0, stream>>>(a.in[5], (bf16_t*)(ws + WS_WBHT), HGW, DM);
      v1::k_transpose_bf16<<<dim3(DM / 64, DM / 64, 1), 256, 0, stream>>>(a.in[6], (bf16_t*)(ws + WS_WOT), DM, DM);
      v1::k_transpose_bf16<<<dim3(UPW / 64, DM / 64, NEXP), 256, 0, stream>>>(a.in[11], (bf16_t*)(ws + WS_WUPT), DM, UPW);
      v1::k_transpose_bf16<<<dim3(DM / 64, DFF / 64, NEXP), 256, 0, stream>>>(a.in[13], (bf16_t*)(ws + WS_WDNT), DFF, DM);
#else
      MK_LAUNCH(0, 1, 0);
#endif
#if MK_HEAD_V1 >= 2
      v1::k_inproj<<<dim3(INW / v1::G_BM, NTOK / v1::G_BM), 256, 0, stream>>>((const bf16_t*)(ws + WS_XB), (const bf16_t*)(ws + WS_WINT), ip);
#else
      MK_LAUNCH(1, 2, 1);
#endif
      MK_LAUNCH(2, 3, 2); MK_LAUNCH(3, 4, 3); MK_LAUNCH(4, 5, 4); MK_LAUNCH(5, 6, 5); }
    { unsigned char* ws = (unsigned char*)d_ws; int* ctl = (int*)(ws + WS_CTL); bf16_t* HB = (bf16_t*)(ws + WS_XS); int* TOPI = (int*)(ws + WS_XS + 32 * MiB); int* SLOTTOK = (int*)(ws + WS_XS + 33 * MiB);
      float* TOPG = (float*)(ws + WS_TOPG); int* DEST = (int*)(ws + WS_DEST); float* H = (float*)(ws + WS_H); bf16_t* ACT = (bf16_t*)(ws + WS_ACT); bf16_t* Y = (bf16_t*)(ws + WS_Y);
      v1::k_ln1_router<<<NTOK / 4, 256, 0, stream>>>((const float*)(ws + WS_PRE), a.in[7], a.in[8], a.in[9], a.in[10], H, HB, TOPI, TOPG);
      v1::k_count<<<NASSIGN / 256, 256, 0, stream>>>(TOPI, ctl, SLOTTOK);
      v1::k_plan<<<1, 64, 0, stream>>>(ctl);
      v1::k_assign<<<NASSIGN / 256, 256, 0, stream>>>(TOPI, ctl, SLOTTOK, DEST);
      v1::k_moe_up<<<dim3(UPW / v1::G_BM, NSLOT_MAX / v1::G_BM), 256, 0, stream>>>(HB, (const bf16_t*)(ws + WS_WUPT), a.in[12], ctl, SLOTTOK, ACT);
      v1::k_moe_down<<<dim3(DM / v1::G_BM, NSLOT_MAX / v1::G_BM), 256, 0, stream>>>(ACT, (const bf16_t*)(ws + WS_WDNT), a.in[14], ctl, Y);
      v1::k_combine_ln2<<<NTOK / 4, 256, 0, stream>>>(H, Y, DEST, TOPG, a.in[15], a.in[16], (float*)d_out); }
#else
    MK_LAUNCH(0, 1, 0); MK_LAUNCH(1, 2, 1); MK_LAUNCH(2, 3, 2); MK_LAUNCH(3, 4, 3); MK_LAUNCH(4, 5, 4); MK_LAUNCH(5, 6, 5); MK_LAUNCH(6, 8, 6); MK_LAUNCH(8, 9, 7); MK_LAUNCH(9, 10, 8); MK_LAUNCH(10, 11, 9);
#endif
}
```

```cpp
#include <hip/hip_runtime.h>
#include <stdint.h>
#include <cstdio>

#define LAS __attribute__((address_space(3)))
#define GAS __attribute__((address_space(1)))
typedef unsigned short bf16_t;
typedef short bf16x8 __attribute__((ext_vector_type(8)));
typedef float f32x4 __attribute__((ext_vector_type(4)));
typedef float f32x16 __attribute__((ext_vector_type(16)));
typedef unsigned u32x4 __attribute__((ext_vector_type(4)));
typedef unsigned u32x2 __attribute__((ext_vector_type(2)));
typedef float f32x2_t __attribute__((ext_vector_type(2)));

constexpr int NTOK = 16384, DM = 1024, INW = 5632, SBW = 512, HGW = 512, NEXP = 32, TOPK = 4, DFF = 1024, UPW = 2048;
constexpr int SEQ = 2048, SBH = 8, SBD = 64, HGH = 4, HGD = 128;
constexpr int NASSIGN = NTOK * TOPK;
constexpr int SLOT_PAD = 256;
constexpr int NSLOT_MAX = NASSIGN + NEXP * SLOT_PAD;
constexpr int NTILE_MAX = NSLOT_MAX / SLOT_PAD;
constexpr float LN_EPS = 1e-5f, RMS_EPS = 1e-6f, DN_ALPHA = 1.189207115002721f, SW_ALPHA = 1.702f, SW_LIMIT = 7.0f, LOG2E = 1.4426950408889634f, LN2 = 0.6931471805599453f;
constexpr int NWAVES = 8, NTHREADS = 512;
constexpr float W8_SCALE = 32.0f; constexpr int W8_E8M0 = 0x7a7a7a7a;
#ifndef MK_Y8
#define MK_Y8 1
#endif
constexpr float Y8_SCALE = 16.0f;
constexpr float ACT8_SCALE = 4.0f; constexpr int ACT8_E8M0 = 0x7d7d7d7d;
#ifndef MK_DUP_P1
#define MK_DUP_P1 1
#endif
#ifndef MK_DUP_HGA
#define MK_DUP_HGA 1
#endif
#ifndef MK_DUP_HGB
#define MK_DUP_HGB 1
#endif
#ifndef MK_DUP_P45
#define MK_DUP_P45 1
#endif
#ifndef MK_BG_WAVES
#define MK_BG_WAVES 3
#endif
#ifndef MK_BG_SEAMS
#define MK_BG_SEAMS 0xFE
#endif
#ifndef MK_PROBE_CONV
#define MK_PROBE_CONV 0
#endif
#ifndef MK_PROBE_BAR
#define MK_PROBE_BAR 0
#endif
#ifndef MK_LOOP_P2
#define MK_LOOP_P2 1
#endif
#ifndef MK_DUP_TAIL
#define MK_DUP_TAIL 0
#endif
#ifndef MK_FP8_GATES
#define MK_FP8_GATES 1
#endif
#ifndef MK_FP8_DN
#define MK_FP8_DN 1
#endif
#ifndef MK_FP8_UP
#define MK_FP8_UP 1
#endif
#ifndef MK_BG
#define MK_BG 1
#endif
#ifndef MK_DUP_P2
#define MK_DUP_P2 1
#define MK_DUP_WHAT 0
#endif
#ifndef MK_PROBE
#define MK_PROBE 0
#endif
#define MK_PROBE_UNUSED 0
#ifndef MK_P0_ROWS
#define MK_P0_ROWS 2
#endif
#ifndef MK_PB_GROWS
#define MK_PB_GROWS 16
#endif
#ifndef MK_P10_ROWS
#define MK_P10_ROWS 4
#endif
#ifndef MK_WGM_P1A
#define MK_WGM_P1A 4
#define MK_WGM_P1B 4
#define MK_WGM_P4 8
#define MK_WGM_P5 8
#endif
#ifndef MK_WGM_DN
#define MK_WGM_DN 4
#endif
#ifndef MK_WGM_UP
#define MK_WGM_UP 4
#endif
#ifndef MK_GATHER_A
#define MK_GATHER_A 1
#endif
#ifndef MK_BR_BATCH
#define MK_BR_BATCH 3
#endif
#ifndef MK_PA0
#define MK_PA0 0
#define MK_PA1 1
#define MK_PB0 1
#define MK_PB1 2
#endif
#ifndef MK_NAIVE_MIX
#define MK_NAIVE_MIX 0
#endif
#ifndef MK_MODE
#ifndef MK_P1_ALIGN
#define MK_P1_ALIGN true
#endif
#ifndef MK_P1_SP2
#define MK_P1_SP2 true
#endif
#ifndef MK_HEAD_V1
#define MK_HEAD_V1 0
#endif
#define MK_MODE 0
#endif

constexpr size_t MiB = 1u << 20;
constexpr size_t WS_SLOTTOK = 262144;
constexpr size_t WS_CTL = 0, CTL_ZERO_BYTES = 262144 + 73728 * 4;
constexpr size_t WS_LB = 1 * MiB;
constexpr size_t WS_CNTM = WS_LB + 4096;
constexpr size_t WS_TOPG = WS_CNTM + 32768;
constexpr size_t WS_DEST = WS_TOPG + 262144;
constexpr size_t WS_RWT = WS_DEST + 262144;
constexpr size_t WS_XB = 3 * MiB;
constexpr size_t WS_WINT = WS_XB + 32 * MiB;
constexpr size_t WS_WBST = WS_WINT + 12 * MiB;
constexpr size_t WS_WBHT = WS_WBST + 1 * MiB;
constexpr size_t WS_WOT = WS_WBHT + 1 * MiB;
constexpr size_t WS_WUPT = WS_WOT + 2 * MiB;
constexpr size_t WS_WDNT = WS_WUPT + 128 * MiB;
constexpr size_t WS_Q = WS_WDNT + 64 * MiB;
constexpr size_t WS_K = WS_Q + 16 * MiB;
constexpr size_t WS_V = WS_K + 16 * MiB;
constexpr size_t WS_HQ = WS_V + 16 * MiB;
constexpr size_t WS_HK = WS_HQ + 16 * MiB;
constexpr size_t WS_HV = WS_HK + 16 * MiB;
constexpr size_t WS_HG = WS_HV + 16 * MiB;
constexpr size_t WS_LOGF = WS_HG + 16 * MiB;
constexpr size_t WS_GS = WS_LOGF + 32 * MiB;
constexpr size_t WS_GH = WS_GS + 32 * MiB;
constexpr size_t WS_OSB = WS_GH + 32 * MiB;
constexpr size_t WS_OHG = WS_OSB + 16 * MiB;
constexpr size_t WS_ORAW = WS_OHG + 16 * MiB;
constexpr size_t WS_MERGED = WS_ORAW + 32 * MiB;
constexpr size_t WS_H = WS_MERGED + 32 * MiB;
constexpr size_t WS_XS = WS_H + 64 * MiB;
constexpr size_t WS_ACT = WS_XS + 144 * MiB;
constexpr size_t WS_QC = WS_ACT + 144 * MiB;
constexpr size_t WS_DS = WS_QC + 16 * MiB;
constexpr size_t WS_DG = WS_DS + 16 * MiB;
constexpr size_t WS_XB8 = WS_DG + 1 * MiB;
constexpr size_t WS_WINT8 = WS_XB8 + 16 * MiB;
constexpr size_t WS_END = WS_WINT8 + 3 * MiB;
constexpr size_t WS_PRE = WS_Q;
constexpr size_t WS_Y = WS_HK;
static_assert(WS_Y + 144 * MiB <= WS_OSB && WS_PRE + 64 * MiB <= WS_HK, "overlays");
static_assert(WS_END <= 1020 * MiB, "ws budget");
constexpr int CW_NTILES = 16;
constexpr int CW_ATTNQ = 32;
constexpr int CW_BGQ = 48;
constexpr int CW_TILEEXP = 64;
constexpr int CW_BAR = 1024;
constexpr int LDS_SCRATCH = 147456;
constexpr int LDSCTL_OFF = LDS_SCRATCH, LDS_BYTES = LDS_SCRATCH + 512;
constexpr int LDS_IDX = 131072 + 1280;
constexpr int LDS_TILEEXP = 131072;
constexpr int MISC_OFF = LDSCTL_OFF;

__device__ __forceinline__ unsigned f2bf(float f) { unsigned u = __builtin_bit_cast(unsigned, f); return (u + 0x7fffu + ((u >> 16) & 1u)) >> 16; }
__device__ __forceinline__ unsigned pk2(float lo, float hi) { return f2bf(lo) | (f2bf(hi) << 16); }
__device__ __forceinline__ float bf2f(unsigned short b) { return __builtin_bit_cast(float, (unsigned)b << 16); }
__device__ __forceinline__ float bflo(unsigned w) { return __builtin_bit_cast(float, w << 16); }
__device__ __forceinline__ float bfhi(unsigned w) { return __builtin_bit_cast(float, w & 0xffff0000u); }
__device__ __forceinline__ float fsigmoid(float v) { return __builtin_amdgcn_rcpf(1.0f + __builtin_amdgcn_exp2f(-v * LOG2E)); }
__device__ __forceinline__ f32x4 fsigmoid4(f32x4 v) { const f32x4 x = v * (f32x4){-LOG2E, -LOG2E, -LOG2E, -LOG2E};
    const f32x4 d = (f32x4){__builtin_amdgcn_exp2f(x[0]), __builtin_amdgcn_exp2f(x[1]), __builtin_amdgcn_exp2f(x[2]), __builtin_amdgcn_exp2f(x[3])} + (f32x4){1.0f, 1.0f, 1.0f, 1.0f};
    return (f32x4){__builtin_amdgcn_rcpf(d[0]), __builtin_amdgcn_rcpf(d[1]), __builtin_amdgcn_rcpf(d[2]), __builtin_amdgcn_rcpf(d[3])}; }
template <int CTRL> __device__ __forceinline__ float dpp_f(float v) { return __builtin_bit_cast(float, __builtin_amdgcn_update_dpp(0, __builtin_bit_cast(int, v), CTRL, 0xF, 0xF, false)); }
__device__ __forceinline__ float row16_sum(float v) { v += dpp_f<0xB1>(v); v += dpp_f<0x4E>(v); v += dpp_f<0x141>(v); v += dpp_f<0x140>(v); return v; }
__device__ __forceinline__ float wave_sum(float v) {
    v = row16_sum(v);
    const float r0 = __builtin_bit_cast(float, __builtin_amdgcn_readlane(__builtin_bit_cast(int, v), 0)), r1 = __builtin_bit_cast(float, __builtin_amdgcn_readlane(__builtin_bit_cast(int, v), 16));
    const float r2 = __builtin_bit_cast(float, __builtin_amdgcn_readlane(__builtin_bit_cast(int, v), 32)), r3 = __builtin_bit_cast(float, __builtin_amdgcn_readlane(__builtin_bit_cast(int, v), 48));
    return (r0 + r1) + (r2 + r3);
}
__device__ __forceinline__ unsigned pk4_fp8(float a, float b, float c, float d) { int w = 0; w = __builtin_amdgcn_cvt_pk_fp8_f32(a, b, w, false); w = __builtin_amdgcn_cvt_pk_fp8_f32(c, d, w, true); return (unsigned)w; }
#define LDS_WAIT() asm volatile("s_waitcnt lgkmcnt(0)" ::: "memory")
#define VM_WAIT() asm volatile("s_waitcnt vmcnt(0)" ::: "memory")

struct InProjOut { bf16_t *Q, *K, *V, *HQ, *HK, *HV, *HG, *GS, *GH; float* LOGF; const float* lb; };

namespace pg8 {
#define PG8_LAS __attribute__((address_space(3)))
constexpr int BM = 256, BK = 64, HALF = 128, HTB = HALF * BK * 2  , STAGE_BYTES = 8 * HTB, NXCD = 8, WGM = 8;
__host__ __device__ __forceinline__ int lds_byte(int r, int c) { const int st = (r >> 4) * 2 + (c >> 5), rr = r & 15, cc = c & 31, ob = rr * 64 + cc * 2; return st * 1024 + (ob ^ (((ob >> 9) & 1) << 5)); }
__host__ __device__ __forceinline__ void stage_rc(int b, int& R, int& C) { const int st = b / 1024, sb = b % 1024, swz = sb ^ (((sb >> 9) & 1) << 5); R = (st >> 1) * 16 + swz / 64; C = (st & 1) * 32 + (swz % 64) / 2; }
__host__ __device__ __forceinline__ int perm32(int rho) { const int n = rho >> 4, i = rho & 15; return 8 * (i >> 2) + 4 * n + (i & 3); }

struct Unit { int pm, pn, aux; const char* a; const char* b; };
struct Gemm { int K; int scale_a = 0x7f7f7f7f, scale_b = 0x7f7f7f7f; };
struct TileOrder {
    int nM, nN, nwg, G, c, wgm;
    __device__ void init(int nM_, int nN_, int G_, int c_, int wgm_ = WGM) { nM = nM_; nN = nN_; nwg = nM * nN; G = G_; c = c_; wgm = wgm_; }
    __device__ bool tile(int i, int& pm, int& pn) const {
        const long L = (long)i * G + c; if (L >= nwg) return false;
        int wgid = (int)L; { const int q = nwg / NXCD, r = nwg % NXCD, xcd = wgid % NXCD, off = wgid / NXCD; wgid = (xcd < r ? xcd * (q + 1) : r * (q + 1) + (xcd - r) * q) + off; }
        const int nig = wgm * nN, gid = wgid / nig, fm = gid * wgm, gsz = (nM - fm) < wgm ? (nM - fm) : wgm;
        pm = fm + ((wgid % nig) % gsz); pn = (wgid % nig) / gsz; return true;
    }
};
struct DenseSched { static constexpr bool GATHER_A = false; TileOrder o; const char* A; const char* Bt; size_t tstep;
    __device__ __forceinline__ bool next(int i, Unit& u) const { if (!o.tile(i, u.pm, u.pn)) return false; u.aux = 0; u.a = A + (size_t)u.pm * tstep; u.b = Bt + (size_t)u.pn * tstep; return true; }
    __device__ __forceinline__ void a_ready(const Unit&) const {}
    __device__ __forceinline__ void done(const Unit&) const {} };
struct BranchSched { static constexpr bool GATHER_A = false; TileOrder o; const char *A0, *B0, *A1, *B1; size_t tstep;
    __device__ __forceinline__ bool next(int i, Unit& u) const { if (!o.tile(i >> 1, u.pm, u.pn)) return false; u.aux = i & 1; u.a = ((i & 1) ? A1 : A0) + (size_t)u.pm * tstep; u.b = ((i & 1) ? B1 : B0) + (size_t)u.pn * tstep; return true; }
    __device__ __forceinline__ void a_ready(const Unit&) const {}
    __device__ __forceinline__ void done(const Unit&) const {} };
struct MoeSched { static constexpr bool GATHER_A = false; TileOrder o; const char* A; const char* W; const LAS int* tile_exp; size_t tstep, estep;
    __device__ __forceinline__ bool next(int i, Unit& u) const { if (!o.tile(i, u.pm, u.pn)) return false; const int e = __builtin_amdgcn_readfirstlane(tile_exp[u.pm]); u.aux = e; u.a = A + (size_t)u.pm * tstep; u.b = W + (size_t)e * estep + (size_t)u.pn * tstep; return true; }
    __device__ __forceinline__ void a_ready(const Unit&) const {}
    __device__ __forceinline__ void done(const Unit&) const {} };

struct MoeGatherSched : MoeSched { static constexpr bool GATHER_A = true; const int* slot_tok;
    __device__ __forceinline__ bool next(int i, Unit& u) const { if (!MoeSched::next(i, u)) return false; u.a = A; return true; }
    __device__ __forceinline__ const int* idx(const Unit& u) const { return slot_tok + u.pm * BM; } };
typedef __bf16 bf16x2_t __attribute__((ext_vector_type(2)));
__device__ __forceinline__ unsigned cvt_pk_bf16(float lo, float hi) { f32x2_t v = {lo, hi}; bf16x2_t b = __builtin_convertvector(v, bf16x2_t); return __builtin_bit_cast(unsigned, b); }
template <int MODE> __device__ __forceinline__ void inproj_store(const f32x4 (&acc)[2][2][4][2], bf16_t* dst, int ld, int row0, int col0, float scale, const float* lb, float* logf_out) {
    f32x4 lbq[2][2];
    if (MODE == 2) {
#pragma unroll
        for (int bj = 0; bj < 2; ++bj) { lbq[bj][0] = *(const f32x4*)(lb + col0 + bj * HALF); lbq[bj][1] = *(const f32x4*)(lb + col0 + bj * HALF + 4); } }
#pragma unroll
    for (int ai = 0; ai < 2; ++ai)
#pragma unroll
        for (int m = 0; m < 4; ++m)
#pragma unroll
            for (int bj = 0; bj < 2; ++bj) {
                const size_t off = (size_t)(row0 + ai * HALF + m * 16) * ld + col0 + bj * HALF;
                f32x4 v[2] = {acc[ai][bj][m][0], acc[ai][bj][m][1]};
                if (MODE == 0) { v[0] = v[0] * scale; v[1] = v[1] * scale; }
                if (MODE == 1) { v[0] = v[0] * fsigmoid4(v[0]); v[1] = v[1] * fsigmoid4(v[1]); }
                if (MODE == 3) { v[0] = fsigmoid4(v[0]); v[1] = fsigmoid4(v[1]); }
                if (MODE == 2) {
                    f32x4 lg[2]; const f32x4 lbv[2] = {lbq[bj][0], lbq[bj][1]};
#pragma unroll
                    for (int n = 0; n < 2; ++n) { const f32x4 one = {1.0f, 1.0f, 1.0f, 1.0f}, l = lbv[n], f = l + (one - l) * fsigmoid4(v[n]); v[n] = one - f;
                        lg[n] = (f32x4){__builtin_amdgcn_logf(f[0]), __builtin_amdgcn_logf(f[1]), __builtin_amdgcn_logf(f[2]), __builtin_amdgcn_logf(f[3])} * (f32x4){LN2, LN2, LN2, LN2}; }
                    *(f32x4*)(logf_out + off) = lg[0]; *(f32x4*)(logf_out + off + 4) = lg[1];
                }
                u32x4 w; w.x = cvt_pk_bf16(v[0][0], v[0][1]); w.y = cvt_pk_bf16(v[0][2], v[0][3]); w.z = cvt_pk_bf16(v[1][0], v[1][1]); w.w = cvt_pk_bf16(v[1][2], v[1][3]);
                *(u32x4*)(dst + off) = w;
            }
}
template <int PN0> struct EpiInProjT { static constexpr bool PERM = true, AFTER_DRAIN = false, ACC_CHAIN = false; static constexpr int INIT = 0; InProjOut o;
    __device__ __forceinline__ void operator()(f32x4 (&acc)[2][2][4][2], const Unit& u, int wr, int wc, int fr, int fq) const {
        const int row0 = u.pm * BM + wr * 64 + fr, pn = u.pn + PN0;
        int seg, cb, ld;
        if (pn < 14) { seg = pn >> 1; cb = (pn & 1) * 256; ld = 512; } else if (pn < 18) { seg = 7; cb = (pn - 14) * 256; ld = 1024; } else { seg = 8; cb = (pn - 18) * 256; ld = 1024; }
        const int col0 = cb + wc * 32 + 8 * fq;
        if constexpr (PN0 != 0) { const size_t off = seg == 6 ? (size_t)(WS_HG - WS_HG) : (seg == 7 ? (size_t)(WS_GS - WS_HG) : (size_t)(WS_GH - WS_HG));
            inproj_store<3>(acc, (bf16_t*)((unsigned char*)o.HG + off), ld, row0, col0, 1.0f, nullptr, nullptr); return; }
        switch (seg) {
            case 0: inproj_store<0>(acc, o.Q, ld, row0, col0, 0.125f * LOG2E, nullptr, nullptr); break;
            case 1: inproj_store<0>(acc, o.K, ld, row0, col0, 1.0f, nullptr, nullptr); break;
            case 2: inproj_store<0>(acc, o.V, ld, row0, col0, 1.0f, nullptr, nullptr); break;
            case 3: inproj_store<1>(acc, o.HQ, ld, row0, col0, 1.0f, nullptr, nullptr); break;
            case 4: inproj_store<2>(acc, o.HK, ld, row0, col0, 1.0f, o.lb, o.LOGF); break;
            case 5: inproj_store<0>(acc, o.HV, ld, row0, col0, 1.0f, nullptr, nullptr); break;
            case 6: inproj_store<3>(acc, o.HG, ld, row0, col0, 1.0f, nullptr, nullptr); break;
            case 7: inproj_store<3>(acc, o.GS, ld, row0, col0, 1.0f, nullptr, nullptr); break;
            default: inproj_store<3>(acc, o.GH, ld, row0, col0, 1.0f, nullptr, nullptr); break;
        }
    }
};
struct EpiBranch { static constexpr bool PERM = true, AFTER_DRAIN = false, ACC_CHAIN = true; static constexpr int INIT = 0; const bf16_t* GS; const bf16_t* GH; bf16_t* MERGED;
    __device__ __forceinline__ void operator()(f32x4 (&acc)[2][2][4][2], const Unit& u, int wr, int wc, int fr, int fq) const {
        const int row0 = u.pm * BM + wr * 64 + fr, col0 = u.pn * BM + wc * 32 + 8 * fq;
        u32x4 ghq[MK_BR_BATCH + 1];
#pragma unroll
        for (int it = 0; it < MK_BR_BATCH; ++it) ghq[it] = *(const u32x4*)(GH + (size_t)(row0 + (it >> 3) * HALF + ((it >> 1) & 3) * 16) * DM + col0 + (it & 1) * HALF);
#pragma unroll
        for (int it = 0; it < 16; ++it) { const int ai = it >> 3, m = (it >> 1) & 3, bj = it & 1;
                    const size_t off = (size_t)(row0 + ai * HALF + m * 16) * DM + col0 + bj * HALF;
                    if (it + MK_BR_BATCH < 16) { const int i2 = it + MK_BR_BATCH; ghq[i2 % (MK_BR_BATCH + 1)] = *(const u32x4*)(GH + (size_t)(row0 + (i2 >> 3) * HALF + ((i2 >> 1) & 3) * 16) * DM + col0 + (i2 & 1) * HALF); }
                    const u32x4 gh = ghq[it % (MK_BR_BATCH + 1)];
                    const float h[8] = {bflo(gh.x), bfhi(gh.x), bflo(gh.y), bfhi(gh.y), bflo(gh.z), bfhi(gh.z), bflo(gh.w), bfhi(gh.w)};
                    if (u.aux == 0) {
                        const u32x4 gs = *(const u32x4*)(GS + off);
                        const float s[8] = {bflo(gs.x), bfhi(gs.x), bflo(gs.y), bfhi(gs.y), bflo(gs.z), bfhi(gs.z), bflo(gs.w), bfhi(gs.w)};
#pragma unroll
                        for (int n = 0; n < 2; ++n)
#pragma unroll
                            for (int j = 0; j < 4; ++j) acc[ai][bj][m][n][j] *= s[4 * n + j] * __builtin_amdgcn_rcpf(h[4 * n + j]);
                    } else {
                        float r[8];
#pragma unroll
                        for (int n = 0; n < 2; ++n)
#pragma unroll
                            for (int j = 0; j < 4; ++j) { r[4 * n + j] = acc[ai][bj][m][n][j] * h[4 * n + j]; acc[ai][bj][m][n][j] = 0.f; }
                        u32x4 w; w.x = cvt_pk_bf16(r[0], r[1]); w.y = cvt_pk_bf16(r[2], r[3]); w.z = cvt_pk_bf16(r[4], r[5]); w.w = cvt_pk_bf16(r[6], r[7]);
                        *(u32x4*)(MERGED + off) = w;
                    }
        }
    }
};
struct EpiOut { static constexpr bool PERM = true, AFTER_DRAIN = false, ACC_CHAIN = false; static constexpr int INIT = 2;     const bf16_t* xb; bf16_t* PRE;
    __device__ __forceinline__ void tile_init(f32x4 (&acc)[2][2][4][2], const Unit& u, int wr, int wc, int fr, int fq) const {
        const int row0 = u.pm * BM + wr * 64 + fr, col0 = u.pn * BM + wc * 32 + 8 * fq;
#pragma unroll
        for (int ai = 0; ai < 2; ++ai)
#pragma unroll
            for (int m = 0; m < 4; ++m)
#pragma unroll
                for (int bj = 0; bj < 2; ++bj) { const size_t off = (size_t)(row0 + ai * HALF + m * 16) * DM + col0 + bj * HALF;
                    const u32x4 xv = *(const u32x4*)(xb + off);
                    acc[ai][bj][m][0] = (f32x4){bflo(xv.x), bfhi(xv.x), bflo(xv.y), bfhi(xv.y)} * DN_ALPHA; acc[ai][bj][m][1] = (f32x4){bflo(xv.z), bfhi(xv.z), bflo(xv.w), bfhi(xv.w)} * DN_ALPHA; }
    }
    __device__ __forceinline__ void operator()(f32x4 (&acc)[2][2][4][2], const Unit& u, int wr, int wc, int fr, int fq) const {
        const int row0 = u.pm * BM + wr * 64 + fr, col0 = u.pn * BM + wc * 32 + 8 * fq;
#pragma unroll
        for (int ai = 0; ai < 2; ++ai)
#pragma unroll
            for (int m = 0; m < 4; ++m)
#pragma unroll
                for (int bj = 0; bj < 2; ++bj) { const size_t off = (size_t)(row0 + ai * HALF + m * 16) * DM + col0 + bj * HALF;
                    const f32x4 v0 = acc[ai][bj][m][0], v1 = acc[ai][bj][m][1];
                    u32x4 w; w.x = cvt_pk_bf16(v0[0], v0[1]); w.y = cvt_pk_bf16(v0[2], v0[3]); w.z = cvt_pk_bf16(v1[0], v1[1]); w.w = cvt_pk_bf16(v1[2], v1[3]);
                    *(u32x4*)(PRE + off) = w; }
    }
};
template <bool F8OUT> struct EpiUpT { static constexpr bool PERM = true, AFTER_DRAIN = false, ACC_CHAIN = false; static constexpr int INIT = 1;     const float* b_up; bf16_t* ACT;
    __device__ __forceinline__ void bias_load(f32x4 (&bv)[2][2], const Unit& u, int wc, int fq) const { const float* bias = b_up + (size_t)u.aux * UPW + u.pn * BM + wc * 32 + 8 * fq;
#pragma unroll
        for (int bj = 0; bj < 2; ++bj)
#pragma unroll
            for (int n = 0; n < 2; ++n) bv[bj][n] = *(const f32x4*)(bias + bj * HALF + 4 * n); }
    __device__ __forceinline__ void operator()(f32x4 (&acc)[2][2][4][2], const Unit& u, int wr, int wc, int fr, int fq) const {
        const int row0 = u.pm * BM + wr * 64 + fr, col0 = u.pn * BM + wc * 32 + 8 * fq;
        constexpr float OS = F8OUT ? ACT8_SCALE : 1.0f;
#pragma unroll
        for (int ai = 0; ai < 2; ++ai)
#pragma unroll
            for (int bj = 0; bj < 2; ++bj) {
                unsigned d[4]; u32x2 wb[4];
#pragma unroll
                for (int m = 0; m < 4; ++m) {
                    const f32x4 v0 = acc[ai][bj][m][0], v1 = acc[ai][bj][m][1];
                    const float gl[4] = {v0[0], v0[2], v1[0], v1[2]}, li[4] = {v0[1], v0[3], v1[1], v1[3]}; float a[4];
#pragma unroll
                    for (int p = 0; p < 4; p += 2) {
                        const f32x2_t g2 = {__builtin_amdgcn_fmed3f(gl[p], -INFINITY, SW_LIMIT), __builtin_amdgcn_fmed3f(gl[p + 1], -INFINITY, SW_LIMIT)}, l2 = {__builtin_amdgcn_fmed3f(li[p], -SW_LIMIT, SW_LIMIT), __builtin_amdgcn_fmed3f(li[p + 1], -SW_LIMIT, SW_LIMIT)};
                        const f32x2_t x2 = g2 * (f32x2_t){-SW_ALPHA * LOG2E, -SW_ALPHA * LOG2E};
                        const f32x2_t d2 = (f32x2_t){__builtin_amdgcn_exp2f(x2[0]), __builtin_amdgcn_exp2f(x2[1])} + (f32x2_t){1.0f, 1.0f};
                        const f32x2_t r2 = {__builtin_amdgcn_rcpf(d2[0]), __builtin_amdgcn_rcpf(d2[1])};
                        const f32x2_t u2 = l2 * (f32x2_t){OS, OS} + (f32x2_t){OS, OS};
                        const f32x2_t a2 = (g2 * r2) * u2;
                        a[p] = a2[0]; a[p + 1] = a2[1]; }
                    if constexpr (F8OUT) d[m] = pk4_fp8(a[0], a[1], a[2], a[3]);
                    else { wb[m].x = cvt_pk_bf16(a[0], a[1]); wb[m].y = cvt_pk_bf16(a[2], a[3]); }
                }
                if constexpr (F8OUT) {
                    auto r = __builtin_amdgcn_permlane16_swap(d[0], d[1], false, false); d[0] = r[0]; d[1] = r[1];
                    r = __builtin_amdgcn_permlane16_swap(d[2], d[3], false, false); d[2] = r[0]; d[3] = r[1];
                    r = __builtin_amdgcn_permlane32_swap(d[0], d[2], false, false); d[0] = r[0]; d[2] = r[1];
                    r = __builtin_amdgcn_permlane32_swap(d[1], d[3], false, false); d[1] = r[0]; d[3] = r[1];
                    *(u32x4*)((unsigned char*)ACT + (size_t)(row0 + ai * HALF + 16 * fq) * DFF + (u.pn * (BM / 2) + wc * 16 + bj * (HALF / 2))) = (u32x4){d[0], d[1], d[2], d[3]};
                } else {
#pragma unroll
                    for (int m = 0; m < 4; ++m) *(u32x2*)(ACT + (size_t)(row0 + ai * HALF + m * 16) * DFF + ((col0 + bj * HALF) >> 1)) = wb[m];
                }
            }
    }
};
struct EpiDown { static constexpr bool PERM = true, AFTER_DRAIN = false, ACC_CHAIN = false; static constexpr int INIT = 1; const float* b_dn; bf16_t* Y;
    __device__ __forceinline__ void bias_load(f32x4 (&bv)[2][2], const Unit& u, int wc, int fq) const { const float* bias = b_dn + (size_t)u.aux * DM + u.pn * BM + wc * 32 + 8 * fq;
#pragma unroll
        for (int bj = 0; bj < 2; ++bj)
#pragma unroll
            for (int n = 0; n < 2; ++n) bv[bj][n] = *(const f32x4*)(bias + bj * HALF + 4 * n); }
    __device__ __forceinline__ void operator()(f32x4 (&acc)[2][2][4][2], const Unit& u, int wr, int wc, int fr, int fq) const {
        const int row0 = u.pm * BM + wr * 64 + fr, col0 = u.pn * BM + wc * 32 + 8 * fq;
#if MK_Y8
#pragma unroll
        for (int ai = 0; ai < 2; ++ai)
#pragma unroll
            for (int bj = 0; bj < 2; ++bj)
#pragma unroll
                for (int mp = 0; mp < 4; mp += 2) {
                    u32x2 w[2];
#pragma unroll
                    for (int q = 0; q < 2; ++q) { const f32x4 v0 = acc[ai][bj][mp + q][0], v1 = acc[ai][bj][mp + q][1];
                        w[q].x = pk4_fp8(v0[0] * Y8_SCALE, v0[1] * Y8_SCALE, v0[2] * Y8_SCALE, v0[3] * Y8_SCALE); w[q].y = pk4_fp8(v1[0] * Y8_SCALE, v1[1] * Y8_SCALE, v1[2] * Y8_SCALE, v1[3] * Y8_SCALE); }
                    auto r = __builtin_amdgcn_permlane16_swap(w[0].x, w[1].x, false, false); w[0].x = r[0]; w[1].x = r[1];
                    r = __builtin_amdgcn_permlane16_swap(w[0].y, w[1].y, false, false); w[0].y = r[0]; w[1].y = r[1];
                    *(u32x4*)((unsigned char*)Y + (size_t)(row0 + ai * HALF + (mp + (fq & 1)) * 16) * DM + (u.pn * BM + wc * 32 + 8 * (fq & 2) + bj * HALF)) = (u32x4){w[0].x, w[0].y, w[1].x, w[1].y};
                }
#else
#pragma unroll
        for (int ai = 0; ai < 2; ++ai)
#pragma unroll
            for (int m = 0; m < 4; ++m)
#pragma unroll
                for (int bj = 0; bj < 2; ++bj) {
                    const f32x4 v0 = acc[ai][bj][m][0], v1 = acc[ai][bj][m][1];
                    u32x4 w; w.x = cvt_pk_bf16(v0[0], v0[1]); w.y = cvt_pk_bf16(v0[2], v0[3]); w.z = cvt_pk_bf16(v1[0], v1[1]); w.w = cvt_pk_bf16(v1[2], v1[3]);
                    *(u32x4*)(Y + (size_t)(row0 + ai * HALF + m * 16) * DM + col0 + bj * HALF) = w;
                }
#endif
    }
};

template <class Epi, class Sched, bool ALIGN_EPI = false, bool SP2 = false>
__device__ __forceinline__ void gemm_phase(PG8_LAS unsigned char* lds, const Gemm g, const Sched& S, const Epi& E) {
    int tid = threadIdx.x; asm volatile("" : "+v"(tid));
    const int wid = __builtin_amdgcn_readfirstlane(tid >> 6), lane = tid & 63, wr = wid >> 2, wc = wid & 3, fr = lane & 15, fq = lane >> 4;
    const int K = g.K, nt = K / BK;
    unsigned voffA[2], voffB[2];
#pragma unroll
    for (int i = 0; i < 2; ++i) { int R, C; stage_rc(tid * 16 + i * 8192, R, C); const int Rb = Epi::PERM ? ((R & ~31) + perm32(R & 31)) : R;
        voffA[i] = (unsigned)(R * K + C) * 2u; voffB[i] = (unsigned)(Rb * K + C) * 2u; }
    const size_t kstep = (size_t)(BK * 2);
    const size_t hstep = (size_t)HALF * K * 2;
    const unsigned ldsw = (unsigned)wid * 1024u;
    const int aoff = lds_byte(wr * 64 + fr, fq * 8), boff = lds_byte(wc * 32 + fr, fq * 8);
#define PG8_SA(b, h) (((b) * 2 + (h)) * HTB)
#define PG8_SB(b, h) ((4 + (b) * 2 + (h)) * HTB)
#define PG8_STAGE(bufoff, gbase, voff) do { _Pragma("unroll") for (int _i = 0; _i < 2; ++_i) \
        __builtin_amdgcn_global_load_lds((const unsigned*)((const char*)(gbase) + (voff)[_i]), (PG8_LAS unsigned*)(lds + (bufoff) + ldsw + _i * 8192), 16, 0, 0); } while (0)
#define PG8_LDA(dst, b, h) do { _Pragma("unroll") for (int m = 0; m < 4; ++m) _Pragma("unroll") for (int k = 0; k < 2; ++k) dst[m][k] = *(const PG8_LAS bf16x8*)(lds + PG8_SA(b, h) + aoff + m * 2048 + k * 1024); } while (0)
#define PG8_LDB(dst, b, h) do { _Pragma("unroll") for (int n = 0; n < 2; ++n) _Pragma("unroll") for (int k = 0; k < 2; ++k) dst[n][k] = *(const PG8_LAS bf16x8*)(lds + PG8_SB(b, h) + boff + n * 2048 + k * 1024); } while (0)
#define PG8_MMA(ai, bj, At, Bt) do { __builtin_amdgcn_s_setprio(1); _Pragma("unroll") for (int m = 0; m < 4; ++m) _Pragma("unroll") for (int n = 0; n < 2; ++n) _Pragma("unroll") for (int k = 0; k < 2; ++k) \
        acc[ai][bj][m][n] = __builtin_amdgcn_mfma_f32_16x16x32_bf16(Bt[n][k], At[m][k], acc[ai][bj][m][n], 0, 0, 0); __builtin_amdgcn_s_setprio(0); } while (0)
#define PG8_WAIT_V(n) asm volatile("s_waitcnt vmcnt(" #n ")" ::: "memory")
#define PG8_WAIT_L(n) asm volatile("s_waitcnt lgkmcnt(" #n ")" ::: "memory")
#define PG8_BAR __builtin_amdgcn_s_barrier()
#define PG8_SCHED __builtin_amdgcn_sched_barrier(0)
    Unit cur, nxt; int ui = 0;
    if (!S.next(0, cur)) return;
    f32x4 acc[2][2][4][2];
    f32x4 bv0[2][2];
    if constexpr (Epi::INIT == 1) E.bias_load(bv0, cur, wc, fq);
#pragma unroll
    for (int a = 0; a < 2; ++a)
#pragma unroll
        for (int b = 0; b < 2; ++b)
#pragma unroll
            for (int m = 0; m < 4; ++m)
#pragma unroll
                for (int n = 0; n < 2; ++n) { if constexpr (Epi::INIT == 1) acc[a][b][m][n] = bv0[b][n]; else acc[a][b][m][n] = (f32x4){0.f, 0.f, 0.f, 0.f}; }
    if constexpr (Epi::INIT == 2) E.tile_init(acc, cur, wr, wc, fr, fq);
    bf16x8 At[4][2], B0[2][2], B1[2][2];
    const char* cA = cur.a; const char* cB = cur.b;
    S.a_ready(cur);
    if constexpr (SP2) {
        PG8_STAGE(PG8_SB(0, 0), cB, voffB); PG8_STAGE(PG8_SB(0, 1), cB + hstep, voffB); PG8_STAGE(PG8_SA(0, 0), cA, voffA); PG8_STAGE(PG8_SA(0, 1), cA + hstep, voffA);
        if (wr == 1) PG8_BAR;
        PG8_WAIT_V(2); PG8_BAR;
        PG8_STAGE(PG8_SB(1, 0), cB + kstep, voffB); PG8_STAGE(PG8_SA(1, 0), cA + kstep, voffA); PG8_STAGE(PG8_SB(1, 1), cB + hstep + kstep, voffB);
        PG8_WAIT_V(6); PG8_BAR;
    } else {
        PG8_STAGE(PG8_SB(0, 0), cB, voffB); PG8_STAGE(PG8_SA(0, 0), cA, voffA); PG8_STAGE(PG8_SB(0, 1), cB + hstep, voffB); PG8_STAGE(PG8_SA(0, 1), cA + hstep, voffA);
        if (wr == 1) PG8_BAR;
        PG8_WAIT_V(4); PG8_BAR;
        PG8_STAGE(PG8_SB(1, 0), cB + kstep, voffB); PG8_STAGE(PG8_SA(1, 0), cA + kstep, voffA); PG8_STAGE(PG8_SB(1, 1), cB + hstep + kstep, voffB);
        PG8_WAIT_V(6); PG8_BAR;
    }
    for (;;) {
        const bool has_next = S.next(ui + 1, nxt);
        const char* nA = has_next ? nxt.a : cA; const char* nB = has_next ? nxt.b : cB;
        for (int t = 0; t < nt; t += 2) {
            const bool last = (t == nt - 2);
            const char* a1 = cA + (size_t)(t + 1) * kstep;
            const char* a2 = last ? nA : cA + (size_t)(t + 2) * kstep; const char* b2 = last ? nB : cB + (size_t)(t + 2) * kstep;
            const char* a3 = a2 + kstep; const char* b3 = b2 + kstep;
            if (last && has_next) S.a_ready(nxt);
            if constexpr (SP2) {
            PG8_LDB(B0, 0, 0); PG8_LDB(B1, 0, 1); PG8_SCHED; PG8_LDA(At, 0, 0); PG8_STAGE(PG8_SA(1, 1), a1 + hstep, voffA);
            PG8_WAIT_V(8); PG8_WAIT_L(0); PG8_BAR; PG8_MMA(0, 0, At, B0); PG8_MMA(0, 1, At, B1); PG8_BAR; PG8_SCHED;
            PG8_LDA(At, 0, 1); PG8_STAGE(PG8_SB(0, 0), b2, voffB); PG8_STAGE(PG8_SB(0, 1), b2 + hstep, voffB); PG8_STAGE(PG8_SA(0, 0), a2, voffA);
            PG8_WAIT_V(8); PG8_WAIT_L(0); PG8_BAR; PG8_MMA(1, 0, At, B0); PG8_MMA(1, 1, At, B1); PG8_BAR; PG8_SCHED;
            PG8_LDB(B0, 1, 0); PG8_LDB(B1, 1, 1); PG8_SCHED; PG8_LDA(At, 1, 0); PG8_STAGE(PG8_SA(0, 1), a2 + hstep, voffA);
            PG8_WAIT_V(8); PG8_WAIT_L(0); PG8_BAR; PG8_MMA(0, 0, At, B0); PG8_MMA(0, 1, At, B1); PG8_BAR; PG8_SCHED;
            PG8_LDA(At, 1, 1); PG8_STAGE(PG8_SB(1, 0), b3, voffB); PG8_STAGE(PG8_SB(1, 1), b3 + hstep, voffB); PG8_STAGE(PG8_SA(1, 0), a3, voffA);
            PG8_WAIT_V(8); PG8_WAIT_L(0); PG8_BAR; PG8_MMA(1, 0, At, B0); PG8_MMA(1, 1, At, B1); PG8_BAR; PG8_SCHED;
            } else {
            PG8_LDB(B0, 0, 0); PG8_SCHED; PG8_LDA(At, 0, 0); PG8_STAGE(PG8_SA(1, 1), a1 + hstep, voffA);
            PG8_WAIT_L(8); PG8_BAR; PG8_WAIT_L(0); PG8_MMA(0, 0, At, B0); PG8_BAR; PG8_SCHED;
            PG8_LDB(B1, 0, 1); PG8_STAGE(PG8_SB(0, 0), b2, voffB);
            PG8_BAR; PG8_WAIT_L(0); PG8_MMA(0, 1, At, B1); PG8_BAR;
            PG8_LDA(At, 0, 1); PG8_STAGE(PG8_SA(0, 0), a2, voffA);
            PG8_BAR; PG8_WAIT_L(0); PG8_MMA(1, 0, At, B0); PG8_BAR; PG8_SCHED;
            PG8_STAGE(PG8_SB(0, 1), b2 + hstep, voffB);
            PG8_WAIT_V(6); PG8_BAR; PG8_MMA(1, 1, At, B1); PG8_BAR;
            PG8_LDB(B0, 1, 0); PG8_SCHED; PG8_LDA(At, 1, 0); PG8_STAGE(PG8_SA(0, 1), a2 + hstep, voffA);
            PG8_WAIT_L(8); PG8_BAR; PG8_WAIT_L(0); PG8_MMA(0, 0, At, B0); PG8_BAR; PG8_SCHED;
            PG8_LDB(B1, 1, 1); PG8_STAGE(PG8_SB(1, 0), b3, voffB);
            PG8_BAR; PG8_WAIT_L(0); PG8_MMA(0, 1, At, B1); PG8_BAR;
            PG8_LDA(At, 1, 1); PG8_STAGE(PG8_SA(1, 0), a3, voffA);
            PG8_BAR; PG8_WAIT_L(0); PG8_MMA(1, 0, At, B0); PG8_BAR; PG8_SCHED;
            PG8_STAGE(PG8_SB(1, 1), b3 + hstep, voffB);
            PG8_WAIT_V(6); PG8_BAR; PG8_MMA(1, 1, At, B1); PG8_BAR;
            }
        }
        if constexpr (ALIGN_EPI) { if (wr == 0) PG8_BAR; }
        f32x4 bvn[2][2]; if constexpr (Epi::INIT == 1) { if (has_next) E.bias_load(bvn, nxt, wc, fq); }
        if constexpr (!Epi::AFTER_DRAIN) { E(acc, cur, wr, wc, fr, fq); S.done(cur); }
        if (!has_next) break;
        if constexpr (!Epi::ACC_CHAIN) {
#pragma unroll
        for (int a = 0; a < 2; ++a)
#pragma unroll
            for (int b = 0; b < 2; ++b)
#pragma unroll
                for (int m = 0; m < 4; ++m)
#pragma unroll
                    for (int n = 0; n < 2; ++n) { if constexpr (Epi::INIT == 1) acc[a][b][m][n] = bvn[b][n]; else acc[a][b][m][n] = (f32x4){0.f, 0.f, 0.f, 0.f}; }
        if constexpr (Epi::INIT == 2) E.tile_init(acc, nxt, wr, wc, fr, fq);
        }
        cur = nxt; cA = nA; cB = nB; ++ui;
        if constexpr (ALIGN_EPI) { if (wr == 1) PG8_BAR; }
    }
    PG8_WAIT_V(0);
    if constexpr (!ALIGN_EPI) { if (wr == 0) PG8_BAR; }
    PG8_BAR;
    if constexpr (Epi::AFTER_DRAIN) { E.fused(acc, cur, wr, wc, fr, fq, lds, wid, lane); S.done(cur); }
#undef PG8_SA
#undef PG8_SB
#undef PG8_STAGE
#undef PG8_LDA
#undef PG8_LDB
#undef PG8_MMA
#undef PG8_WAIT_V
#undef PG8_WAIT_L
#undef PG8_BAR
#undef PG8_SCHED
}
typedef int v8i_t __attribute__((ext_vector_type(8)));
template <class Epi, class Sched, bool ALIGN_EPI = false, bool SP2 = false>
__device__ __forceinline__ void gemm_phase_f8(PG8_LAS unsigned char* lds, const Gemm g, const Sched& S, const Epi& E) {
    int tid = threadIdx.x; asm volatile("" : "+v"(tid));
    const int wid = __builtin_amdgcn_readfirstlane(tid >> 6), lane = tid & 63, wr = wid >> 2, wc = wid & 3, fr = lane & 15, fq = lane >> 4;
    const int K = g.K, nt = K / BK;
    unsigned voffA[2], voffB[2];
#pragma unroll
    for (int i = 0; i < 2; ++i) { int R, C; stage_rc(tid * 16 + i * 8192, R, C); const int Rb = Epi::PERM ? ((R & ~31) + perm32(R & 31)) : R;
        voffA[i] = (unsigned)(R * K + C) * 2u; voffB[i] = (unsigned)(Rb * K + C) * 2u; }
    const size_t kstep = (size_t)(BK * 2);
    const size_t hstep = (size_t)HALF * K * 2;
    const unsigned ldsw = (unsigned)wid * 1024u;
    const int aoff = lds_byte(wr * 64 + fr, fq * 16), boff = lds_byte(wc * 32 + fr, fq * 16);
#define PG8_SA(b, h) (((b) * 2 + (h)) * HTB)
#define PG8_SB(b, h) ((4 + (b) * 2 + (h)) * HTB)
#define PG8_STAGE(bufoff, gbase, voff) do { _Pragma("unroll") for (int _i = 0; _i < 2; ++_i) \
        __builtin_amdgcn_global_load_lds((const unsigned*)((const char*)(gbase) + (voff)[_i]), (PG8_LAS unsigned*)(lds + (bufoff) + ldsw + _i * 8192), 16, 0, 0); } while (0)
#define PG8_STAGE_A(bufoff, gbase, h) do { if constexpr (Sched::GATHER_A) { PG8_STAGE(bufoff, gbase, goff[h]); } else { PG8_STAGE(bufoff, (gbase) + (size_t)(h) * hstep, voffA); } } while (0)
#define PG8_LDA(dst, b, h) do { _Pragma("unroll") for (int m = 0; m < 4; ++m) dst[m] = *(const PG8_LAS v8i_t*)(lds + PG8_SA(b, h) + aoff + m * 2048); } while (0)
#define PG8_LDB(dst, b, h) do { _Pragma("unroll") for (int n = 0; n < 2; ++n) dst[n] = *(const PG8_LAS v8i_t*)(lds + PG8_SB(b, h) + boff + n * 2048); } while (0)
#define PG8_F8(x) (x)
#define PG8_MMA(ai, bj, At, Bt) do { __builtin_amdgcn_s_setprio(1); _Pragma("unroll") for (int m = 0; m < 4; ++m) _Pragma("unroll") for (int n = 0; n < 2; ++n) \
        asm volatile("v_mfma_scale_f32_16x16x128_f8f6f4 %0, %1, %2, %0, %3, %4 op_sel_hi:[0,0,0]" : "+v"(acc[ai][bj][m][n]) : "v"(Bt[n]), "v"(At[m]), "v"(sc_w), "v"(sc_x)); __builtin_amdgcn_s_setprio(0); } while (0)
#define PG8_WAIT_V(n) asm volatile("s_waitcnt vmcnt(" #n ")" ::: "memory")
#define PG8_WAIT_L(n) asm volatile("s_waitcnt lgkmcnt(" #n ")" ::: "memory")
#define PG8_BAR __builtin_amdgcn_s_barrier()
#define PG8_SCHED __builtin_amdgcn_sched_barrier(0)
    const int sc_w = g.scale_b, sc_x = g.scale_a;
    Unit cur, nxt; int ui = 0;
    if (!S.next(0, cur)) return;
    f32x4 acc[2][2][4][2];
    f32x4 bv0[2][2];
    if constexpr (Epi::INIT == 1) E.bias_load(bv0, cur, wc, fq);
#pragma unroll
    for (int a = 0; a < 2; ++a)
#pragma unroll
        for (int b = 0; b < 2; ++b)
#pragma unroll
            for (int m = 0; m < 4; ++m)
#pragma unroll
                for (int n = 0; n < 2; ++n) { if constexpr (Epi::INIT == 1) acc[a][b][m][n] = bv0[b][n]; else acc[a][b][m][n] = (f32x4){0.f, 0.f, 0.f, 0.f}; }
    if constexpr (Epi::INIT == 2) E.tile_init(acc, cur, wr, wc, fr, fq);
    v8i_t At[4], B0[2], B1[2];
    const char* cA = cur.a; const char* cB = cur.b;
    unsigned goff[2][2]; int Rg[2], Cg[2];
    if constexpr (Sched::GATHER_A) {
#pragma unroll
        for (int i = 0; i < 2; ++i) { stage_rc(tid * 16 + i * 8192, Rg[i], Cg[i]); }
        const int* ix = S.idx(cur);
#pragma unroll
        for (int h = 0; h < 2; ++h)
#pragma unroll
            for (int i = 0; i < 2; ++i) goff[h][i] = (unsigned)ix[h * HALF + Rg[i]] * (unsigned)(K * 2) + (unsigned)(Cg[i] * 2);
    }
#define PG8_VA(h) goff[h]
#define PG8_AH(h) (Sched::GATHER_A ? (size_t)0 : (size_t)(h) * hstep)
    S.a_ready(cur);
    if constexpr (SP2) {
        PG8_STAGE(PG8_SB(0, 0), cB, voffB); PG8_STAGE(PG8_SB(0, 1), cB + hstep, voffB); PG8_STAGE_A(PG8_SA(0, 0), cA, 0); PG8_STAGE_A(PG8_SA(0, 1), cA, 1);
        if (wr == 1) PG8_BAR;
        PG8_WAIT_V(2); PG8_BAR;
        PG8_STAGE(PG8_SB(1, 0), cB + kstep, voffB); PG8_STAGE_A(PG8_SA(1, 0), cA + kstep, 0); PG8_STAGE(PG8_SB(1, 1), cB + hstep + kstep, voffB);
        PG8_WAIT_V(6); PG8_BAR;
    } else {
        PG8_STAGE(PG8_SB(0, 0), cB, voffB); PG8_STAGE_A(PG8_SA(0, 0), cA, 0); PG8_STAGE(PG8_SB(0, 1), cB + hstep, voffB); PG8_STAGE_A(PG8_SA(0, 1), cA, 1);
        if (wr == 1) PG8_BAR;
        PG8_WAIT_V(4); PG8_BAR;
        PG8_STAGE(PG8_SB(1, 0), cB + kstep, voffB); PG8_STAGE_A(PG8_SA(1, 0), cA + kstep, 0); PG8_STAGE(PG8_SB(1, 1), cB + hstep + kstep, voffB);
        PG8_WAIT_V(6); PG8_BAR;
    }
    for (;;) {
        const bool has_next = S.next(ui + 1, nxt);
        if constexpr (Sched::GATHER_A) { if (has_next && wid < 4) __builtin_amdgcn_global_load_lds((const unsigned*)(S.idx(nxt) + wid * 64 + lane), (PG8_LAS unsigned*)(lds + LDS_IDX + wid * 256), 4, 0, 0); }
        const char* nA = has_next ? nxt.a : cA; const char* nB = has_next ? nxt.b : cB;
#pragma unroll 1
        for (int t = 0; t < nt; t += 2) {
            const bool last = (t == nt - 2);
            const char* a1 = cA + (size_t)(t + 1) * kstep;
            const char* a2 = last ? nA : cA + (size_t)(t + 2) * kstep; const char* b2 = last ? nB : cB + (size_t)(t + 2) * kstep;
            const char* a3 = a2 + kstep; const char* b3 = b2 + kstep;
            if (last && has_next) S.a_ready(nxt);
            if constexpr (SP2) {
            PG8_LDB(B0, 0, 0); PG8_LDB(B1, 0, 1); PG8_SCHED; PG8_LDA(At, 0, 0); PG8_STAGE_A(PG8_SA(1, 1), a1, 1);
            if constexpr (Sched::GATHER_A) { if (last && has_next) {
                const PG8_LAS int* ixl = (const PG8_LAS int*)(lds + LDS_IDX);
#pragma unroll
                for (int h = 0; h < 2; ++h)
#pragma unroll
                    for (int i = 0; i < 2; ++i) goff[h][i] = (unsigned)ixl[h * HALF + Rg[i]] * (unsigned)(K * 2) + (unsigned)(Cg[i] * 2); } }
            PG8_WAIT_V(8); PG8_WAIT_L(0); PG8_BAR; PG8_MMA(0, 0, At, B0); PG8_MMA(0, 1, At, B1); PG8_BAR; PG8_SCHED;
            PG8_LDA(At, 0, 1); PG8_STAGE(PG8_SB(0, 0), b2, voffB); PG8_STAGE(PG8_SB(0, 1), b2 + hstep, voffB); PG8_STAGE_A(PG8_SA(0, 0), a2, 0);
            PG8_WAIT_V(8); PG8_WAIT_L(0); PG8_BAR; PG8_MMA(1, 0, At, B0); PG8_MMA(1, 1, At, B1); PG8_BAR; PG8_SCHED;
            PG8_LDB(B0, 1, 0); PG8_LDB(B1, 1, 1); PG8_SCHED; PG8_LDA(At, 1, 0); PG8_STAGE_A(PG8_SA(0, 1), a2, 1);
            PG8_WAIT_V(8); PG8_WAIT_L(0); PG8_BAR; PG8_MMA(0, 0, At, B0); PG8_MMA(0, 1, At, B1); PG8_BAR; PG8_SCHED;
            PG8_LDA(At, 1, 1); PG8_STAGE(PG8_SB(1, 0), b3, voffB); PG8_STAGE(PG8_SB(1, 1), b3 + hstep, voffB); PG8_STAGE_A(PG8_SA(1, 0), a3, 0);
            PG8_WAIT_V(8); PG8_WAIT_L(0); PG8_BAR; PG8_MMA(1, 0, At, B0); PG8_MMA(1, 1, At, B1); PG8_BAR; PG8_SCHED;
            } else {
            PG8_LDB(B0, 0, 0); PG8_SCHED; PG8_LDA(At, 0, 0); PG8_STAGE_A(PG8_SA(1, 1), a1, 1);
            PG8_WAIT_L(8); PG8_BAR; PG8_WAIT_L(0); PG8_MMA(0, 0, At, B0); PG8_BAR; PG8_SCHED;
            PG8_LDB(B1, 0, 1); PG8_STAGE(PG8_SB(0, 0), b2, voffB);
            PG8_BAR; PG8_WAIT_L(0); PG8_MMA(0, 1, At, B1); PG8_BAR;
            PG8_LDA(At, 0, 1); PG8_STAGE_A(PG8_SA(0, 0), a2, 0);
            PG8_BAR; PG8_WAIT_L(0); PG8_MMA(1, 0, At, B0); PG8_BAR; PG8_SCHED;
            PG8_STAGE(PG8_SB(0, 1), b2 + hstep, voffB);
            PG8_WAIT_V(6); PG8_BAR; PG8_MMA(1, 1, At, B1); PG8_BAR;
            PG8_LDB(B0, 1, 0); PG8_SCHED; PG8_LDA(At, 1, 0); PG8_STAGE_A(PG8_SA(0, 1), a2, 1);
            PG8_WAIT_L(8); PG8_BAR; PG8_WAIT_L(0); PG8_MMA(0, 0, At, B0); PG8_BAR; PG8_SCHED;
            PG8_LDB(B1, 1, 1); PG8_STAGE(PG8_SB(1, 0), b3, voffB);
            PG8_BAR; PG8_WAIT_L(0); PG8_MMA(0, 1, At, B1); PG8_BAR;
            PG8_LDA(At, 1, 1); PG8_STAGE_A(PG8_SA(1, 0), a3, 0);
            PG8_BAR; PG8_WAIT_L(0); PG8_MMA(1, 0, At, B0); PG8_BAR; PG8_SCHED;
            PG8_STAGE(PG8_SB(1, 1), b3 + hstep, voffB);
            PG8_WAIT_V(6); PG8_BAR; PG8_MMA(1, 1, At, B1); PG8_BAR;
            }
        }
        if constexpr (ALIGN_EPI) { if (wr == 0) PG8_BAR; }
        asm volatile("s_nop 15\n\ts_nop 7" ::: "memory"); __builtin_amdgcn_sched_barrier(0);
        f32x4 bvn[2][2]; if constexpr (Epi::INIT == 1) { if (has_next) E.bias_load(bvn, nxt, wc, fq); }
        if constexpr (!Epi::AFTER_DRAIN) { E(acc, cur, wr, wc, fr, fq); S.done(cur); }
        if (!has_next) break;
        if constexpr (!Epi::ACC_CHAIN) {
#pragma unroll
        for (int a = 0; a < 2; ++a)
#pragma unroll
            for (int b = 0; b < 2; ++b)
#pragma unroll
                for (int m = 0; m < 4; ++m)
#pragma unroll
                    for (int n = 0; n < 2; ++n) { if constexpr (Epi::INIT == 1) acc[a][b][m][n] = bvn[b][n]; else acc[a][b][m][n] = (f32x4){0.f, 0.f, 0.f, 0.f}; }
        if constexpr (Epi::INIT == 2) E.tile_init(acc, nxt, wr, wc, fr, fq);
        }
        cur = nxt; cA = nA; cB = nB; ++ui;
        if constexpr (ALIGN_EPI) { if (wr == 1) PG8_BAR; }
    }
    PG8_WAIT_V(0);
    if constexpr (!ALIGN_EPI) { if (wr == 0) PG8_BAR; }
    PG8_BAR;
    if constexpr (Epi::AFTER_DRAIN) { E.fused(acc, cur, wr, wc, fr, fq, lds, wid, lane); S.done(cur); }
#undef PG8_SA
#undef PG8_SB
#undef PG8_STAGE
#undef PG8_STAGE_A
#undef PG8_VA
#undef PG8_AH
#undef PG8_LDA
#undef PG8_LDB
#undef PG8_MMA
#undef PG8_F8
#undef PG8_WAIT_V
#undef PG8_WAIT_L
#undef PG8_BAR
#undef PG8_SCHED
}
}

typedef GAS unsigned gu32;
#define RLX_AGENT __ATOMIC_RELAXED, __HIP_MEMORY_SCOPE_AGENT
#define XB_TMO      128
#define XB_XCNT(j)  (256  + 64 * (j))
#define XB_XSUB(j)  (1280 + 64 * (j))
#define XB_XGEN(j)  (2304 + 64 * (j))
#define XB_TOP      3328
#define XB_TOPGEN   3392
#define XCD_BAR_WORDS 3456
#define XB_SPIN_CAP (1u << 26)

__device__ __forceinline__ unsigned xb_ld(unsigned* p)              { return __hip_atomic_load(p, __ATOMIC_RELAXED, __HIP_MEMORY_SCOPE_AGENT); }
__device__ __forceinline__ unsigned xb_add(unsigned* p, unsigned v) { return __hip_atomic_fetch_add(p, v, __ATOMIC_RELAXED, __HIP_MEMORY_SCOPE_AGENT); }
__device__ __forceinline__ unsigned xb_xcc_id() { return (unsigned)__builtin_amdgcn_s_getreg((3 << 11) | 20) & 0xFu; }
#define XB_SPIN(cond, bar) do { unsigned _sp = 0; while (cond) { __builtin_amdgcn_s_sleep(1); \
    if ((++_sp & 255u) == 0u) { if (xb_ld(&(bar)[XB_TMO])) break; if (_sp > XB_SPIN_CAP) { atomicAdd(&(bar)[XB_TMO], 1u); break; } } } } while (0)

struct XcdBarrier {
    unsigned* bar; unsigned x;
    volatile LAS unsigned* st;
};

__device__ __forceinline__ XcdBarrier xcd_barrier_post(unsigned* bar, volatile LAS unsigned* st) {
    XcdBarrier b; b.bar = bar; b.x = xb_xcc_id(); b.st = st;
    if (threadIdx.x == 0) (void)xb_add(&bar[XB_XCNT(b.x)], 1u);
    return b;
}
__device__ __forceinline__ void xcd_barrier_complete(unsigned* bar, unsigned x, unsigned& nloc, unsigned& nx) {
    const unsigned G = gridDim.x * gridDim.y * gridDim.z;
    unsigned sum, cnt, mine, sp = 0u;
    for (;;) {
        sum = 0u; cnt = 0u; mine = 0u;
#pragma unroll
        for (unsigned j = 0; j < 16; ++j) { const unsigned c = xb_ld(&bar[XB_XCNT(j)]); sum += c; cnt += (c > 0u) ? 1u : 0u; mine = (j == x) ? c : mine; }
        if (sum == G) break;
        __builtin_amdgcn_s_sleep(1);
        if ((++sp & 255u) == 0u) { if (xb_ld(&bar[XB_TMO])) break; if (sp > XB_SPIN_CAP) { atomicAdd(&bar[XB_TMO], 1u); break; } }
    }
    nloc = mine > 0u ? mine : 1u; nx = cnt > 0u ? cnt : 1u;
}

__device__ __forceinline__ void xcd_barrier(const XcdBarrier& b) {
    asm volatile("s_waitcnt vmcnt(0)" ::: "memory");
    __syncthreads();
    if (threadIdx.x == 0) {
        unsigned* bar = b.bar;
        __builtin_amdgcn_s_waitcnt(0);
        unsigned nloc = b.st[0], nx = b.st[1];
        if (nloc == 0u) { xcd_barrier_complete(bar, b.x, nloc, nx); b.st[0] = nloc; b.st[1] = nx; }
        const unsigned old = xb_add(&bar[XB_XSUB(b.x)], 1u);
        const unsigned gen = old / nloc;
        if (old + 1u == (gen + 1u) * nloc) {
            __builtin_amdgcn_fence(__ATOMIC_RELEASE, "agent");
            asm volatile("s_waitcnt vmcnt(0)" ::: "memory");
            const unsigned og = xb_add(&bar[XB_TOP], 1u);
            const unsigned tg = og / nx;
            if (og + 1u == (tg + 1u) * nx) xb_add(&bar[XB_TOPGEN], 1u);
            else XB_SPIN(xb_ld(&bar[XB_TOPGEN]) == tg, bar);
            __builtin_amdgcn_fence(__ATOMIC_ACQUIRE, "");
            xb_add(&bar[XB_XGEN(b.x)], 1u);
            asm volatile("s_waitcnt vmcnt(0)" ::: "memory");
        } else {
            XB_SPIN(xb_ld(&bar[XB_XGEN(b.x)]) == gen, bar);
            __builtin_amdgcn_fence(__ATOMIC_ACQUIRE, "");
            asm volatile("s_waitcnt vmcnt(0)" ::: "memory");
        }
    }
    __syncthreads();
}


template <bool BG, class ArgsT> __device__ __forceinline__ void xcd_barrier_bg(const XcdBarrier& b, const ArgsT& A, LAS unsigned char* lds, volatile LAS unsigned* MISC);
__device__ __forceinline__ int fresh_tid() { int t = threadIdx.x; asm volatile("" : "+v"(t)); return t; }
#define FRESH_IDS() const int tid = fresh_tid(), lane = tid & 63, wave = __builtin_amdgcn_readfirstlane(tid >> 6); (void)tid; (void)lane; (void)wave
struct Args { const float* in[17]; float* out; unsigned char* ws; int ph_lo, ph_hi, li, pad; };

__device__ __forceinline__ void p0_transpose_item(const float* W, int K, int N, bf16_t* WT, LAS float* scr, int item, int lane) {
    (void)scr;
    const int nblk = N / 32, kb = item / nblk, nb = item % nblk, k0 = 64 * kb + 8 * (lane >> 3), n0 = 32 * nb + 4 * (lane & 7);
    f32x4 v[8];
#pragma unroll
    for (int j2 = 0; j2 < 8; ++j2) v[j2] = *(const GAS f32x4*)(W + (size_t)(k0 + j2) * N + n0);
#pragma unroll
    for (int i2 = 0; i2 < 4; ++i2) { u32x4 o; o.x = pk2(v[0][i2], v[1][i2]); o.y = pk2(v[2][i2], v[3][i2]); o.z = pk2(v[4][i2], v[5][i2]); o.w = pk2(v[6][i2], v[7][i2]);
        *(GAS u32x4*)(WT + (size_t)(n0 + i2) * K + k0) = o; }
}
__device__ __forceinline__ void p0_transpose_item_f8(const float* W, int K, int N, unsigned char* WT8, LAS float* scr, int item, int lane, float wscale, int nblk_sub = 0) {
    (void)scr;
    const int nblk = nblk_sub ? nblk_sub : N / 32, kb = (item / (2 * nblk)) * 2 + (item & 1), nb = (item >> 1) % nblk, k0 = 64 * kb + 8 * (lane >> 3), n0 = 32 * nb + 4 * (lane & 7);
    f32x4 v[8];
#pragma unroll
    for (int j2 = 0; j2 < 8; ++j2) v[j2] = *(const GAS f32x4*)(W + (size_t)(k0 + j2) * N + n0);
#pragma unroll
    for (int i = 0; i < 4; ++i) { u32x2 o; o.x = pk4_fp8(v[0][i] * wscale, v[1][i] * wscale, v[2][i] * wscale, v[3][i] * wscale); o.y = pk4_fp8(v[4][i] * wscale, v[5][i] * wscale, v[6][i] * wscale, v[7][i] * wscale);
        *(GAS u32x2*)(WT8 + (size_t)(n0 + i) * K + k0) = o; }
}
constexpr int BG_BATCH = 8, BG_I_UP1 = (DM / 64) * (UPW / 32), BG_I_DN1 = (DFF / 64) * (DM / 32), BG_I_UP = NEXP * BG_I_UP1, BG_TOTAL = BG_I_UP + NEXP * BG_I_DN1;
static_assert(BG_I_UP % BG_BATCH == 0 && BG_TOTAL % BG_BATCH == 0, "batches do not straddle the up/down boundary");
__device__ __forceinline__ void bg_item(const Args& A, int it, LAS float* scr, int lane) {
    if (it < BG_I_UP) { const int e = it / BG_I_UP1;
#if MK_FP8_UP
        p0_transpose_item_f8(A.in[11] + (size_t)e * DM * UPW, DM, UPW, (unsigned char*)(A.ws + WS_WUPT) + (size_t)e * DM * UPW, scr, it % BG_I_UP1, lane, W8_SCALE);
#else
        p0_transpose_item(A.in[11] + (size_t)e * DM * UPW, DM, UPW, (bf16_t*)(A.ws + WS_WUPT) + (size_t)e * DM * UPW, scr, it % BG_I_UP1, lane);
#endif
    }
    else { const int r = it - BG_I_UP, e = r / BG_I_DN1;
#if MK_FP8_DN
        p0_transpose_item_f8(A.in[13] + (size_t)e * DFF * DM, DFF, DM, (unsigned char*)(A.ws + WS_WDNT) + (size_t)e * DFF * DM, scr, r % BG_I_DN1, lane, W8_SCALE);
#else
        p0_transpose_item(A.in[13] + (size_t)e * DFF * DM, DFF, DM, (bf16_t*)(A.ws + WS_WDNT) + (size_t)e * DFF * DM, scr, r % BG_I_DN1, lane);
#endif
    }
}
__device__ __forceinline__ bool bg_step(const Args& A, volatile LAS int* st, LAS float* scr, int lane, int limit) {
    int cur = st[0], end = st[1];
    if (cur >= end) {
        if (cur >= BG_TOTAL) return false;
        int start = 0; if (lane == 0) start = __hip_atomic_fetch_add((int*)(A.ws + WS_CTL) + CW_BGQ, BG_BATCH, __ATOMIC_RELAXED, __HIP_MEMORY_SCOPE_AGENT);
        start = __builtin_amdgcn_readfirstlane(start);
        if (start >= BG_TOTAL) { if (lane == 0) { st[0] = BG_TOTAL; st[1] = BG_TOTAL; } return false; }
        cur = start; end = start + BG_BATCH; if (lane == 0) { st[0] = cur; st[1] = end; }
    }
    if (cur >= limit) return false;
    bg_item(A, cur, scr, lane);
    if (lane == 0) st[0] = cur + 1;
    return true;
}
__device__ __forceinline__ void phase_prologue(const Args& A, LAS unsigned char* lds, int gw, int NGW, int lane, int wave) {
    unsigned char* ws = A.ws;
    LAS float* scr = (LAS float*)(lds + wave * 16384);
    constexpr int I_IN = (DM / 64) * (INW / 32), I_BS = (SBW / 64) * (DM / 32), I_WO = (DM / 64) * (DM / 32), I_RW = (DM / 64) * (NEXP / 32);
    constexpr int I_UP1 = (DM / 64) * (UPW / 32), I_DN1 = (DFF / 64) * (DM / 32), I_UP = NEXP * I_UP1, I_DN = NEXP * I_DN1;
    constexpr int NITEMS = I_IN + 2 * I_BS + I_WO + I_RW + (MK_BG ? 0 : I_UP + I_DN);
    for (int it = gw; it < NITEMS; it += NGW) {
        int r = it;
#if MK_FP8_GATES
        if (r < I_IN) { constexpr int NB16 = 3072 / 32, NB8 = (INW - 3072) / 32, I16 = (DM / 64) * NB16;
            if (r < I16) { const int kb = r / NB16, nb = r % NB16; p0_transpose_item(A.in[1], DM, INW, (bf16_t*)(ws + WS_WINT), scr, kb * (INW / 32) + nb, lane); }
            else p0_transpose_item_f8(A.in[1] + 3072, DM, INW, (unsigned char*)(ws + WS_WINT8), scr, r - I16, lane, W8_SCALE, NB8);
            continue; } r -= I_IN;
#else
        if (r < I_IN) { p0_transpose_item(A.in[1], DM, INW, (bf16_t*)(ws + WS_WINT), scr, r, lane); continue; } r -= I_IN;
#endif
        if (r < I_BS) { p0_transpose_item(A.in[4], SBW, DM, (bf16_t*)(ws + WS_WBST), scr, r, lane); continue; } r -= I_BS;
        if (r < I_BS) { p0_transpose_item(A.in[5], HGW, DM, (bf16_t*)(ws + WS_WBHT), scr, r, lane); continue; } r -= I_BS;
        if (r < I_WO) { p0_transpose_item(A.in[6], DM, DM, (bf16_t*)(ws + WS_WOT), scr, r, lane); continue; } r -= I_WO;
        if (r < I_RW) { p0_transpose_item(A.in[9], DM, NEXP, (bf16_t*)(ws + WS_RWT), scr, r, lane); continue; } r -= I_RW;
        if (r < I_UP) { const int e = r / I_UP1; p0_transpose_item(A.in[11] + (size_t)e * DM * UPW, DM, UPW, (bf16_t*)(ws + WS_WUPT) + (size_t)e * DM * UPW, scr, r % I_UP1, lane); continue; } r -= I_UP;
        { const int e = r / I_DN1; p0_transpose_item(A.in[13] + (size_t)e * DFF * DM, DFF, DM, (bf16_t*)(ws + WS_WDNT) + (size_t)e * DFF * DM, scr, r % I_DN1, lane); }
    }
    bf16_t* XB = (bf16_t*)(ws + WS_XB);
    for (int m0 = gw; m0 < NTOK; m0 += MK_P0_ROWS * NGW) {
        f32x4 xv[MK_P0_ROWS][4];
#pragma unroll
        for (int q = 0; q < MK_P0_ROWS; ++q) { const int m = m0 + q * NGW; const GAS f32x4* xr = (const GAS f32x4*)(A.in[0] + (size_t)(m < NTOK ? m : m0) * DM) + lane;
#pragma unroll
            for (int j = 0; j < 4; ++j) xv[q][j] = xr[64 * j]; }
#pragma unroll
        for (int q = 0; q < MK_P0_ROWS; ++q) { const int m = m0 + q * NGW; if (m < NTOK) { GAS u32x2* o8 = (GAS u32x2*)(XB + (size_t)m * DM) + lane;
#pragma unroll
            for (int j = 0; j < 4; ++j) { const f32x4 v = xv[q][j]; u32x2 w; w.x = pk2(v[0], v[1]); w.y = pk2(v[2], v[3]); o8[64 * j] = w;
#if MK_FP8_GATES
                ((GAS unsigned*)((unsigned char*)(ws + WS_XB8) + (size_t)m * DM))[lane + 64 * j] = pk4_fp8(v[0], v[1], v[2], v[3]);
#endif
            } } }
    }
    if (gw < 8) { const int c = gw * 64 + lane; const float l0 = A.in[2][c], l1 = A.in[2][HGW + c]; ((float*)(ws + WS_LB))[c] = 1.0f / (1.0f + expf(l1 - l0)); }
}

__device__ __forceinline__ void attn_naive_unit(const bf16_t* __restrict__ Q, const bf16_t* __restrict__ K, const bf16_t* __restrict__ V, bf16_t* __restrict__ O, int bh, int qb, int lane) {
    const int b = bh >> 3, h = bh & 7, t = qb * 64 + lane; const size_t rowbase = (size_t)b * SEQ;
    float q[64], o[64];
    { const bf16_t* qp = Q + (rowbase + t) * SBW + h * SBD;
#pragma unroll
      for (int d = 0; d < 64; ++d) { q[d] = bf2f(qp[d]); o[d] = 0.f; } }
    float R = 1.0f;
    for (int s = qb * 64 + 63; s >= 0; --s) {
        const bf16_t* kr = K + (rowbase + s) * SBW + h * SBD; const bf16_t* vr = V + (rowbase + s) * SBW + h * SBD;
        float z = 0.f;
#pragma unroll
        for (int d = 0; d < 64; ++d) z += q[d] * bf2f(kr[d]);
        const bool valid = s < t;
        const float ez = expf(fminf(z, 60.0f)), keep = 1.0f / (1.0f + ez);
        const float a = valid ? ez * keep * R : 0.f;
        R = valid ? R * keep : R;
#pragma unroll
        for (int d = 0; d < 64; ++d) o[d] += a * bf2f(vr[d]);
    }
    bf16_t* op = O + (rowbase + t) * SBW + h * SBD;
#pragma unroll
    for (int d = 0; d < 64; ++d) op[d] = (bf16_t)f2bf(o[d]);
}
__device__ __forceinline__ void hgrn_naive_block(const bf16_t* __restrict__ HQ, const bf16_t* __restrict__ HK, const float* __restrict__ LOGF, const bf16_t* __restrict__ HV, float* __restrict__ ORAW,
                                                 LAS unsigned char* lds, int blk, int tid) {
    const int grp = tid >> 7, v = tid & 127, bh = blk * 4 + grp, b = bh >> 2, hh = bh & 3;
    LAS float* sf = (LAS float*)lds + grp * 384; LAS float* sk = sf + 128; LAS float* sq = sf + 256;
    float S[128];
#pragma unroll
    for (int k = 0; k < 128; ++k) S[k] = 0.f;
    for (int t = 0; t < SEQ; ++t) {
        const size_t base = ((size_t)b * SEQ + t) * HGW + hh * HGD;
        sf[v] = expf(LOGF[base + v]); sk[v] = bf2f(HK[base + v]); sq[v] = bf2f(HQ[base + v]);
        const float vv = bf2f(HV[base + v]);
        __syncthreads();
        float o = 0.f;
#pragma unroll
        for (int k = 0; k < 128; ++k) { S[k] = sf[k] * S[k] + sk[k] * vv; o += sq[k] * S[k]; }
        ORAW[base + v] = o;
        __syncthreads();
    }
}
__device__ __forceinline__ void hgrn_post_item(const float* __restrict__ ORAW, const bf16_t* __restrict__ HG, const float* __restrict__ norm_g, bf16_t* __restrict__ OHG, int item, int lane) {
    const size_t base = (size_t)item * HGD; const int c0 = (item & 3) * HGD;
    const float x0 = ORAW[base + lane], x1 = ORAW[base + 64 + lane];
    const float r = 1.0f / sqrtf(wave_sum(x0 * x0 + x1 * x1) * (1.0f / HGD) + RMS_EPS);
    OHG[base + lane] = (bf16_t)f2bf(x0 * r * norm_g[c0 + lane] * bf2f(HG[base + lane]));
    OHG[base + 64 + lane] = (bf16_t)f2bf(x1 * r * norm_g[c0 + 64 + lane] * bf2f(HG[base + 64 + lane]));
}

__device__ __forceinline__ int crow(int r, int hi) { return (r & 3) + 8 * (r >> 2) + 4 * hi; }
typedef short v4i16_t __attribute__((ext_vector_type(4)));
__device__ __forceinline__ v4i16_t tr16(LAS const unsigned char* p) { return __builtin_amdgcn_ds_read_tr16_b64_v4i16((LAS v4i16_t*)p); }
__device__ __forceinline__ bf16x8 cat8(v4i16_t lo, v4i16_t hi) { return (bf16x8){lo[0], lo[1], lo[2], lo[3], hi[0], hi[1], hi[2], hi[3]}; }
__device__ __forceinline__ bf16x8 pack8(const f32x16& p, int base) {
    u32x4 w; w.x = pg8::cvt_pk_bf16(p[base + 0], p[base + 1]); w.y = pg8::cvt_pk_bf16(p[base + 2], p[base + 3]); w.z = pg8::cvt_pk_bf16(p[base + 4], p[base + 5]); w.w = pg8::cvt_pk_bf16(p[base + 6], p[base + 7]);
    return __builtin_bit_cast(bf16x8, w);
}
__device__ __forceinline__ float xhalf(float v) {
    auto rr = __builtin_amdgcn_permlane32_swap(__float_as_uint(v), __float_as_uint(v), false, false);
    return __uint_as_float((threadIdx.x & 32) ? rr[0] : rr[1]);
}
#define WAIT_ALL_BAR() asm volatile("s_waitcnt vmcnt(0) lgkmcnt(0)\n\ts_barrier" ::: "memory")

constexpr int AT_K = 0, AT_V = 16384, AT_OST = 32768, AT_Q = 65536, AT_FLAG = 65600;
__device__ __forceinline__ void attn_unit(const bf16_t* Q, const bf16_t* K, const bf16_t* V, bf16_t* O, int bh, int qb, LAS unsigned char* lds, int lane, int wid) {
    const int b = bh >> 3, h = bh & 7, r32 = lane & 31, hi = lane >> 5;
    const size_t rowbase = (size_t)b * SEQ; const int q0 = qb * 256, qw0 = q0 + wid * 32;
    bf16x8 qr[4];
    { const bf16_t* qp = Q + (rowbase + qw0 + r32) * SBW + h * SBD + hi * 8;
#pragma unroll
      for (int d0 = 0; d0 < 4; ++d0) qr[d0] = *(const bf16x8*)(qp + d0 * 16); }
    f32x16 o0 = {}, o1 = {}; float R = 1.0f;
    const int NT = 4 * qb + 4;
    const bf16_t* ksrc = K + (rowbase + lane) * SBW + h * SBD + wid * 8;
    const bf16_t* vsrc = V + (rowbase + 16 * (wid & 3) + (lane >> 2)) * SBW + h * SBD + (wid >> 2) * 32 + (lane & 3) * 8;
    LAS unsigned char* kdst = lds + AT_K + wid * 1024; LAS unsigned char* vdst = lds + AT_V + wid * 1024;
    const int vb = ((lane >> 4) & 1) * 32 + (lane & 3) * 8 + (4 * hi + ((lane & 15) >> 2)) * 64;
    { const size_t go = (size_t)(NT - 1) * 64 * SBW;
      __builtin_amdgcn_global_load_lds((const unsigned*)(ksrc + go), (LAS unsigned*)kdst, 16, 0, 0);
      __builtin_amdgcn_global_load_lds((const unsigned*)(vsrc + go), (LAS unsigned*)vdst, 16, 0, 0); }
    if (lane == 0) *(LAS int*)(lds + AT_FLAG + wid * 4) = 0;
    bool wz = false;
    for (int it = 0; it < NT; ++it) {
        const int kt = NT - 1 - it, slot = (it & 1) * 8192, k0 = kt * 64;
        WAIT_ALL_BAR();
        { const u32x4 f0 = *(const LAS u32x4*)(lds + AT_FLAG), f1 = *(const LAS u32x4*)(lds + AT_FLAG + 16);
          if (__builtin_amdgcn_readfirstlane((f0.x & f0.y & f0.z & f0.w & f1.x & f1.y & f1.z & f1.w) != 0u)) break; }
        if (it + 1 < NT) { const size_t go = (size_t)(kt - 1) * 64 * SBW;
            __builtin_amdgcn_global_load_lds((const unsigned*)(ksrc + go), (LAS unsigned*)(kdst + (slot ^ 8192)), 16, 0, 0);
            __builtin_amdgcn_global_load_lds((const unsigned*)(vsrc + go), (LAS unsigned*)(vdst + (slot ^ 8192)), 16, 0, 0); }
        if (k0 < qw0 + 31 && !wz) {
            f32x16 p0 = {}, p1 = {};
            const LAS unsigned char* kb = lds + AT_K + slot + hi * 1024 + r32 * 16;
#pragma unroll
            for (int d0 = 0; d0 < 4; ++d0) {
                const bf16x8 a0 = *(const LAS bf16x8*)(kb + d0 * 2048), a1 = *(const LAS bf16x8*)(kb + d0 * 2048 + 512);
                p0 = __builtin_amdgcn_mfma_f32_32x32x16_bf16(a0, qr[d0], p0, 0, 0, 0);
                p1 = __builtin_amdgcn_mfma_f32_32x32x16_bf16(a1, qr[d0], p1, 0, 0, 0);
            }
#pragma unroll
            for (int r = 0; r < 16; ++r) { p0[r] = __builtin_amdgcn_rcpf(1.0f + __builtin_amdgcn_exp2f(p0[r])); p1[r] = __builtin_amdgcn_rcpf(1.0f + __builtin_amdgcn_exp2f(p1[r])); }
            if (k0 + 63 >= qw0) {
                const int tq = qw0 + r32 - k0 - 4 * hi;
#pragma unroll
                for (int r = 0; r < 16; ++r) { const int kv = (r & 3) + 8 * (r >> 2); if (kv >= tq) p0[r] = 1.0f; if (kv + 32 >= tq) p1[r] = 1.0f; }
            }
            float gm[8], gp[8];
#pragma unroll
            for (int i = 0; i < 4; ++i) { gm[i] = (p0[4 * i] * p0[4 * i + 1]) * (p0[4 * i + 2] * p0[4 * i + 3]); gm[4 + i] = (p1[4 * i] * p1[4 * i + 1]) * (p1[4 * i + 2] * p1[4 * i + 3]); }
#pragma unroll
            for (int i = 0; i < 8; ++i) gp[i] = xhalf(gm[i]);
            float run = R, E[8];
#pragma unroll
            for (int i = 7; i >= 0; --i) {
                const float pre = hi ? 1.0f : gp[i], post = hi ? gp[i] : 1.0f;
                run *= pre; E[i] = run; run *= gm[i]; run *= post;
            }
            R = run;
#pragma unroll
            for (int i = 0; i < 4; ++i) {
                { float X = E[i];
#pragma unroll
                  for (int j = 3; j >= 0; --j) { const float s = p0[4 * i + j] * X; p0[4 * i + j] = X - s; X = s; } }
                { float X = E[4 + i];
#pragma unroll
                  for (int j = 3; j >= 0; --j) { const float s = p1[4 * i + j] * X; p1[4 * i + j] = X - s; X = s; } }
            }
            const bf16x8 pa0 = pack8(p0, 0), pa1 = pack8(p0, 8), pa2 = pack8(p1, 0), pa3 = pack8(p1, 8);
            const LAS unsigned char* vp = lds + AT_V + slot + vb;
#pragma unroll
            for (int d0 = 0; d0 < 2; ++d0) {
                f32x16 acc = d0 ? o1 : o0;
                acc = __builtin_amdgcn_mfma_f32_32x32x16_bf16(pa0, cat8(tr16(vp + d0 * 4096), tr16(vp + d0 * 4096 + 512)), acc, 0, 0, 0);
                acc = __builtin_amdgcn_mfma_f32_32x32x16_bf16(pa1, cat8(tr16(vp + d0 * 4096 + 1024), tr16(vp + d0 * 4096 + 1024 + 512)), acc, 0, 0, 0);
                acc = __builtin_amdgcn_mfma_f32_32x32x16_bf16(pa2, cat8(tr16(vp + d0 * 4096 + 2048), tr16(vp + d0 * 4096 + 2048 + 512)), acc, 0, 0, 0);
                acc = __builtin_amdgcn_mfma_f32_32x32x16_bf16(pa3, cat8(tr16(vp + d0 * 4096 + 3072), tr16(vp + d0 * 4096 + 3072 + 512)), acc, 0, 0, 0);
                if (d0) o1 = acc; else o0 = acc;
            }
            { const int allz = __all(R == 0.0f) ? 1 : 0; if (lane == 0) *(LAS int*)(lds + AT_FLAG + wid * 4) = allz; wz = allz != 0; }
        }
    }
    { LAS unsigned short* stg = (LAS unsigned short*)(lds + AT_OST + wid * 4096);
#pragma unroll
      for (int r = 0; r < 16; ++r) { const int orow = crow(r, hi); stg[orow * 64 + r32] = (unsigned short)f2bf(o0[r]); stg[orow * 64 + 32 + r32] = (unsigned short)f2bf(o1[r]); }
      LDS_WAIT();
      bf16_t* Ow = O + (rowbase + qw0) * SBW + h * SBD;
#pragma unroll
      for (int i = 0; i < 4; ++i) { const int row = i * 8 + (lane >> 3), ch = lane & 7; const u32x4 v = *(const LAS u32x4*)((LAS unsigned char*)stg + row * 128 + ch * 16); *(u32x4*)(Ow + (size_t)row * SBW + ch * 8) = v; } }
}

constexpr int HP_RD = 272, HP_TR = 320;
constexpr int HL_QT = 0, HL_KH = HL_QT + 64 * HP_RD, HL_KD = HL_KH + 64 * HP_RD, HL_VT = HL_KD + 64 * HP_TR, HL_SB = HL_VT + 64 * HP_TR, HL_DEC = HL_SB + 128 * HP_TR, HL_SEG = HL_DEC + 512, HL_END = HL_SEG + 8 * 128 * 4;
static_assert(HL_END <= LDS_SCRATCH, "HGRN LDS map");
constexpr int HG_GROUPS = 8, HG_CHUNKS = SEQ / 64 / HG_GROUPS;
#define LDS_BAR() asm volatile("s_waitcnt lgkmcnt(0)\n\ts_barrier" ::: "memory")
__device__ __forceinline__ void hgrn_unit_a(const bf16_t* HQ, const bf16_t* HK, const float* LOGF, const bf16_t* HV, float* ORAW, bf16_t* QC, float* DS, float* DG, int unit, LAS unsigned char* lds, int tid, int lane, int wid) {
    const int bh = unit >> 3, g = unit & 7, b = bh >> 2, hh = bh & 3, r32 = lane & 31, hi = lane >> 5, tb = wid >> 2, vj = wid & 3;
    const size_t row0 = (size_t)b * SEQ + (size_t)g * (SEQ / HG_GROUPS); const int cb = hh * HGD;
    const int kp = lane, seg = wid;
    const int vr = tid >> 3, vp8 = tid & 7;
    for (int i = tid; i < 128 * HP_TR / 16; i += NTHREADS) *(LAS u32x4*)(lds + HL_SB + i * 16) = (u32x4){0u, 0u, 0u, 0u};
    f32x16 S0 = {}, S1 = {};
    float gb0 = 0.f, gb1 = 0.f;
    f32x2_t lf[8]; unsigned qv[8], kv[8]; u32x4 vv0, vv1;
#define HG_LOAD(c) do { const size_t base_ = (row0 + (size_t)(c) * 64 + 8 * seg) * HGW + cb + 2 * kp; \
        _Pragma("unroll") for (int i = 0; i < 8; ++i) { lf[i] = *(const f32x2_t*)(LOGF + base_ + (size_t)i * HGW); qv[i] = *(const unsigned*)(HQ + base_ + (size_t)i * HGW); kv[i] = *(const unsigned*)(HK + base_ + (size_t)i * HGW); } \
        const bf16_t* vsrc_ = HV + (row0 + (size_t)(c) * 64 + vr) * HGW + cb + vp8 * 16; vv0 = *(const u32x4*)vsrc_; vv1 = *(const u32x4*)(vsrc_ + 8); } while (0)
    HG_LOAD(0);
    for (int c = 0; c < HG_CHUNKS; ++c) {
        float cs0[8], cs1[8]; { float a0 = 0.f, a1 = 0.f;
#pragma unroll
            for (int i = 0; i < 8; ++i) { a0 += lf[i].x; a1 += lf[i].y; cs0[i] = a0; cs1[i] = a1; } }
        *(LAS f32x2_t*)(lds + HL_SEG + (seg * 128 + 2 * kp) * 4) = (f32x2_t){cs0[7], cs1[7]};
        *(LAS u32x4*)(lds + HL_VT + vr * HP_TR + vp8 * 32) = vv0; *(LAS u32x4*)(lds + HL_VT + vr * HP_TR + vp8 * 32 + 16) = vv1;
        LDS_BAR();
        { float pre0 = 0.f, pre1 = 0.f, bl0 = 0.f, bl1 = 0.f;
#pragma unroll
          for (int s2 = 0; s2 < 8; ++s2) { const f32x2_t t = *(const LAS f32x2_t*)(lds + HL_SEG + (s2 * 128 + 2 * kp) * 4); if (s2 < seg) { pre0 += t.x; pre1 += t.y; } bl0 += t.x; bl1 += t.y; }
          if (seg == 0) *(LAS f32x2_t*)(lds + HL_DEC + 2 * kp * 4) = (f32x2_t){__builtin_amdgcn_exp2f(bl0 * LOG2E), __builtin_amdgcn_exp2f(bl1 * LOG2E)};
          const size_t qcb = (row0 + (size_t)c * 64 + 8 * seg) * HGW + cb + 2 * kp;
          const float eB0 = __builtin_amdgcn_exp2f(bl0 * LOG2E), eB1 = __builtin_amdgcn_exp2f(bl1 * LOG2E), eG0 = __builtin_amdgcn_exp2f(fmaxf(gb0 * LOG2E, -120.f)), eG1 = __builtin_amdgcn_exp2f(fmaxf(gb1 * LOG2E, -120.f));
#pragma unroll
          for (int i = 0; i < 8; ++i) { const int t = 8 * seg + i;
              const float bb0 = (pre0 + cs0[i]) * LOG2E, bb1 = (pre1 + cs1[i]) * LOG2E, q0 = bflo(qv[i]), q1 = bfhi(qv[i]), k0 = bflo(kv[i]), k1 = bfhi(kv[i]);
              const float qe0 = q0 * __builtin_amdgcn_exp2f(fmaxf(bb0, -120.f)), qe1 = q1 * __builtin_amdgcn_exp2f(fmaxf(bb1, -120.f)), ke0 = k0 * __builtin_amdgcn_exp2f(fminf(-bb0, 120.f)), ke1 = k1 * __builtin_amdgcn_exp2f(fminf(-bb1, 120.f));
              *(LAS unsigned*)(lds + HL_QT + t * HP_RD + kp * 4) = pg8::cvt_pk_bf16(qe0, qe1);
              *(LAS unsigned*)(lds + HL_KH + t * HP_RD + kp * 4) = pg8::cvt_pk_bf16(ke0, ke1);
              *(LAS unsigned*)(lds + HL_KD + t * HP_TR + kp * 4) = pg8::cvt_pk_bf16(ke0 * eB0, ke1 * eB1);
              if (g > 0) *(unsigned*)(QC + qcb + (size_t)i * HGW) = pg8::cvt_pk_bf16(qe0 * eG0, qe1 * eG1); }
          gb0 += bl0; gb1 += bl1; }
        if (c + 1 < HG_CHUNKS) HG_LOAD(c + 1);
        LDS_BAR();
        f32x16 oacc = {};
        bf16x8 pa[2][2];
#pragma unroll
        for (int a = 0; a < 2; ++a) if (a <= tb) {
            f32x16 x = {};
#pragma unroll
            for (int ks = 0; ks < 8; ++ks) {
                const bf16x8 af = *(const LAS bf16x8*)(lds + HL_KH + (32 * a + r32) * HP_RD + (16 * ks + 8 * hi) * 2);
                const bf16x8 bfr = *(const LAS bf16x8*)(lds + HL_QT + (32 * tb + r32) * HP_RD + (16 * ks + 8 * hi) * 2);
                x = __builtin_amdgcn_mfma_f32_32x32x16_bf16(af, bfr, x, 0, 0, 0);
            }
            if (a == tb) {
#pragma unroll
                for (int r = 0; r < 16; ++r) if (crow(r, hi) > r32) x[r] = 0.f;
            }
            pa[a][0] = pack8(x, 0); pa[a][1] = pack8(x, 8);
        }
#pragma unroll
        for (int ks = 0; ks < 8; ++ks) {
            const bf16x8 af = *(const LAS bf16x8*)(lds + HL_QT + (32 * tb + r32) * HP_RD + (16 * ks + 8 * hi) * 2);
            const LAS unsigned char* sp = lds + HL_SB + (16 * ks + 8 * hi + ((lane & 15) >> 2)) * HP_TR + (32 * vj + 16 * ((lane >> 4) & 1) + 4 * (lane & 3)) * 2;
            oacc = __builtin_amdgcn_mfma_f32_32x32x16_bf16(af, cat8(tr16(sp), tr16(sp + 4 * HP_TR)), oacc, 0, 0, 0);
        }
#pragma unroll
        for (int a = 0; a < 2; ++a) if (a <= tb) {
#pragma unroll
            for (int s2 = 0; s2 < 2; ++s2) {
                const LAS unsigned char* vp = lds + HL_VT + (32 * a + 16 * s2 + 4 * hi + ((lane & 15) >> 2)) * HP_TR + (32 * vj + 16 * ((lane >> 4) & 1) + 4 * (lane & 3)) * 2;
                oacc = __builtin_amdgcn_mfma_f32_32x32x16_bf16(pa[a][s2], cat8(tr16(vp), tr16(vp + 8 * HP_TR)), oacc, 0, 0, 0);
            }
        }
#pragma unroll
        for (int u = 0; u < 2; ++u) {
            f32x16 Sx = u ? S1 : S0; const int kt = 2 * tb + u;
            const LAS float* dec = (const LAS float*)(lds + HL_DEC) + 32 * kt;
#pragma unroll
            for (int r = 0; r < 16; ++r) Sx[r] *= dec[crow(r, hi)];
#pragma unroll
            for (int ks = 0; ks < 4; ++ks) {
                const int srow = 16 * ks + 8 * hi + ((lane & 15) >> 2), cq = 16 * ((lane >> 4) & 1) + 4 * (lane & 3);
                const LAS unsigned char* ap = lds + HL_KD + srow * HP_TR + (32 * kt + cq) * 2;
                const LAS unsigned char* bp = lds + HL_VT + srow * HP_TR + (32 * vj + cq) * 2;
                Sx = __builtin_amdgcn_mfma_f32_32x32x16_bf16(cat8(tr16(ap), tr16(ap + 4 * HP_TR)), cat8(tr16(bp), tr16(bp + 4 * HP_TR)), Sx, 0, 0, 0);
            }
            if (u) S1 = Sx; else S0 = Sx;
        }
        { float* op = ORAW + (row0 + (size_t)c * 64 + 32 * tb) * HGW + cb + 32 * vj + r32;
#pragma unroll
          for (int r = 0; r < 16; ++r) op[(size_t)crow(r, hi) * HGW] = oacc[r]; }
        LDS_BAR();
        if (c + 1 < HG_CHUNKS) {
#pragma unroll
            for (int u = 0; u < 2; ++u) { const f32x16 Sx = u ? S1 : S0; const int kt = 2 * tb + u;
#pragma unroll
                for (int r = 0; r < 16; ++r) *(LAS unsigned short*)(lds + HL_SB + (32 * kt + crow(r, hi)) * HP_TR + (32 * vj + r32) * 2) = (unsigned short)f2bf(Sx[r]); }
        }
    }
#undef HG_LOAD
    if (g + 1 < HG_GROUPS) {
        float* ds = DS + (size_t)unit * (HGD * HGD);
#pragma unroll
        for (int u = 0; u < 2; ++u) { const f32x16 Sx = u ? S1 : S0; const int kt = 2 * tb + u;
#pragma unroll
            for (int r = 0; r < 16; ++r) ds[(32 * kt + crow(r, hi)) * HGD + 32 * vj + r32] = Sx[r]; }
        if (seg == 0) *(f32x2_t*)(DG + (size_t)unit * HGD + 2 * kp) = (f32x2_t){__builtin_amdgcn_exp2f(gb0 * LOG2E), __builtin_amdgcn_exp2f(gb1 * LOG2E)};
    }
    LDS_BAR();
}
__device__ __forceinline__ void hgrn_unit_b(const float* ORAW, const bf16_t* QC, const float* DS, const float* DG, const bf16_t* HG, const float* norm_g, bf16_t* OHG, int unit, LAS unsigned char* lds, int tid, int lane, int wid) {
    const int bh = unit >> 3, g = unit & 7, b = bh >> 2, hh = bh & 3, r32 = lane & 31, hi = lane >> 5;
    const size_t tok0 = (size_t)b * SEQ + (size_t)g * (SEQ / HG_GROUPS) + 32 * wid; const int cb = hh * HGD;
    if (g > 0) {
        { float S[32];
#pragma unroll
          for (int i = 0; i < 32; ++i) S[i] = 0.f;
          const int k = tid >> 2;
          for (int g2 = 0; g2 < g; ++g2) { const float* ds = DS + (size_t)(bh * 8 + g2) * (HGD * HGD) + tid * 32; const float d = DG[(size_t)(bh * 8 + g2) * HGD + k];
#pragma unroll
              for (int j = 0; j < 8; ++j) { const f32x4 x = *(const f32x4*)(ds + 4 * j);
#pragma unroll
                  for (int t = 0; t < 4; ++t) S[4 * j + t] = d * S[4 * j + t] + x[t]; } }
#pragma unroll
          for (int j = 0; j < 4; ++j) { u32x4 w; w.x = pg8::cvt_pk_bf16(S[8 * j], S[8 * j + 1]); w.y = pg8::cvt_pk_bf16(S[8 * j + 2], S[8 * j + 3]); w.z = pg8::cvt_pk_bf16(S[8 * j + 4], S[8 * j + 5]); w.w = pg8::cvt_pk_bf16(S[8 * j + 6], S[8 * j + 7]);
              *(LAS u32x4*)(lds + HL_SB + k * HP_TR + (tid & 3) * 64 + j * 16) = w; } }
        LDS_BAR();
    }
    asm volatile("" ::: "memory");
    f32x16 acc[4];
#pragma unroll
    for (int vj = 0; vj < 4; ++vj)
#pragma unroll
        for (int r = 0; r < 16; ++r) acc[vj][r] = ORAW[(tok0 + crow(r, hi)) * HGW + cb + 32 * vj + r32];
    if (g > 0) {
#pragma unroll
        for (int ks = 0; ks < 8; ++ks) {
            const bf16x8 af = *(const bf16x8*)(QC + (tok0 + r32) * HGW + cb + 16 * ks + 8 * hi);
#pragma unroll
            for (int vj = 0; vj < 4; ++vj) {
                const LAS unsigned char* sp = lds + HL_SB + (16 * ks + 8 * hi + ((lane & 15) >> 2)) * HP_TR + (32 * vj + 16 * ((lane >> 4) & 1) + 4 * (lane & 3)) * 2;
                acc[vj] = __builtin_amdgcn_mfma_f32_32x32x16_bf16(af, cat8(tr16(sp), tr16(sp + 4 * HP_TR)), acc[vj], 0, 0, 0);
            }
        }
    }
    float ng[4];
#pragma unroll
    for (int vj = 0; vj < 4; ++vj) ng[vj] = norm_g[cb + 32 * vj + r32];
#pragma unroll
    for (int rb = 0; rb < 16; rb += MK_PB_GROWS) {
        bf16_t hgv[MK_PB_GROWS][4];
#pragma unroll
        for (int r2 = 0; r2 < MK_PB_GROWS; ++r2) { const size_t ro = (tok0 + crow(rb + r2, hi)) * HGW + cb + r32;
#pragma unroll
            for (int vj = 0; vj < 4; ++vj) hgv[r2][vj] = HG[ro + 32 * vj]; }
#pragma unroll
        for (int r2 = 0; r2 < MK_PB_GROWS; ++r2) { const int r = rb + r2;
            float ss = (acc[0][r] * acc[0][r] + acc[1][r] * acc[1][r]) + (acc[2][r] * acc[2][r] + acc[3][r] * acc[3][r]);
            ss = row16_sum(ss); ss += __shfl_xor(ss, 16);
            const float rs = __builtin_amdgcn_rsqf(ss * (1.0f / HGD) + RMS_EPS);
            const size_t ro = (tok0 + crow(r, hi)) * HGW + cb + r32;
#pragma unroll
            for (int vj = 0; vj < 4; ++vj) OHG[ro + 32 * vj] = (bf16_t)f2bf(acc[vj][r] * rs * ng[vj] * bf2f(hgv[r2][vj]));
        }
        asm volatile("" ::: "memory");
    }
    LDS_BAR();
}

constexpr int TROW = 2064;
constexpr int L_TILE = 0, L_LOGITS = 64 * TROW, L_TOPI = L_LOGITS + 64 * 32 * 4, L_HIST = L_TOPI + 1024, L_SLOT = L_HIST + 128, L_TOT = L_SLOT + 1024, L_BEF = L_TOT + 128, L_PAD = L_BEF + 128, L_PART = L_PAD + 256, L_END5 = L_PART + 2 * 16 * 32 * 4;
static_assert(L_END5 <= LDS_SCRATCH, "P5/P6 LDS map");
__device__ __forceinline__ void phase_ln1_router(const Args& A, LAS unsigned char* lds, int vb, int tid, int lane, int wave) {
    unsigned char* ws = A.ws;
    const bf16_t* PRE = (const bf16_t*)(ws + WS_PRE); float* STATS = (float*)(ws + WS_H); const float* g = A.in[7]; const float* bta = A.in[8];
    LAS int* HIST = (LAS int*)(lds + L_HIST);
    if (tid < NEXP) HIST[tid] = 0;
    u32x4 pp[8][2];
#pragma unroll
    for (int rr = 0; rr < 8; ++rr)
#pragma unroll
        for (int h = 0; h < 2; ++h) pp[rr][h] = *(const u32x4*)(PRE + (size_t)(vb * 64 + wave * 8 + rr) * DM + lane * 8 + 512 * h);
    f32x4 gq[4], bq[4];
#pragma unroll
    for (int j = 0; j < 4; ++j) { const int c = lane * 8 + 512 * (j >> 1) + 4 * (j & 1); gq[j] = *(const f32x4*)(g + c); bq[j] = *(const f32x4*)(bta + c); }
    bf16x8 rwf[16];
    { const bf16_t* RWT = (const bf16_t*)(ws + WS_RWT); const int kq = wave >> 1, r = lane & 31, hh = lane >> 5;
#pragma unroll
      for (int ks = 0; ks < 16; ++ks) rwf[ks] = *(const bf16x8*)(RWT + (size_t)r * DM + 256 * kq + 16 * ks + 8 * hh); }
#pragma unroll
    for (int rr = 0; rr < 8; ++rr) {
        const int rl = wave * 8 + rr, row = vb * 64 + rl;
        f32x4 v[4]; float s = 0.f;
#pragma unroll
        for (int j = 0; j < 4; ++j) { const u32x4 q = pp[rr][j >> 1]; const unsigned px = (j & 1) ? q.z : q.x, py = (j & 1) ? q.w : q.y; v[j] = (f32x4){bflo(px), bfhi(px), bflo(py), bfhi(py)}; s += (v[j][0] + v[j][1]) + (v[j][2] + v[j][3]); }
        const float mean = wave_sum(s) * (1.0f / DM); float s2 = 0.f;
#pragma unroll
        for (int j = 0; j < 4; ++j) { v[j] = v[j] - mean; s2 += (v[j][0] * v[j][0] + v[j][1] * v[j][1]) + (v[j][2] * v[j][2] + v[j][3] * v[j][3]); }
        const float rstd = __builtin_amdgcn_rsqf(wave_sum(s2) * (1.0f / DM) + LN_EPS);
        if (lane == 0) *(f32x2_t*)(STATS + (size_t)row * 2) = (f32x2_t){mean, rstd};
#pragma unroll
        for (int h = 0; h < 2; ++h) { const f32x4 ha = v[2 * h] * rstd * gq[2 * h] + bq[2 * h], hb = v[2 * h + 1] * rstd * gq[2 * h + 1] + bq[2 * h + 1];
            u32x4 w; w.x = pk2(ha[0], ha[1]); w.y = pk2(ha[2], ha[3]); w.z = pk2(hb[0], hb[1]); w.w = pk2(hb[2], hb[3]); *(LAS u32x4*)(lds + L_TILE + rl * TROW + (lane * 8 + 512 * h) * 2) = w; }
    }
    LDS_BAR();
    {
        const int rt = wave & 1, kq = wave >> 1, r = lane & 31, hh = lane >> 5;
        const bf16_t* RWT = (const bf16_t*)(ws + WS_RWT);
        f32x16 acc = {};
#pragma unroll
        for (int ks = 0; ks < 16; ++ks) {
            const int k = 256 * kq + 16 * ks + 8 * hh;
            const bf16x8 af = *(const LAS bf16x8*)(lds + L_TILE + (32 * rt + r) * TROW + k * 2);
            acc = __builtin_amdgcn_mfma_f32_32x32x16_bf16(af, rwf[ks], acc, 0, 0, 0);
        }
        (void)RWT;
        LAS float* LG = (LAS float*)(lds + L_LOGITS);
        for (int q = 0; q < 4; ++q) {
            if (kq == q) {
#pragma unroll
                for (int i = 0; i < 16; ++i) { const int rowl = 32 * rt + (i & 3) + 8 * (i >> 2) + 4 * hh; LAS float* p = LG + rowl * 32 + r; if (q == 0) *p = acc[i]; else *p += acc[i]; }
            }
            LDS_BAR();
        }
    }
    {
        const float* rb = A.in[10]; float* TOPG = (float*)(ws + WS_TOPG); LAS int* TOPI = (LAS int*)(lds + L_TOPI); const LAS float* LG = (const LAS float*)(lds + L_LOGITS);
        const int e = lane & 31, half = lane >> 5;
        for (int it = 0; it < 4; ++it) {
            const int rl = wave * 8 + it * 2 + half;
            float val = LG[rl * 32 + e] + rb[e]; int idx = e; float tv[4]; int ti[4];
#pragma unroll
            for (int rnk = 0; rnk < 4; ++rnk) {
                float bv = val; int bi = idx;
#define TOPK_STEP(OV, OI) do { const float ov = (OV); const int oi = (OI); if (ov > bv || (ov == bv && oi < bi)) { bv = ov; bi = oi; } } while (0)
                TOPK_STEP(dpp_f<0xB1>(bv), __builtin_amdgcn_update_dpp(0, bi, 0xB1, 0xF, 0xF, false)); TOPK_STEP(dpp_f<0x4E>(bv), __builtin_amdgcn_update_dpp(0, bi, 0x4E, 0xF, 0xF, false));
                TOPK_STEP(dpp_f<0x141>(bv), __builtin_amdgcn_update_dpp(0, bi, 0x141, 0xF, 0xF, false)); TOPK_STEP(dpp_f<0x140>(bv), __builtin_amdgcn_update_dpp(0, bi, 0x140, 0xF, 0xF, false));
                TOPK_STEP(__shfl_xor(bv, 16), __shfl_xor(bi, 16));
#undef TOPK_STEP
                tv[rnk] = bv; ti[rnk] = bi; if (e == bi) val = -INFINITY;
            }
            if (e == 0) {
                const float e1 = expf(tv[1] - tv[0]), e2 = expf(tv[2] - tv[0]), e3 = expf(tv[3] - tv[0]), inv = 1.0f / (1.0f + e1 + e2 + e3);
                *(float4*)(TOPG + (size_t)(vb * 64 + rl) * 4) = make_float4(inv, e1 * inv, e2 * inv, e3 * inv);
#pragma unroll
                for (int k = 0; k < 4; ++k) { TOPI[rl * 4 + k] = ti[k]; __hip_atomic_fetch_add(&HIST[ti[k]], 1, __ATOMIC_RELAXED, __HIP_MEMORY_SCOPE_WORKGROUP); }
            }
        }
    }
    LDS_BAR();
    if (tid < NEXP) ((int*)(ws + WS_CNTM))[vb * NEXP + tid] = HIST[tid];
}
__device__ __forceinline__ void phase_assign(const Args& A, LAS unsigned char* lds, int vb, int G, int tid, int lane, int wave) {
    unsigned char* ws = A.ws; const int* CNTM = (const int*)(ws + WS_CNTM); int* ctl = (int*)(ws + WS_CTL);
    LAS int* PART = (LAS int*)(lds + L_PART); LAS int* TOT = (LAS int*)(lds + L_TOT); LAS int* BEF = (LAS int*)(lds + L_BEF); LAS int* PAD = (LAS int*)(lds + L_PAD);
    LAS int* TOPI = (LAS int*)(lds + L_TOPI); LAS int* SLOT = (LAS int*)(lds + L_SLOT);
    { const int e = tid & 31, part = tid >> 5; int tot = 0, bef = 0;
      int cv[16];
#pragma unroll
      for (int q = 0; q < 16; ++q) { const int b2 = part * 16 + q; cv[q] = CNTM[(b2 < G ? b2 : G - 1) * NEXP + e]; }
#pragma unroll
      for (int q = 0; q < 16; ++q) { const int b2 = part * 16 + q; const int c = (b2 < G) ? cv[q] : 0; tot += c; if (b2 < vb) bef += c; }
      PART[part * 32 + e] = tot; PART[512 + part * 32 + e] = bef; }
    LDS_BAR();
    if (tid < NEXP) { int tot = 0, bef = 0;
#pragma unroll
        for (int p = 0; p < 16; ++p) { tot += PART[p * 32 + tid]; bef += PART[512 + p * 32 + tid]; }
        TOT[tid] = tot; BEF[tid] = bef; }
    LDS_BAR();
    if (tid < 64) {
        const int te = (tid < NEXP) ? (TOT[tid & 31] + SLOT_PAD - 1) / SLOT_PAD : 0; int inc = te;
#pragma unroll
        for (int d = 1; d < 32; d <<= 1) { const int o = __shfl_up(inc, d); if ((tid & 63) >= d) inc += o; }
        const int tb = inc - te;
        if (tid < NEXP) { PAD[tid] = tb * SLOT_PAD; if (vb == 0) for (int i = 0; i < te; ++i) ctl[CW_TILEEXP + tb + i] = tid; }
        if (vb == 0 && tid == NEXP - 1) ctl[CW_NTILES] = inc; }
    LDS_BAR();
    if (tid < 256) { const int e = TOPI[tid]; int rank = 0; for (int j = 0; j < tid; ++j) rank += (TOPI[j] == e) ? 1 : 0;
        const int slot = PAD[e] + BEF[e] + rank; SLOT[tid] = slot; ((int*)(ws + WS_DEST))[vb * 256 + tid] = slot;
#if MK_GATHER_A
        ((int*)(ws + WS_SLOTTOK))[slot] = vb * 64 + (tid >> 2);
#endif
    }
    LDS_BAR();
    bf16_t* XS = (bf16_t*)(ws + WS_XS);
#if MK_GATHER_A
#pragma unroll
    for (int rq = 0; rq < 8; ++rq) { const int r = wave * 8 + rq;
        const int i = 4 * r; const int slot = vb * 64 + r; const LAS unsigned char* src = lds + L_TILE + (i >> 2) * TROW; unsigned char* dst = (unsigned char*)(XS + (size_t)slot * DM);
#else
    for (int i = wave * 32; i < wave * 32 + 32; ++i) {
        const int slot = SLOT[i]; const LAS unsigned char* src = lds + L_TILE + (i >> 2) * TROW; unsigned char* dst = (unsigned char*)(XS + (size_t)slot * DM);
#endif
#if MK_FP8_UP
        { const u32x4 a = *(const LAS u32x4*)(src + lane * 32), b = *(const LAS u32x4*)(src + lane * 32 + 16); u32x4 o;
          o.x = pk4_fp8(bflo(a.x), bfhi(a.x), bflo(a.y), bfhi(a.y)); o.y = pk4_fp8(bflo(a.z), bfhi(a.z), bflo(a.w), bfhi(a.w)); o.z = pk4_fp8(bflo(b.x), bfhi(b.x), bflo(b.y), bfhi(b.y)); o.w = pk4_fp8(bflo(b.z), bfhi(b.z), bflo(b.w), bfhi(b.w));
          *(u32x4*)((unsigned char*)(ws + WS_XS) + (size_t)slot * DM + lane * 16) = o; (void)dst; }
#else
        const u32x4 a = *(const LAS u32x4*)(src + lane * 16), b = *(const LAS u32x4*)(src + 1024 + lane * 16);
        *(u32x4*)(dst + lane * 16) = a; *(u32x4*)(dst + 1024 + lane * 16) = b;
#endif
    }
}
template <int NR> __device__ __forceinline__ void combine_rows(const Args& A, int row0, int rstep, int lane, const f32x4 (&g1)[4], const f32x4 (&b1)[4], const f32x4 (&g2)[4], const f32x4 (&b2)[4]) {
    unsigned char* ws = A.ws; const bf16_t* PRE = (const bf16_t*)(ws + WS_PRE); const unsigned char* Y = (const unsigned char*)(ws + WS_Y);
    f32x2_t st[NR]; int4 d[NR]; float4 gt[NR]; u32x2 p[NR][4]; unsigned y[NR][4][4];
#pragma unroll
    for (int q = 0; q < NR; ++q) { const int row = row0 + q * rstep; st[q] = *(const f32x2_t*)((const float*)(ws + WS_H) + (size_t)row * 2); d[q] = *(const int4*)((const int*)(ws + WS_DEST) + row * 4); gt[q] = *(const float4*)((const float*)(ws + WS_TOPG) + row * 4);
#pragma unroll
        for (int j = 0; j < 4; ++j) p[q][j] = *(const u32x2*)(PRE + (size_t)row * DM + lane * 4 + 256 * j); }
#pragma unroll
    for (int q = 0; q < NR; ++q) { const int ds[4] = {d[q].x, d[q].y, d[q].z, d[q].w};
#pragma unroll
        for (int j = 0; j < 4; ++j)
#pragma unroll
            for (int k = 0; k < 4; ++k) y[q][j][k] = *(const unsigned*)(Y + (size_t)ds[k] * DM + lane * 4 + 256 * j); }
#pragma unroll
    for (int q = 0; q < NR; ++q) { const int row = row0 + q * rstep;
        const float gs[4] = {gt[q].x * (1.0f / Y8_SCALE), gt[q].y * (1.0f / Y8_SCALE), gt[q].z * (1.0f / Y8_SCALE), gt[q].w * (1.0f / Y8_SCALE)};
        f32x4 v[4]; float s = 0.f;
#pragma unroll
        for (int j = 0; j < 4; ++j) {
            f32x4 a = (((f32x4){bflo(p[q][j].x), bfhi(p[q][j].x), bflo(p[q][j].y), bfhi(p[q][j].y)} - st[q][0]) * st[q][1] * g1[j] + b1[j]) * DN_ALPHA;
#pragma unroll
            for (int k = 0; k < 4; ++k) { const f32x2_t y01 = __builtin_amdgcn_cvt_pk_f32_fp8(y[q][j][k], false), y23 = __builtin_amdgcn_cvt_pk_f32_fp8(y[q][j][k], true);
                a[0] += gs[k] * y01[0]; a[1] += gs[k] * y01[1]; a[2] += gs[k] * y23[0]; a[3] += gs[k] * y23[1]; }
            v[j] = a; s += (a[0] + a[1]) + (a[2] + a[3]); }
        const float mean = wave_sum(s) * (1.0f / DM); float s2 = 0.f;
#pragma unroll
        for (int j = 0; j < 4; ++j) { v[j] = v[j] - mean; s2 += (v[j][0] * v[j][0] + v[j][1] * v[j][1]) + (v[j][2] * v[j][2] + v[j][3] * v[j][3]); }
        const float rstd = __builtin_amdgcn_rsqf(wave_sum(s2) * (1.0f / DM) + LN_EPS);
#pragma unroll
        for (int j = 0; j < 4; ++j) { const int c = lane * 4 + 256 * j; *(f32x4*)(A.out + (size_t)row * DM + c) = v[j] * rstd * g2[j] + b2[j]; }
    }
}

template <bool BG, class ArgsT> __device__ __forceinline__ void xcd_barrier_bg(const XcdBarrier& b, const ArgsT& A, LAS unsigned char* lds, volatile LAS unsigned* MISC) {
    const int wave = __builtin_amdgcn_readfirstlane(threadIdx.x >> 6), lane = threadIdx.x & 63;
    const unsigned e0 = MISC[10];
    asm volatile("s_waitcnt vmcnt(0)" ::: "memory");
    __syncthreads();
    if (wave == 0) {
        if (threadIdx.x == 0) {
            unsigned* bar = b.bar;
            __builtin_amdgcn_s_waitcnt(0);
            unsigned nloc = b.st[0], nx = b.st[1];
            if (nloc == 0u) { xcd_barrier_complete(bar, b.x, nloc, nx); b.st[0] = nloc; b.st[1] = nx; }
            const unsigned old = xb_add(&bar[XB_XSUB(b.x)], 1u);
            const unsigned gen = old / nloc;
            if (old + 1u == (gen + 1u) * nloc) {
                __builtin_amdgcn_fence(__ATOMIC_RELEASE, "agent");
                asm volatile("s_waitcnt vmcnt(0)" ::: "memory");
                const unsigned og = xb_add(&bar[XB_TOP], 1u);
                const unsigned tg = og / nx;
                if (og + 1u == (tg + 1u) * nx) xb_add(&bar[XB_TOPGEN], 1u);
                else XB_SPIN(xb_ld(&bar[XB_TOPGEN]) == tg, bar);
                __builtin_amdgcn_fence(__ATOMIC_ACQUIRE, "");
                xb_add(&bar[XB_XGEN(b.x)], 1u);
                asm volatile("s_waitcnt vmcnt(0)" ::: "memory");
            } else {
                XB_SPIN(xb_ld(&bar[XB_XGEN(b.x)]) == gen, bar);
                __builtin_amdgcn_fence(__ATOMIC_ACQUIRE, "");
                asm volatile("s_waitcnt vmcnt(0)" ::: "memory");
            }
            MISC[10] = e0 + 1u;
        }
    } else if (BG && wave <= MK_BG_WAVES) {
        volatile LAS int* st = (volatile LAS int*)(MISC + 16 + 2 * wave);
        LAS float* scr = (LAS float*)(lds + wave * 16384);
        while (MISC[10] == e0) { if (!bg_step(A, st, scr, lane, BG_TOTAL)) __builtin_amdgcn_s_sleep(16); }
    }
    __syncthreads();
}
__device__ __forceinline__ void bg_drain(const Args& A, LAS unsigned char* lds, volatile LAS unsigned* MISC, int limit) {
    const int wave = __builtin_amdgcn_readfirstlane(threadIdx.x >> 6), lane = threadIdx.x & 63;
    volatile LAS int* st = (volatile LAS int*)(MISC + 16 + 2 * wave);
    while (bg_step(A, st, (LAS float*)(lds + wave * 16384), lane, limit)) {}
}
template <int LO, int HI> __global__ void __launch_bounds__(NTHREADS, 2) mk_fwd(Args args) {
    extern __shared__ __attribute__((aligned(16))) unsigned char lds_raw[];
    LAS unsigned char* lds = (LAS unsigned char*)lds_raw;
    volatile LAS unsigned* MISC = (volatile LAS unsigned*)(lds + MISC_OFF);
    const int G = gridDim.x, bx = blockIdx.x, vcu = (G % 8 == 0) ? (bx % 8) * (G / 8) + bx / 8 : bx;
    const int NGW = G * NWAVES;
#define GW (vcu * NWAVES + wave)
    unsigned char* ws = args.ws;
    for (int u = threadIdx.x; u < (LDS_BYTES - LDSCTL_OFF) / 4; u += NTHREADS) ((LAS unsigned*)(lds + LDSCTL_OFF))[u] = 0u;
    __syncthreads();
    XcdBarrier bar = xcd_barrier_post((unsigned*)(ws + WS_CTL) + CW_BAR + args.li * XCD_BAR_WORDS, MISC + 8);
#define IN(k) (LO <= (k) && (k) < HI)
#if MK_PROBE
    unsigned long long ts[16]; ts[0] = __builtin_amdgcn_s_memrealtime();
#define TS(i) ts[i] = __builtin_amdgcn_s_memrealtime()
#else
#define TS(i) do { } while (0)
#endif
#if 1
#if MK_BG
#define SEAM(k) do { if constexpr (IN(k) && IN((k) + 1)) { \
        if constexpr ((k) == 7) { __syncthreads(); bg_drain(args, lds, MISC, BG_I_UP); } \
        if constexpr ((k) == 8) { TS(13); bg_drain(args, lds, MISC, BG_TOTAL); TS(14); } \
        if constexpr (((MK_BG_SEAMS) >> (k)) & 1) xcd_barrier_bg<true>(bar, args, lds, MISC); else xcd_barrier_bg<false>(bar, args, lds, MISC); } } while (0)
#else
#define SEAM(k) do { if constexpr (IN(k) && IN((k) + 1)) xcd_barrier(bar); } while (0)
#endif
#endif
    InProjOut ip; ip.Q = (bf16_t*)(ws + WS_Q); ip.K = (bf16_t*)(ws + WS_K); ip.V = (bf16_t*)(ws + WS_V); ip.HQ = (bf16_t*)(ws + WS_HQ); ip.HK = (bf16_t*)(ws + WS_HK); ip.HV = (bf16_t*)(ws + WS_HV);
    ip.HG = (bf16_t*)(ws + WS_HG); ip.GS = (bf16_t*)(ws + WS_GS); ip.GH = (bf16_t*)(ws + WS_GH); ip.LOGF = (float*)(ws + WS_LOGF); ip.lb = (const float*)(ws + WS_LB);

    if constexpr (IN(0)) { FRESH_IDS(); phase_prologue(args, lds, GW, NGW, lane, wave); }
#if MK_PROBE_CONV
    bg_drain(args, lds, MISC, BG_TOTAL);
#if MK_PROBE_CONV > 1
    xcd_barrier(bar);
    if (threadIdx.x == 0) __hip_atomic_store((int*)(ws + WS_CTL) + CW_BGQ, 0, __ATOMIC_RELAXED, __HIP_MEMORY_SCOPE_AGENT);
    { const int w_ = __builtin_amdgcn_readfirstlane(threadIdx.x >> 6); if ((threadIdx.x & 63) == 0) { MISC[16 + 2 * w_] = 0; MISC[17 + 2 * w_] = 0; } }
    xcd_barrier(bar);
    bg_drain(args, lds, MISC, BG_TOTAL);
#endif
#endif
    SEAM(0); TS(1);
    if constexpr (IN(1)) {
#if MK_FP8_GATES
      { pg8::Gemm g{DM}; pg8::DenseSched S; S.o.init(NTOK / 256, 12, G, bx, MK_WGM_P1A); S.A = (const char*)(ws + WS_XB); S.Bt = (const char*)(ws + WS_WINT); S.tstep = (size_t)256 * DM * 2;
        pg8::EpiInProjT<0> E{ip};
        pg8::gemm_phase<pg8::EpiInProjT<0>, pg8::DenseSched, true, true>(lds, g, S, E); }
      { pg8::Gemm g{DM / 2, 0x7f7f7f7f, W8_E8M0}; pg8::DenseSched S; S.o.init(NTOK / 256, 10, G, G - 1 - bx, MK_WGM_P1B); S.A = (const char*)(ws + WS_XB8);     S.Bt = (const char*)(ws + WS_WINT8); S.tstep = (size_t)256 * DM;
        pg8::EpiInProjT<12> E{ip};
        pg8::gemm_phase_f8<pg8::EpiInProjT<12>, pg8::DenseSched, true, true>(lds, g, S, E); }
#else
      { pg8::Gemm g{DM}; pg8::DenseSched S; S.o.init(NTOK / 256, INW / 256, G, bx); S.A = (const char*)(ws + WS_XB); S.Bt = (const char*)(ws + WS_WINT); S.tstep = (size_t)256 * DM * 2;
        pg8::EpiInProjT<0> E{ip};
        pg8::gemm_phase<pg8::EpiInProjT<0>, pg8::DenseSched, true, true>(lds, g, S, E); }
#endif
    }
    SEAM(1); TS(2);
    if constexpr (IN(2)) { _Pragma("unroll 1") for (int rp2_ = 0; rp2_ < MK_LOOP_P2; ++rp2_) { if (rp2_) xcd_barrier(bar); FRESH_IDS(); const int gw = GW; (void)gw; const int qw_ = rp2_;
#if MK_NAIVE_MIX
    { const int u = gw; if (u < 2048) attn_naive_unit(ip.Q, ip.K, ip.V, (bf16_t*)(ws + WS_OSB), u & 63, 31 - (u >> 6), lane); }
    __syncthreads();
    if (vcu < 8) hgrn_naive_block(ip.HQ, ip.HK, ip.LOGF, ip.HV, (float*)(ws + WS_ORAW), lds, vcu, tid);
#else
#define MK_P2_BODY(QW) \
    hgrn_unit_a(ip.HQ, ip.HK, ip.LOGF, ip.HV, (float*)(ws + WS_ORAW), (bf16_t*)(ws + WS_QC), (float*)(ws + WS_DS), (float*)(ws + WS_DG), vcu, lds, tid, lane, wave); TS(12); \
    for (;;) { \
        if (tid == 0) *(LAS int*)(lds + AT_Q) = __hip_atomic_fetch_add((int*)(ws + WS_CTL) + CW_ATTNQ + (QW), 1, __ATOMIC_RELAXED, __HIP_MEMORY_SCOPE_AGENT); \
        LDS_BAR(); \
        const int u = __builtin_amdgcn_readfirstlane(*(LAS int*)(lds + AT_Q)); \
        LDS_BAR(); \
        if (u >= 512) break; \
        attn_unit(ip.Q, ip.K, ip.V, (bf16_t*)(ws + WS_OSB), u & 63, 7 - (u >> 6), lds, lane, wave); \
    }
    MK_P2_BODY(qw_)
#if MK_DUP_P2 > 1
    xcd_barrier(bar);
#if MK_DUP_WHAT == 1
    hgrn_unit_a(ip.HQ, ip.HK, ip.LOGF, ip.HV, (float*)(ws + WS_ORAW), (bf16_t*)(ws + WS_QC), (float*)(ws + WS_DS), (float*)(ws + WS_DG), vcu, lds, tid, lane, wave);
#elif MK_DUP_WHAT == 2
    for (;;) {
        if (tid == 0) *(LAS int*)(lds + AT_Q) = __hip_atomic_fetch_add((int*)(ws + WS_CTL) + CW_ATTNQ + 1, 1, __ATOMIC_RELAXED, __HIP_MEMORY_SCOPE_AGENT);
        __syncthreads();
        const int u = __builtin_amdgcn_readfirstlane(*(LAS int*)(lds + AT_Q));
        __syncthreads();
        if (u >= 512) break;
        attn_unit(ip.Q, ip.K, ip.V, (bf16_t*)(ws + WS_OSB), u & 63, 7 - (u >> 6), lds, lane, wave);
    }
#else
    MK_P2_BODY(1)
#endif
#endif
#if 0
    for (;;) {
        if (tid == 0) {
        __syncthreads();
        const int u = __builtin_amdgcn_readfirstlane(*(LAS int*)(lds + AT_Q));
        __syncthreads();
        if (u >= 512) break;
        attn_unit(ip.Q, ip.K, ip.V, (bf16_t*)(ws + WS_OSB), u & 63, 7 - (u >> 6), lds, lane, wave);
    }
#endif
#endif
    } }
    SEAM(2); TS(3);
#if MK_NAIVE_MIX
    if constexpr (IN(3)) { FRESH_IDS(); const int gw = GW; for (int it = gw; it < NTOK * HGH; it += NGW) hgrn_post_item((const float*)(ws + WS_ORAW), ip.HG, args.in[3], (bf16_t*)(ws + WS_OHG), it, lane); }
#else
    if constexpr (IN(3)) { _Pragma("unroll 1") for (int rb_ = 0; rb_ < MK_DUP_HGB; ++rb_) { if (rb_) xcd_barrier(bar); FRESH_IDS(); hgrn_unit_b((const float*)(ws + WS_ORAW), (const bf16_t*)(ws + WS_QC), (const float*)(ws + WS_DS), (const float*)(ws + WS_DG), ip.HG, args.in[3], (bf16_t*)(ws + WS_OHG), vcu, lds, tid, lane, wave); } }
#endif
    SEAM(3); TS(4);
#if MK_PROBE_BAR
    for (int rb2_ = 0; rb2_ < MK_PROBE_BAR; ++rb2_) xcd_barrier(bar);
#endif
#pragma unroll 1
    for (int rep4_ = 0; rep4_ < MK_DUP_P45; ++rep4_) { if (rep4_) xcd_barrier(bar);
    if constexpr (IN(4)) { pg8::Gemm g{SBW}; pg8::BranchSched S; S.o.init(NTOK / 256, DM / 256, G, bx, MK_WGM_P4); S.A0 = (const char*)(ws + WS_OSB); S.B0 = (const char*)(ws + WS_WBST); S.A1 = (const char*)(ws + WS_OHG); S.B1 = (const char*)(ws + WS_WBHT); S.tstep = (size_t)256 * SBW * 2;
      pg8::EpiBranch E{ip.GS, ip.GH, (bf16_t*)(ws + WS_MERGED)};
      pg8::gemm_phase<pg8::EpiBranch, pg8::BranchSched, true, true>(lds, g, S, E); }
    SEAM(4); TS(5);
    if constexpr (IN(5)) { pg8::Gemm g{DM}; pg8::DenseSched S; S.o.init(NTOK / 256, DM / 256, G, bx, MK_WGM_P5); S.A = (const char*)(ws + WS_MERGED); S.Bt = (const char*)(ws + WS_WOT); S.tstep = (size_t)256 * DM * 2;
      pg8::EpiOut E{(const bf16_t*)(ws + WS_XB), (bf16_t*)(ws + WS_PRE)};
      pg8::gemm_phase<pg8::EpiOut, pg8::DenseSched, true, true>(lds, g, S, E); }
    }
    SEAM(5); TS(6);
#if MK_DUP_TAIL & 1
    { FRESH_IDS(); phase_ln1_router(args, lds, bx, tid, lane, wave); } xcd_barrier(bar);
    { FRESH_IDS(); phase_assign(args, lds, bx, G, tid, lane, wave); } xcd_barrier(bar);
#endif
    if constexpr (IN(6)) { FRESH_IDS(); phase_ln1_router(args, lds, bx, tid, lane, wave); }
    SEAM(6); TS(7);
    if constexpr (IN(7)) { FRESH_IDS(); phase_assign(args, lds, bx, G, tid, lane, wave); }
    SEAM(7); TS(8);
    int ntiles = 0; if constexpr (IN(8) || IN(9)) ntiles = __builtin_amdgcn_readfirstlane(__hip_atomic_load((const int*)(ws + WS_CTL) + CW_NTILES, __ATOMIC_RELAXED, __HIP_MEMORY_SCOPE_AGENT)); const LAS int* tile_exp = (const LAS int*)(lds + LDS_TILEEXP);
    if constexpr (IN(8) || IN(9)) { for (int i = threadIdx.x; i < ntiles; i += NTHREADS) ((LAS int*)(lds + LDS_TILEEXP))[i] = __hip_atomic_load((const int*)(ws + WS_CTL) + CW_TILEEXP + i, __ATOMIC_RELAXED, __HIP_MEMORY_SCOPE_AGENT); __syncthreads(); }
#if MK_FP8_UP
#if MK_GATHER_A
    if constexpr (IN(8)) { pg8::Gemm g{DM / 2, 0x7f7f7f7f, W8_E8M0}; pg8::MoeGatherSched S; S.o.init(ntiles, UPW / 256, G, bx, MK_WGM_UP); S.A = (const char*)(ws + WS_XS); S.W = (const char*)(ws + WS_WUPT); S.tile_exp = tile_exp; S.tstep = (size_t)256 * DM; S.estep = (size_t)UPW * DM; S.slot_tok = (const int*)(ws + WS_SLOTTOK);
      pg8::EpiUpT<MK_FP8_DN != 0> E{args.in[12], (bf16_t*)(ws + WS_ACT)};
      pg8::gemm_phase_f8<pg8::EpiUpT<MK_FP8_DN != 0>, pg8::MoeGatherSched, true, true>(lds, g, S, E); }
#else
    if constexpr (IN(8)) { pg8::Gemm g{DM / 2, 0x7f7f7f7f, W8_E8M0}; pg8::MoeSched S; S.o.init(ntiles, UPW / 256, G, bx); S.A = (const char*)(ws + WS_XS); S.W = (const char*)(ws + WS_WUPT); S.tile_exp = tile_exp; S.tstep = (size_t)256 * DM; S.estep = (size_t)UPW * DM;
      pg8::EpiUpT<MK_FP8_DN != 0> E{args.in[12], (bf16_t*)(ws + WS_ACT)};
      pg8::gemm_phase_f8<pg8::EpiUpT<MK_FP8_DN != 0>, pg8::MoeSched, true, true>(lds, g, S, E); }
#endif
#else
    if constexpr (IN(8)) { pg8::Gemm g{DM}; pg8::MoeSched S; S.o.init(ntiles, UPW / 256, G, bx); S.A = (const char*)(ws + WS_XS); S.W = (const char*)(ws + WS_WUPT); S.tile_exp = tile_exp; S.tstep = (size_t)256 * DM * 2; S.estep = (size_t)UPW * DM * 2;
      pg8::EpiUpT<MK_FP8_DN != 0> E{args.in[12], (bf16_t*)(ws + WS_ACT)};
      pg8::gemm_phase<pg8::EpiUpT<MK_FP8_DN != 0>, pg8::MoeSched, true, true>(lds, g, S, E); }
#endif
    SEAM(8); TS(9);
#if MK_FP8_DN
    if constexpr (IN(9)) { pg8::Gemm g{DFF / 2, ACT8_E8M0, W8_E8M0}; pg8::MoeSched S; S.o.init(ntiles, DM / 256, G, bx, MK_WGM_DN); S.A = (const char*)(ws + WS_ACT); S.W = (const char*)(ws + WS_WDNT); S.tile_exp = tile_exp; S.tstep = (size_t)256 * DFF; S.estep = (size_t)DM * DFF;
      pg8::EpiDown E{args.in[14], (bf16_t*)(ws + WS_Y)};
      pg8::gemm_phase_f8<pg8::EpiDown, pg8::MoeSched, true, true>(lds, g, S, E); }
#else
    if constexpr (IN(9)) { pg8::Gemm g{DFF}; pg8::MoeSched S; S.o.init(ntiles, DM / 256, G, bx); S.A = (const char*)(ws + WS_ACT); S.W = (const char*)(ws + WS_WDNT); S.tile_exp = tile_exp; S.tstep = (size_t)256 * DFF * 2; S.estep = (size_t)DM * DFF * 2;
      pg8::EpiDown E{args.in[14], (bf16_t*)(ws + WS_Y)};
      pg8::gemm_phase<pg8::EpiDown, pg8::MoeSched, true, true>(lds, g, S, E); }
#endif
    SEAM(9); TS(10);
    if constexpr (IN(10)) { FRESH_IDS(); f32x4 g1[4], b1[4], g2[4], b2[4];
#pragma unroll
        for (int j = 0; j < 4; ++j) { const int c = lane * 4 + 256 * j; g1[j] = *(const f32x4*)(args.in[7] + c); b1[j] = *(const f32x4*)(args.in[8] + c); g2[j] = *(const f32x4*)(args.in[15] + c); b2[j] = *(const f32x4*)(args.in[16] + c); }
        int row = GW;
        for (; row + (MK_P10_ROWS - 1) * NGW < NTOK; row += MK_P10_ROWS * NGW) combine_rows<MK_P10_ROWS>(args, row, NGW, lane, g1, b1, g2, b2);
        for (; row < NTOK; row += NGW) combine_rows<1>(args, row, NGW, lane, g1, b1, g2, b2); }
#if MK_PROBE
    xcd_barrier(bar); TS(11);
    if (bx == 0 && threadIdx.x == 0) { unsigned* mk = (unsigned*)(ws + WS_LB + 3072); const bool warm = __hip_atomic_load(mk, __ATOMIC_RELAXED, __HIP_MEMORY_SCOPE_AGENT) == 0x51a7e5u; __hip_atomic_store(mk, 0x51a7e5u, __ATOMIC_RELAXED, __HIP_MEMORY_SCOPE_AGENT);
        const float dA = (float)(ts[MK_PA1] - ts[MK_PA0]) * 0.01f;
        __hip_atomic_store((float*)(ws + WS_CTL) + 40, warm ? dA * (1.0f / 500.0f) : 0.f, __ATOMIC_RELAXED, __HIP_MEMORY_SCOPE_AGENT); }
    xcd_barrier(bar);
    { FRESH_IDS(); const float eps = __hip_atomic_load((float*)(ws + WS_CTL) + 40, __ATOMIC_RELAXED, __HIP_MEMORY_SCOPE_AGENT);
      for (int row = GW; row < NTOK; row += NGW) for (int j2 = 0; j2 < 4; ++j2) { f32x4* p = (f32x4*)(args.out + (size_t)row * DM + lane * 4 + 256 * j2); *p = *p * (1.0f + eps); } }
#endif
}


#if MK_MODE == 2
namespace v1 {
constexpr int CW_CNT = 60000, CW_CUR = 60064, CW_PADSTART = 60128, CW_NTILES = 60192, CW_TILEEXP = 60256;
__device__ __forceinline__ float sigmoidf_(float v) { return 1.0f / (1.0f + expf(-v)); }
__global__ __launch_bounds__(256) void k_transpose_bf16(const float* __restrict__ W, bf16_t* __restrict__ WT, int K, int N) {
    __shared__ float tile[64][65];
    const size_t g = blockIdx.z; W += g * (size_t)K * N; WT += g * (size_t)K * N;
    const int k0 = blockIdx.y * 64, n0 = blockIdx.x * 64, tx = threadIdx.x & 63, ty = threadIdx.x >> 6;
    for (int i = ty; i < 64; i += 4) tile[i][tx] = W[(size_t)(k0 + i) * N + n0 + tx];
    __syncthreads();
    for (int i = ty; i < 64; i += 4) WT[(size_t)(n0 + i) * K + k0 + tx] = (bf16_t)f2bf(tile[tx][i]);
}
__global__ __launch_bounds__(256) void k_convert_x(const float* __restrict__ x, bf16_t* __restrict__ xb, const float* __restrict__ lbl, float* __restrict__ lb) {
    const size_t i = (size_t)blockIdx.x * 256 + threadIdx.x;
    const f32x4 v = ((const f32x4*)x)[i];
    uint2 o; o.x = f2bf(v[0]) | (f2bf(v[1]) << 16); o.y = f2bf(v[2]) | (f2bf(v[3]) << 16);
    ((uint2*)xb)[i] = o;
    if (blockIdx.x == 0) for (int c = threadIdx.x; c < HGW; c += 256) { const float l0 = lbl[c], l1 = lbl[HGW + c]; lb[c] = 1.0f / (1.0f + expf(l1 - l0)); }
}

constexpr int G_BM = 128, G_BK = 32, G_HTB = G_BM * G_BK * 2;
__device__ __forceinline__ void g128_loop(f32x4 (&acc)[4][4], const bf16_t* a0, const bf16_t* a1, const bf16_t* b0, const bf16_t* b1, int K, LAS unsigned char* shm) {
    const int tid = threadIdx.x, wid = tid >> 6, lane = tid & 63, wr = wid >> 1, wc = wid & 1, fr = lane & 15, fq = lane >> 4;
    LAS unsigned char* SA = shm; LAS unsigned char* SB = shm + G_HTB;
    for (int t = 0; t < K / G_BK; ++t) {
        __builtin_amdgcn_global_load_lds((const unsigned*)(a0 + t * G_BK), (LAS unsigned*)(SA + tid * 16), 16, 0, 0);
        __builtin_amdgcn_global_load_lds((const unsigned*)(a1 + t * G_BK), (LAS unsigned*)(SA + tid * 16 + 4096), 16, 0, 0);
        __builtin_amdgcn_global_load_lds((const unsigned*)(b0 + t * G_BK), (LAS unsigned*)(SB + tid * 16), 16, 0, 0);
        __builtin_amdgcn_global_load_lds((const unsigned*)(b1 + t * G_BK), (LAS unsigned*)(SB + tid * 16 + 4096), 16, 0, 0);
        asm volatile("s_waitcnt vmcnt(0)" ::: "memory"); __syncthreads();
        bf16x8 At[4], Bt[4];
#pragma unroll
        for (int m = 0; m < 4; ++m) { At[m] = *(const LAS bf16x8*)(SA + (wr * 64 + m * 16 + fr) * (G_BK * 2) + fq * 16); Bt[m] = *(const LAS bf16x8*)(SB + (wc * 64 + m * 16 + fr) * (G_BK * 2) + fq * 16); }
        asm volatile("s_waitcnt lgkmcnt(0)" ::: "memory"); __builtin_amdgcn_sched_barrier(0);
#pragma unroll
        for (int m = 0; m < 4; ++m)
#pragma unroll
            for (int n = 0; n < 4; ++n) acc[m][n] = __builtin_amdgcn_mfma_f32_16x16x32_bf16(At[m], Bt[n], acc[m][n], 0, 0, 0);
        __syncthreads();
    }
}
#define G128_ZERO(acc) _Pragma("unroll") for (int m_ = 0; m_ < 4; ++m_) _Pragma("unroll") for (int n_ = 0; n_ < 4; ++n_) acc[m_][n_] = (f32x4){0.f, 0.f, 0.f, 0.f}
#define G128_FOREACH(...) do { const int wid_ = threadIdx.x >> 6, lane_ = threadIdx.x & 63, wr_ = wid_ >> 1, wc_ = wid_ & 1, fr_ = lane_ & 15, fq_ = lane_ >> 4; \
    _Pragma("unroll") for (int m_ = 0; m_ < 4; ++m_) _Pragma("unroll") for (int n_ = 0; n_ < 4; ++n_) _Pragma("unroll") for (int j_ = 0; j_ < 4; ++j_) { \
        const int trow = wr_ * 64 + m_ * 16 + fq_ * 4 + j_, tcol = wc_ * 64 + n_ * 16 + fr_; __VA_ARGS__ } } while (0)


__global__ __launch_bounds__(256) void k_inproj(const bf16_t* __restrict__ XB, const bf16_t* __restrict__ WinT, InProjOut o) {
    __shared__ __attribute__((aligned(16))) unsigned char shm[2 * G_HTB];
    const int bcol = blockIdx.x * G_BM, brow = blockIdx.y * G_BM, tid = threadIdx.x, r0 = tid >> 2, c = (tid & 3) * 8;
    f32x4 acc[4][4]; G128_ZERO(acc);
    g128_loop(acc, XB + (size_t)(brow + r0) * DM + c, XB + (size_t)(brow + r0 + 64) * DM + c, WinT + (size_t)(bcol + r0) * DM + c, WinT + (size_t)(bcol + r0 + 64) * DM + c, DM, (LAS unsigned char*)shm);
    const int seg = bcol / 512;
    G128_FOREACH({
        const int row = brow + trow, col = bcol + tcol; const float v = acc[m_][n_][j_];
        if (seg == 0) o.Q[(size_t)row * 512 + col] = (bf16_t)f2bf(v * 0.125f);
        else if (seg == 1) o.K[(size_t)row * 512 + (col - 512)] = (bf16_t)f2bf(v);
        else if (seg == 2) o.V[(size_t)row * 512 + (col - 1024)] = (bf16_t)f2bf(v);
        else if (seg == 3) o.HQ[(size_t)row * 512 + (col - 1536)] = (bf16_t)f2bf(v * sigmoidf_(v));
        else if (seg == 4) { const int cc = col - 2048; const float l = o.lb[cc], f = l + (1.0f - l) * sigmoidf_(v);
            o.HK[(size_t)row * 512 + cc] = (bf16_t)f2bf(1.0f - f); o.LOGF[(size_t)row * 512 + cc] = logf(f); }
        else if (seg == 5) o.HV[(size_t)row * 512 + (col - 2560)] = (bf16_t)f2bf(v);
        else if (seg == 6) o.HG[(size_t)row * 512 + (col - 3072)] = (bf16_t)f2bf(sigmoidf_(v));
        else if (seg < 9) o.GS[(size_t)row * 1024 + (col - 3584)] = (bf16_t)f2bf(sigmoidf_(v));
        else o.GH[(size_t)row * 1024 + (col - 4608)] = (bf16_t)f2bf(sigmoidf_(v));
    });
}

__global__ __launch_bounds__(256) void k_branch(const bf16_t* __restrict__ OSB, const bf16_t* __restrict__ OHG, const bf16_t* __restrict__ WbsT, const bf16_t* __restrict__ WbhT,
                                                const bf16_t* __restrict__ GS, const bf16_t* __restrict__ GH, bf16_t* __restrict__ MERGED) {
    __shared__ __attribute__((aligned(16))) unsigned char shm[2 * G_HTB];
    const int bcol = blockIdx.x * G_BM, brow = blockIdx.y * G_BM, tid = threadIdx.x, r0 = tid >> 2, c = (tid & 3) * 8;
    f32x4 accA[4][4], accB[4][4]; G128_ZERO(accA); G128_ZERO(accB);
    g128_loop(accA, OSB + (size_t)(brow + r0) * SBW + c, OSB + (size_t)(brow + r0 + 64) * SBW + c, WbsT + (size_t)(bcol + r0) * SBW + c, WbsT + (size_t)(bcol + r0 + 64) * SBW + c, SBW, (LAS unsigned char*)shm);
    g128_loop(accB, OHG + (size_t)(brow + r0) * HGW + c, OHG + (size_t)(brow + r0 + 64) * HGW + c, WbhT + (size_t)(bcol + r0) * HGW + c, WbhT + (size_t)(bcol + r0 + 64) * HGW + c, HGW, (LAS unsigned char*)shm);
    G128_FOREACH({
        const size_t idx = (size_t)(brow + trow) * DM + bcol + tcol;
        MERGED[idx] = (bf16_t)f2bf(bf2f(GS[idx]) * accA[m_][n_][j_] + bf2f(GH[idx]) * accB[m_][n_][j_]);
    });
}

__global__ __launch_bounds__(256) void k_outproj(const bf16_t* __restrict__ MERGED, const bf16_t* __restrict__ WoT, const float* __restrict__ x, float* __restrict__ PRE) {
    __shared__ __attribute__((aligned(16))) unsigned char shm[2 * G_HTB];
    const int bcol = blockIdx.x * G_BM, brow = blockIdx.y * G_BM, tid = threadIdx.x, r0 = tid >> 2, c = (tid & 3) * 8;
    f32x4 acc[4][4]; G128_ZERO(acc);
    g128_loop(acc, MERGED + (size_t)(brow + r0) * DM + c, MERGED + (size_t)(brow + r0 + 64) * DM + c, WoT + (size_t)(bcol + r0) * DM + c, WoT + (size_t)(bcol + r0 + 64) * DM + c, DM, (LAS unsigned char*)shm);
    G128_FOREACH({ const size_t idx = (size_t)(brow + trow) * DM + bcol + tcol; PRE[idx] = DN_ALPHA * x[idx] + acc[m_][n_][j_]; });
}

__global__ __launch_bounds__(256) void k_moe_up(const bf16_t* __restrict__ HB, const bf16_t* __restrict__ WupT, const float* __restrict__ b_up, const int* __restrict__ ctl,
                                                const int* __restrict__ slot_tok, bf16_t* __restrict__ ACT) {
    __shared__ __attribute__((aligned(16))) unsigned char shm[2 * G_HTB];
    const int rt = blockIdx.y; if (rt >= 2 * ctl[CW_NTILES]) return;
    const int e = ctl[CW_TILEEXP + (rt >> 1)];
    const int bcol = blockIdx.x * G_BM, brow = rt * G_BM, tid = threadIdx.x, r0 = tid >> 2, c = (tid & 3) * 8;
    int t0 = slot_tok[brow + r0], t1 = slot_tok[brow + r0 + 64]; if (t0 < 0) t0 = 0; if (t1 < 0) t1 = 0;
    const bf16_t* W = WupT + (size_t)e * UPW * DM;
    f32x4 acc[4][4]; G128_ZERO(acc);
    g128_loop(acc, HB + (size_t)t0 * DM + c, HB + (size_t)t1 * DM + c, W + (size_t)(bcol + r0) * DM + c, W + (size_t)(bcol + r0 + 64) * DM + c, DM, (LAS unsigned char*)shm);
    G128_FOREACH({
        const int col = bcol + tcol; const float v = acc[m_][n_][j_] + b_up[e * UPW + col];
        const float other = __shfl_xor(v, 1);
        if ((col & 1) == 0) { const float g = fminf(v, SW_LIMIT), l = fminf(fmaxf(other, -SW_LIMIT), SW_LIMIT);
            ACT[(size_t)(brow + trow) * DFF + (col >> 1)] = (bf16_t)f2bf(g * sigmoidf_(SW_ALPHA * g) * (l + 1.0f)); }
    });
}
__global__ __launch_bounds__(256) void k_moe_down(const bf16_t* __restrict__ ACT, const bf16_t* __restrict__ WdnT, const float* __restrict__ b_dn, const int* __restrict__ ctl, bf16_t* __restrict__ Y) {
    __shared__ __attribute__((aligned(16))) unsigned char shm[2 * G_HTB];
    const int rt = blockIdx.y; if (rt >= 2 * ctl[CW_NTILES]) return;
    const int e = ctl[CW_TILEEXP + (rt >> 1)];
    const int bcol = blockIdx.x * G_BM, brow = rt * G_BM, tid = threadIdx.x, r0 = tid >> 2, c = (tid & 3) * 8;
    const bf16_t* W = WdnT + (size_t)e * DM * DFF;
    f32x4 acc[4][4]; G128_ZERO(acc);
    g128_loop(acc, ACT + (size_t)(brow + r0) * DFF + c, ACT + (size_t)(brow + r0 + 64) * DFF + c, W + (size_t)(bcol + r0) * DFF + c, W + (size_t)(bcol + r0 + 64) * DFF + c, DFF, (LAS unsigned char*)shm);
    G128_FOREACH({ const int col = bcol + tcol; Y[(size_t)(brow + trow) * DM + col] = (bf16_t)f2bf(acc[m_][n_][j_] + b_dn[e * DM + col]); });
}

__global__ __launch_bounds__(64) void k_attn_naive(const bf16_t* __restrict__ Q, const bf16_t* __restrict__ K, const bf16_t* __restrict__ V, bf16_t* __restrict__ O) {
    const int qb = 31 - (int)blockIdx.x, bh = blockIdx.y, b = bh >> 3, h = bh & 7;
    const int t = qb * 64 + threadIdx.x; const size_t rowbase = (size_t)b * SEQ;
    float q[64], o[64];
    { const bf16_t* qp = Q + (rowbase + t) * SBW + h * SBD;
#pragma unroll
      for (int d = 0; d < 64; ++d) { q[d] = bf2f(qp[d]); o[d] = 0.f; } }
    float R = 1.0f;
    for (int s = qb * 64 + 63; s >= 0; --s) {
        const bf16_t* kr = K + (rowbase + s) * SBW + h * SBD; const bf16_t* vr = V + (rowbase + s) * SBW + h * SBD;
        float z = 0.f;
#pragma unroll
        for (int d = 0; d < 64; ++d) z += q[d] * bf2f(kr[d]);
        const bool valid = s < t;
        const float ez = expf(fminf(z, 60.0f)), keep = 1.0f / (1.0f + ez);
        const float a = valid ? ez * keep * R : 0.f;
        R = valid ? R * keep : R;
#pragma unroll
        for (int d = 0; d < 64; ++d) o[d] += a * bf2f(vr[d]);
    }
    bf16_t* op = O + (rowbase + t) * SBW + h * SBD;
#pragma unroll
    for (int d = 0; d < 64; ++d) op[d] = (bf16_t)f2bf(o[d]);
}

__global__ __launch_bounds__(128) void k_hgrn_naive(const bf16_t* __restrict__ HQ, const bf16_t* __restrict__ HK, const float* __restrict__ LOGF, const bf16_t* __restrict__ HV, float* __restrict__ ORAW) {
    __shared__ __attribute__((aligned(16))) float sf[128], sk[128], sq[128];
    const int bh = blockIdx.x, b = bh >> 2, hh = bh & 3, v = threadIdx.x;
    float S[128];
#pragma unroll
    for (int k = 0; k < 128; ++k) S[k] = 0.f;
    for (int t = 0; t < SEQ; ++t) {
        const size_t base = ((size_t)b * SEQ + t) * HGW + hh * HGD;
        sf[v] = expf(LOGF[base + v]); sk[v] = bf2f(HK[base + v]); sq[v] = bf2f(HQ[base + v]);
        const float vv = bf2f(HV[base + v]);
        __syncthreads();
        float o = 0.f;
#pragma unroll
        for (int k = 0; k < 128; ++k) { S[k] = sf[k] * S[k] + sk[k] * vv; o += sq[k] * S[k]; }
        ORAW[base + v] = o;
        __syncthreads();
    }
}
__global__ __launch_bounds__(256) void k_hgrn_post(const float* __restrict__ ORAW, const bf16_t* __restrict__ HG, const float* __restrict__ norm_g, bf16_t* __restrict__ OHG) {
    const int gw = blockIdx.x * 4 + (threadIdx.x >> 6), lane = threadIdx.x & 63;
    const size_t base = (size_t)gw * HGD; const int c0 = (gw & 3) * HGD;
    const float x0 = ORAW[base + lane], x1 = ORAW[base + 64 + lane];
    const float r = 1.0f / sqrtf(wave_sum(x0 * x0 + x1 * x1) * (1.0f / HGD) + RMS_EPS);
    OHG[base + lane] = (bf16_t)f2bf(x0 * r * norm_g[c0 + lane] * bf2f(HG[base + lane]));
    OHG[base + 64 + lane] = (bf16_t)f2bf(x1 * r * norm_g[c0 + 64 + lane] * bf2f(HG[base + 64 + lane]));
}

__global__ __launch_bounds__(256) void k_ln1_router(const float* __restrict__ PRE, const float* __restrict__ g, const float* __restrict__ bta, const float* __restrict__ rw, const float* __restrict__ rb,
                                                    float* __restrict__ H, bf16_t* __restrict__ HB, int* __restrict__ TOPI, float* __restrict__ TOPG) {
    __shared__ __attribute__((aligned(16))) float hs[4][DM];
    const int w = threadIdx.x >> 6, lane = threadIdx.x & 63, row = blockIdx.x * 4 + w;
    f32x4 v[4]; float s = 0.f;
#pragma unroll
    for (int j = 0; j < 4; ++j) { v[j] = *(const f32x4*)(PRE + (size_t)row * DM + lane * 4 + 256 * j); s += (v[j][0] + v[j][1]) + (v[j][2] + v[j][3]); }
    const float mean = wave_sum(s) * (1.0f / DM); float s2 = 0.f;
#pragma unroll
    for (int j = 0; j < 4; ++j) { v[j] = v[j] - mean; s2 += (v[j][0] * v[j][0] + v[j][1] * v[j][1]) + (v[j][2] * v[j][2] + v[j][3] * v[j][3]); }
    const float rstd = 1.0f / sqrtf(wave_sum(s2) * (1.0f / DM) + LN_EPS);
#pragma unroll
    for (int j = 0; j < 4; ++j) { const int c = lane * 4 + 256 * j; const f32x4 gg = *(const f32x4*)(g + c), bb = *(const f32x4*)(bta + c);
        f32x4 hv = v[j] * rstd * gg + bb; *(f32x4*)(H + (size_t)row * DM + c) = hv; *(f32x4*)(&hs[w][c]) = hv;
        uint2 o; o.x = f2bf(hv[0]) | (f2bf(hv[1]) << 16); o.y = f2bf(hv[2]) | (f2bf(hv[3]) << 16); *(uint2*)(HB + (size_t)row * DM + c) = o; }
    __syncthreads();
    const int e = lane & 31, half = lane >> 5; float a = 0.f;
    for (int c = half * 512; c < half * 512 + 512; ++c) a += hs[w][c] * rw[c * NEXP + e];
    a += __shfl_xor(a, 32);
    float val = (lane < 32) ? a + rb[e] : -INFINITY; int idx = e;
    float tv[4]; int ti[4];
#pragma unroll
    for (int r = 0; r < 4; ++r) {
        float bv = val; int bi = idx;
#pragma unroll
        for (int off = 32; off >= 1; off >>= 1) { const float ov = __shfl_xor(bv, off); const int oi = __shfl_xor(bi, off); if (ov > bv || (ov == bv && oi < bi)) { bv = ov; bi = oi; } }
        tv[r] = bv; ti[r] = bi; if (lane < 32 && e == bi) val = -INFINITY;
    }
    if (lane == 0) { const float e1 = expf(tv[1] - tv[0]), e2 = expf(tv[2] - tv[0]), e3 = expf(tv[3] - tv[0]), inv = 1.0f / (1.0f + e1 + e2 + e3);
        *(int4*)(TOPI + row * 4) = make_int4(ti[0], ti[1], ti[2], ti[3]); *(float4*)(TOPG + row * 4) = make_float4(inv, e1 * inv, e2 * inv, e3 * inv); }
}

__global__ __launch_bounds__(256) void k_count(const int* __restrict__ TOPI, int* __restrict__ ctl, int* __restrict__ slot_tok) {
    __shared__ int hist[NEXP];
    if (threadIdx.x < NEXP) hist[threadIdx.x] = 0;
    __syncthreads();
    const int i = blockIdx.x * 256 + threadIdx.x;
    atomicAdd(&hist[TOPI[i]], 1);
    __syncthreads();
    if (threadIdx.x < NEXP) atomicAdd(&ctl[CW_CNT + threadIdx.x], hist[threadIdx.x]);
    for (int s = i; s < NSLOT_MAX; s += NASSIGN) slot_tok[s] = -1;
}
__global__ __launch_bounds__(64) void k_plan(int* __restrict__ ctl) {
    if (threadIdx.x == 0) { int ps = 0, nt = 0;
        for (int e = 0; e < NEXP; ++e) { ctl[CW_PADSTART + e] = ps; const int te = (ctl[CW_CNT + e] + SLOT_PAD - 1) / SLOT_PAD; for (int i = 0; i < te; ++i) ctl[CW_TILEEXP + nt++] = e; ps += te * SLOT_PAD; }
        ctl[CW_PADSTART + NEXP] = ps; ctl[CW_NTILES] = nt; }
}
__global__ __launch_bounds__(256) void k_assign(const int* __restrict__ TOPI, int* __restrict__ ctl, int* __restrict__ slot_tok, int* __restrict__ DEST) {
    const int i = blockIdx.x * 256 + threadIdx.x, e = TOPI[i];
    const int slot = ctl[CW_PADSTART + e] + atomicAdd(&ctl[CW_CUR + e], 1);
    slot_tok[slot] = i >> 2; DEST[i] = slot;
}
__global__ __launch_bounds__(256) void k_combine_ln2(const float* __restrict__ H, const bf16_t* __restrict__ Y, const int* __restrict__ DEST, const float* __restrict__ TOPG,
                                                     const float* __restrict__ g, const float* __restrict__ bta, float* __restrict__ out) {
    const int lane = threadIdx.x & 63, row = blockIdx.x * 4 + (threadIdx.x >> 6);
    const int4 d = *(const int4*)(DEST + row * 4); const float4 gt = *(const float4*)(TOPG + row * 4);
    const int ds[4] = {d.x, d.y, d.z, d.w}; const float gs[4] = {gt.x, gt.y, gt.z, gt.w};
    f32x4 v[4]; float s = 0.f;
#pragma unroll
    for (int j = 0; j < 4; ++j) { const int c = lane * 4 + 256 * j; f32x4 a = *(const f32x4*)(H + (size_t)row * DM + c) * DN_ALPHA;
#pragma unroll
        for (int k = 0; k < 4; ++k) { const uint2 y = *(const uint2*)(Y + (size_t)ds[k] * DM + c);
            a[0] += gs[k] * bf2f(y.x & 0xffff); a[1] += gs[k] * bf2f(y.x >> 16); a[2] += gs[k] * bf2f(y.y & 0xffff); a[3] += gs[k] * bf2f(y.y >> 16); }
        v[j] = a; s += (a[0] + a[1]) + (a[2] + a[3]); }
    const float mean = wave_sum(s) * (1.0f / DM); float s2 = 0.f;
#pragma unroll
    for (int j = 0; j < 4; ++j) { v[j] = v[j] - mean; s2 += (v[j][0] * v[j][0] + v[j][1] * v[j][1]) + (v[j][2] * v[j][2] + v[j][3] * v[j][3]); }
    const float rstd = 1.0f / sqrtf(wave_sum(s2) * (1.0f / DM) + LN_EPS);
#pragma unroll
    for (int j = 0; j < 4; ++j) { const int c = lane * 4 + 256 * j; *(f32x4*)(out + (size_t)row * DM + c) = v[j] * rstd * *(const f32x4*)(g + c) + *(const f32x4*)(bta + c); }
}

}
#endif
extern "C" void kernel_launch(void* const* d_in, const int* in_sizes, int n_in, void* d_out, int out_size, void* d_ws, size_t ws_size, hipStream_t stream) {
    static int grid = 0;
    if (grid == 0) {
        if (n_in != 17 || ws_size < WS_END) { fprintf(stderr, "kernel_launch: unexpected n_in %d or ws_size %zu (< %zu)\n", n_in, ws_size, (size_t)WS_END); grid = -1; return; }
        int dev = 0, cus = 0;
        if (hipGetDevice(&dev) != hipSuccess || hipDeviceGetAttribute(&cus, hipDeviceAttributeMultiprocessorCount, dev) != hipSuccess) { grid = -1; return; }
#define MK_ATTR(LO_, HI_) if (hipFuncSetAttribute((const void*)mk_fwd<LO_, HI_>, hipFuncAttributeMaxDynamicSharedMemorySize, LDS_BYTES) != hipSuccess) { fprintf(stderr, "kernel_launch: hipFuncSetAttribute failed\n"); grid = -1; return; }
#if MK_MODE == 0
        MK_ATTR(0, 11)
#elif MK_MODE == 2
        MK_ATTR(0, 1) MK_ATTR(1, 2) MK_ATTR(2, 3) MK_ATTR(3, 4) MK_ATTR(4, 5) MK_ATTR(5, 6)
#else
        MK_ATTR(0, 1) MK_ATTR(1, 2) MK_ATTR(2, 3) MK_ATTR(3, 4) MK_ATTR(4, 5) MK_ATTR(5, 6) MK_ATTR(6, 8) MK_ATTR(8, 9) MK_ATTR(9, 10) MK_ATTR(10, 11)
#endif
        grid = cus;
        if (grid != 256) fprintf(stderr, "kernel_launch: %d CUs (built for 256)\n", grid);
    }
    if (grid < 0) return;
    (void)hipMemsetAsync((char*)d_ws + WS_CTL, 0, CTL_ZERO_BYTES, stream);
    Args a{};
    for (int i = 0; i < 17; ++i) a.in[i] = (const float*)d_in[i];
    a.out = (float*)d_out; a.ws = (unsigned char*)d_ws;
#define MK_LAUNCH(LO_, HI_, LI_) do { a.ph_lo = LO_; a.ph_hi = HI_; a.li = LI_; hipLaunchKernelGGL((mk_fwd<LO_, HI_>), dim3(grid), dim3(NTHREADS), LDS_BYTES, stream, a); } while (0)
#if MK_MODE == 0
    MK_LAUNCH(0, 11, 0);
#elif MK_MODE == 2
    { unsigned char* ws = (unsigned char*)d_ws;
      InProjOut ip{}; ip.Q = (bf16_t*)(ws + WS_Q); ip.K = (bf16_t*)(ws + WS_K); ip.V = (bf16_t*)(ws + WS_V); ip.HQ = (bf16_t*)(ws + WS_HQ); ip.HK = (bf16_t*)(ws + WS_HK); ip.HV = (bf16_t*)(ws + WS_HV);
      ip.HG = (bf16_t*)(ws + WS_HG); ip.GS = (bf16_t*)(ws + WS_GS); ip.GH = (bf16_t*)(ws + WS_GH); ip.LOGF = (float*)(ws + WS_LOGF); ip.lb = (const float*)(ws + WS_LB);
#if MK_HEAD_V1 >= 1
      v1::k_convert_x<<<NTOK * DM / 4 / 256, 256, 0, stream>>>(a.in[0], (bf16_t*)(ws + WS_XB), a.in[2], (float*)(ws + WS_LB));
      v1::k_transpose_bf16<<<dim3(INW / 64, DM / 64, 1), 256, 0, stream>>>(a.in[1], (bf16_t*)(ws + WS_WINT), DM, INW);
      v1::k_transpose_bf16<<<dim3(DM / 64, SBW / 64, 1), 256, 0, stream>>>(a.in[4], (bf16_t*)(ws + WS_WBST), SBW, DM);
      v1::k_transpose_bf16<<<dim3(DM / 64, HGW / 64, 1), 256, 0, stream>>>(a.in[5], (bf16_t*)(ws + WS_WBHT), HGW, DM);
      v1::k_transpose_bf16<<<dim3(DM / 64, DM / 64, 1), 256, 0, stream>>>(a.in[6], (bf16_t*)(ws + WS_WOT), DM, DM);
      v1::k_transpose_bf16<<<dim3(UPW / 64, DM / 64, NEXP), 256, 0, stream>>>(a.in[11], (bf16_t*)(ws + WS_WUPT), DM, UPW);
      v1::k_transpose_bf16<<<dim3(DM / 64, DFF / 64, NEXP), 256, 0, stream>>>(a.in[13], (bf16_t*)(ws + WS_WDNT), DFF, DM);
#else
      MK_LAUNCH(0, 1, 0);
#endif
#if MK_HEAD_V1 >= 2
      v1::k_inproj<<<dim3(INW / v1::G_BM, NTOK / v1::G_BM), 256, 0, stream>>>((const bf16_t*)(ws + WS_XB), (const bf16_t*)(ws + WS_WINT), ip);
#else
      MK_LAUNCH(1, 2, 1);
#endif
      MK_LAUNCH(2, 3, 2); MK_LAUNCH(3, 4, 3); MK_LAUNCH(4, 5, 4); MK_LAUNCH(5, 6, 5); }
    { unsigned char* ws = (unsigned char*)d_ws; int* ctl = (int*)(ws + WS_CTL); bf16_t* HB = (bf16_t*)(ws + WS_XS); int* TOPI = (int*)(ws + WS_XS + 32 * MiB); int* SLOTTOK = (int*)(ws + WS_XS + 33 * MiB);
      float* TOPG = (float*)(ws + WS_TOPG); int* DEST = (int*)(ws + WS_DEST); float* H = (float*)(ws + WS_H); bf16_t* ACT = (bf16_t*)(ws + WS_ACT); bf16_t* Y = (bf16_t*)(ws + WS_Y);
      v1::k_ln1_router<<<NTOK / 4, 256, 0, stream>>>((const float*)(ws + WS_PRE), a.in[7], a.in[8], a.in[9], a.in[10], H, HB, TOPI, TOPG);
      v1::k_count<<<NASSIGN / 256, 256, 0, stream>>>(TOPI, ctl, SLOTTOK);
      v1::k_plan<<<1, 64, 0, stream>>>(ctl);
      v1::k_assign<<<NASSIGN / 256, 256, 0, stream>>>(TOPI, ctl, SLOTTOK, DEST);
      v1::k_moe_up<<<dim3(UPW / v1::G_BM, NSLOT_MAX / v1::G_BM), 256, 0, stream>>>(HB, (const bf16_t*)(ws + WS_WUPT), a.in[12], ctl, SLOTTOK, ACT);
      v1::k_moe_down<<<dim3(DM / v1::G_BM, NSLOT_MAX / v1::G_BM), 256, 0, stream>>>(ACT, (const bf16_t*)(ws + WS_WDNT), a.in[14], ctl, Y);
      v1::k_combine_ln2<<<NTOK / 4, 256, 0, stream>>>(H, Y, DEST, TOPG, a.in[15], a.in[16], (float*)d_out); }
#else
    MK_LAUNCH(0, 1, 0); MK_LAUNCH(1, 2, 1); MK_LAUNCH(2, 3, 2); MK_LAUNCH(3, 4, 3); MK_LAUNCH(4, 5, 4); MK_LAUNCH(5, 6, 5); MK_LAUNCH(6, 8, 6); MK_LAUNCH(8, 9, 7); MK_LAUNCH(9, 10, 8); MK_LAUNCH(10, 11, 9);
#endif
}
```

```cpp
#include <hip/hip_runtime.h>
#include <stdint.h>
#include <cstdio>

#define LAS __attribute__((address_space(3)))
#define GAS __attribute__((address_space(1)))
typedef unsigned short bf16_t;
typedef short bf16x8 __attribute__((ext_vector_type(8)));
typedef float f32x4 __attribute__((ext_vector_type(4)));
typedef float f32x16 __attribute__((ext_vector_type(16)));
typedef unsigned u32x4 __attribute__((ext_vector_type(4)));
typedef unsigned u32x2 __attribute__((ext_vector_type(2)));
typedef float f32x2_t __attribute__((ext_vector_type(2)));

constexpr int NTOK = 16384, DM = 1024, INW = 5632, SBW = 512, HGW = 512, NEXP = 32, TOPK = 4, DFF = 1024, UPW = 2048;
constexpr int SEQ = 2048, SBH = 8, SBD = 64, HGH = 4, HGD = 128;
constexpr int NASSIGN = NTOK * TOPK;
constexpr int SLOT_PAD = 256;
constexpr int NSLOT_MAX = NASSIGN + NEXP * SLOT_PAD;
constexpr int NTILE_MAX = NSLOT_MAX / SLOT_PAD;
constexpr float LN_EPS = 1e-5f, RMS_EPS = 1e-6f, DN_ALPHA = 1.189207115002721f, SW_ALPHA = 1.702f, SW_LIMIT = 7.0f, LOG2E = 1.4426950408889634f, LN2 = 0.6931471805599453f;
constexpr int NWAVES = 8, NTHREADS = 512;
constexpr float W8_SCALE = 32.0f; constexpr int W8_E8M0 = 0x7a7a7a7a;
#ifndef MK_Y8
#define MK_Y8 1
#endif
constexpr float Y8_SCALE = 16.0f;
constexpr float ACT8_SCALE = 4.0f; constexpr int ACT8_E8M0 = 0x7d7d7d7d;
#ifndef MK_DUP_P1
#define MK_DUP_P1 1
#endif
#ifndef MK_DUP_HGA
#define MK_DUP_HGA 1
#endif
#ifndef MK_DUP_HGB
#define MK_DUP_HGB 1
#endif
#ifndef MK_DUP_P45
#define MK_DUP_P45 1
#endif
#ifndef MK_BG_WAVES
#define MK_BG_WAVES 3
#endif
#ifndef MK_BG_SEAMS
#define MK_BG_SEAMS 0xFE
#endif
#ifndef MK_PROBE_CONV
#define MK_PROBE_CONV 0
#endif
#ifndef MK_PROBE_BAR
#define MK_PROBE_BAR 0
#endif
#ifndef MK_LOOP_P2
#define MK_LOOP_P2 1
#endif
#ifndef MK_DUP_TAIL
#define MK_DUP_TAIL 0
#endif
#ifndef MK_FP8_GATES
#define MK_FP8_GATES 1
#endif
#ifndef MK_FP8_DN
#define MK_FP8_DN 1
#endif
#ifndef MK_FP8_UP
#define MK_FP8_UP 1
#endif
#ifndef MK_BG
#define MK_BG 1
#endif
#ifndef MK_DUP_P2
#define MK_DUP_P2 1
#define MK_DUP_WHAT 0
#endif
#ifndef MK_PROBE
#define MK_PROBE 0
#endif
#define MK_PROBE_UNUSED 0
#ifndef MK_P0_ROWS
#define MK_P0_ROWS 2
#endif
#ifndef MK_PB_GROWS
#define MK_PB_GROWS 16
#endif
#ifndef MK_P10_ROWS
#define MK_P10_ROWS 4
#endif
#ifndef MK_WGM_P1A
#define MK_WGM_P1A 4
#define MK_WGM_P1B 4
#define MK_WGM_P4 8
#define MK_WGM_P5 8
#endif
#ifndef MK_WGM_DN
#define MK_WGM_DN 4
#endif
#ifndef MK_WGM_UP
#define MK_WGM_UP 4
#endif
#ifndef MK_GATHER_A
#define MK_GATHER_A 1
#endif
#ifndef MK_BR_BATCH
#define MK_BR_BATCH 3
#endif
#ifndef MK_PA0
#define MK_PA0 0
#define MK_PA1 1
#define MK_PB0 1
#define MK_PB1 2
#endif
#ifndef MK_NAIVE_MIX
#define MK_NAIVE_MIX 0
#endif
#ifndef MK_MODE
#ifndef MK_P1_ALIGN
#define MK_P1_ALIGN true
#endif
#ifndef MK_P1_SP2
#define MK_P1_SP2 true
#endif
#ifndef MK_HEAD_V1
#define MK_HEAD_V1 0
#endif
#define MK_MODE 0
#endif

constexpr size_t MiB = 1u << 20;
constexpr size_t WS_SLOTTOK = 262144;
constexpr size_t WS_CTL = 0, CTL_ZERO_BYTES = 262144 + 73728 * 4;
constexpr size_t WS_LB = 1 * MiB;
constexpr size_t WS_CNTM = WS_LB + 4096;
constexpr size_t WS_TOPG = WS_CNTM + 32768;
constexpr size_t WS_DEST = WS_TOPG + 262144;
constexpr size_t WS_RWT = WS_DEST + 262144;
constexpr size_t WS_XB = 3 * MiB;
constexpr size_t WS_WINT = WS_XB + 32 * MiB;
constexpr size_t WS_WBST = WS_WINT + 12 * MiB;
constexpr size_t WS_WBHT = WS_WBST + 1 * MiB;
constexpr size_t WS_WOT = WS_WBHT + 1 * MiB;
constexpr size_t WS_WUPT = WS_WOT + 2 * MiB;
constexpr size_t WS_WDNT = WS_WUPT + 128 * MiB;
constexpr size_t WS_Q = WS_WDNT + 64 * MiB;
constexpr size_t WS_K = WS_Q + 16 * MiB;
constexpr size_t WS_V = WS_K + 16 * MiB;
constexpr size_t WS_HQ = WS_V + 16 * MiB;
constexpr size_t WS_HK = WS_HQ + 16 * MiB;
constexpr size_t WS_HV = WS_HK + 16 * MiB;
constexpr size_t WS_HG = WS_HV + 16 * MiB;
constexpr size_t WS_LOGF = WS_HG + 16 * MiB;
constexpr size_t WS_GS = WS_LOGF + 32 * MiB;
constexpr size_t WS_GH = WS_GS + 32 * MiB;
constexpr size_t WS_OSB = WS_GH + 32 * MiB;
constexpr size_t WS_OHG = WS_OSB + 16 * MiB;
constexpr size_t WS_ORAW = WS_OHG + 16 * MiB;
constexpr size_t WS_MERGED = WS_ORAW + 32 * MiB;
constexpr size_t WS_H = WS_MERGED + 32 * MiB;
constexpr size_t WS_XS = WS_H + 64 * MiB;
constexpr size_t WS_ACT = WS_XS + 144 * MiB;
constexpr size_t WS_QC = WS_ACT + 144 * MiB;
constexpr size_t WS_DS = WS_QC + 16 * MiB;
constexpr size_t WS_DG = WS_DS + 16 * MiB;
constexpr size_t WS_XB8 = WS_DG + 1 * MiB;
constexpr size_t WS_WINT8 = WS_XB8 + 16 * MiB;
constexpr size_t WS_END = WS_WINT8 + 3 * MiB;
constexpr size_t WS_PRE = WS_Q;
constexpr size_t WS_Y = WS_HK;
static_assert(WS_Y + 144 * MiB <= WS_OSB && WS_PRE + 64 * MiB <= WS_HK, "overlays");
static_assert(WS_END <= 1020 * MiB, "ws budget");
constexpr int CW_NTILES = 16;
constexpr int CW_ATTNQ = 32;
constexpr int CW_BGQ = 48;
constexpr int CW_TILEEXP = 64;
constexpr int CW_BAR = 1024;
constexpr int LDS_SCRATCH = 147456;
constexpr int LDSCTL_OFF = LDS_SCRATCH, LDS_BYTES = LDS_SCRATCH + 512;
constexpr int LDS_IDX = 131072 + 1280;
constexpr int LDS_TILEEXP = 131072;
constexpr int MISC_OFF = LDSCTL_OFF;

__device__ __forceinline__ unsigned f2bf(float f) { unsigned u = __builtin_bit_cast(unsigned, f); return (u + 0x7fffu + ((u >> 16) & 1u)) >> 16; }
__device__ __forceinline__ unsigned pk2(float lo, float hi) { return f2bf(lo) | (f2bf(hi) << 16); }
__device__ __forceinline__ float bf2f(unsigned short b) { return __builtin_bit_cast(float, (unsigned)b << 16); }
__device__ __forceinline__ float bflo(unsigned w) { return __builtin_bit_cast(float, w << 16); }
__device__ __forceinline__ float bfhi(unsigned w) { return __builtin_bit_cast(float, w & 0xffff0000u); }
__device__ __forceinline__ float fsigmoid(float v) { return __builtin_amdgcn_rcpf(1.0f + __builtin_amdgcn_exp2f(-v * LOG2E)); }
__device__ __forceinline__ f32x4 fsigmoid4(f32x4 v) { const f32x4 x = v * (f32x4){-LOG2E, -LOG2E, -LOG2E, -LOG2E};
    const f32x4 d = (f32x4){__builtin_amdgcn_exp2f(x[0]), __builtin_amdgcn_exp2f(x[1]), __builtin_amdgcn_exp2f(x[2]), __builtin_amdgcn_exp2f(x[3])} + (f32x4){1.0f, 1.0f, 1.0f, 1.0f};
    return (f32x4){__builtin_amdgcn_rcpf(d[0]), __builtin_amdgcn_rcpf(d[1]), __builtin_amdgcn_rcpf(d[2]), __builtin_amdgcn_rcpf(d[3])}; }
template <int CTRL> __device__ __forceinline__ float dpp_f(float v) { return __builtin_bit_cast(float, __builtin_amdgcn_update_dpp(0, __builtin_bit_cast(int, v), CTRL, 0xF, 0xF, false)); }
__device__ __forceinline__ float row16_sum(float v) { v += dpp_f<0xB1>(v); v += dpp_f<0x4E>(v); v += dpp_f<0x141>(v); v += dpp_f<0x140>(v); return v; }
__device__ __forceinline__ float wave_sum(float v) {
    v = row16_sum(v);
    const float r0 = __builtin_bit_cast(float, __builtin_amdgcn_readlane(__builtin_bit_cast(int, v), 0)), r1 = __builtin_bit_cast(float, __builtin_amdgcn_readlane(__builtin_bit_cast(int, v), 16));
    const float r2 = __builtin_bit_cast(float, __builtin_amdgcn_readlane(__builtin_bit_cast(int, v), 32)), r3 = __builtin_bit_cast(float, __builtin_amdgcn_readlane(__builtin_bit_cast(int, v), 48));
    return (r0 + r1) + (r2 + r3);
}
__device__ __forceinline__ unsigned pk4_fp8(float a, float b, float c, float d) { int w = 0; w = __builtin_amdgcn_cvt_pk_fp8_f32(a, b, w, false); w = __builtin_amdgcn_cvt_pk_fp8_f32(c, d, w, true); return (unsigned)w; }
#define LDS_WAIT() asm volatile("s_waitcnt lgkmcnt(0)" ::: "memory")
#define VM_WAIT() asm volatile("s_waitcnt vmcnt(0)" ::: "memory")

struct InProjOut { bf16_t *Q, *K, *V, *HQ, *HK, *HV, *HG, *GS, *GH; float* LOGF; const float* lb; };

namespace pg8 {
#define PG8_LAS __attribute__((address_space(3)))
constexpr int BM = 256, BK = 64, HALF = 128, HTB = HALF * BK * 2  , STAGE_BYTES = 8 * HTB, NXCD = 8, WGM = 8;
__host__ __device__ __forceinline__ int lds_byte(int r, int c) { const int st = (r >> 4) * 2 + (c >> 5), rr = r & 15, cc = c & 31, ob = rr * 64 + cc * 2; return st * 1024 + (ob ^ (((ob >> 9) & 1) << 5)); }
__host__ __device__ __forceinline__ void stage_rc(int b, int& R, int& C) { const int st = b / 1024, sb = b % 1024, swz = sb ^ (((sb >> 9) & 1) << 5); R = (st >> 1) * 16 + swz / 64; C = (st & 1) * 32 + (swz % 64) / 2; }
__host__ __device__ __forceinline__ int perm32(int rho) { const int n = rho >> 4, i = rho & 15; return 8 * (i >> 2) + 4 * n + (i & 3); }

struct Unit { int pm, pn, aux; const char* a; const char* b; };
struct Gemm { int K; int scale_a = 0x7f7f7f7f, scale_b = 0x7f7f7f7f; };
struct TileOrder {
    int nM, nN, nwg, G, c, wgm;
    __device__ void init(int nM_, int nN_, int G_, int c_, int wgm_ = WGM) { nM = nM_; nN = nN_; nwg = nM * nN; G = G_; c = c_; wgm = wgm_; }
    __device__ bool tile(int i, int& pm, int& pn) const {
        const long L = (long)i * G + c; if (L >= nwg) return false;
        int wgid = (int)L; { const int q = nwg / NXCD, r = nwg % NXCD, xcd = wgid % NXCD, off = wgid / NXCD; wgid = (xcd < r ? xcd * (q + 1) : r * (q + 1) + (xcd - r) * q) + off; }
        const int nig = wgm * nN, gid = wgid / nig, fm = gid * wgm, gsz = (nM - fm) < wgm ? (nM - fm) : wgm;
        pm = fm + ((wgid % nig) % gsz); pn = (wgid % nig) / gsz; return true;
    }
};
struct DenseSched { static constexpr bool GATHER_A = false; TileOrder o; const char* A; const char* Bt; size_t tstep;
    __device__ __forceinline__ bool next(int i, Unit& u) const { if (!o.tile(i, u.pm, u.pn)) return false; u.aux = 0; u.a = A + (size_t)u.pm * tstep; u.b = Bt + (size_t)u.pn * tstep; return true; }
    __device__ __forceinline__ void a_ready(const Unit&) const {}
    __device__ __forceinline__ void done(const Unit&) const {} };
struct BranchSched { static constexpr bool GATHER_A = false; TileOrder o; const char *A0, *B0, *A1, *B1; size_t tstep;
    __device__ __forceinline__ bool next(int i, Unit& u) const { if (!o.tile(i >> 1, u.pm, u.pn)) return false; u.aux = i & 1; u.a = ((i & 1) ? A1 : A0) + (size_t)u.pm * tstep; u.b = ((i & 1) ? B1 : B0) + (size_t)u.pn * tstep; return true; }
    __device__ __forceinline__ void a_ready(const Unit&) const {}
    __device__ __forceinline__ void done(const Unit&) const {} };
struct MoeSched { static constexpr bool GATHER_A = false; TileOrder o; const char* A; const char* W; const LAS int* tile_exp; size_t tstep, estep;
    __device__ __forceinline__ bool next(int i, Unit& u) const { if (!o.tile(i, u.pm, u.pn)) return false; const int e = __builtin_amdgcn_readfirstlane(tile_exp[u.pm]); u.aux = e; u.a = A + (size_t)u.pm * tstep; u.b = W + (size_t)e * estep + (size_t)u.pn * tstep; return true; }
    __device__ __forceinline__ void a_ready(const Unit&) const {}
    __device__ __forceinline__ void done(const Unit&) const {} };

struct MoeGatherSched : MoeSched { static constexpr bool GATHER_A = true; const int* slot_tok;
    __device__ __forceinline__ bool next(int i, Unit& u) const { if (!MoeSched::next(i, u)) return false; u.a = A; return true; }
    __device__ __forceinline__ const int* idx(const Unit& u) const { return slot_tok + u.pm * BM; } };
typedef __bf16 bf16x2_t __attribute__((ext_vector_type(2)));
__device__ __forceinline__ unsigned cvt_pk_bf16(float lo, float hi) { f32x2_t v = {lo, hi}; bf16x2_t b = __builtin_convertvector(v, bf16x2_t); return __builtin_bit_cast(unsigned, b); }
template <int MODE> __device__ __forceinline__ void inproj_store(const f32x4 (&acc)[2][2][4][2], bf16_t* dst, int ld, int row0, int col0, float scale, const float* lb, float* logf_out) {
    f32x4 lbq[2][2];
    if (MODE == 2) {
#pragma unroll
        for (int bj = 0; bj < 2; ++bj) { lbq[bj][0] = *(const f32x4*)(lb + col0 + bj * HALF); lbq[bj][1] = *(const f32x4*)(lb + col0 + bj * HALF + 4); } }
#pragma unroll
    for (int ai = 0; ai < 2; ++ai)
#pragma unroll
        for (int m = 0; m < 4; ++m)
#pragma unroll
            for (int bj = 0; bj < 2; ++bj) {
                const size_t off = (size_t)(row0 + ai * HALF + m * 16) * ld + col0 + bj * HALF;
                f32x4 v[2] = {acc[ai][bj][m][0], acc[ai][bj][m][1]};
                if (MODE == 0) { v[0] = v[0] * scale; v[1] = v[1] * scale; }
                if (MODE == 1) { v[0] = v[0] * fsigmoid4(v[0]); v[1] = v[1] * fsigmoid4(v[1]); }
                if (MODE == 3) { v[0] = fsigmoid4(v[0]); v[1] = fsigmoid4(v[1]); }
                if (MODE == 2) {
                    f32x4 lg[2]; const f32x4 lbv[2] = {lbq[bj][0], lbq[bj][1]};
#pragma unroll
                    for (int n = 0; n < 2; ++n) { const f32x4 one = {1.0f, 1.0f, 1.0f, 1.0f}, l = lbv[n], f = l + (one - l) * fsigmoid4(v[n]); v[n] = one - f;
                        lg[n] = (f32x4){__builtin_amdgcn_logf(f[0]), __builtin_amdgcn_logf(f[1]), __builtin_amdgcn_logf(f[2]), __builtin_amdgcn_logf(f[3])} * (f32x4){LN2, LN2, LN2, LN2}; }
                    *(f32x4*)(logf_out + off) = lg[0]; *(f32x4*)(logf_out + off + 4) = lg[1];
                }
                u32x4 w; w.x = cvt_pk_bf16(v[0][0], v[0][1]); w.y = cvt_pk_bf16(v[0][2], v[0][3]); w.z = cvt_pk_bf16(v[1][0], v[1][1]); w.w = cvt_pk_bf16(v[1][2], v[1][3]);
                *(u32x4*)(dst + off) = w;
            }
}
template <int PN0> struct EpiInProjT { static constexpr bool PERM = true, AFTER_DRAIN = false, ACC_CHAIN = false; static constexpr int INIT = 0; InProjOut o;
    __device__ __forceinline__ void operator()(f32x4 (&acc)[2][2][4][2], const Unit& u, int wr, int wc, int fr, int fq) const {
        const int row0 = u.pm * BM + wr * 64 + fr, pn = u.pn + PN0;
        int seg, cb, ld;
        if (pn < 14) { seg = pn >> 1; cb = (pn & 1) * 256; ld = 512; } else if (pn < 18) { seg = 7; cb = (pn - 14) * 256; ld = 1024; } else { seg = 8; cb = (pn - 18) * 256; ld = 1024; }
        const int col0 = cb + wc * 32 + 8 * fq;
        if constexpr (PN0 != 0) { const size_t off = seg == 6 ? (size_t)(WS_HG - WS_HG) : (seg == 7 ? (size_t)(WS_GS - WS_HG) : (size_t)(WS_GH - WS_HG));
            inproj_store<3>(acc, (bf16_t*)((unsigned char*)o.HG + off), ld, row0, col0, 1.0f, nullptr, nullptr); return; }
        switch (seg) {
            case 0: inproj_store<0>(acc, o.Q, ld, row0, col0, 0.125f * LOG2E, nullptr, nullptr); break;
            case 1: inproj_store<0>(acc, o.K, ld, row0, col0, 1.0f, nullptr, nullptr); break;
            case 2: inproj_store<0>(acc, o.V, ld, row0, col0, 1.0f, nullptr, nullptr); break;
            case 3: inproj_store<1>(acc, o.HQ, ld, row0, col0, 1.0f, nullptr, nullptr); break;
            case 4: inproj_store<2>(acc, o.HK, ld, row0, col0, 1.0f, o.lb, o.LOGF); break;
            case 5: inproj_store<0>(acc, o.HV, ld, row0, col0, 1.0f, nullptr, nullptr); break;
            case 6: inproj_store<3>(acc, o.HG, ld, row0, col0, 1.0f, nullptr, nullptr); break;
            case 7: inproj_store<3>(acc, o.GS, ld, row0, col0, 1.0f, nullptr, nullptr); break;
            default: inproj_store<3>(acc, o.GH, ld, row0, col0, 1.0f, nullptr, nullptr); break;
        }
    }
};
struct EpiBranch { static constexpr bool PERM = true, AFTER_DRAIN = false, ACC_CHAIN = true; static constexpr int INIT = 0; const bf16_t* GS; const bf16_t* GH; bf16_t* MERGED;
    __device__ __forceinline__ void operator()(f32x4 (&acc)[2][2][4][2], const Unit& u, int wr, int wc, int fr, int fq) const {
        const int row0 = u.pm * BM + wr * 64 + fr, col0 = u.pn * BM + wc * 32 + 8 * fq;
        u32x4 ghq[MK_BR_BATCH + 1];
#pragma unroll
        for (int it = 0; it < MK_BR_BATCH; ++it) ghq[it] = *(const u32x4*)(GH + (size_t)(row0 + (it >> 3) * HALF + ((it >> 1) & 3) * 16) * DM + col0 + (it & 1) * HALF);
#pragma unroll
        for (int it = 0; it < 16; ++it) { const int ai = it >> 3, m = (it >> 1) & 3, bj = it & 1;
                    const size_t off = (size_t)(row0 + ai * HALF + m * 16) * DM + col0 + bj * HALF;
                    if (it + MK_BR_BATCH < 16) { const int i2 = it + MK_BR_BATCH; ghq[i2 % (MK_BR_BATCH + 1)] = *(const u32x4*)(GH + (size_t)(row0 + (i2 >> 3) * HALF + ((i2 >> 1) & 3) * 16) * DM + col0 + (i2 & 1) * HALF); }
                    const u32x4 gh = ghq[it % (MK_BR_BATCH + 1)];
                    const float h[8] = {bflo(gh.x), bfhi(gh.x), bflo(gh.y), bfhi(gh.y), bflo(gh.z), bfhi(gh.z), bflo(gh.w), bfhi(gh.w)};
                    if (u.aux == 0) {
                        const u32x4 gs = *(const u32x4*)(GS + off);
                        const float s[8] = {bflo(gs.x), bfhi(gs.x), bflo(gs.y), bfhi(gs.y), bflo(gs.z), bfhi(gs.z), bflo(gs.w), bfhi(gs.w)};
#pragma unroll
                        for (int n = 0; n < 2; ++n)
#pragma unroll
                            for (int j = 0; j < 4; ++j) acc[ai][bj][m][n][j] *= s[4 * n + j] * __builtin_amdgcn_rcpf(h[4 * n + j]);
                    } else {
                        float r[8];
#pragma unroll
                        for (int n = 0; n < 2; ++n)
#pragma unroll
                            for (int j = 0; j < 4; ++j) { r[4 * n + j] = acc[ai][bj][m][n][j] * h[4 * n + j]; acc[ai][bj][m][n][j] = 0.f; }
                        u32x4 w; w.x = cvt_pk_bf16(r[0], r[1]); w.y = cvt_pk_bf16(r[2], r[3]); w.z = cvt_pk_bf16(r[4], r[5]); w.w = cvt_pk_bf16(r[6], r[7]);
                        *(u32x4*)(MERGED + off) = w;
                    }
        }
    }
};
struct EpiOut { static constexpr bool PERM = true, AFTER_DRAIN = false, ACC_CHAIN = false; static constexpr int INIT = 2;     const bf16_t* xb; bf16_t* PRE;
    __device__ __forceinline__ void tile_init(f32x4 (&acc)[2][2][4][2], const Unit& u, int wr, int wc, int fr, int fq) const {
        const int row0 = u.pm * BM + wr * 64 + fr, col0 = u.pn * BM + wc * 32 + 8 * fq;
#pragma unroll
        for (int ai = 0; ai < 2; ++ai)
#pragma unroll
            for (int m = 0; m < 4; ++m)
#pragma unroll
                for (int bj = 0; bj < 2; ++bj) { const size_t off = (size_t)(row0 + ai * HALF + m * 16) * DM + col0 + bj * HALF;
                    const u32x4 xv = *(const u32x4*)(xb + off);
                    acc[ai][bj][m][0] = (f32x4){bflo(xv.x), bfhi(xv.x), bflo(xv.y), bfhi(xv.y)} * DN_ALPHA; acc[ai][bj][m][1] = (f32x4){bflo(xv.z), bfhi(xv.z), bflo(xv.w), bfhi(xv.w)} * DN_ALPHA; }
    }
    __device__ __forceinline__ void operator()(f32x4 (&acc)[2][2][4][2], const Unit& u, int wr, int wc, int fr, int fq) const {
        const int row0 = u.pm * BM + wr * 64 + fr, col0 = u.pn * BM + wc * 32 + 8 * fq;
#pragma unroll
        for (int ai = 0; ai < 2; ++ai)
#pragma unroll
            for (int m = 0; m < 4; ++m)
#pragma unroll
                for (int bj = 0; bj < 2; ++bj) { const size_t off = (size_t)(row0 + ai * HALF + m * 16) * DM + col0 + bj * HALF;
                    const f32x4 v0 = acc[ai][bj][m][0], v1 = acc[ai][bj][m][1];
                    u32x4 w; w.x = cvt_pk_bf16(v0[0], v0[1]); w.y = cvt_pk_bf16(v0[2], v0[3]); w.z = cvt_pk_bf16(v1[0], v1[1]); w.w = cvt_pk_bf16(v1[2], v1[3]);
                    *(u32x4*)(PRE + off) = w; }
    }
};
template <bool F8OUT> struct EpiUpT { static constexpr bool PERM = true, AFTER_DRAIN = false, ACC_CHAIN = false; static constexpr int INIT = 1;     const float* b_up; bf16_t* ACT;
    __device__ __forceinline__ void bias_load(f32x4 (&bv)[2][2], const Unit& u, int wc, int fq) const { const float* bias = b_up + (size_t)u.aux * UPW + u.pn * BM + wc * 32 + 8 * fq;
#pragma unroll
        for (int bj = 0; bj < 2; ++bj)
#pragma unroll
            for (int n = 0; n < 2; ++n) bv[bj][n] = *(const f32x4*)(bias + bj * HALF + 4 * n); }
    __device__ __forceinline__ void operator()(f32x4 (&acc)[2][2][4][2], const Unit& u, int wr, int wc, int fr, int fq) const {
        const int row0 = u.pm * BM + wr * 64 + fr, col0 = u.pn * BM + wc * 32 + 8 * fq;
        constexpr float OS = F8OUT ? ACT8_SCALE : 1.0f;
#pragma unroll
        for (int ai = 0; ai < 2; ++ai)
#pragma unroll
            for (int bj = 0; bj < 2; ++bj) {
                unsigned d[4]; u32x2 wb[4];
#pragma unroll
                for (int m = 0; m < 4; ++m) {
                    const f32x4 v0 = acc[ai][bj][m][0], v1 = acc[ai][bj][m][1];
                    const float gl[4] = {v0[0], v0[2], v1[0], v1[2]}, li[4] = {v0[1], v0[3], v1[1], v1[3]}; float a[4];
#pragma unroll
                    for (int p = 0; p < 4; p += 2) {
                        const f32x2_t g2 = {__builtin_amdgcn_fmed3f(gl[p], -INFINITY, SW_LIMIT), __builtin_amdgcn_fmed3f(gl[p + 1], -INFINITY, SW_LIMIT)}, l2 = {__builtin_amdgcn_fmed3f(li[p], -SW_LIMIT, SW_LIMIT), __builtin_amdgcn_fmed3f(li[p + 1], -SW_LIMIT, SW_LIMIT)};
                        const f32x2_t x2 = g2 * (f32x2_t){-SW_ALPHA * LOG2E, -SW_ALPHA * LOG2E};
                        const f32x2_t d2 = (f32x2_t){__builtin_amdgcn_exp2f(x2[0]), __builtin_amdgcn_exp2f(x2[1])} + (f32x2_t){1.0f, 1.0f};
                        const f32x2_t r2 = {__builtin_amdgcn_rcpf(d2[0]), __builtin_amdgcn_rcpf(d2[1])};
                        const f32x2_t u2 = l2 * (f32x2_t){OS, OS} + (f32x2_t){OS, OS};
                        const f32x2_t a2 = (g2 * r2) * u2;
                        a[p] = a2[0]; a[p + 1] = a2[1]; }
                    if constexpr (F8OUT) d[m] = pk4_fp8(a[0], a[1], a[2], a[3]);
                    else { wb[m].x = cvt_pk_bf16(a[0], a[1]); wb[m].y = cvt_pk_bf16(a[2], a[3]); }
                }
                if constexpr (F8OUT) {
                    auto r = __builtin_amdgcn_permlane16_swap(d[0], d[1], false, false); d[0] = r[0]; d[1] = r[1];
                    r = __builtin_amdgcn_permlane16_swap(d[2], d[3], false, false); d[2] = r[0]; d[3] = r[1];
                    r = __builtin_amdgcn_permlane32_swap(d[0], d[2], false, false); d[0] = r[0]; d[2] = r[1];
                    r = __builtin_amdgcn_permlane32_swap(d[1], d[3], false, false); d[1] = r[0]; d[3] = r[1];
                    *(u32x4*)((unsigned char*)ACT + (size_t)(row0 + ai * HALF + 16 * fq) * DFF + (u.pn * (BM / 2) + wc * 16 + bj * (HALF / 2))) = (u32x4){d[0], d[1], d[2], d[3]};
                } else {
#pragma unroll
                    for (int m = 0; m < 4; ++m) *(u32x2*)(ACT + (size_t)(row0 + ai * HALF + m * 16) * DFF + ((col0 + bj * HALF) >> 1)) = wb[m];
                }
            }
    }
};
struct EpiDown { static constexpr bool PERM = true, AFTER_DRAIN = false, ACC_CHAIN = false; static constexpr int INIT = 1; const float* b_dn; bf16_t* Y;
    __device__ __forceinline__ void bias_load(f32x4 (&bv)[2][2], const Unit& u, int wc, int fq) const { const float* bias = b_dn + (size_t)u.aux * DM + u.pn * BM + wc * 32 + 8 * fq;
#pragma unroll
        for (int bj = 0; bj < 2; ++bj)
#pragma unroll
            for (int n = 0; n < 2; ++n) bv[bj][n] = *(const f32x4*)(bias + bj * HALF + 4 * n); }
    __device__ __forceinline__ void operator()(f32x4 (&acc)[2][2][4][2], const Unit& u, int wr, int wc, int fr, int fq) const {
        const int row0 = u.pm * BM + wr * 64 + fr, col0 = u.pn * BM + wc * 32 + 8 * fq;
#if MK_Y8
#pragma unroll
        for (int ai = 0; ai < 2; ++ai)
#pragma unroll
            for (int bj = 0; bj < 2; ++bj)
#pragma unroll
                for (int mp = 0; mp < 4; mp += 2) {
                    u32x2 w[2];
#pragma unroll
                    for (int q = 0; q < 2; ++q) { const f32x4 v0 = acc[ai][bj][mp + q][0], v1 = acc[ai][bj][mp + q][1];
                        w[q].x = pk4_fp8(v0[0] * Y8_SCALE, v0[1] * Y8_SCALE, v0[2] * Y8_SCALE, v0[3] * Y8_SCALE); w[q].y = pk4_fp8(v1[0] * Y8_SCALE, v1[1] * Y8_SCALE, v1[2] * Y8_SCALE, v1[3] * Y8_SCALE); }
                    auto r = __builtin_amdgcn_permlane16_swap(w[0].x, w[1].x, false, false); w[0].x = r[0]; w[1].x = r[1];
                    r = __builtin_amdgcn_permlane16_swap(w[0].y, w[1].y, false, false); w[0].y = r[0]; w[1].y = r[1];
                    *(u32x4*)((unsigned char*)Y + (size_t)(row0 + ai * HALF + (mp + (fq & 1)) * 16) * DM + (u.pn * BM + wc * 32 + 8 * (fq & 2) + bj * HALF)) = (u32x4){w[0].x, w[0].y, w[1].x, w[1].y};
                }
#else
#pragma unroll
        for (int ai = 0; ai < 2; ++ai)
#pragma unroll
            for (int m = 0; m < 4; ++m)
#pragma unroll
                for (int bj = 0; bj < 2; ++bj) {
                    const f32x4 v0 = acc[ai][bj][m][0], v1 = acc[ai][bj][m][1];
                    u32x4 w; w.x = cvt_pk_bf16(v0[0], v0[1]); w.y = cvt_pk_bf16(v0[2], v0[3]); w.z = cvt_pk_bf16(v1[0], v1[1]); w.w = cvt_pk_bf16(v1[2], v1[3]);
                    *(u32x4*)(Y + (size_t)(row0 + ai * HALF + m * 16) * DM + col0 + bj * HALF) = w;
                }
#endif
    }
};

template <class Epi, class Sched, bool ALIGN_EPI = false, bool SP2 = false>
__device__ __forceinline__ void gemm_phase(PG8_LAS unsigned char* lds, const Gemm g, const Sched& S, const Epi& E) {
    int tid = threadIdx.x; asm volatile("" : "+v"(tid));
    const int wid = __builtin_amdgcn_readfirstlane(tid >> 6), lane = tid & 63, wr = wid >> 2, wc = wid & 3, fr = lane & 15, fq = lane >> 4;
    const int K = g.K, nt = K / BK;
    unsigned voffA[2], voffB[2];
#pragma unroll
    for (int i = 0; i < 2; ++i) { int R, C; stage_rc(tid * 16 + i * 8192, R, C); const int Rb = Epi::PERM ? ((R & ~31) + perm32(R & 31)) : R;
        voffA[i] = (unsigned)(R * K + C) * 2u; voffB[i] = (unsigned)(Rb * K + C) * 2u; }
    const size_t kstep = (size_t)(BK * 2);
    const size_t hstep = (size_t)HALF * K * 2;
    const unsigned ldsw = (unsigned)wid * 1024u;
    const int aoff = lds_byte(wr * 64 + fr, fq * 8), boff = lds_byte(wc * 32 + fr, fq * 8);
#define PG8_SA(b, h) (((b) * 2 + (h)) * HTB)
#define PG8_SB(b, h) ((4 + (b) * 2 + (h)) * HTB)
#define PG8_STAGE(bufoff, gbase, voff) do { _Pragma("unroll") for (int _i = 0; _i < 2; ++_i) \
        __builtin_amdgcn_global_load_lds((const unsigned*)((const char*)(gbase) + (voff)[_i]), (PG8_LAS unsigned*)(lds + (bufoff) + ldsw + _i * 8192), 16, 0, 0); } while (0)
#define PG8_LDA(dst, b, h) do { _Pragma("unroll") for (int m = 0; m < 4; ++m) _Pragma("unroll") for (int k = 0; k < 2; ++k) dst[m][k] = *(const PG8_LAS bf16x8*)(lds + PG8_SA(b, h) + aoff + m * 2048 + k * 1024); } while (0)
#define PG8_LDB(dst, b, h) do { _Pragma("unroll") for (int n = 0; n < 2; ++n) _Pragma("unroll") for (int k = 0; k < 2; ++k) dst[n][k] = *(const PG8_LAS bf16x8*)(lds + PG8_SB(b, h) + boff + n * 2048 + k * 1024); } while (0)
#define PG8_MMA(ai, bj, At, Bt) do { __builtin_amdgcn_s_setprio(1); _Pragma("unroll") for (int m = 0; m < 4; ++m) _Pragma("unroll") for (int n = 0; n < 2; ++n) _Pragma("unroll") for (int k = 0; k < 2; ++k) \
        acc[ai][bj][m][n] = __builtin_amdgcn_mfma_f32_16x16x32_bf16(Bt[n][k], At[m][k], acc[ai][bj][m][n], 0, 0, 0); __builtin_amdgcn_s_setprio(0); } while (0)
#define PG8_WAIT_V(n) asm volatile("s_waitcnt vmcnt(" #n ")" ::: "memory")
#define PG8_WAIT_L(n) asm volatile("s_waitcnt lgkmcnt(" #n ")" ::: "memory")
#define PG8_BAR __builtin_amdgcn_s_barrier()
#define PG8_SCHED __builtin_amdgcn_sched_barrier(0)
    Unit cur, nxt; int ui = 0;
    if (!S.next(0, cur)) return;
    f32x4 acc[2][2][4][2];
    f32x4 bv0[2][2];
    if constexpr (Epi::INIT == 1) E.bias_load(bv0, cur, wc, fq);
#pragma unroll
    for (int a = 0; a < 2; ++a)
#pragma unroll
        for (int b = 0; b < 2; ++b)
#pragma unroll
            for (int m = 0; m < 4; ++m)
#pragma unroll
                for (int n = 0; n < 2; ++n) { if constexpr (Epi::INIT == 1) acc[a][b][m][n] = bv0[b][n]; else acc[a][b][m][n] = (f32x4){0.f, 0.f, 0.f, 0.f}; }
    if constexpr (Epi::INIT == 2) E.tile_init(acc, cur, wr, wc, fr, fq);
    bf16x8 At[4][2], B0[2][2], B1[2][2];
    const char* cA = cur.a; const char* cB = cur.b;
    S.a_ready(cur);
    if constexpr (SP2) {
        PG8_STAGE(PG8_SB(0, 0), cB, voffB); PG8_STAGE(PG8_SB(0, 1), cB + hstep, voffB); PG8_STAGE(PG8_SA(0, 0), cA, voffA); PG8_STAGE(PG8_SA(0, 1), cA + hstep, voffA);
        if (wr == 1) PG8_BAR;
        PG8_WAIT_V(2); PG8_BAR;
        PG8_STAGE(PG8_SB(1, 0), cB + kstep, voffB); PG8_STAGE(PG8_SA(1, 0), cA + kstep, voffA); PG8_STAGE(PG8_SB(1, 1), cB + hstep + kstep, voffB);
        PG8_WAIT_V(6); PG8_BAR;
    } else {
        PG8_STAGE(PG8_SB(0, 0), cB, voffB); PG8_STAGE(PG8_SA(0, 0), cA, voffA); PG8_STAGE(PG8_SB(0, 1), cB + hstep, voffB); PG8_STAGE(PG8_SA(0, 1), cA + hstep, voffA);
        if (wr == 1) PG8_BAR;
        PG8_WAIT_V(4); PG8_BAR;
        PG8_STAGE(PG8_SB(1, 0), cB + kstep, voffB); PG8_STAGE(PG8_SA(1, 0), cA + kstep, voffA); PG8_STAGE(PG8_SB(1, 1), cB + hstep + kstep, voffB);
        PG8_WAIT_V(6); PG8_BAR;
    }
    for (;;) {
        const bool has_next = S.next(ui + 1, nxt);
        const char* nA = has_next ? nxt.a : cA; const char* nB = has_next ? nxt.b : cB;
        for (int t = 0; t < nt; t += 2) {
            const bool last = (t == nt - 2);
            const char* a1 = cA + (size_t)(t + 1) * kstep;
            const char* a2 = last ? nA : cA + (size_t)(t + 2) * kstep; const char* b2 = last ? nB : cB + (size_t)(t + 2) * kstep;
            const char* a3 = a2 + kstep; const char* b3 = b2 + kstep;
            if (last && has_next) S.a_ready(nxt);
            if constexpr (SP2) {
            PG8_LDB(B0, 0, 0); PG8_LDB(B1, 0, 1); PG8_SCHED; PG8_LDA(At, 0, 0); PG8_STAGE(PG8_SA(1, 1), a1 + hstep, voffA);
            PG8_WAIT_V(8); PG8_WAIT_L(0); PG8_BAR; PG8_MMA(0, 0, At, B0); PG8_MMA(0, 1, At, B1); PG8_BAR; PG8_SCHED;
            PG8_LDA(At, 0, 1); PG8_STAGE(PG8_SB(0, 0), b2, voffB); PG8_STAGE(PG8_SB(0, 1), b2 + hstep, voffB); PG8_STAGE(PG8_SA(0, 0), a2, voffA);
            PG8_WAIT_V(8); PG8_WAIT_L(0); PG8_BAR; PG8_MMA(1, 0, At, B0); PG8_MMA(1, 1, At, B1); PG8_BAR; PG8_SCHED;
            PG8_LDB(B0, 1, 0); PG8_LDB(B1, 1, 1); PG8_SCHED; PG8_LDA(At, 1, 0); PG8_STAGE(PG8_SA(0, 1), a2 + hstep, voffA);
            PG8_WAIT_V(8); PG8_WAIT_L(0); PG8_BAR; PG8_MMA(0, 0, At, B0); PG8_MMA(0, 1, At, B1); PG8_BAR; PG8_SCHED;
            PG8_LDA(At, 1, 1); PG8_STAGE(PG8_SB(1, 0), b3, voffB); PG8_STAGE(PG8_SB(1, 1), b3 + hstep, voffB); PG8_STAGE(PG8_SA(1, 0), a3, voffA);
            PG8_WAIT_V(8); PG8_WAIT_L(0); PG8_BAR; PG8_MMA(1, 0, At, B0); PG8_MMA(1, 1, At, B1); PG8_BAR; PG8_SCHED;
            } else {
            PG8_LDB(B0, 0, 0); PG8_SCHED; PG8_LDA(At, 0, 0); PG8_STAGE(PG8_SA(1, 1), a1 + hstep, voffA);
            PG8_WAIT_L(8); PG8_BAR; PG8_WAIT_L(0); PG8_MMA(0, 0, At, B0); PG8_BAR; PG8_SCHED;
            PG8_LDB(B1, 0, 1); PG8_STAGE(PG8_SB(0, 0), b2, voffB);
            PG8_BAR; PG8_WAIT_L(0); PG8_MMA(0, 1, At, B1); PG8_BAR;
            PG8_LDA(At, 0, 1); PG8_STAGE(PG8_SA(0, 0), a2, voffA);
            PG8_BAR; PG8_WAIT_L(0); PG8_MMA(1, 0, At, B0); PG8_BAR; PG8_SCHED;
            PG8_STAGE(PG8_SB(0, 1), b2 + hstep, voffB);
            PG8_WAIT_V(6); PG8_BAR; PG8_MMA(1, 1, At, B1); PG8_BAR;
            PG8_LDB(B0, 1, 0); PG8_SCHED; PG8_LDA(At, 1, 0); PG8_STAGE(PG8_SA(0, 1), a2 + hstep, voffA);
            PG8_WAIT_L(8); PG8_BAR; PG8_WAIT_L(0); PG8_MMA(0, 0, At, B0); PG8_BAR; PG8_SCHED;
            PG8_LDB(B1, 1, 1); PG8_STAGE(PG8_SB(1, 0), b3, voffB);
            PG8_BAR; PG8_WAIT_L(0); PG8_MMA(0, 1, At, B1); PG8_BAR;
            PG8_LDA(At, 1, 1); PG8_STAGE(PG8_SA(1, 0), a3, voffA);
            PG8_BAR; PG8_WAIT_L(0); PG8_MMA(1, 0, At, B0); PG8_BAR; PG8_SCHED;
            PG8_STAGE(PG8_SB(1, 1), b3 + hstep, voffB);
            PG8_WAIT_V(6); PG8_BAR; PG8_MMA(1, 1, At, B1); PG8_BAR;
            }
        }
        if constexpr (ALIGN_EPI) { if (wr == 0) PG8_BAR; }
        f32x4 bvn[2][2]; if constexpr (Epi::INIT == 1) { if (has_next) E.bias_load(bvn, nxt, wc, fq); }
        if constexpr (!Epi::AFTER_DRAIN) { E(acc, cur, wr, wc, fr, fq); S.done(cur); }
        if (!has_next) break;
        if constexpr (!Epi::ACC_CHAIN) {
#pragma unroll
        for (int a = 0; a < 2; ++a)
#pragma unroll
            for (int b = 0; b < 2; ++b)
#pragma unroll
                for (int m = 0; m < 4; ++m)
#pragma unroll
                    for (int n = 0; n < 2; ++n) { if constexpr (Epi::INIT == 1) acc[a][b][m][n] = bvn[b][n]; else acc[a][b][m][n] = (f32x4){0.f, 0.f, 0.f, 0.f}; }
        if constexpr (Epi::INIT == 2) E.tile_init(acc, nxt, wr, wc, fr, fq);
        }
        cur = nxt; cA = nA; cB = nB; ++ui;
        if constexpr (ALIGN_EPI) { if (wr == 1) PG8_BAR; }
    }
    PG8_WAIT_V(0);
    if constexpr (!ALIGN_EPI) { if (wr == 0) PG8_BAR; }
    PG8_BAR;
    if constexpr (Epi::AFTER_DRAIN) { E.fused(acc, cur, wr, wc, fr, fq, lds, wid, lane); S.done(cur); }
#undef PG8_SA
#undef PG8_SB
#undef PG8_STAGE
#undef PG8_LDA
#undef PG8_LDB
#undef PG8_MMA
#undef PG8_WAIT_V
#undef PG8_WAIT_L
#undef PG8_BAR
#undef PG8_SCHED
}
typedef int v8i_t __attribute__((ext_vector_type(8)));
template <class Epi, class Sched, bool ALIGN_EPI = false, bool SP2 = false>
__device__ __forceinline__ void gemm_phase_f8(PG8_LAS unsigned char* lds, const Gemm g, const Sched& S, const Epi& E) {
    int tid = threadIdx.x; asm volatile("" : "+v"(tid));
    const int wid = __builtin_amdgcn_readfirstlane(tid >> 6), lane = tid & 63, wr = wid >> 2, wc = wid & 3, fr = lane & 15, fq = lane >> 4;
    const int K = g.K, nt = K / BK;
    unsigned voffA[2], voffB[2];
#pragma unroll
    for (int i = 0; i < 2; ++i) { int R, C; stage_rc(tid * 16 + i * 8192, R, C); const int Rb = Epi::PERM ? ((R & ~31) + perm32(R & 31)) : R;
        voffA[i] = (unsigned)(R * K + C) * 2u; voffB[i] = (unsigned)(Rb * K + C) * 2u; }
    const size_t kstep = (size_t)(BK * 2);
    const size_t hstep = (size_t)HALF * K * 2;
    const unsigned ldsw = (unsigned)wid * 1024u;
    const int aoff = lds_byte(wr * 64 + fr, fq * 16), boff = lds_byte(wc * 32 + fr, fq * 16);
#define PG8_SA(b, h) (((b) * 2 + (h)) * HTB)
#define PG8_SB(b, h) ((4 + (b) * 2 + (h)) * HTB)
#define PG8_STAGE(bufoff, gbase, voff) do { _Pragma("unroll") for (int _i = 0; _i < 2; ++_i) \
        __builtin_amdgcn_global_load_lds((const unsigned*)((const char*)(gbase) + (voff)[_i]), (PG8_LAS unsigned*)(lds + (bufoff) + ldsw + _i * 8192), 16, 0, 0); } while (0)
#define PG8_STAGE_A(bufoff, gbase, h) do { if constexpr (Sched::GATHER_A) { PG8_STAGE(bufoff, gbase, goff[h]); } else { PG8_STAGE(bufoff, (gbase) + (size_t)(h) * hstep, voffA); } } while (0)
#define PG8_LDA(dst, b, h) do { _Pragma("unroll") for (int m = 0; m < 4; ++m) dst[m] = *(const PG8_LAS v8i_t*)(lds + PG8_SA(b, h) + aoff + m * 2048); } while (0)
#define PG8_LDB(dst, b, h) do { _Pragma("unroll") for (int n = 0; n < 2; ++n) dst[n] = *(const PG8_LAS v8i_t*)(lds + PG8_SB(b, h) + boff + n * 2048); } while (0)
#define PG8_F8(x) (x)
#define PG8_MMA(ai, bj, At, Bt) do { __builtin_amdgcn_s_setprio(1); _Pragma("unroll") for (int m = 0; m < 4; ++m) _Pragma("unroll") for (int n = 0; n < 2; ++n) \
        asm volatile("v_mfma_scale_f32_16x16x128_f8f6f4 %0, %1, %2, %0, %3, %4 op_sel_hi:[0,0,0]" : "+v"(acc[ai][bj][m][n]) : "v"(Bt[n]), "v"(At[m]), "v"(sc_w), "v"(sc_x)); __builtin_amdgcn_s_setprio(0); } while (0)
#define PG8_WAIT_V(n) asm volatile("s_waitcnt vmcnt(" #n ")" ::: "memory")
#define PG8_WAIT_L(n) asm volatile("s_waitcnt lgkmcnt(" #n ")" ::: "memory")
#define PG8_BAR __builtin_amdgcn_s_barrier()
#define PG8_SCHED __builtin_amdgcn_sched_barrier(0)
    const int sc_w = g.scale_b, sc_x = g.scale_a;
    Unit cur, nxt; int ui = 0;
    if (!S.next(0, cur)) return;
    f32x4 acc[2][2][4][2];
    f32x4 bv0[2][2];
    if constexpr (Epi::INIT == 1) E.bias_load(bv0, cur, wc, fq);
#pragma unroll
    for (int a = 0; a < 2; ++a)
#pragma unroll
        for (int b = 0; b < 2; ++b)
#pragma unroll
            for (int m = 0; m < 4; ++m)
#pragma unroll
                for (int n = 0; n < 2; ++n) { if constexpr (Epi::INIT == 1) acc[a][b][m][n] = bv0[b][n]; else acc[a][b][m][n] = (f32x4){0.f, 0.f, 0.f, 0.f}; }
    if constexpr (Epi::INIT == 2) E.tile_init(acc, cur, wr, wc, fr, fq);
    v8i_t At[4], B0[2], B1[2];
    const char* cA = cur.a; const char* cB = cur.b;
    unsigned goff[2][2]; int Rg[2], Cg[2];
    if constexpr (Sched::GATHER_A) {
#pragma unroll
        for (int i = 0; i < 2; ++i) { stage_rc(tid * 16 + i * 8192, Rg[i], Cg[i]); }
        const int* ix = S.idx(cur);
#pragma unroll
        for (int h = 0; h < 2; ++h)
#pragma unroll
            for (int i = 0; i < 2; ++i) goff[h][i] = (unsigned)ix[h * HALF + Rg[i]] * (unsigned)(K * 2) + (unsigned)(Cg[i] * 2);
    }
#define PG8_VA(h) goff[h]
#define PG8_AH(h) (Sched::GATHER_A ? (size_t)0 : (size_t)(h) * hstep)
    S.a_ready(cur);
    if constexpr (SP2) {
        PG8_STAGE(PG8_SB(0, 0), cB, voffB); PG8_STAGE(PG8_SB(0, 1), cB + hstep, voffB); PG8_STAGE_A(PG8_SA(0, 0), cA, 0); PG8_STAGE_A(PG8_SA(0, 1), cA, 1);
        if (wr == 1) PG8_BAR;
        PG8_WAIT_V(2); PG8_BAR;
        PG8_STAGE(PG8_SB(1, 0), cB + kstep, voffB); PG8_STAGE_A(PG8_SA(1, 0), cA + kstep, 0); PG8_STAGE(PG8_SB(1, 1), cB + hstep + kstep, voffB);
        PG8_WAIT_V(6); PG8_BAR;
    } else {
        PG8_STAGE(PG8_SB(0, 0), cB, voffB); PG8_STAGE_A(PG8_SA(0, 0), cA, 0); PG8_STAGE(PG8_SB(0, 1), cB + hstep, voffB); PG8_STAGE_A(PG8_SA(0, 1), cA, 1);
        if (wr == 1) PG8_BAR;
        PG8_WAIT_V(4); PG8_BAR;
        PG8_STAGE(PG8_SB(1, 0), cB + kstep, voffB); PG8_STAGE_A(PG8_SA(1, 0), cA + kstep, 0); PG8_STAGE(PG8_SB(1, 1), cB + hstep + kstep, voffB);
        PG8_WAIT_V(6); PG8_BAR;
    }
    for (;;) {
        const bool has_next = S.next(ui + 1, nxt);
        if constexpr (Sched::GATHER_A) { if (has_next && wid < 4) __builtin_amdgcn_global_load_lds((const unsigned*)(S.idx(nxt) + wid * 64 + lane), (PG8_LAS unsigned*)(lds + LDS_IDX + wid * 256), 4, 0, 0); }
        const char* nA = has_next ? nxt.a : cA; const char* nB = has_next ? nxt.b : cB;
#pragma unroll 1
        for (int t = 0; t < nt; t += 2) {
            const bool last = (t == nt - 2);
            const char* a1 = cA + (size_t)(t + 1) * kstep;
            const char* a2 = last ? nA : cA + (size_t)(t + 2) * kstep; const char* b2 = last ? nB : cB + (size_t)(t + 2) * kstep;
            const char* a3 = a2 + kstep; const char* b3 = b2 + kstep;
            if (last && has_next) S.a_ready(nxt);
            if constexpr (SP2) {
            PG8_LDB(B0, 0, 0); PG8_LDB(B1, 0, 1); PG8_SCHED; PG8_LDA(At, 0, 0); PG8_STAGE_A(PG8_SA(1, 1), a1, 1);
            if constexpr (Sched::GATHER_A) { if (last && has_next) {
                const PG8_LAS int* ixl = (const PG8_LAS int*)(lds + LDS_IDX);
#pragma unroll
                for (int h = 0; h < 2; ++h)
#pragma unroll
                    for (int i = 0; i < 2; ++i) goff[h][i] = (unsigned)ixl[h * HALF + Rg[i]] * (unsigned)(K * 2) + (unsigned)(Cg[i] * 2); } }
            PG8_WAIT_V(8); PG8_WAIT_L(0); PG8_BAR; PG8_MMA(0, 0, At, B0); PG8_MMA(0, 1, At, B1); PG8_BAR; PG8_SCHED;
            PG8_LDA(At, 0, 1); PG8_STAGE(PG8_SB(0, 0), b2, voffB); PG8_STAGE(PG8_SB(0, 1), b2 + hstep, voffB); PG8_STAGE_A(PG8_SA(0, 0), a2, 0);
            PG8_WAIT_V(8); PG8_WAIT_L(0); PG8_BAR; PG8_MMA(1, 0, At, B0); PG8_MMA(1, 1, At, B1); PG8_BAR; PG8_SCHED;
            PG8_LDB(B0, 1, 0); PG8_LDB(B1, 1, 1); PG8_SCHED; PG8_LDA(At, 1, 0); PG8_STAGE_A(PG8_SA(0, 1), a2, 1);
            PG8_WAIT_V(8); PG8_WAIT_L(0); PG8_BAR; PG8_MMA(0, 0, At, B0); PG8_MMA(0, 1, At, B1); PG8_BAR; PG8_SCHED;
            PG8_LDA(At, 1, 1); PG8_STAGE(PG8_SB(1, 0), b3, voffB); PG8_STAGE(PG8_SB(1, 1), b3 + hstep, voffB); PG8_STAGE_A(PG8_SA(1, 0), a3, 0);
            PG8_WAIT_V(8); PG8_WAIT_L(0); PG8_BAR; PG8_MMA(1, 0, At, B0); PG8_MMA(1, 1, At, B1); PG8_BAR; PG8_SCHED;
            } else {
            PG8_LDB(B0, 0, 0); PG8_SCHED; PG8_LDA(At, 0, 0); PG8_STAGE_A(PG8_SA(1, 1), a1, 1);
            PG8_WAIT_L(8); PG8_BAR; PG8_WAIT_L(0); PG8_MMA(0, 0, At, B0); PG8_BAR; PG8_SCHED;
            PG8_LDB(B1, 0, 1); PG8_STAGE(PG8_SB(0, 0), b2, voffB);
            PG8_BAR; PG8_WAIT_L(0); PG8_MMA(0, 1, At, B1); PG8_BAR;
            PG8_LDA(At, 0, 1); PG8_STAGE_A(PG8_SA(0, 0), a2, 0);
            PG8_BAR; PG8_WAIT_L(0); PG8_MMA(1, 0, At, B0); PG8_BAR; PG8_SCHED;
            PG8_STAGE(PG8_SB(0, 1), b2 + hstep, voffB);
            PG8_WAIT_V(6); PG8_BAR; PG8_MMA(1, 1, At, B1); PG8_BAR;
            PG8_LDB(B0, 1, 0); PG8_SCHED; PG8_LDA(At, 1, 0); PG8_STAGE_A(PG8_SA(0, 1), a2, 1);
            PG8_WAIT_L(8); PG8_BAR; PG8_WAIT_L(0); PG8_MMA(0, 0, At, B0); PG8_BAR; PG8_SCHED;
            PG8_LDB(B1, 1, 1); PG8_STAGE(PG8_SB(1, 0), b3, voffB);
            PG8_BAR; PG8_WAIT_L(0); PG8_MMA(0, 1, At, B1); PG8_BAR;
            PG8_LDA(At, 1, 1); PG8_STAGE_A(PG8_SA(1, 0), a3, 0);
            PG8_BAR; PG8_WAIT_L(0); PG8_MMA(1, 0, At, B0); PG8_BAR; PG8_SCHED;
            PG8_STAGE(PG8_SB(1, 1), b3 + hstep, voffB);
            PG8_WAIT_V(6); PG8_BAR; PG8_MMA(1, 1, At, B1); PG8_BAR;
            }
        }
        if constexpr (ALIGN_EPI) { if (wr == 0) PG8_BAR; }
        asm volatile("s_nop 15\n\ts_nop 7" ::: "memory"); __builtin_amdgcn_sched_barrier(0);
        f32x4 bvn[2][2]; if constexpr (Epi::INIT == 1) { if (has_next) E.bias_load(bvn, nxt, wc, fq); }
        if constexpr (!Epi::AFTER_DRAIN) { E(acc, cur, wr, wc, fr, fq); S.done(cur); }
        if (!has_next) break;
        if constexpr (!Epi::ACC_CHAIN) {
#pragma unroll
        for (int a = 0; a < 2; ++a)
#pragma unroll
            for (int b = 0; b < 2; ++b)
#pragma unroll
                for (int m = 0; m < 4; ++m)
#pragma unroll
                    for (int n = 0; n < 2; ++n) { if constexpr (Epi::INIT == 1) acc[a][b][m][n] = bvn[b][n]; else acc[a][b][m][n] = (f32x4){0.f, 0.f, 0.f, 0.f}; }
        if constexpr (Epi::INIT == 2) E.tile_init(acc, nxt, wr, wc, fr, fq);
        }
        cur = nxt; cA = nA; cB = nB; ++ui;
        if constexpr (ALIGN_EPI) { if (wr == 1) PG8_BAR; }
    }
    PG8_WAIT_V(0);
    if constexpr (!ALIGN_EPI) { if (wr == 0) PG8_BAR; }
    PG8_BAR;
    if constexpr (Epi::AFTER_DRAIN) { E.fused(acc, cur, wr, wc, fr, fq, lds, wid, lane); S.done(cur); }
#undef PG8_SA
#undef PG8_SB
#undef PG8_STAGE
#undef PG8_STAGE_A
#undef PG8_VA
#undef PG8_AH
#undef PG8_LDA
#undef PG8_LDB
#undef PG8_MMA
#undef PG8_F8
#undef PG8_WAIT_V
#undef PG8_WAIT_L
#undef PG8_BAR
#undef PG8_SCHED
}
}

typedef GAS unsigned gu32;
#define RLX_AGENT __ATOMIC_RELAXED, __HIP_MEMORY_SCOPE_AGENT
#define XB_TMO      128
#define XB_XCNT(j)  (256  + 64 * (j))
#define XB_XSUB(j)  (1280 + 64 * (j))
#define XB_XGEN(j)  (2304 + 64 * (j))
#define XB_TOP      3328
#define XB_TOPGEN   3392
#define XCD_BAR_WORDS 3456
#define XB_SPIN_CAP (1u << 26)

__device__ __forceinline__ unsigned xb_ld(unsigned* p)              { return __hip_atomic_load(p, __ATOMIC_RELAXED, __HIP_MEMORY_SCOPE_AGENT); }
__device__ __forceinline__ unsigned xb_add(unsigned* p, unsigned v) { return __hip_atomic_fetch_add(p, v, __ATOMIC_RELAXED, __HIP_MEMORY_SCOPE_AGENT); }
__device__ __forceinline__ unsigned xb_xcc_id() { return (unsigned)__builtin_amdgcn_s_getreg((3 << 11) | 20) & 0xFu; }
#define XB_SPIN(cond, bar) do { unsigned _sp = 0; while (cond) { __builtin_amdgcn_s_sleep(1); \
    if ((++_sp & 255u) == 0u) { if (xb_ld(&(bar)[XB_TMO])) break; if (_sp > XB_SPIN_CAP) { atomicAdd(&(bar)[XB_TMO], 1u); break; } } } } while (0)

struct XcdBarrier {
    unsigned* bar; unsigned x;
    volatile LAS unsigned* st;
};

__device__ __forceinline__ XcdBarrier xcd_barrier_post(unsigned* bar, volatile LAS unsigned* st) {
    XcdBarrier b; b.bar = bar; b.x = xb_xcc_id(); b.st = st;
    if (threadIdx.x == 0) (void)xb_add(&bar[XB_XCNT(b.x)], 1u);
    return b;
}
__device__ __forceinline__ void xcd_barrier_complete(unsigned* bar, unsigned x, unsigned& nloc, unsigned& nx) {
    const unsigned G = gridDim.x * gridDim.y * gridDim.z;
    unsigned sum, cnt, mine, sp = 0u;
    for (;;) {
        sum = 0u; cnt = 0u; mine = 0u;
#pragma unroll
        for (unsigned j = 0; j < 16; ++j) { const unsigned c = xb_ld(&bar[XB_XCNT(j)]); sum += c; cnt += (c > 0u) ? 1u : 0u; mine = (j == x) ? c : mine; }
        if (sum == G) break;
        __builtin_amdgcn_s_sleep(1);
        if ((++sp & 255u) == 0u) { if (xb_ld(&bar[XB_TMO])) break; if (sp > XB_SPIN_CAP) { atomicAdd(&bar[XB_TMO], 1u); break; } }
    }
    nloc = mine > 0u ? mine : 1u; nx = cnt > 0u ? cnt : 1u;
}

__device__ __forceinline__ void xcd_barrier(const XcdBarrier& b) {
    asm volatile("s_waitcnt vmcnt(0)" ::: "memory");
    __syncthreads();
    if (threadIdx.x == 0) {
        unsigned* bar = b.bar;
        __builtin_amdgcn_s_waitcnt(0);
        unsigned nloc = b.st[0], nx = b.st[1];
        if (nloc == 0u) { xcd_barrier_complete(bar, b.x, nloc, nx); b.st[0] = nloc; b.st[1] = nx; }
        const unsigned old = xb_add(&bar[XB_XSUB(b.x)], 1u);
        const unsigned gen = old / nloc;
        if (old + 1u == (gen + 1u) * nloc) {
            __builtin_amdgcn_fence(__ATOMIC_RELEASE, "agent");
            asm volatile("s_waitcnt vmcnt(0)" ::: "memory");
            const unsigned og = xb_add(&bar[XB_TOP], 1u);
            const unsigned tg = og / nx;
            if (og + 1u == (tg + 1u) * nx) xb_add(&bar[XB_TOPGEN], 1u);
            else XB_SPIN(xb_ld(&bar[XB_TOPGEN]) == tg, bar);
            __builtin_amdgcn_fence(__ATOMIC_ACQUIRE, "");
            xb_add(&bar[XB_XGEN(b.x)], 1u);
            asm volatile("s_waitcnt vmcnt(0)" ::: "memory");
        } else {
            XB_SPIN(xb_ld(&bar[XB_XGEN(b.x)]) == gen, bar);
            __builtin_amdgcn_fence(__ATOMIC_ACQUIRE, "");
            asm volatile("s_waitcnt vmcnt(0)" ::: "memory");
        }
    }
    __syncthreads();
}


template <bool BG, class ArgsT> __device__ __forceinline__ void xcd_barrier_bg(const XcdBarrier& b, const ArgsT& A, LAS unsigned char* lds, volatile LAS unsigned* MISC);
__device__ __forceinline__ int fresh_tid() { int t = threadIdx.x; asm volatile("" : "+v"(t)); return t; }
#define FRESH_IDS() const int tid = fresh_tid(), lane = tid & 63, wave = __builtin_amdgcn_readfirstlane(tid >> 6); (void)tid; (void)lane; (void)wave
struct Args { const float* in[17]; float* out; unsigned char* ws; int ph_lo, ph_hi, li, pad; };

__device__ __forceinline__ void p0_transpose_item(const float* W, int K, int N, bf16_t* WT, LAS float* scr, int item, int lane) {
    (void)scr;
    const int nblk = N / 32, kb = item / nblk, nb = item % nblk, k0 = 64 * kb + 8 * (lane >> 3), n0 = 32 * nb + 4 * (lane & 7);
    f32x4 v[8];
#pragma unroll
    for (int j2 = 0; j2 < 8; ++j2) v[j2] = *(const GAS f32x4*)(W + (size_t)(k0 + j2) * N + n0);
#pragma unroll
    for (int i2 = 0; i2 < 4; ++i2) { u32x4 o; o.x = pk2(v[0][i2], v[1][i2]); o.y = pk2(v[2][i2], v[3][i2]); o.z = pk2(v[4][i2], v[5][i2]); o.w = pk2(v[6][i2], v[7][i2]);
        *(GAS u32x4*)(WT + (size_t)(n0 + i2) * K + k0) = o; }
}
__device__ __forceinline__ void p0_transpose_item_f8(const float* W, int K, int N, unsigned char* WT8, LAS float* scr, int item, int lane, float wscale, int nblk_sub = 0) {
    (void)scr;
    const int nblk = nblk_sub ? nblk_sub : N / 32, kb = (item / (2 * nblk)) * 2 + (item & 1), nb = (item >> 1) % nblk, k0 = 64 * kb + 8 * (lane >> 3), n0 = 32 * nb + 4 * (lane & 7);
    f32x4 v[8];
#pragma unroll
    for (int j2 = 0; j2 < 8; ++j2) v[j2] = *(const GAS f32x4*)(W + (size_t)(k0 + j2) * N + n0);
#pragma unroll
    for (int i = 0; i < 4; ++i) { u32x2 o; o.x = pk4_fp8(v[0][i] * wscale, v[1][i] * wscale, v[2][i] * wscale, v[3][i] * wscale); o.y = pk4_fp8(v[4][i] * wscale, v[5][i] * wscale, v[6][i] * wscale, v[7][i] * wscale);
        *(GAS u32x2*)(WT8 + (size_t)(n0 + i) * K + k0) = o; }
}
constexpr int BG_BATCH = 8, BG_I_UP1 = (DM / 64) * (UPW / 32), BG_I_DN1 = (DFF / 64) * (DM / 32), BG_I_UP = NEXP * BG_I_UP1, BG_TOTAL = BG_I_UP + NEXP * BG_I_DN1;
static_assert(BG_I_UP % BG_BATCH == 0 && BG_TOTAL % BG_BATCH == 0, "batches do not straddle the up/down boundary");
__device__ __forceinline__ void bg_item(const Args& A, int it, LAS float* scr, int lane) {
    if (it < BG_I_UP) { const int e = it / BG_I_UP1;
#if MK_FP8_UP
        p0_transpose_item_f8(A.in[11] + (size_t)e * DM * UPW, DM, UPW, (unsigned char*)(A.ws + WS_WUPT) + (size_t)e * DM * UPW, scr, it % BG_I_UP1, lane, W8_SCALE);
#else
        p0_transpose_item(A.in[11] + (size_t)e * DM * UPW, DM, UPW, (bf16_t*)(A.ws + WS_WUPT) + (size_t)e * DM * UPW, scr, it % BG_I_UP1, lane);
#endif
    }
    else { const int r = it - BG_I_UP, e = r / BG_I_DN1;
#if MK_FP8_DN
        p0_transpose_item_f8(A.in[13] + (size_t)e * DFF * DM, DFF, DM, (unsigned char*)(A.ws + WS_WDNT) + (size_t)e * DFF * DM, scr, r % BG_I_DN1, lane, W8_SCALE);
#else
        p0_transpose_item(A.in[13] + (size_t)e * DFF * DM, DFF, DM, (bf16_t*)(A.ws + WS_WDNT) + (size_t)e * DFF * DM, scr, r % BG_I_DN1, lane);
#endif
    }
}
__device__ __forceinline__ bool bg_step(const Args& A, volatile LAS int* st, LAS float* scr, int lane, int limit) {
    int cur = st[0], end = st[1];
    if (cur >= end) {
        if (cur >= BG_TOTAL) return false;
        int start = 0; if (lane == 0) start = __hip_atomic_fetch_add((int*)(A.ws + WS_CTL) + CW_BGQ, BG_BATCH, __ATOMIC_RELAXED, __HIP_MEMORY_SCOPE_AGENT);
        start = __builtin_amdgcn_readfirstlane(start);
        if (start >= BG_TOTAL) { if (lane == 0) { st[0] = BG_TOTAL; st[1] = BG_TOTAL; } return false; }
        cur = start; end = start + BG_BATCH; if (lane == 0) { st[0] = cur; st[1] = end; }
    }
    if (cur >= limit) return false;
    bg_item(A, cur, scr, lane);
    if (lane == 0) st[0] = cur + 1;
    return true;
}
__device__ __forceinline__ void phase_prologue(const Args& A, LAS unsigned char* lds, int gw, int NGW, int lane, int wave) {
    unsigned char* ws = A.ws;
    LAS float* scr = (LAS float*)(lds + wave * 16384);
    constexpr int I_IN = (DM / 64) * (INW / 32), I_BS = (SBW / 64) * (DM / 32), I_WO = (DM / 64) * (DM / 32), I_RW = (DM / 64) * (NEXP / 32);
    constexpr int I_UP1 = (DM / 64) * (UPW / 32), I_DN1 = (DFF / 64) * (DM / 32), I_UP = NEXP * I_UP1, I_DN = NEXP * I_DN1;
    constexpr int NITEMS = I_IN + 2 * I_BS + I_WO + I_RW + (MK_BG ? 0 : I_UP + I_DN);
    for (int it = gw; it < NITEMS; it += NGW) {
        int r = it;
#if MK_FP8_GATES
        if (r < I_IN) { constexpr int NB16 = 3072 / 32, NB8 = (INW - 3072) / 32, I16 = (DM / 64) * NB16;
            if (r < I16) { const int kb = r / NB16, nb = r % NB16; p0_transpose_item(A.in[1], DM, INW, (bf16_t*)(ws + WS_WINT), scr, kb * (INW / 32) + nb, lane); }
            else p0_transpose_item_f8(A.in[1] + 3072, DM, INW, (unsigned char*)(ws + WS_WINT8), scr, r - I16, lane, W8_SCALE, NB8);
            continue; } r -= I_IN;
#else
        if (r < I_IN) { p0_transpose_item(A.in[1], DM, INW, (bf16_t*)(ws + WS_WINT), scr, r, lane); continue; } r -= I_IN;
#endif
        if (r < I_BS) { p0_transpose_item(A.in[4], SBW, DM, (bf16_t*)(ws + WS_WBST), scr, r, lane); continue; } r -= I_BS;
        if (r < I_BS) { p0_transpose_item(A.in[5], HGW, DM, (bf16_t*)(ws + WS_WBHT), scr, r, lane); continue; } r -= I_BS;
        if (r < I_WO) { p0_transpose_item(A.in[6], DM, DM, (bf16_t*)(ws + WS_WOT), scr, r, lane); continue; } r -= I_WO;
        if (r < I_RW) { p0_transpose_item(A.in[9], DM, NEXP, (bf16_t*)(ws + WS_RWT), scr, r, lane); continue; } r -= I_RW;
        if (r < I_UP) { const int e = r / I_UP1; p0_transpose_item(A.in[11] + (size_t)e * DM * UPW, DM, UPW, (bf16_t*)(ws + WS_WUPT) + (size_t)e * DM * UPW, scr, r % I_UP1, lane); continue; } r -= I_UP;
        { const int e = r / I_DN1; p0_transpose_item(A.in[13] + (size_t)e * DFF * DM, DFF, DM, (bf16_t*)(ws + WS_WDNT) + (size_t)e * DFF * DM, scr, r % I_DN1, lane); }
    }
    bf16_t* XB = (bf16_t*)(ws + WS_XB);
    for (int m0 = gw; m0 < NTOK; m0 += MK_P0_ROWS * NGW) {
        f32x4 xv[MK_P0_ROWS][4];
#pragma unroll
        for (int q = 0; q < MK_P0_ROWS; ++q) { const int m = m0 + q * NGW; const GAS f32x4* xr = (const GAS f32x4*)(A.in[0] + (size_t)(m < NTOK ? m : m0) * DM) + lane;
#pragma unroll
            for (int j = 0; j < 4; ++j) xv[q][j] = xr[64 * j]; }
#pragma unroll
        for (int q = 0; q < MK_P0_ROWS; ++q) { const int m = m0 + q * NGW; if (m < NTOK) { GAS u32x2* o8 = (GAS u32x2*)(XB + (size_t)m * DM) + lane;
#pragma unroll
            for (int j = 0; j < 4; ++j) { const f32x4 v = xv[q][j]; u32x2 w; w.x = pk2(v[0], v[1]); w.y = pk2(v[2], v[3]); o8[64 * j] = w;
#if MK_FP8_GATES
                ((GAS unsigned*)((unsigned char*)(ws + WS_XB8) + (size_t)m * DM))[lane + 64 * j] = pk4_fp8(v[0], v[1], v[2], v[3]);
#endif
            } } }
    }
    if (gw < 8) { const int c = gw * 64 + lane; const float l0 = A.in[2][c], l1 = A.in[2][HGW + c]; ((float*)(ws + WS_LB))[c] = 1.0f / (1.0f + expf(l1 - l0)); }
}

__device__ __forceinline__ void attn_naive_unit(const bf16_t* __restrict__ Q, const bf16_t* __restrict__ K, const bf16_t* __restrict__ V, bf16_t* __restrict__ O, int bh, int qb, int lane) {
    const int b = bh >> 3, h = bh & 7, t = qb * 64 + lane; const size_t rowbase = (size_t)b * SEQ;
    float q[64], o[64];
    { const bf16_t* qp = Q + (rowbase + t) * SBW + h * SBD;
#pragma unroll
      for (int d = 0; d < 64; ++d) { q[d] = bf2f(qp[d]); o[d] = 0.f; } }
    float R = 1.0f;
    for (int s = qb * 64 + 63; s >= 0; --s) {
        const bf16_t* kr = K + (rowbase + s) * SBW + h * SBD; const bf16_t* vr = V + (rowbase + s) * SBW + h * SBD;
        float z = 0.f;
#pragma unroll
        for (int d = 0; d < 64; ++d) z += q[d] * bf2f(kr[d]);
        const bool valid = s < t;
        const float ez = expf(fminf(z, 60.0f)), keep = 1.0f / (1.0f + ez);
        const float a = valid ? ez * keep * R : 0.f;
        R = valid ? R * keep : R;
#pragma unroll
        for (int d = 0; d < 64; ++d) o[d] += a * bf2f(vr[d]);
    }
    bf16_t* op = O + (rowbase + t) * SBW + h * SBD;
#pragma unroll
    for (int d = 0; d < 64; ++d) op[d] = (bf16_t)f2bf(o[d]);
}
__device__ __forceinline__ void hgrn_naive_block(const bf16_t* __restrict__ HQ, const bf16_t* __restrict__ HK, const float* __restrict__ LOGF, const bf16_t* __restrict__ HV, float* __restrict__ ORAW,
                                                 LAS unsigned char* lds, int blk, int tid) {
    const int grp = tid >> 7, v = tid & 127, bh = blk * 4 + grp, b = bh >> 2, hh = bh & 3;
    LAS float* sf = (LAS float*)lds + grp * 384; LAS float* sk = sf + 128; LAS float* sq = sf + 256;
    float S[128];
#pragma unroll
    for (int k = 0; k < 128; ++k) S[k] = 0.f;
    for (int t = 0; t < SEQ; ++t) {
        const size_t base = ((size_t)b * SEQ + t) * HGW + hh * HGD;
        sf[v] = expf(LOGF[base + v]); sk[v] = bf2f(HK[base + v]); sq[v] = bf2f(HQ[base + v]);
        const float vv = bf2f(HV[base + v]);
        __syncthreads();
        float o = 0.f;
#pragma unroll
        for (int k = 0; k < 128; ++k) { S[k] = sf[k] * S[k] + sk[k] * vv; o += sq[k] * S[k]; }
        ORAW[base + v] = o;
        __syncthreads();
    }
}
__device__ __forceinline__ void hgrn_post_item(const float* __restrict__ ORAW, const bf16_t* __restrict__ HG, const float* __restrict__ norm_g, bf16_t* __restrict__ OHG, int item, int lane) {
    const size_t base = (size_t)item * HGD; const int c0 = (item & 3) * HGD;
    const float x0 = ORAW[base + lane], x1 = ORAW[base + 64 + lane];
    const float r = 1.0f / sqrtf(wave_sum(x0 * x0 + x1 * x1) * (1.0f / HGD) + RMS_EPS);
    OHG[base + lane] = (bf16_t)f2bf(x0 * r * norm_g[c0 + lane] * bf2f(HG[base + lane]));
    OHG[base + 64 + lane] = (bf16_t)f2bf(x1 * r * norm_g[c0 + 64 + lane] * bf2f(HG[base + 64 + lane]));
}

__device__ __forceinline__ int crow(int r, int hi) { return (r & 3) + 8 * (r >> 2) + 4 * hi; }
typedef short v4i16_t __attribute__((ext_vector_type(4)));
__device__ __forceinline__ v4i16_t tr16(LAS const unsigned char* p) { return __builtin_amdgcn_ds_read_tr16_b64_v4i16((LAS v4i16_t*)p); }
__device__ __forceinline__ bf16x8 cat8(v4i16_t lo, v4i16_t hi) { return (bf16x8){lo[0], lo[1], lo[2], lo[3], hi[0], hi[1], hi[2], hi[3]}; }
__device__ __forceinline__ bf16x8 pack8(const f32x16& p, int base) {
    u32x4 w; w.x = pg8::cvt_pk_bf16(p[base + 0], p[base + 1]); w.y = pg8::cvt_pk_bf16(p[base + 2], p[base + 3]); w.z = pg8::cvt_pk_bf16(p[base + 4], p[base + 5]); w.w = pg8::cvt_pk_bf16(p[base + 6], p[base + 7]);
    return __builtin_bit_cast(bf16x8, w);
}
__device__ __forceinline__ float xhalf(float v) {
    auto rr = __builtin_amdgcn_permlane32_swap(__float_as_uint(v), __float_as_uint(v), false, false);
    return __uint_as_float((threadIdx.x & 32) ? rr[0] : rr[1]);
}
#define WAIT_ALL_BAR() asm volatile("s_waitcnt vmcnt(0) lgkmcnt(0)\n\ts_barrier" ::: "memory")

constexpr int AT_K = 0, AT_V = 16384, AT_OST = 32768, AT_Q = 65536, AT_FLAG = 65600;
__device__ __forceinline__ void attn_unit(const bf16_t* Q, const bf16_t* K, const bf16_t* V, bf16_t* O, int bh, int qb, LAS unsigned char* lds, int lane, int wid) {
    const int b = bh >> 3, h = bh & 7, r32 = lane & 31, hi = lane >> 5;
    const size_t rowbase = (size_t)b * SEQ; const int q0 = qb * 256, qw0 = q0 + wid * 32;
    bf16x8 qr[4];
    { const bf16_t* qp = Q + (rowbase + qw0 + r32) * SBW + h * SBD + hi * 8;
#pragma unroll
      for (int d0 = 0; d0 < 4; ++d0) qr[d0] = *(const bf16x8*)(qp + d0 * 16); }
    f32x16 o0 = {}, o1 = {}; float R = 1.0f;
    const int NT = 4 * qb + 4;
    const bf16_t* ksrc = K + (rowbase + lane) * SBW + h * SBD + wid * 8;
    const bf16_t* vsrc = V + (rowbase + 16 * (wid & 3) + (lane >> 2)) * SBW + h * SBD + (wid >> 2) * 32 + (lane & 3) * 8;
    LAS unsigned char* kdst = lds + AT_K + wid * 1024; LAS unsigned char* vdst = lds + AT_V + wid * 1024;
    const int vb = ((lane >> 4) & 1) * 32 + (lane & 3) * 8 + (4 * hi + ((lane & 15) >> 2)) * 64;
    { const size_t go = (size_t)(NT - 1) * 64 * SBW;
      __builtin_amdgcn_global_load_lds((const unsigned*)(ksrc + go), (LAS unsigned*)kdst, 16, 0, 0);
      __builtin_amdgcn_global_load_lds((const unsigned*)(vsrc + go), (LAS unsigned*)vdst, 16, 0, 0); }
    if (lane == 0) *(LAS int*)(lds + AT_FLAG + wid * 4) = 0;
    bool wz = false;
    for (int it = 0; it < NT; ++it) {
        const int kt = NT - 1 - it, slot = (it & 1) * 8192, k0 = kt * 64;
        WAIT_ALL_BAR();
        { const u32x4 f0 = *(const LAS u32x4*)(lds + AT_FLAG), f1 = *(const LAS u32x4*)(lds + AT_FLAG + 16);
          if (__builtin_amdgcn_readfirstlane((f0.x & f0.y & f0.z & f0.w & f1.x & f1.y & f1.z & f1.w) != 0u)) break; }
        if (it + 1 < NT) { const size_t go = (size_t)(kt - 1) * 64 * SBW;
            __builtin_amdgcn_global_load_lds((const unsigned*)(ksrc + go), (LAS unsigned*)(kdst + (slot ^ 8192)), 16, 0, 0);
            __builtin_amdgcn_global_load_lds((const unsigned*)(vsrc + go), (LAS unsigned*)(vdst + (slot ^ 8192)), 16, 0, 0); }
        if (k0 < qw0 + 31 && !wz) {
            f32x16 p0 = {}, p1 = {};
            const LAS unsigned char* kb = lds + AT_K + slot + hi * 1024 + r32 * 16;
#pragma unroll
            for (int d0 = 0; d0 < 4; ++d0) {
                const bf16x8 a0 = *(const LAS bf16x8*)(kb + d0 * 2048), a1 = *(const LAS bf16x8*)(kb + d0 * 2048 + 512);
                p0 = __builtin_amdgcn_mfma_f32_32x32x16_bf16(a0, qr[d0], p0, 0, 0, 0);
                p1 = __builtin_amdgcn_mfma_f32_32x32x16_bf16(a1, qr[d0], p1, 0, 0, 0);
            }
#pragma unroll
            for (int r = 0; r < 16; ++r) { p0[r] = __builtin_amdgcn_rcpf(1.0f + __builtin_amdgcn_exp2f(p0[r])); p1[r] = __builtin_amdgcn_rcpf(1.0f + __builtin_amdgcn_exp2f(p1[r])); }
            if (k0 + 63 >= qw0) {
                const int tq = qw0 + r32 - k0 - 4 * hi;
#pragma unroll
                for (int r = 0; r < 16; ++r) { const int kv = (r & 3) + 8 * (r >> 2); if (kv >= tq) p0[r] = 1.0f; if (kv + 32 >= tq) p1[r] = 1.0f; }
            }
            float gm[8], gp[8];
#pragma unroll
            for (int i = 0; i < 4; ++i) { gm[i] = (p0[4 * i] * p0[4 * i + 1]) * (p0[4 * i + 2] * p0[4 * i + 3]); gm[4 + i] = (p1[4 * i] * p1[4 * i + 1]) * (p1[4 * i + 2] * p1[4 * i + 3]); }
#pragma unroll
            for (int i = 0; i < 8; ++i) gp[i] = xhalf(gm[i]);
            float run = R, E[8];
#pragma unroll
            for (int i = 7; i >= 0; --i) {
                const float pre = hi ? 1.0f : gp[i], post = hi ? gp[i] : 1.0f;
                run *= pre; E[i] = run; run *= gm[i]; run *= post;
            }
            R = run;
#pragma unroll
            for (int i = 0; i < 4; ++i) {
                { float X = E[i];
#pragma unroll
                  for (int j = 3; j >= 0; --j) { const float s = p0[4 * i + j] * X; p0[4 * i + j] = X - s; X = s; } }
                { float X = E[4 + i];
#pragma unroll
                  for (int j = 3; j >= 0; --j) { const float s = p1[4 * i + j] * X; p1[4 * i + j] = X - s; X = s; } }
            }
            const bf16x8 pa0 = pack8(p0, 0), pa1 = pack8(p0, 8), pa2 = pack8(p1, 0), pa3 = pack8(p1, 8);
            const LAS unsigned char* vp = lds + AT_V + slot + vb;
#pragma unroll
            for (int d0 = 0; d0 < 2; ++d0) {
                f32x16 acc = d0 ? o1 : o0;
                acc = __builtin_amdgcn_mfma_f32_32x32x16_bf16(pa0, cat8(tr16(vp + d0 * 4096), tr16(vp + d0 * 4096 + 512)), acc, 0, 0, 0);
                acc = __builtin_amdgcn_mfma_f32_32x32x16_bf16(pa1, cat8(tr16(vp + d0 * 4096 + 1024), tr16(vp + d0 * 4096 + 1024 + 512)), acc, 0, 0, 0);
                acc = __builtin_amdgcn_mfma_f32_32x32x16_bf16(pa2, cat8(tr16(vp + d0 * 4096 + 2048), tr16(vp + d0 * 4096 + 2048 + 512)), acc, 0, 0, 0);
                acc = __builtin_amdgcn_mfma_f32_32x32x16_bf16(pa3, cat8(tr16(vp + d0 * 4096 + 3072), tr16(vp + d0 * 4096 + 3072 + 512)), acc, 0, 0, 0);
                if (d0) o1 = acc; else o0 = acc;
            }
            { const int allz = __all(R == 0.0f) ? 1 : 0; if (lane == 0) *(LAS int*)(lds + AT_FLAG + wid * 4) = allz; wz = allz != 0; }
        }
    }
    { LAS unsigned short* stg = (LAS unsigned short*)(lds + AT_OST + wid * 4096);
#pragma unroll
      for (int r = 0; r < 16; ++r) { const int orow = crow(r, hi); stg[orow * 64 + r32] = (unsigned short)f2bf(o0[r]); stg[orow * 64 + 32 + r32] = (unsigned short)f2bf(o1[r]); }
      LDS_WAIT();
      bf16_t* Ow = O + (rowbase + qw0) * SBW + h * SBD;
#pragma unroll
      for (int i = 0; i < 4; ++i) { const int row = i * 8 + (lane >> 3), ch = lane & 7; const u32x4 v = *(const LAS u32x4*)((LAS unsigned char*)stg + row * 128 + ch * 16); *(u32x4*)(Ow + (size_t)row * SBW + ch * 8) = v; } }
}

constexpr int HP_RD = 272, HP_TR = 320;
constexpr int HL_QT = 0, HL_KH = HL_QT + 64 * HP_RD, HL_KD = HL_KH + 64 * HP_RD, HL_VT = HL_KD + 64 * HP_TR, HL_SB = HL_VT + 64 * HP_TR, HL_DEC = HL_SB + 128 * HP_TR, HL_SEG = HL_DEC + 512, HL_END = HL_SEG + 8 * 128 * 4;
static_assert(HL_END <= LDS_SCRATCH, "HGRN LDS map");
constexpr int HG_GROUPS = 8, HG_CHUNKS = SEQ / 64 / HG_GROUPS;
#define LDS_BAR() asm volatile("s_waitcnt lgkmcnt(0)\n\ts_barrier" ::: "memory")
__device__ __forceinline__ void hgrn_unit_a(const bf16_t* HQ, const bf16_t* HK, const float* LOGF, const bf16_t* HV, float* ORAW, bf16_t* QC, float* DS, float* DG, int unit, LAS unsigned char* lds, int tid, int lane, int wid) {
    const int bh = unit >> 3, g = unit & 7, b = bh >> 2, hh = bh & 3, r32 = lane & 31, hi = lane >> 5, tb = wid >> 2, vj = wid & 3;
    const size_t row0 = (size_t)b * SEQ + (size_t)g * (SEQ / HG_GROUPS); const int cb = hh * HGD;
    const int kp = lane, seg = wid;
    const int vr = tid >> 3, vp8 = tid & 7;
    for (int i = tid; i < 128 * HP_TR / 16; i += NTHREADS) *(LAS u32x4*)(lds + HL_SB + i * 16) = (u32x4){0u, 0u, 0u, 0u};
    f32x16 S0 = {}, S1 = {};
    float gb0 = 0.f, gb1 = 0.f;
    f32x2_t lf[8]; unsigned qv[8], kv[8]; u32x4 vv0, vv1;
#define HG_LOAD(c) do { const size_t base_ = (row0 + (size_t)(c) * 64 + 8 * seg) * HGW + cb + 2 * kp; \
        _Pragma("unroll") for (int i = 0; i < 8; ++i) { lf[i] = *(const f32x2_t*)(LOGF + base_ + (size_t)i * HGW); qv[i] = *(const unsigned*)(HQ + base_ + (size_t)i * HGW); kv[i] = *(const unsigned*)(HK + base_ + (size_t)i * HGW); } \
        const bf16_t* vsrc_ = HV + (row0 + (size_t)(c) * 64 + vr) * HGW + cb + vp8 * 16; vv0 = *(const u32x4*)vsrc_; vv1 = *(const u32x4*)(vsrc_ + 8); } while (0)
    HG_LOAD(0);
    for (int c = 0; c < HG_CHUNKS; ++c) {
        float cs0[8], cs1[8]; { float a0 = 0.f, a1 = 0.f;
#pragma unroll
            for (int i = 0; i < 8; ++i) { a0 += lf[i].x; a1 += lf[i].y; cs0[i] = a0; cs1[i] = a1; } }
        *(LAS f32x2_t*)(lds + HL_SEG + (seg * 128 + 2 * kp) * 4) = (f32x2_t){cs0[7], cs1[7]};
        *(LAS u32x4*)(lds + HL_VT + vr * HP_TR + vp8 * 32) = vv0; *(LAS u32x4*)(lds + HL_VT + vr * HP_TR + vp8 * 32 + 16) = vv1;
        LDS_BAR();
        { float pre0 = 0.f, pre1 = 0.f, bl0 = 0.f, bl1 = 0.f;
#pragma unroll
          for (int s2 = 0; s2 < 8; ++s2) { const f32x2_t t = *(const LAS f32x2_t*)(lds + HL_SEG + (s2 * 128 + 2 * kp) * 4); if (s2 < seg) { pre0 += t.x; pre1 += t.y; } bl0 += t.x; bl1 += t.y; }
          if (seg == 0) *(LAS f32x2_t*)(lds + HL_DEC + 2 * kp * 4) = (f32x2_t){__builtin_amdgcn_exp2f(bl0 * LOG2E), __builtin_amdgcn_exp2f(bl1 * LOG2E)};
          const size_t qcb = (row0 + (size_t)c * 64 + 8 * seg) * HGW + cb + 2 * kp;
          const float eB0 = __builtin_amdgcn_exp2f(bl0 * LOG2E), eB1 = __builtin_amdgcn_exp2f(bl1 * LOG2E), eG0 = __builtin_amdgcn_exp2f(fmaxf(gb0 * LOG2E, -120.f)), eG1 = __builtin_amdgcn_exp2f(fmaxf(gb1 * LOG2E, -120.f));
#pragma unroll
          for (int i = 0; i < 8; ++i) { const int t = 8 * seg + i;
              const float bb0 = (pre0 + cs0[i]) * LOG2E, bb1 = (pre1 + cs1[i]) * LOG2E, q0 = bflo(qv[i]), q1 = bfhi(qv[i]), k0 = bflo(kv[i]), k1 = bfhi(kv[i]);
              const float qe0 = q0 * __builtin_amdgcn_exp2f(fmaxf(bb0, -120.f)), qe1 = q1 * __builtin_amdgcn_exp2f(fmaxf(bb1, -120.f)), ke0 = k0 * __builtin_amdgcn_exp2f(fminf(-bb0, 120.f)), ke1 = k1 * __builtin_amdgcn_exp2f(fminf(-bb1, 120.f));
              *(LAS unsigned*)(lds + HL_QT + t * HP_RD + kp * 4) = pg8::cvt_pk_bf16(qe0, qe1);
              *(LAS unsigned*)(lds + HL_KH + t * HP_RD + kp * 4) = pg8::cvt_pk_bf16(ke0, ke1);
              *(LAS unsigned*)(lds + HL_KD + t * HP_TR + kp * 4) = pg8::cvt_pk_bf16(ke0 * eB0, ke1 * eB1);
              if (g > 0) *(unsigned*)(QC + qcb + (size_t)i * HGW) = pg8::cvt_pk_bf16(qe0 * eG0, qe1 * eG1); }
          gb0 += bl0; gb1 += bl1; }
        if (c + 1 < HG_CHUNKS) HG_LOAD(c + 1);
        LDS_BAR();
        f32x16 oacc = {};
        bf16x8 pa[2][2];
#pragma unroll
        for (int a = 0; a < 2; ++a) if (a <= tb) {
            f32x16 x = {};
#pragma unroll
            for (int ks = 0; ks < 8; ++ks) {
                const bf16x8 af = *(const LAS bf16x8*)(lds + HL_KH + (32 * a + r32) * HP_RD + (16 * ks + 8 * hi) * 2);
                const bf16x8 bfr = *(const LAS bf16x8*)(lds + HL_QT + (32 * tb + r32) * HP_RD + (16 * ks + 8 * hi) * 2);
                x = __builtin_amdgcn_mfma_f32_32x32x16_bf16(af, bfr, x, 0, 0, 0);
            }
            if (a == tb) {
#pragma unroll
                for (int r = 0; r < 16; ++r) if (crow(r, hi) > r32) x[r] = 0.f;
            }
            pa[a][0] = pack8(x, 0); pa[a][1] = pack8(x, 8);
        }
#pragma unroll
        for (int ks = 0; ks < 8; ++ks) {
            const bf16x8 af = *(const LAS bf16x8*)(lds + HL_QT + (32 * tb + r32) * HP_RD + (16 * ks + 8 * hi) * 2);
            const LAS unsigned char* sp = lds + HL_SB + (16 * ks + 8 * hi + ((lane & 15) >> 2)) * HP_TR + (32 * vj + 16 * ((lane >> 4) & 1) + 4 * (lane & 3)) * 2;
            oacc = __builtin_amdgcn_mfma_f32_32x32x16_bf16(af, cat8(tr16(sp), tr16(sp + 4 * HP_TR)), oacc, 0, 0, 0);
        }
#pragma unroll
        for (int a = 0; a < 2; ++a) if (a <= tb) {
#pragma unroll
            for (int s2 = 0; s2 < 2; ++s2) {
                const LAS unsigned char* vp = lds + HL_VT + (32 * a + 16 * s2 + 4 * hi + ((lane & 15) >> 2)) * HP_TR + (32 * vj + 16 * ((lane >> 4) & 1) + 4 * (lane & 3)) * 2;
                oacc = __builtin_amdgcn_mfma_f32_32x32x16_bf16(pa[a][s2], cat8(tr16(vp), tr16(vp + 8 * HP_TR)), oacc, 0, 0, 0);
            }
        }
#pragma unroll
        for (int u = 0; u < 2; ++u) {
            f32x16 Sx = u ? S1 : S0; const int kt = 2 * tb + u;
            const LAS float* dec = (const LAS float*)(lds + HL_DEC) + 32 * kt;
#pragma unroll
            for (int r = 0; r < 16; ++r) Sx[r] *= dec[crow(r, hi)];
#pragma unroll
            for (int ks = 0; ks < 4; ++ks) {
                const int srow = 16 * ks + 8 * hi + ((lane & 15) >> 2), cq = 16 * ((lane >> 4) & 1) + 4 * (lane & 3);
                const LAS unsigned char* ap = lds + HL_KD + srow * HP_TR + (32 * kt + cq) * 2;
                const LAS unsigned char* bp = lds + HL_VT + srow * HP_TR + (32 * vj + cq) * 2;
                Sx = __builtin_amdgcn_mfma_f32_32x32x16_bf16(cat8(tr16(ap), tr16(ap + 4 * HP_TR)), cat8(tr16(bp), tr16(bp + 4 * HP_TR)), Sx, 0, 0, 0);
            }
            if (u) S1 = Sx; else S0 = Sx;
        }
        { float* op = ORAW + (row0 + (size_t)c * 64 + 32 * tb) * HGW + cb + 32 * vj + r32;
#pragma unroll
          for (int r = 0; r < 16; ++r) op[(size_t)crow(r, hi) * HGW] = oacc[r]; }
        LDS_BAR();
        if (c + 1 < HG_CHUNKS) {
#pragma unroll
            for (int u = 0; u < 2; ++u) { const f32x16 Sx = u ? S1 : S0; const int kt = 2 * tb + u;
#pragma unroll
                for (int r = 0; r < 16; ++r) *(LAS unsigned short*)(lds + HL_SB + (32 * kt + crow(r, hi)) * HP_TR + (32 * vj + r32) * 2) = (unsigned short)f2bf(Sx[r]); }
        }
    }
#undef HG_LOAD
    if (g + 1 < HG_GROUPS) {
        float* ds = DS + (size_t)unit * (HGD * HGD);
#pragma unroll
        for (int u = 0; u < 2; ++u) { const f32x16 Sx = u ? S1 : S0; const int kt = 2 * tb + u;
#pragma unroll
            for (int r = 0; r < 16; ++r) ds[(32 * kt + crow(r, hi)) * HGD + 32 * vj + r32] = Sx[r]; }
        if (seg == 0) *(f32x2_t*)(DG + (size_t)unit * HGD + 2 * kp) = (f32x2_t){__builtin_amdgcn_exp2f(gb0 * LOG2E), __builtin_amdgcn_exp2f(gb1 * LOG2E)};
    }
    LDS_BAR();
}
__device__ __forceinline__ void hgrn_unit_b(const float* ORAW, const bf16_t* QC, const float* DS, const float* DG, const bf16_t* HG, const float* norm_g, bf16_t* OHG, int unit, LAS unsigned char* lds, int tid, int lane, int wid) {
    const int bh = unit >> 3, g = unit & 7, b = bh >> 2, hh = bh & 3, r32 = lane & 31, hi = lane >> 5;
    const size_t tok0 = (size_t)b * SEQ + (size_t)g * (SEQ / HG_GROUPS) + 32 * wid; const int cb = hh * HGD;
    if (g > 0) {
        { float S[32];
#pragma unroll
          for (int i = 0; i < 32; ++i) S[i] = 0.f;
          const int k = tid >> 2;
          for (int g2 = 0; g2 < g; ++g2) { const float* ds = DS + (size_t)(bh * 8 + g2) * (HGD * HGD) + tid * 32; const float d = DG[(size_t)(bh * 8 + g2) * HGD + k];
#pragma unroll
              for (int j = 0; j < 8; ++j) { const f32x4 x = *(const f32x4*)(ds + 4 * j);
#pragma unroll
                  for (int t = 0; t < 4; ++t) S[4 * j + t] = d * S[4 * j + t] + x[t]; } }
#pragma unroll
          for (int j = 0; j < 4; ++j) { u32x4 w; w.x = pg8::cvt_pk_bf16(S[8 * j], S[8 * j + 1]); w.y = pg8::cvt_pk_bf16(S[8 * j + 2], S[8 * j + 3]); w.z = pg8::cvt_pk_bf16(S[8 * j + 4], S[8 * j + 5]); w.w = pg8::cvt_pk_bf16(S[8 * j + 6], S[8 * j + 7]);
              *(LAS u32x4*)(lds + HL_SB + k * HP_TR + (tid & 3) * 64 + j * 16) = w; } }
        LDS_BAR();
    }
    asm volatile("" ::: "memory");
    f32x16 acc[4];
#pragma unroll
    for (int vj = 0; vj < 4; ++vj)
#pragma unroll
        for (int r = 0; r < 16; ++r) acc[vj][r] = ORAW[(tok0 + crow(r, hi)) * HGW + cb + 32 * vj + r32];
    if (g > 0) {
#pragma unroll
        for (int ks = 0; ks < 8; ++ks) {
            const bf16x8 af = *(const bf16x8*)(QC + (tok0 + r32) * HGW + cb + 16 * ks + 8 * hi);
#pragma unroll
            for (int vj = 0; vj < 4; ++vj) {
                const LAS unsigned char* sp = lds + HL_SB + (16 * ks + 8 * hi + ((lane & 15) >> 2)) * HP_TR + (32 * vj + 16 * ((lane >> 4) & 1) + 4 * (lane & 3)) * 2;
                acc[vj] = __builtin_amdgcn_mfma_f32_32x32x16_bf16(af, cat8(tr16(sp), tr16(sp + 4 * HP_TR)), acc[vj], 0, 0, 0);
            }
        }
    }
    float ng[4];
#pragma unroll
    for (int vj = 0; vj < 4; ++vj) ng[vj] = norm_g[cb + 32 * vj + r32];
#pragma unroll
    for (int rb = 0; rb < 16; rb += MK_PB_GROWS) {
        bf16_t hgv[MK_PB_GROWS][4];
#pragma unroll
        for (int r2 = 0; r2 < MK_PB_GROWS; ++r2) { const size_t ro = (tok0 + crow(rb + r2, hi)) * HGW + cb + r32;
#pragma unroll
            for (int vj = 0; vj < 4; ++vj) hgv[r2][vj] = HG[ro + 32 * vj]; }
#pragma unroll
        for (int r2 = 0; r2 < MK_PB_GROWS; ++r2) { const int r = rb + r2;
            float ss = (acc[0][r] * acc[0][r] + acc[1][r] * acc[1][r]) + (acc[2][r] * acc[2][r] + acc[3][r] * acc[3][r]);
            ss = row16_sum(ss); ss += __shfl_xor(ss, 16);
            const float rs = __builtin_amdgcn_rsqf(ss * (1.0f / HGD) + RMS_EPS);
            const size_t ro = (tok0 + crow(r, hi)) * HGW + cb + r32;
#pragma unroll
            for (int vj = 0; vj < 4; ++vj) OHG[ro + 32 * vj] = (bf16_t)f2bf(acc[vj][r] * rs * ng[vj] * bf2f(hgv[r2][vj]));
        }
        asm volatile("" ::: "memory");
    }
    LDS_BAR();
}

constexpr int TROW = 2064;
constexpr int L_TILE = 0, L_LOGITS = 64 * TROW, L_TOPI = L_LOGITS + 64 * 32 * 4, L_HIST = L_TOPI + 1024, L_SLOT = L_HIST + 128, L_TOT = L_SLOT + 1024, L_BEF = L_TOT + 128, L_PAD = L_BEF + 128, L_PART = L_PAD + 256, L_END5 = L_PART + 2 * 16 * 32 * 4;
static_assert(L_END5 <= LDS_SCRATCH, "P5/P6 LDS map");
__device__ __forceinline__ void phase_ln1_router(const Args& A, LAS unsigned char* lds, int vb, int tid, int lane, int wave) {
    unsigned char* ws = A.ws;
    const bf16_t* PRE = (const bf16_t*)(ws + WS_PRE); float* STATS = (float*)(ws + WS_H); const float* g = A.in[7]; const float* bta = A.in[8];
    LAS int* HIST = (LAS int*)(lds + L_HIST);
    if (tid < NEXP) HIST[tid] = 0;
    u32x4 pp[8][2];
#pragma unroll
    for (int rr = 0; rr < 8; ++rr)
#pragma unroll
        for (int h = 0; h < 2; ++h) pp[rr][h] = *(const u32x4*)(PRE + (size_t)(vb * 64 + wave * 8 + rr) * DM + lane * 8 + 512 * h);
    f32x4 gq[4], bq[4];
#pragma unroll
    for (int j = 0; j < 4; ++j) { const int c = lane * 8 + 512 * (j >> 1) + 4 * (j & 1); gq[j] = *(const f32x4*)(g + c); bq[j] = *(const f32x4*)(bta + c); }
    bf16x8 rwf[16];
    { const bf16_t* RWT = (const bf16_t*)(ws + WS_RWT); const int kq = wave >> 1, r = lane & 31, hh = lane >> 5;
#pragma unroll
      for (int ks = 0; ks < 16; ++ks) rwf[ks] = *(const bf16x8*)(RWT + (size_t)r * DM + 256 * kq + 16 * ks + 8 * hh); }
#pragma unroll
    for (int rr = 0; rr < 8; ++rr) {
        const int rl = wave * 8 + rr, row = vb * 64 + rl;
        f32x4 v[4]; float s = 0.f;
#pragma unroll
        for (int j = 0; j < 4; ++j) { const u32x4 q = pp[rr][j >> 1]; const unsigned px = (j & 1) ? q.z : q.x, py = (j & 1) ? q.w : q.y; v[j] = (f32x4){bflo(px), bfhi(px), bflo(py), bfhi(py)}; s += (v[j][0] + v[j][1]) + (v[j][2] + v[j][3]); }
        const float mean = wave_sum(s) * (1.0f / DM); float s2 = 0.f;
#pragma unroll
        for (int j = 0; j < 4; ++j) { v[j] = v[j] - mean; s2 += (v[j][0] * v[j][0] + v[j][1] * v[j][1]) + (v[j][2] * v[j][2] + v[j][3] * v[j][3]); }
        const float rstd = __builtin_amdgcn_rsqf(wave_sum(s2) * (1.0f / DM) + LN_EPS);
        if (lane == 0) *(f32x2_t*)(STATS + (size_t)row * 2) = (f32x2_t){mean, rstd};
#pragma unroll
        for (int h = 0; h < 2; ++h) { const f32x4 ha = v[2 * h] * rstd * gq[2 * h] + bq[2 * h], hb = v[2 * h + 1] * rstd * gq[2 * h + 1] + bq[2 * h + 1];
            u32x4 w; w.x = pk2(ha[0], ha[1]); w.y = pk2(ha[2], ha[3]); w.z = pk2(hb[0], hb[1]); w.w = pk2(hb[2], hb[3]); *(LAS u32x4*)(lds + L_TILE + rl * TROW + (lane * 8 + 512 * h) * 2) = w; }
    }
    LDS_BAR();
    {
        const int rt = wave & 1, kq = wave >> 1, r = lane & 31, hh = lane >> 5;
        const bf16_t* RWT = (const bf16_t*)(ws + WS_RWT);
        f32x16 acc = {};
#pragma unroll
        for (int ks = 0; ks < 16; ++ks) {
            const int k = 256 * kq + 16 * ks + 8 * hh;
            const bf16x8 af = *(const LAS bf16x8*)(lds + L_TILE + (32 * rt + r) * TROW + k * 2);
            acc = __builtin_amdgcn_mfma_f32_32x32x16_bf16(af, rwf[ks], acc, 0, 0, 0);
        }
        (void)RWT;
        LAS float* LG = (LAS float*)(lds + L_LOGITS);
        for (int q = 0; q < 4; ++q) {
            if (kq == q) {
#pragma unroll
                for (int i = 0; i < 16; ++i) { const int rowl = 32 * rt + (i & 3) + 8 * (i >> 2) + 4 * hh; LAS float* p = LG + rowl * 32 + r; if (q == 0) *p = acc[i]; else *p += acc[i]; }
            }
            LDS_BAR();
        }
    }
    {
        const float* rb = A.in[10]; float* TOPG = (float*)(ws + WS_TOPG); LAS int* TOPI = (LAS int*)(lds + L_TOPI); const LAS float* LG = (const LAS float*)(lds + L_LOGITS);
        const int el = lane & 15, rg = lane >> 4; const float rb0 = rb[el], rb1 = rb[el + 16];
#pragma unroll
        for (int it = 0; it < 2; ++it) {
            const int rl = wave * 8 + it * 4 + rg;
            float val0 = LG[rl * 32 + el] + rb0, val1 = LG[rl * 32 + el + 16] + rb1; float tv[4]; int ti[4];
#pragma unroll
            for (int rnk = 0; rnk < 4; ++rnk) {
                float bv = val0; int bi = el;
#define TOPK_STEP(OV, OI) do { const float ov = (OV); const int oi = (OI); if (ov > bv || (ov == bv && oi < bi)) { bv = ov; bi = oi; } } while (0)
                TOPK_STEP(val1, el + 16);
                TOPK_STEP(dpp_f<0xB1>(bv), __builtin_amdgcn_update_dpp(0, bi, 0xB1, 0xF, 0xF, false)); TOPK_STEP(dpp_f<0x4E>(bv), __builtin_amdgcn_update_dpp(0, bi, 0x4E, 0xF, 0xF, false));
                TOPK_STEP(dpp_f<0x141>(bv), __builtin_amdgcn_update_dpp(0, bi, 0x141, 0xF, 0xF, false)); TOPK_STEP(dpp_f<0x140>(bv), __builtin_amdgcn_update_dpp(0, bi, 0x140, 0xF, 0xF, false));
#undef TOPK_STEP
                tv[rnk] = bv; ti[rnk] = bi; if (bi == el) val0 = -INFINITY; if (bi == el + 16) val1 = -INFINITY;
            }
            if (el == 0) {
                const float e1 = expf(tv[1] - tv[0]), e2 = expf(tv[2] - tv[0]), e3 = expf(tv[3] - tv[0]), inv = 1.0f / (1.0f + e1 + e2 + e3);
                *(float4*)(TOPG + (size_t)(vb * 64 + rl) * 4) = make_float4(inv, e1 * inv, e2 * inv, e3 * inv);
#pragma unroll
                for (int k = 0; k < 4; ++k) { TOPI[rl * 4 + k] = ti[k]; __hip_atomic_fetch_add(&HIST[ti[k]], 1, __ATOMIC_RELAXED, __HIP_MEMORY_SCOPE_WORKGROUP); }
            }
        }
    }
    LDS_BAR();
    if (tid < NEXP) ((int*)(ws + WS_CNTM))[vb * NEXP + tid] = HIST[tid];
}
__device__ __forceinline__ void phase_assign(const Args& A, LAS unsigned char* lds, int vb, int G, int tid, int lane, int wave) {
    unsigned char* ws = A.ws; const int* CNTM = (const int*)(ws + WS_CNTM); int* ctl = (int*)(ws + WS_CTL);
    LAS int* PART = (LAS int*)(lds + L_PART); LAS int* TOT = (LAS int*)(lds + L_TOT); LAS int* BEF = (LAS int*)(lds + L_BEF); LAS int* PAD = (LAS int*)(lds + L_PAD);
    LAS int* TOPI = (LAS int*)(lds + L_TOPI); LAS int* SLOT = (LAS int*)(lds + L_SLOT);
    { const int e = tid & 31, part = tid >> 5; int tot = 0, bef = 0;
      int cv[16];
#pragma unroll
      for (int q = 0; q < 16; ++q) { const int b2 = part * 16 + q; cv[q] = CNTM[(b2 < G ? b2 : G - 1) * NEXP + e]; }
#pragma unroll
      for (int q = 0; q < 16; ++q) { const int b2 = part * 16 + q; const int c = (b2 < G) ? cv[q] : 0; tot += c; if (b2 < vb) bef += c; }
      PART[part * 32 + e] = tot; PART[512 + part * 32 + e] = bef; }
    LDS_BAR();
    if (tid < NEXP) { int tot = 0, bef = 0;
#pragma unroll
        for (int p = 0; p < 16; ++p) { tot += PART[p * 32 + tid]; bef += PART[512 + p * 32 + tid]; }
        TOT[tid] = tot; BEF[tid] = bef; }
    LDS_BAR();
    if (tid < 64) {
        const int te = (tid < NEXP) ? (TOT[tid & 31] + SLOT_PAD - 1) / SLOT_PAD : 0; int inc = te;
#pragma unroll
        for (int d = 1; d < 32; d <<= 1) { const int o = __shfl_up(inc, d); if ((tid & 63) >= d) inc += o; }
        const int tb = inc - te;
        if (tid < NEXP) { PAD[tid] = tb * SLOT_PAD; if (vb == 0) for (int i = 0; i < te; ++i) ctl[CW_TILEEXP + tb + i] = tid; }
        if (vb == 0 && tid == NEXP - 1) ctl[CW_NTILES] = inc; }
    LDS_BAR();
    if (tid < 256) { const int e = TOPI[tid]; int rank = 0; for (int j = 0; j < tid; ++j) rank += (TOPI[j] == e) ? 1 : 0;
        const int slot = PAD[e] + BEF[e] + rank; SLOT[tid] = slot; ((int*)(ws + WS_DEST))[vb * 256 + tid] = slot;
#if MK_GATHER_A
        ((int*)(ws + WS_SLOTTOK))[slot] = vb * 64 + (tid >> 2);
#endif
    }
    LDS_BAR();
    bf16_t* XS = (bf16_t*)(ws + WS_XS);
#if MK_GATHER_A
#pragma unroll
    for (int rq = 0; rq < 8; ++rq) { const int r = wave * 8 + rq;
        const int i = 4 * r; const int slot = vb * 64 + r; const LAS unsigned char* src = lds + L_TILE + (i >> 2) * TROW; unsigned char* dst = (unsigned char*)(XS + (size_t)slot * DM);
#else
    for (int i = wave * 32; i < wave * 32 + 32; ++i) {
        const int slot = SLOT[i]; const LAS unsigned char* src = lds + L_TILE + (i >> 2) * TROW; unsigned char* dst = (unsigned char*)(XS + (size_t)slot * DM);
#endif
#if MK_FP8_UP
        { const u32x4 a = *(const LAS u32x4*)(src + lane * 32), b = *(const LAS u32x4*)(src + lane * 32 + 16); u32x4 o;
          o.x = pk4_fp8(bflo(a.x), bfhi(a.x), bflo(a.y), bfhi(a.y)); o.y = pk4_fp8(bflo(a.z), bfhi(a.z), bflo(a.w), bfhi(a.w)); o.z = pk4_fp8(bflo(b.x), bfhi(b.x), bflo(b.y), bfhi(b.y)); o.w = pk4_fp8(bflo(b.z), bfhi(b.z), bflo(b.w), bfhi(b.w));
          *(u32x4*)((unsigned char*)(ws + WS_XS) + (size_t)slot * DM + lane * 16) = o; (void)dst; }
#else
        const u32x4 a = *(const LAS u32x4*)(src + lane * 16), b = *(const LAS u32x4*)(src + 1024 + lane * 16);
        *(u32x4*)(dst + lane * 16) = a; *(u32x4*)(dst + 1024 + lane * 16) = b;
#endif
    }
}
template <int NR> __device__ __forceinline__ void combine_rows(const Args& A, int row0, int rstep, int lane, const f32x4 (&g1)[4], const f32x4 (&b1)[4], const f32x4 (&g2)[4], const f32x4 (&b2)[4]) {
    unsigned char* ws = A.ws; const bf16_t* PRE = (const bf16_t*)(ws + WS_PRE); const unsigned char* Y = (const unsigned char*)(ws + WS_Y);
    f32x2_t st[NR]; int4 d[NR]; float4 gt[NR]; u32x2 p[NR][4]; unsigned y[NR][4][4];
#pragma unroll
    for (int q = 0; q < NR; ++q) { const int row = row0 + q * rstep; st[q] = *(const f32x2_t*)((const float*)(ws + WS_H) + (size_t)row * 2); d[q] = *(const int4*)((const int*)(ws + WS_DEST) + row * 4); gt[q] = *(const float4*)((const float*)(ws + WS_TOPG) + row * 4);
#pragma unroll
        for (int j = 0; j < 4; ++j) p[q][j] = *(const u32x2*)(PRE + (size_t)row * DM + lane * 4 + 256 * j); }
#pragma unroll
    for (int q = 0; q < NR; ++q) { const int ds[4] = {d[q].x, d[q].y, d[q].z, d[q].w};
#pragma unroll
        for (int j = 0; j < 4; ++j)
#pragma unroll
            for (int k = 0; k < 4; ++k) y[q][j][k] = *(const unsigned*)(Y + (size_t)ds[k] * DM + lane * 4 + 256 * j); }
#pragma unroll
    for (int q = 0; q < NR; ++q) { const int row = row0 + q * rstep;
        const float gs[4] = {gt[q].x * (1.0f / Y8_SCALE), gt[q].y * (1.0f / Y8_SCALE), gt[q].z * (1.0f / Y8_SCALE), gt[q].w * (1.0f / Y8_SCALE)};
        f32x4 v[4]; float s = 0.f;
#pragma unroll
        for (int j = 0; j < 4; ++j) {
            f32x4 a = (((f32x4){bflo(p[q][j].x), bfhi(p[q][j].x), bflo(p[q][j].y), bfhi(p[q][j].y)} - st[q][0]) * st[q][1] * g1[j] + b1[j]) * DN_ALPHA;
#pragma unroll
            for (int k = 0; k < 4; ++k) { const f32x2_t y01 = __builtin_amdgcn_cvt_pk_f32_fp8(y[q][j][k], false), y23 = __builtin_amdgcn_cvt_pk_f32_fp8(y[q][j][k], true);
                a[0] += gs[k] * y01[0]; a[1] += gs[k] * y01[1]; a[2] += gs[k] * y23[0]; a[3] += gs[k] * y23[1]; }
            v[j] = a; s += (a[0] + a[1]) + (a[2] + a[3]); }
        const float mean = wave_sum(s) * (1.0f / DM); float s2 = 0.f;
#pragma unroll
        for (int j = 0; j < 4; ++j) { v[j] = v[j] - mean; s2 += (v[j][0] * v[j][0] + v[j][1] * v[j][1]) + (v[j][2] * v[j][2] + v[j][3] * v[j][3]); }
        const float rstd = __builtin_amdgcn_rsqf(wave_sum(s2) * (1.0f / DM) + LN_EPS);
#pragma unroll
        for (int j = 0; j < 4; ++j) { const int c = lane * 4 + 256 * j; *(f32x4*)(A.out + (size_t)row * DM + c) = v[j] * rstd * g2[j] + b2[j]; }
    }
}

template <bool BG, class ArgsT> __device__ __forceinline__ void xcd_barrier_bg(const XcdBarrier& b, const ArgsT& A, LAS unsigned char* lds, volatile LAS unsigned* MISC) {
    const int wave = __builtin_amdgcn_readfirstlane(threadIdx.x >> 6), lane = threadIdx.x & 63;
    const unsigned e0 = MISC[10];
    asm volatile("s_waitcnt vmcnt(0)" ::: "memory");
    __syncthreads();
    if (wave == 0) {
        if (threadIdx.x == 0) {
            unsigned* bar = b.bar;
            __builtin_amdgcn_s_waitcnt(0);
            unsigned nloc = b.st[0], nx = b.st[1];
            if (nloc == 0u) { xcd_barrier_complete(bar, b.x, nloc, nx); b.st[0] = nloc; b.st[1] = nx; }
            const unsigned old = xb_add(&bar[XB_XSUB(b.x)], 1u);
            const unsigned gen = old / nloc;
            if (old + 1u == (gen + 1u) * nloc) {
                __builtin_amdgcn_fence(__ATOMIC_RELEASE, "agent");
                asm volatile("s_waitcnt vmcnt(0)" ::: "memory");
                const unsigned og = xb_add(&bar[XB_TOP], 1u);
                const unsigned tg = og / nx;
                if (og + 1u == (tg + 1u) * nx) xb_add(&bar[XB_TOPGEN], 1u);
                else XB_SPIN(xb_ld(&bar[XB_TOPGEN]) == tg, bar);
                __builtin_amdgcn_fence(__ATOMIC_ACQUIRE, "");
                xb_add(&bar[XB_XGEN(b.x)], 1u);
                asm volatile("s_waitcnt vmcnt(0)" ::: "memory");
            } else {
                XB_SPIN(xb_ld(&bar[XB_XGEN(b.x)]) == gen, bar);
                __builtin_amdgcn_fence(__ATOMIC_ACQUIRE, "");
                asm volatile("s_waitcnt vmcnt(0)" ::: "memory");
            }
            MISC[10] = e0 + 1u;
        }
    } else if (BG && wave <= MK_BG_WAVES) {
        volatile LAS int* st = (volatile LAS int*)(MISC + 16 + 2 * wave);
        LAS float* scr = (LAS float*)(lds + wave * 16384);
        while (MISC[10] == e0) { if (!bg_step(A, st, scr, lane, BG_TOTAL)) __builtin_amdgcn_s_sleep(16); }
    }
    __syncthreads();
}
__device__ __forceinline__ void bg_drain(const Args& A, LAS unsigned char* lds, volatile LAS unsigned* MISC, int limit) {
    const int wave = __builtin_amdgcn_readfirstlane(threadIdx.x >> 6), lane = threadIdx.x & 63;
    volatile LAS int* st = (volatile LAS int*)(MISC + 16 + 2 * wave);
    while (bg_step(A, st, (LAS float*)(lds + wave * 16384), lane, limit)) {}
}
template <int LO, int HI> __global__ void __launch_bounds__(NTHREADS, 2) mk_fwd(Args args) {
    extern __shared__ __attribute__((aligned(16))) unsigned char lds_raw[];
    LAS unsigned char* lds = (LAS unsigned char*)lds_raw;
    volatile LAS unsigned* MISC = (volatile LAS unsigned*)(lds + MISC_OFF);
    const int G = gridDim.x, bx = blockIdx.x, vcu = (G % 8 == 0) ? (bx % 8) * (G / 8) + bx / 8 : bx;
    const int NGW = G * NWAVES;
#define GW (vcu * NWAVES + wave)
    unsigned char* ws = args.ws;
    for (int u = threadIdx.x; u < (LDS_BYTES - LDSCTL_OFF) / 4; u += NTHREADS) ((LAS unsigned*)(lds + LDSCTL_OFF))[u] = 0u;
    __syncthreads();
    XcdBarrier bar = xcd_barrier_post((unsigned*)(ws + WS_CTL) + CW_BAR + args.li * XCD_BAR_WORDS, MISC + 8);
#define IN(k) (LO <= (k) && (k) < HI)
#if MK_PROBE
    unsigned long long ts[16]; ts[0] = __builtin_amdgcn_s_memrealtime();
#define TS(i) ts[i] = __builtin_amdgcn_s_memrealtime()
#else
#define TS(i) do { } while (0)
#endif
#if 1
#if MK_BG
#define SEAM(k) do { if constexpr (IN(k) && IN((k) + 1)) { \
        if constexpr ((k) == 7) { __syncthreads(); bg_drain(args, lds, MISC, BG_I_UP); } \
        if constexpr ((k) == 8) { TS(13); bg_drain(args, lds, MISC, BG_TOTAL); TS(14); } \
        if constexpr (((MK_BG_SEAMS) >> (k)) & 1) xcd_barrier_bg<true>(bar, args, lds, MISC); else xcd_barrier_bg<false>(bar, args, lds, MISC); } } while (0)
#else
#define SEAM(k) do { if constexpr (IN(k) && IN((k) + 1)) xcd_barrier(bar); } while (0)
#endif
#endif
    InProjOut ip; ip.Q = (bf16_t*)(ws + WS_Q); ip.K = (bf16_t*)(ws + WS_K); ip.V = (bf16_t*)(ws + WS_V); ip.HQ = (bf16_t*)(ws + WS_HQ); ip.HK = (bf16_t*)(ws + WS_HK); ip.HV = (bf16_t*)(ws + WS_HV);
    ip.HG = (bf16_t*)(ws + WS_HG); ip.GS = (bf16_t*)(ws + WS_GS); ip.GH = (bf16_t*)(ws + WS_GH); ip.LOGF = (float*)(ws + WS_LOGF); ip.lb = (const float*)(ws + WS_LB);

    if constexpr (IN(0)) { FRESH_IDS(); phase_prologue(args, lds, GW, NGW, lane, wave); }
#if MK_PROBE_CONV
    bg_drain(args, lds, MISC, BG_TOTAL);
#if MK_PROBE_CONV > 1
    xcd_barrier(bar);
    if (threadIdx.x == 0) __hip_atomic_store((int*)(ws + WS_CTL) + CW_BGQ, 0, __ATOMIC_RELAXED, __HIP_MEMORY_SCOPE_AGENT);
    { const int w_ = __builtin_amdgcn_readfirstlane(threadIdx.x >> 6); if ((threadIdx.x & 63) == 0) { MISC[16 + 2 * w_] = 0; MISC[17 + 2 * w_] = 0; } }
    xcd_barrier(bar);
    bg_drain(args, lds, MISC, BG_TOTAL);
#endif
#endif
    SEAM(0); TS(1);
    if constexpr (IN(1)) {
#if MK_FP8_GATES
      { pg8::Gemm g{DM}; pg8::DenseSched S; S.o.init(NTOK / 256, 12, G, bx, MK_WGM_P1A); S.A = (const char*)(ws + WS_XB); S.Bt = (const char*)(ws + WS_WINT); S.tstep = (size_t)256 * DM * 2;
        pg8::EpiInProjT<0> E{ip};
        pg8::gemm_phase<pg8::EpiInProjT<0>, pg8::DenseSched, true, true>(lds, g, S, E); }
      { pg8::Gemm g{DM / 2, 0x7f7f7f7f, W8_E8M0}; pg8::DenseSched S; S.o.init(NTOK / 256, 10, G, G - 1 - bx, MK_WGM_P1B); S.A = (const char*)(ws + WS_XB8);     S.Bt = (const char*)(ws + WS_WINT8); S.tstep = (size_t)256 * DM;
        pg8::EpiInProjT<12> E{ip};
        pg8::gemm_phase_f8<pg8::EpiInProjT<12>, pg8::DenseSched, true, true>(lds, g, S, E); }
#else
      { pg8::Gemm g{DM}; pg8::DenseSched S; S.o.init(NTOK / 256, INW / 256, G, bx); S.A = (const char*)(ws + WS_XB); S.Bt = (const char*)(ws + WS_WINT); S.tstep = (size_t)256 * DM * 2;
        pg8::EpiInProjT<0> E{ip};
        pg8::gemm_phase<pg8::EpiInProjT<0>, pg8::DenseSched, true, true>(lds, g, S, E); }
#endif
    }
    SEAM(1); TS(2);
    if constexpr (IN(2)) { _Pragma("unroll 1") for (int rp2_ = 0; rp2_ < MK_LOOP_P2; ++rp2_) { if (rp2_) xcd_barrier(bar); FRESH_IDS(); const int gw = GW; (void)gw; const int qw_ = rp2_;
#if MK_NAIVE_MIX
    { const int u = gw; if (u < 2048) attn_naive_unit(ip.Q, ip.K, ip.V, (bf16_t*)(ws + WS_OSB), u & 63, 31 - (u >> 6), lane); }
    __syncthreads();
    if (vcu < 8) hgrn_naive_block(ip.HQ, ip.HK, ip.LOGF, ip.HV, (float*)(ws + WS_ORAW), lds, vcu, tid);
#else
#define MK_P2_BODY(QW) \
    hgrn_unit_a(ip.HQ, ip.HK, ip.LOGF, ip.HV, (float*)(ws + WS_ORAW), (bf16_t*)(ws + WS_QC), (float*)(ws + WS_DS), (float*)(ws + WS_DG), vcu, lds, tid, lane, wave); TS(12); \
    for (;;) { \
        if (tid == 0) *(LAS int*)(lds + AT_Q) = __hip_atomic_fetch_add((int*)(ws + WS_CTL) + CW_ATTNQ + (QW), 1, __ATOMIC_RELAXED, __HIP_MEMORY_SCOPE_AGENT); \
        LDS_BAR(); \
        const int u = __builtin_amdgcn_readfirstlane(*(LAS int*)(lds + AT_Q)); \
        LDS_BAR(); \
        if (u >= 512) break; \
        attn_unit(ip.Q, ip.K, ip.V, (bf16_t*)(ws + WS_OSB), u & 63, 7 - (u >> 6), lds, lane, wave); \
    }
    MK_P2_BODY(qw_)
#if MK_DUP_P2 > 1
    xcd_barrier(bar);
#if MK_DUP_WHAT == 1
    hgrn_unit_a(ip.HQ, ip.HK, ip.LOGF, ip.HV, (float*)(ws + WS_ORAW), (bf16_t*)(ws + WS_QC), (float*)(ws + WS_DS), (float*)(ws + WS_DG), vcu, lds, tid, lane, wave);
#elif MK_DUP_WHAT == 2
    for (;;) {
        if (tid == 0) *(LAS int*)(lds + AT_Q) = __hip_atomic_fetch_add((int*)(ws + WS_CTL) + CW_ATTNQ + 1, 1, __ATOMIC_RELAXED, __HIP_MEMORY_SCOPE_AGENT);
        __syncthreads();
        const int u = __builtin_amdgcn_readfirstlane(*(LAS int*)(lds + AT_Q));
        __syncthreads();
        if (u >= 512) break;
        attn_unit(ip.Q, ip.K, ip.V, (bf16_t*)(ws + WS_OSB), u & 63, 7 - (u >> 6), lds, lane, wave);
    }
#else
    MK_P2_BODY(1)
#endif
#endif
#if 0
    for (;;) {
        if (tid == 0) {
        __syncthreads();
        const int u = __builtin_amdgcn_readfirstlane(*(LAS int*)(lds + AT_Q));
        __syncthreads();
        if (u >= 512) break;
        attn_unit(ip.Q, ip.K, ip.V, (bf16_t*)(ws + WS_OSB), u & 63, 7 - (u >> 6), lds, lane, wave);
    }
#endif
#endif
    } }
    SEAM(2); TS(3);
#if MK_NAIVE_MIX
    if constexpr (IN(3)) { FRESH_IDS(); const int gw = GW; for (int it = gw; it < NTOK * HGH; it += NGW) hgrn_post_item((const float*)(ws + WS_ORAW), ip.HG, args.in[3], (bf16_t*)(ws + WS_OHG), it, lane); }
#else
    if constexpr (IN(3)) { _Pragma("unroll 1") for (int rb_ = 0; rb_ < MK_DUP_HGB; ++rb_) { if (rb_) xcd_barrier(bar); FRESH_IDS(); hgrn_unit_b((const float*)(ws + WS_ORAW), (const bf16_t*)(ws + WS_QC), (const float*)(ws + WS_DS), (const float*)(ws + WS_DG), ip.HG, args.in[3], (bf16_t*)(ws + WS_OHG), vcu, lds, tid, lane, wave); } }
#endif
    SEAM(3); TS(4);
#if MK_PROBE_BAR
    for (int rb2_ = 0; rb2_ < MK_PROBE_BAR; ++rb2_) xcd_barrier(bar);
#endif
#pragma unroll 1
    for (int rep4_ = 0; rep4_ < MK_DUP_P45; ++rep4_) { if (rep4_) xcd_barrier(bar);
    if constexpr (IN(4)) { pg8::Gemm g{SBW}; pg8::BranchSched S; S.o.init(NTOK / 256, DM / 256, G, bx, MK_WGM_P4); S.A0 = (const char*)(ws + WS_OSB); S.B0 = (const char*)(ws + WS_WBST); S.A1 = (const char*)(ws + WS_OHG); S.B1 = (const char*)(ws + WS_WBHT); S.tstep = (size_t)256 * SBW * 2;
      pg8::EpiBranch E{ip.GS, ip.GH, (bf16_t*)(ws + WS_MERGED)};
      pg8::gemm_phase<pg8::EpiBranch, pg8::BranchSched, true, true>(lds, g, S, E); }
    SEAM(4); TS(5);
    if constexpr (IN(5)) { pg8::Gemm g{DM}; pg8::DenseSched S; S.o.init(NTOK / 256, DM / 256, G, bx, MK_WGM_P5); S.A = (const char*)(ws + WS_MERGED); S.Bt = (const char*)(ws + WS_WOT); S.tstep = (size_t)256 * DM * 2;
      pg8::EpiOut E{(const bf16_t*)(ws + WS_XB), (bf16_t*)(ws + WS_PRE)};
      pg8::gemm_phase<pg8::EpiOut, pg8::DenseSched, true, true>(lds, g, S, E); }
    }
    SEAM(5); TS(6);
#if MK_DUP_TAIL & 1
    { FRESH_IDS(); phase_ln1_router(args, lds, bx, tid, lane, wave); } xcd_barrier(bar);
    { FRESH_IDS(); phase_assign(args, lds, bx, G, tid, lane, wave); } xcd_barrier(bar);
#endif
    if constexpr (IN(6)) { FRESH_IDS(); phase_ln1_router(args, lds, bx, tid, lane, wave); }
    SEAM(6); TS(7);
    if constexpr (IN(7)) { FRESH_IDS(); phase_assign(args, lds, bx, G, tid, lane, wave); }
    SEAM(7); TS(8);
    int ntiles = 0; if constexpr (IN(8) || IN(9)) ntiles = __builtin_amdgcn_readfirstlane(__hip_atomic_load((const int*)(ws + WS_CTL) + CW_NTILES, __ATOMIC_RELAXED, __HIP_MEMORY_SCOPE_AGENT)); const LAS int* tile_exp = (const LAS int*)(lds + LDS_TILEEXP);
    if constexpr (IN(8) || IN(9)) { for (int i = threadIdx.x; i < ntiles; i += NTHREADS) ((LAS int*)(lds + LDS_TILEEXP))[i] = __hip_atomic_load((const int*)(ws + WS_CTL) + CW_TILEEXP + i, __ATOMIC_RELAXED, __HIP_MEMORY_SCOPE_AGENT); __syncthreads(); }
#if MK_FP8_UP
#if MK_GATHER_A
    if constexpr (IN(8)) { pg8::Gemm g{DM / 2, 0x7f7f7f7f, W8_E8M0}; pg8::MoeGatherSched S; S.o.init(ntiles, UPW / 256, G, bx, MK_WGM_UP); S.A = (const char*)(ws + WS_XS); S.W = (const char*)(ws + WS_WUPT); S.tile_exp = tile_exp; S.tstep = (size_t)256 * DM; S.estep = (size_t)UPW * DM; S.slot_tok = (const int*)(ws + WS_SLOTTOK);
      pg8::EpiUpT<MK_FP8_DN != 0> E{args.in[12], (bf16_t*)(ws + WS_ACT)};
      pg8::gemm_phase_f8<pg8::EpiUpT<MK_FP8_DN != 0>, pg8::MoeGatherSched, true, true>(lds, g, S, E); }
#else
    if constexpr (IN(8)) { pg8::Gemm g{DM / 2, 0x7f7f7f7f, W8_E8M0}; pg8::MoeSched S; S.o.init(ntiles, UPW / 256, G, bx); S.A = (const char*)(ws + WS_XS); S.W = (const char*)(ws + WS_WUPT); S.tile_exp = tile_exp; S.tstep = (size_t)256 * DM; S.estep = (size_t)UPW * DM;
      pg8::EpiUpT<MK_FP8_DN != 0> E{args.in[12], (bf16_t*)(ws + WS_ACT)};
      pg8::gemm_phase_f8<pg8::EpiUpT<MK_FP8_DN != 0>, pg8::MoeSched, true, true>(lds, g, S, E); }
#endif
#else
    if constexpr (IN(8)) { pg8::Gemm g{DM}; pg8::MoeSched S; S.o.init(ntiles, UPW / 256, G, bx); S.A = (const char*)(ws + WS_XS); S.W = (const char*)(ws + WS_WUPT); S.tile_exp = tile_exp; S.tstep = (size_t)256 * DM * 2; S.estep = (size_t)UPW * DM * 2;
      pg8::EpiUpT<MK_FP8_DN != 0> E{args.in[12], (bf16_t*)(ws + WS_ACT)};
      pg8::gemm_phase<pg8::EpiUpT<MK_FP8_DN != 0>, pg8::MoeSched, true, true>(lds, g, S, E); }
#endif
    SEAM(8); TS(9);
#if MK_FP8_DN
    if constexpr (IN(9)) { pg8::Gemm g{DFF / 2, ACT8_E8M0, W8_E8M0}; pg8::MoeSched S; S.o.init(ntiles, DM / 256, G, bx, MK_WGM_DN); S.A = (const char*)(ws + WS_ACT); S.W = (const char*)(ws + WS_WDNT); S.tile_exp = tile_exp; S.tstep = (size_t)256 * DFF; S.estep = (size_t)DM * DFF;
      pg8::EpiDown E{args.in[14], (bf16_t*)(ws + WS_Y)};
      pg8::gemm_phase_f8<pg8::EpiDown, pg8::MoeSched, true, true>(lds, g, S, E); }
#else
    if constexpr (IN(9)) { pg8::Gemm g{DFF}; pg8::MoeSched S; S.o.init(ntiles, DM / 256, G, bx); S.A = (const char*)(ws + WS_ACT); S.W = (const char*)(ws + WS_WDNT); S.tile_exp = tile_exp; S.tstep = (size_t)256 * DFF * 2; S.estep = (size_t)DM * DFF * 2;
      pg8::EpiDown E{args.in[14], (bf16_t*)(ws + WS_Y)};
      pg8::gemm_phase<pg8::EpiDown, pg8::MoeSched, true, true>(lds, g, S, E); }
#endif
    SEAM(9); TS(10);
    if constexpr (IN(10)) { FRESH_IDS(); f32x4 g1[4], b1[4], g2[4], b2[4];
#pragma unroll
        for (int j = 0; j < 4; ++j) { const int c = lane * 4 + 256 * j; g1[j] = *(const f32x4*)(args.in[7] + c); b1[j] = *(const f32x4*)(args.in[8] + c); g2[j] = *(const f32x4*)(args.in[15] + c); b2[j] = *(const f32x4*)(args.in[16] + c); }
        int row = GW;
        for (; row + (MK_P10_ROWS - 1) * NGW < NTOK; row += MK_P10_ROWS * NGW) combine_rows<MK_P10_ROWS>(args, row, NGW, lane, g1, b1, g2, b2);
        for (; row < NTOK; row += NGW) combine_rows<1>(args, row, NGW, lane, g1, b1, g2, b2); }
#if MK_PROBE
    xcd_barrier(bar); TS(11);
    if (bx == 0 && threadIdx.x == 0) { unsigned* mk = (unsigned*)(ws + WS_LB + 3072); const bool warm = __hip_atomic_load(mk, __ATOMIC_RELAXED, __HIP_MEMORY_SCOPE_AGENT) == 0x51a7e5u; __hip_atomic_store(mk, 0x51a7e5u, __ATOMIC_RELAXED, __HIP_MEMORY_SCOPE_AGENT);
        const float dA = (float)(ts[MK_PA1] - ts[MK_PA0]) * 0.01f;
        __hip_atomic_store((float*)(ws + WS_CTL) + 40, warm ? dA * (1.0f / 500.0f) : 0.f, __ATOMIC_RELAXED, __HIP_MEMORY_SCOPE_AGENT); }
    xcd_barrier(bar);
    { FRESH_IDS(); const float eps = __hip_atomic_load((float*)(ws + WS_CTL) + 40, __ATOMIC_RELAXED, __HIP_MEMORY_SCOPE_AGENT);
      for (int row = GW; row < NTOK; row += NGW) for (int j2 = 0; j2 < 4; ++j2) { f32x4* p = (f32x4*)(args.out + (size_t)row * DM + lane * 4 + 256 * j2); *p = *p * (1.0f + eps); } }
#endif
}


#if MK_MODE == 2
namespace v1 {
constexpr int CW_CNT = 60000, CW_CUR = 60064, CW_PADSTART = 60128, CW_NTILES = 60192, CW_TILEEXP = 60256;
__device__ __forceinline__ float sigmoidf_(float v) { return 1.0f / (1.0f + expf(-v)); }
__global__ __launch_bounds__(256) void k_transpose_bf16(const float* __restrict__ W, bf16_t* __restrict__ WT, int K, int N) {
    __shared__ float tile[64][65];
    const size_t g = blockIdx.z; W += g * (size_t)K * N; WT += g * (size_t)K * N;
    const int k0 = blockIdx.y * 64, n0 = blockIdx.x * 64, tx = threadIdx.x & 63, ty = threadIdx.x >> 6;
    for (int i = ty; i < 64; i += 4) tile[i][tx] = W[(size_t)(k0 + i) * N + n0 + tx];
    __syncthreads();
    for (int i = ty; i < 64; i += 4) WT[(size_t)(n0 + i) * K + k0 + tx] = (bf16_t)f2bf(tile[tx][i]);
}
__global__ __launch_bounds__(256) void k_convert_x(const float* __restrict__ x, bf16_t* __restrict__ xb, const float* __restrict__ lbl, float* __restrict__ lb) {
    const size_t i = (size_t)blockIdx.x * 256 + threadIdx.x;
    const f32x4 v = ((const f32x4*)x)[i];
    uint2 o; o.x = f2bf(v[0]) | (f2bf(v[1]) << 16); o.y = f2bf(v[2]) | (f2bf(v[3]) << 16);
    ((uint2*)xb)[i] = o;
    if (blockIdx.x == 0) for (int c = threadIdx.x; c < HGW; c += 256) { const float l0 = lbl[c], l1 = lbl[HGW + c]; lb[c] = 1.0f / (1.0f + expf(l1 - l0)); }
}

constexpr int G_BM = 128, G_BK = 32, G_HTB = G_BM * G_BK * 2;
__device__ __forceinline__ void g128_loop(f32x4 (&acc)[4][4], const bf16_t* a0, const bf16_t* a1, const bf16_t* b0, const bf16_t* b1, int K, LAS unsigned char* shm) {
    const int tid = threadIdx.x, wid = tid >> 6, lane = tid & 63, wr = wid >> 1, wc = wid & 1, fr = lane & 15, fq = lane >> 4;
    LAS unsigned char* SA = shm; LAS unsigned char* SB = shm + G_HTB;
    for (int t = 0; t < K / G_BK; ++t) {
        __builtin_amdgcn_global_load_lds((const unsigned*)(a0 + t * G_BK), (LAS unsigned*)(SA + tid * 16), 16, 0, 0);
        __builtin_amdgcn_global_load_lds((const unsigned*)(a1 + t * G_BK), (LAS unsigned*)(SA + tid * 16 + 4096), 16, 0, 0);
        __builtin_amdgcn_global_load_lds((const unsigned*)(b0 + t * G_BK), (LAS unsigned*)(SB + tid * 16), 16, 0, 0);
        __builtin_amdgcn_global_load_lds((const unsigned*)(b1 + t * G_BK), (LAS unsigned*)(SB + tid * 16 + 4096), 16, 0, 0);
        asm volatile("s_waitcnt vmcnt(0)" ::: "memory"); __syncthreads();
        bf16x8 At[4], Bt[4];
#pragma unroll
        for (int m = 0; m < 4; ++m) { At[m] = *(const LAS bf16x8*)(SA + (wr * 64 + m * 16 + fr) * (G_BK * 2) + fq * 16); Bt[m] = *(const LAS bf16x8*)(SB + (wc * 64 + m * 16 + fr) * (G_BK * 2) + fq * 16); }
        asm volatile("s_waitcnt lgkmcnt(0)" ::: "memory"); __builtin_amdgcn_sched_barrier(0);
#pragma unroll
        for (int m = 0; m < 4; ++m)
#pragma unroll
            for (int n = 0; n < 4; ++n) acc[m][n] = __builtin_amdgcn_mfma_f32_16x16x32_bf16(At[m], Bt[n], acc[m][n], 0, 0, 0);
        __syncthreads();
    }
}
#define G128_ZERO(acc) _Pragma("unroll") for (int m_ = 0; m_ < 4; ++m_) _Pragma("unroll") for (int n_ = 0; n_ < 4; ++n_) acc[m_][n_] = (f32x4){0.f, 0.f, 0.f, 0.f}
#define G128_FOREACH(...) do { const int wid_ = threadIdx.x >> 6, lane_ = threadIdx.x & 63, wr_ = wid_ >> 1, wc_ = wid_ & 1, fr_ = lane_ & 15, fq_ = lane_ >> 4; \
    _Pragma("unroll") for (int m_ = 0; m_ < 4; ++m_) _Pragma("unroll") for (int n_ = 0; n_ < 4; ++n_) _Pragma("unroll") for (int j_ = 0; j_ < 4; ++j_) { \
        const int trow = wr_ * 64 + m_ * 16 + fq_ * 4 + j_, tcol = wc_ * 64 + n_ * 16 + fr_; __VA_ARGS__ } } while (0)


__global__ __launch_bounds__(256) void k_inproj(const bf16_t* __restrict__ XB, const bf16_t* __restrict__ WinT, InProjOut o) {
    __shared__ __attribute__((aligned(16))) unsigned char shm[2 * G_HTB];
    const int bcol = blockIdx.x * G_BM, brow = blockIdx.y * G_BM, tid = threadIdx.x, r0 = tid >> 2, c = (tid & 3) * 8;
    f32x4 acc[4][4]; G128_ZERO(acc);
    g128_loop(acc, XB + (size_t)(brow + r0) * DM + c, XB + (size_t)(brow + r0 + 64) * DM + c, WinT + (size_t)(bcol + r0) * DM + c, WinT + (size_t)(bcol + r0 + 64) * DM + c, DM, (LAS unsigned char*)shm);
    const int seg = bcol / 512;
    G128_FOREACH({
        const int row = brow + trow, col = bcol + tcol; const float v = acc[m_][n_][j_];
        if (seg == 0) o.Q[(size_t)row * 512 + col] = (bf16_t)f2bf(v * 0.125f);
        else if (seg == 1) o.K[(size_t)row * 512 + (col - 512)] = (bf16_t)f2bf(v);
        else if (seg == 2) o.V[(size_t)row * 512 + (col - 1024)] = (bf16_t)f2bf(v);
        else if (seg == 3) o.HQ[(size_t)row * 512 + (col - 1536)] = (bf16_t)f2bf(v * sigmoidf_(v));
        else if (seg == 4) { const int cc = col - 2048; const float l = o.lb[cc], f = l + (1.0f - l) * sigmoidf_(v);
            o.HK[(size_t)row * 512 + cc] = (bf16_t)f2bf(1.0f - f); o.LOGF[(size_t)row * 512 + cc] = logf(f); }
        else if (seg == 5) o.HV[(size_t)row * 512 + (col - 2560)] = (bf16_t)f2bf(v);
        else if (seg == 6) o.HG[(size_t)row * 512 + (col - 3072)] = (bf16_t)f2bf(sigmoidf_(v));
        else if (seg < 9) o.GS[(size_t)row * 1024 + (col - 3584)] = (bf16_t)f2bf(sigmoidf_(v));
        else o.GH[(size_t)row * 1024 + (col - 4608)] = (bf16_t)f2bf(sigmoidf_(v));
    });
}

__global__ __launch_bounds__(256) void k_branch(const bf16_t* __restrict__ OSB, const bf16_t* __restrict__ OHG, const bf16_t* __restrict__ WbsT, const bf16_t* __restrict__ WbhT,
                                                const bf16_t* __restrict__ GS, const bf16_t* __restrict__ GH, bf16_t* __restrict__ MERGED) {
    __shared__ __attribute__((aligned(16))) unsigned char shm[2 * G_HTB];
    const int bcol = blockIdx.x * G_BM, brow = blockIdx.y * G_BM, tid = threadIdx.x, r0 = tid >> 2, c = (tid & 3) * 8;
    f32x4 accA[4][4], accB[4][4]; G128_ZERO(accA); G128_ZERO(accB);
    g128_loop(accA, OSB + (size_t)(brow + r0) * SBW + c, OSB + (size_t)(brow + r0 + 64) * SBW + c, WbsT + (size_t)(bcol + r0) * SBW + c, WbsT + (size_t)(bcol + r0 + 64) * SBW + c, SBW, (LAS unsigned char*)shm);
    g128_loop(accB, OHG + (size_t)(brow + r0) * HGW + c, OHG + (size_t)(brow + r0 + 64) * HGW + c, WbhT + (size_t)(bcol + r0) * HGW + c, WbhT + (size_t)(bcol + r0 + 64) * HGW + c, HGW, (LAS unsigned char*)shm);
    G128_FOREACH({
        const size_t idx = (size_t)(brow + trow) * DM + bcol + tcol;
        MERGED[idx] = (bf16_t)f2bf(bf2f(GS[idx]) * accA[m_][n_][j_] + bf2f(GH[idx]) * accB[m_][n_][j_]);
    });
}

__global__ __launch_bounds__(256) void k_outproj(const bf16_t* __restrict__ MERGED, const bf16_t* __restrict__ WoT, const float* __restrict__ x, float* __restrict__ PRE) {
    __shared__ __attribute__((aligned(16))) unsigned char shm[2 * G_HTB];
    const int bcol = blockIdx.x * G_BM, brow = blockIdx.y * G_BM, tid = threadIdx.x, r0 = tid >> 2, c = (tid & 3) * 8;
    f32x4 acc[4][4]; G128_ZERO(acc);
    g128_loop(acc, MERGED + (size_t)(brow + r0) * DM + c, MERGED + (size_t)(brow + r0 + 64) * DM + c, WoT + (size_t)(bcol + r0) * DM + c, WoT + (size_t)(bcol + r0 + 64) * DM + c, DM, (LAS unsigned char*)shm);
    G128_FOREACH({ const size_t idx = (size_t)(brow + trow) * DM + bcol + tcol; PRE[idx] = DN_ALPHA * x[idx] + acc[m_][n_][j_]; });
}

__global__ __launch_bounds__(256) void k_moe_up(const bf16_t* __restrict__ HB, const bf16_t* __restrict__ WupT, const float* __restrict__ b_up, const int* __restrict__ ctl,
                                                const int* __restrict__ slot_tok, bf16_t* __restrict__ ACT) {
    __shared__ __attribute__((aligned(16))) unsigned char shm[2 * G_HTB];
    const int rt = blockIdx.y; if (rt >= 2 * ctl[CW_NTILES]) return;
    const int e = ctl[CW_TILEEXP + (rt >> 1)];
    const int bcol = blockIdx.x * G_BM, brow = rt * G_BM, tid = threadIdx.x, r0 = tid >> 2, c = (tid & 3) * 8;
    int t0 = slot_tok[brow + r0], t1 = slot_tok[brow + r0 + 64]; if (t0 < 0) t0 = 0; if (t1 < 0) t1 = 0;
    const bf16_t* W = WupT + (size_t)e * UPW * DM;
    f32x4 acc[4][4]; G128_ZERO(acc);
    g128_loop(acc, HB + (size_t)t0 * DM + c, HB + (size_t)t1 * DM + c, W + (size_t)(bcol + r0) * DM + c, W + (size_t)(bcol + r0 + 64) * DM + c, DM, (LAS unsigned char*)shm);
    G128_FOREACH({
        const int col = bcol + tcol; const float v = acc[m_][n_][j_] + b_up[e * UPW + col];
        const float other = __shfl_xor(v, 1);
        if ((col & 1) == 0) { const float g = fminf(v, SW_LIMIT), l = fminf(fmaxf(other, -SW_LIMIT), SW_LIMIT);
            ACT[(size_t)(brow + trow) * DFF + (col >> 1)] = (bf16_t)f2bf(g * sigmoidf_(SW_ALPHA * g) * (l + 1.0f)); }
    });
}
__global__ __launch_bounds__(256) void k_moe_down(const bf16_t* __restrict__ ACT, const bf16_t* __restrict__ WdnT, const float* __restrict__ b_dn, const int* __restrict__ ctl, bf16_t* __restrict__ Y) {
    __shared__ __attribute__((aligned(16))) unsigned char shm[2 * G_HTB];
    const int rt = blockIdx.y; if (rt >= 2 * ctl[CW_NTILES]) return;
    const int e = ctl[CW_TILEEXP + (rt >> 1)];
    const int bcol = blockIdx.x * G_BM, brow = rt * G_BM, tid = threadIdx.x, r0 = tid >> 2, c = (tid & 3) * 8;
    const bf16_t* W = WdnT + (size_t)e * DM * DFF;
    f32x4 acc[4][4]; G128_ZERO(acc);
    g128_loop(acc, ACT + (size_t)(brow + r0) * DFF + c, ACT + (size_t)(brow + r0 + 64) * DFF + c, W + (size_t)(bcol + r0) * DFF + c, W + (size_t)(bcol + r0 + 64) * DFF + c, DFF, (LAS unsigned char*)shm);
    G128_FOREACH({ const int col = bcol + tcol; Y[(size_t)(brow + trow) * DM + col] = (bf16_t)f2bf(acc[m_][n_][j_] + b_dn[e * DM + col]); });
}

__global__ __launch_bounds__(64) void k_attn_naive(const bf16_t* __restrict__ Q, const bf16_t* __restrict__ K, const bf16_t* __restrict__ V, bf16_t* __restrict__ O) {
    const int qb = 31 - (int)blockIdx.x, bh = blockIdx.y, b = bh >> 3, h = bh & 7;
    const int t = qb * 64 + threadIdx.x; const size_t rowbase = (size_t)b * SEQ;
    float q[64], o[64];
    { const bf16_t* qp = Q + (rowbase + t) * SBW + h * SBD;
#pragma unroll
      for (int d = 0; d < 64; ++d) { q[d] = bf2f(qp[d]); o[d] = 0.f; } }
    float R = 1.0f;
    for (int s = qb * 64 + 63; s >= 0; --s) {
        const bf16_t* kr = K + (rowbase + s) * SBW + h * SBD; const bf16_t* vr = V + (rowbase + s) * SBW + h * SBD;
        float z = 0.f;
#pragma unroll
        for (int d = 0; d < 64; ++d) z += q[d] * bf2f(kr[d]);
        const bool valid = s < t;
        const float ez = expf(fminf(z, 60.0f)), keep = 1.0f / (1.0f + ez);
        const float a = valid ? ez * keep * R : 0.f;
        R = valid ? R * keep : R;
#pragma unroll
        for (int d = 0; d < 64; ++d) o[d] += a * bf2f(vr[d]);
    }
    bf16_t* op = O + (rowbase + t) * SBW + h * SBD;
#pragma unroll
    for (int d = 0; d < 64; ++d) op[d] = (bf16_t)f2bf(o[d]);
}

__global__ __launch_bounds__(128) void k_hgrn_naive(const bf16_t* __restrict__ HQ, const bf16_t* __restrict__ HK, const float* __restrict__ LOGF, const bf16_t* __restrict__ HV, float* __restrict__ ORAW) {
    __shared__ __attribute__((aligned(16))) float sf[128], sk[128], sq[128];
    const int bh = blockIdx.x, b = bh >> 2, hh = bh & 3, v = threadIdx.x;
    float S[128];
#pragma unroll
    for (int k = 0; k < 128; ++k) S[k] = 0.f;
    for (int t = 0; t < SEQ; ++t) {
        const size_t base = ((size_t)b * SEQ + t) * HGW + hh * HGD;
        sf[v] = expf(LOGF[base + v]); sk[v] = bf2f(HK[base + v]); sq[v] = bf2f(HQ[base + v]);
        const float vv = bf2f(HV[base + v]);
        __syncthreads();
        float o = 0.f;
#pragma unroll
        for (int k = 0; k < 128; ++k) { S[k] = sf[k] * S[k] + sk[k] * vv; o += sq[k] * S[k]; }
        ORAW[base + v] = o;
        __syncthreads();
    }
}
__global__ __launch_bounds__(256) void k_hgrn_post(const float* __restrict__ ORAW, const bf16_t* __restrict__ HG, const float* __restrict__ norm_g, bf16_t* __restrict__ OHG) {
    const int gw = blockIdx.x * 4 + (threadIdx.x >> 6), lane = threadIdx.x & 63;
    const size_t base = (size_t)gw * HGD; const int c0 = (gw & 3) * HGD;
    const float x0 = ORAW[base + lane], x1 = ORAW[base + 64 + lane];
    const float r = 1.0f / sqrtf(wave_sum(x0 * x0 + x1 * x1) * (1.0f / HGD) + RMS_EPS);
    OHG[base + lane] = (bf16_t)f2bf(x0 * r * norm_g[c0 + lane] * bf2f(HG[base + lane]));
    OHG[base + 64 + lane] = (bf16_t)f2bf(x1 * r * norm_g[c0 + 64 + lane] * bf2f(HG[base + 64 + lane]));
}

__global__ __launch_bounds__(256) void k_ln1_router(const float* __restrict__ PRE, const float* __restrict__ g, const float* __restrict__ bta, const float* __restrict__ rw, const float* __restrict__ rb,
                                                    float* __restrict__ H, bf16_t* __restrict__ HB, int* __restrict__ TOPI, float* __restrict__ TOPG) {
    __shared__ __attribute__((aligned(16))) float hs[4][DM];
    const int w = threadIdx.x >> 6, lane = threadIdx.x & 63, row = blockIdx.x * 4 + w;
    f32x4 v[4]; float s = 0.f;
#pragma unroll
    for (int j = 0; j < 4; ++j) { v[j] = *(const f32x4*)(PRE + (size_t)row * DM + lane * 4 + 256 * j); s += (v[j][0] + v[j][1]) + (v[j][2] + v[j][3]); }
    const float mean = wave_sum(s) * (1.0f / DM); float s2 = 0.f;
#pragma unroll
    for (int j = 0; j < 4; ++j) { v[j] = v[j] - mean; s2 += (v[j][0] * v[j][0] + v[j][1] * v[j][1]) + (v[j][2] * v[j][2] + v[j][3] * v[j][3]); }
    const float rstd = 1.0f / sqrtf(wave_sum(s2) * (1.0f / DM) + LN_EPS);
#pragma unroll
    for (int j = 0; j < 4; ++j) { const int c = lane * 4 + 256 * j; const f32x4 gg = *(const f32x4*)(g + c), bb = *(const f32x4*)(bta + c);
        f32x4 hv = v[j] * rstd * gg + bb; *(f32x4*)(H + (size_t)row * DM + c) = hv; *(f32x4*)(&hs[w][c]) = hv;
        uint2 o; o.x = f2bf(hv[0]) | (f2bf(hv[1]) << 16); o.y = f2bf(hv[2]) | (f2bf(hv[3]) << 16); *(uint2*)(HB + (size_t)row * DM + c) = o; }
    __syncthreads();
    const int e = lane & 31, half = lane >> 5; float a = 0.f;
    for (int c = half * 512; c < half * 512 + 512; ++c) a += hs[w][c] * rw[c * NEXP + e];
    a += __shfl_xor(a, 32);
    float val = (lane < 32) ? a + rb[e] : -INFINITY; int idx = e;
    float tv[4]; int ti[4];
#pragma unroll
    for (int r = 0; r < 4; ++r) {
        float bv = val; int bi = idx;
#pragma unroll
        for (int off = 32; off >= 1; off >>= 1) { const float ov = __shfl_xor(bv, off); const int oi = __shfl_xor(bi, off); if (ov > bv || (ov == bv && oi < bi)) { bv = ov; bi = oi; } }
        tv[r] = bv; ti[r] = bi; if (lane < 32 && e == bi) val = -INFINITY;
    }
    if (lane == 0) { const float e1 = expf(tv[1] - tv[0]), e2 = expf(tv[2] - tv[0]), e3 = expf(tv[3] - tv[0]), inv = 1.0f / (1.0f + e1 + e2 + e3);
        *(int4*)(TOPI + row * 4) = make_int4(ti[0], ti[1], ti[2], ti[3]); *(float4*)(TOPG + row * 4) = make_float4(inv, e1 * inv, e2 * inv, e3 * inv); }
}

__global__ __launch_bounds__(256) void k_count(const int* __restrict__ TOPI, int* __restrict__ ctl, int* __restrict__ slot_tok) {
    __shared__ int hist[NEXP];
    if (threadIdx.x < NEXP) hist[threadIdx.x] = 0;
    __syncthreads();
    const int i = blockIdx.x * 256 + threadIdx.x;
    atomicAdd(&hist[TOPI[i]], 1);
    __syncthreads();
    if (threadIdx.x < NEXP) atomicAdd(&ctl[CW_CNT + threadIdx.x], hist[threadIdx.x]);
    for (int s = i; s < NSLOT_MAX; s += NASSIGN) slot_tok[s] = -1;
}
__global__ __launch_bounds__(64) void k_plan(int* __restrict__ ctl) {
    if (threadIdx.x == 0) { int ps = 0, nt = 0;
        for (int e = 0; e < NEXP; ++e) { ctl[CW_PADSTART + e] = ps; const int te = (ctl[CW_CNT + e] + SLOT_PAD - 1) / SLOT_PAD; for (int i = 0; i < te; ++i) ctl[CW_TILEEXP + nt++] = e; ps += te * SLOT_PAD; }
        ctl[CW_PADSTART + NEXP] = ps; ctl[CW_NTILES] = nt; }
}
__global__ __launch_bounds__(256) void k_assign(const int* __restrict__ TOPI, int* __restrict__ ctl, int* __restrict__ slot_tok, int* __restrict__ DEST) {
    const int i = blockIdx.x * 256 + threadIdx.x, e = TOPI[i];
    const int slot = ctl[CW_PADSTART + e] + atomicAdd(&ctl[CW_CUR + e], 1);
    slot_tok[slot] = i >> 2; DEST[i] = slot;
}
__global__ __launch_bounds__(256) void k_combine_ln2(const float* __restrict__ H, const bf16_t* __restrict__ Y, const int* __restrict__ DEST, const float* __restrict__ TOPG,
                                                     const float* __restrict__ g, const float* __restrict__ bta, float* __restrict__ out) {
    const int lane = threadIdx.x & 63, row = blockIdx.x * 4 + (threadIdx.x >> 6);
    const int4 d = *(const int4*)(DEST + row * 4); const float4 gt = *(const float4*)(TOPG + row * 4);
    const int ds[4] = {d.x, d.y, d.z, d.w}; const float gs[4] = {gt.x, gt.y, gt.z, gt.w};
    f32x4 v[4]; float s = 0.f;
#pragma unroll
    for (int j = 0; j < 4; ++j) { const int c = lane * 4 + 256 * j; f32x4 a = *(const f32x4*)(H + (size_t)row * DM + c) * DN_ALPHA;
#pragma unroll
        for (int k = 0; k < 4; ++k) { const uint2 y = *(const uint2*)(Y + (size_t)ds[k] * DM + c);
            a[0] += gs[k] * bf2f(y.x & 0xffff); a[1] += gs[k] * bf2f(y.x >> 16); a[2] += gs[k] * bf2f(y.y & 0xffff); a[3] += gs[k] * bf2f(y.y >> 16); }
        v[j] = a; s += (a[0] + a[1]) + (a[2] + a[3]); }
    const float mean = wave_sum(s) * (1.0f / DM); float s2 = 0.f;
#pragma unroll
    for (int j = 0; j < 4; ++j) { v[j] = v[j] - mean; s2 += (v[j][0] * v[j][0] + v[j][1] * v[j][1]) + (v[j][2] * v[j][2] + v[j][3] * v[j][3]); }
    const float rstd = 1.0f / sqrtf(wave_sum(s2) * (1.0f / DM) + LN_EPS);
#pragma unroll
    for (int j = 0; j < 4; ++j) { const int c = lane * 4 + 256 * j; *(f32x4*)(out + (size_t)row * DM + c) = v[j] * rstd * *(const f32x4*)(g + c) + *(const f32x4*)(bta + c); }
}

}
#endif
extern "C" void kernel_launch(void* const* d_in, const int* in_sizes, int n_in, void* d_out, int out_size, void* d_ws, size_t ws_size, hipStream_t stream) {
    static int grid = 0;
    if (grid == 0) {
        if (n_in != 17 || ws_size < WS_END) { fprintf(stderr, "kernel_launch: unexpected n_in %d or ws_size %zu (< %zu)\n", n_in, ws_size, (size_t)WS_END); grid = -1; return; }
        int dev = 0, cus = 0;
        if (hipGetDevice(&dev) != hipSuccess || hipDeviceGetAttribute(&cus, hipDeviceAttributeMultiprocessorCount, dev) != hipSuccess) { grid = -1; return; }
#define MK_ATTR(LO_, HI_) if (hipFuncSetAttribute((const void*)mk_fwd<LO_, HI_>, hipFuncAttributeMaxDynamicSharedMemorySize, LDS_BYTES) != hipSuccess) { fprintf(stderr, "kernel_launch: hipFuncSetAttribute failed\n"); grid = -1; return; }
#if MK_MODE == 0
        MK_ATTR(0, 11)
#elif MK_MODE == 2
        MK_ATTR(0, 1) MK_ATTR(1, 2) MK_ATTR(2, 3) MK_ATTR(3, 4) MK_ATTR(4, 5) MK_ATTR(5, 6)
#else
        MK_ATTR(0, 1) MK_ATTR(1, 2) MK_ATTR(2, 3) MK_ATTR(3, 4) MK_ATTR(4, 5) MK_ATTR(5, 6) MK_ATTR(6, 8) MK_ATTR(8, 9) MK_ATTR(9, 10) MK_ATTR(10, 11)
#endif
        grid = cus;
        if (grid != 256) fprintf(stderr, "kernel_launch: %d CUs (built for 256)\n", grid);
    }
    if (grid < 0) return;
    (void)hipMemsetAsync((char*)d_ws + WS_CTL, 0, CTL_ZERO_BYTES, stream);
    Args a{};
    for (int i = 0; i < 17; ++i) a.in[i] = (const float*)d_in[i];
    a.out = (float*)d_out; a.ws = (unsigned char*)d_ws;
#define MK_LAUNCH(LO_, HI_, LI_) do { a.ph_lo = LO_; a.ph_hi = HI_; a.li = LI_; hipLaunchKernelGGL((mk_fwd<LO_, HI_>), dim3(grid), dim3(NTHREADS), LDS_BYTES, stream, a); } while (0)
#if MK_MODE == 0
    MK_LAUNCH(0, 11, 0);
#elif MK_MODE == 2
    { unsigned char* ws = (unsigned char*)d_ws;
      InProjOut ip{}; ip.Q = (bf16_t*)(ws + WS_Q); ip.K = (bf16_t*)(ws + WS_K); ip.V = (bf16_t*)(ws + WS_V); ip.HQ = (bf16_t*)(ws + WS_HQ); ip.HK = (bf16_t*)(ws + WS_HK); ip.HV = (bf16_t*)(ws + WS_HV);
      ip.HG = (bf16_t*)(ws + WS_HG); ip.GS = (bf16_t*)(ws + WS_GS); ip.GH = (bf16_t*)(ws + WS_GH); ip.LOGF = (float*)(ws + WS_LOGF); ip.lb = (const float*)(ws + WS_LB);
#if MK_HEAD_V1 >= 1
      v1::k_convert_x<<<NTOK * DM / 4 / 256, 256, 0, stream>>>(a.in[0], (bf16_t*)(ws + WS_XB), a.in[2], (float*)(ws + WS_LB));
      v1::k_transpose_bf16<<<dim3(INW / 64, DM / 64, 1), 256, 0, stream>>>(a.in[1], (bf16_t*)(ws + WS_WINT), DM, INW);
      v1::k_transpose_bf16<<<dim3(DM / 64, SBW / 64, 1), 256, 0, stream>>>(a.in[4], (bf16_t*)(ws + WS_WBST), SBW, DM);
      v1::k_transpose_bf16<<<dim3(DM / 64, HGW / 64, 1), 256, 0, stream>>>(a.in[5], (bf16_t*)(ws + WS_WBHT), HGW, DM);
      v1::k_transpose_bf16<<<dim3(DM / 64, DM / 64, 1), 256, 0, stream>>>(a.in[6], (bf16_t*)(ws + WS_WOT), DM, DM);
      v1::k_transpose_bf16<<<dim3(UPW / 64, DM / 64, NEXP), 256, 0, stream>>>(a.in[11], (bf16_t*)(ws + WS_WUPT), DM, UPW);
      v1::k_transpose_bf16<<<dim3(DM / 64, DFF / 64, NEXP), 256, 0, stream>>>(a.in[13], (bf16_t*)(ws + WS_WDNT), DFF, DM);
#else
      MK_LAUNCH(0, 1, 0);
#endif
#if MK_HEAD_V1 >= 2
      v1::k_inproj<<<dim3(INW / v1::G_BM, NTOK / v1::G_BM), 256, 0, stream>>>((const bf16_t*)(ws + WS_XB), (const bf16_t*)(ws + WS_WINT), ip);
#else
      MK_LAUNCH(1, 2, 1);
#endif
      MK_LAUNCH(2, 3, 2); MK_LAUNCH(3, 4, 3); MK_LAUNCH(4, 5, 4); MK_LAUNCH(5, 6, 5); }
    { unsigned char* ws = (unsigned char*)d_ws; int* ctl = (int*)(ws + WS_CTL); bf16_t* HB = (bf16_t*)(ws + WS_XS); int* TOPI = (int*)(ws + WS_XS + 32 * MiB); int* SLOTTOK = (int*)(ws + WS_XS + 33 * MiB);
      float* TOPG = (float*)(ws + WS_TOPG); int* DEST = (int*)(ws + WS_DEST); float* H = (float*)(ws + WS_H); bf16_t* ACT = (bf16_t*)(ws + WS_ACT); bf16_t* Y = (bf16_t*)(ws + WS_Y);
      v1::k_ln1_router<<<NTOK / 4, 256, 0, stream>>>((const float*)(ws + WS_PRE), a.in[7], a.in[8], a.in[9], a.in[10], H, HB, TOPI, TOPG);
      v1::k_count<<<NASSIGN / 256, 256, 0, stream>>>(TOPI, ctl, SLOTTOK);
      v1::k_plan<<<1, 64, 0, stream>>>(ctl);
      v1::k_assign<<<NASSIGN / 256, 256, 0, stream>>>(TOPI, ctl, SLOTTOK, DEST);
      v1::k_moe_up<<<dim3(UPW / v1::G_BM, NSLOT_MAX / v1::G_BM), 256, 0, stream>>>(HB, (const bf16_t*)(ws + WS_WUPT), a.in[12], ctl, SLOTTOK, ACT);
      v1::k_moe_down<<<dim3(DM / v1::G_BM, NSLOT_MAX / v1::G_BM), 256, 0, stream>>>(ACT, (const bf16_t*)(ws + WS_WDNT), a.in[14], ctl, Y);
      v1::k_combine_ln2<<<NTOK / 4, 256, 0, stream>>>(H, Y, DEST, TOPG, a.in[15], a.in[16], (float*)d_out); }
#else
    MK_LAUNCH(0, 1, 0); MK_LAUNCH(1, 2, 1); MK_LAUNCH(2, 3, 2); MK_LAUNCH(3, 4, 3); MK_LAUNCH(4, 5, 4); MK_LAUNCH(5, 6, 5); MK_LAUNCH(6, 8, 6); MK_LAUNCH(8, 9, 7); MK_LAUNCH(9, 10, 8); MK_LAUNCH(10, 11, 9);
#endif
}
```

```cpp
#include <hip/hip_runtime.h>
#include <stdint.h>
#include <cstdio>

#define LAS __attribute__((address_space(3)))
#define GAS __attribute__((address_space(1)))
typedef unsigned short bf16_t;
typedef short bf16x8 __attribute__((ext_vector_type(8)));
typedef float f32x4 __attribute__((ext_vector_type(4)));
typedef float f32x16 __attribute__((ext_vector_type(16)));
typedef unsigned u32x4 __attribute__((ext_vector_type(4)));
typedef unsigned u32x2 __attribute__((ext_vector_type(2)));
typedef float f32x2_t __attribute__((ext_vector_type(2)));

constexpr int NTOK = 16384, DM = 1024, INW = 5632, SBW = 512, HGW = 512, NEXP = 32, TOPK = 4, DFF = 1024, UPW = 2048;
constexpr int SEQ = 2048, SBH = 8, SBD = 64, HGH = 4, HGD = 128;
constexpr int NASSIGN = NTOK * TOPK;
constexpr int SLOT_PAD = 256;
constexpr int NSLOT_MAX = NASSIGN + NEXP * SLOT_PAD;
constexpr int NTILE_MAX = NSLOT_MAX / SLOT_PAD;
constexpr float LN_EPS = 1e-5f, RMS_EPS = 1e-6f, DN_ALPHA = 1.189207115002721f, SW_ALPHA = 1.702f, SW_LIMIT = 7.0f, LOG2E = 1.4426950408889634f, LN2 = 0.6931471805599453f;
constexpr int NWAVES = 8, NTHREADS = 512;
constexpr float W8_SCALE = 32.0f; constexpr int W8_E8M0 = 0x7a7a7a7a;
#ifndef MK_Y8
#define MK_Y8 1
#endif
constexpr float Y8_SCALE = 16.0f;
constexpr float ACT8_SCALE = 4.0f; constexpr int ACT8_E8M0 = 0x7d7d7d7d;
#ifndef MK_DUP_P1
#define MK_DUP_P1 1
#endif
#ifndef MK_DUP_HGA
#define MK_DUP_HGA 1
#endif
#ifndef MK_DUP_HGB
#define MK_DUP_HGB 1
#endif
#ifndef MK_DUP_P45
#define MK_DUP_P45 1
#endif
#ifndef MK_BG_WAVES
#define MK_BG_WAVES 3
#endif
#ifndef MK_BG_SEAMS
#define MK_BG_SEAMS 0xFE
#endif
#ifndef MK_PROBE_CONV
#define MK_PROBE_CONV 0
#endif
#ifndef MK_PROBE_BAR
#define MK_PROBE_BAR 0
#endif
#ifndef MK_LOOP_P2
#define MK_LOOP_P2 1
#endif
#ifndef MK_DUP_TAIL
#define MK_DUP_TAIL 0
#endif
#ifndef MK_FP8_GATES
#define MK_FP8_GATES 1
#endif
#ifndef MK_FP8_DN
#define MK_FP8_DN 1
#endif
#ifndef MK_FP8_UP
#define MK_FP8_UP 1
#endif
#ifndef MK_BG
#define MK_BG 1
#endif
#ifndef MK_DUP_P2
#define MK_DUP_P2 1
#define MK_DUP_WHAT 0
#endif
#ifndef MK_PROBE
#define MK_PROBE 0
#endif
#define MK_PROBE_UNUSED 0
#ifndef MK_P0_ROWS
#define MK_P0_ROWS 2
#endif
#ifndef MK_PB_GROWS
#define MK_PB_GROWS 16
#endif
#ifndef MK_P10_ROWS
#define MK_P10_ROWS 3
#endif
#ifndef MK_WGM_P1A
#define MK_WGM_P1A 4
#define MK_WGM_P1B 4
#define MK_WGM_P4 8
#define MK_WGM_P5 8
#endif
#ifndef MK_WGM_DN
#define MK_WGM_DN 4
#endif
#ifndef MK_WGM_UP
#define MK_WGM_UP 4
#endif
#ifndef MK_GATHER_A
#define MK_GATHER_A 1
#endif
#ifndef MK_BR_BATCH
#define MK_BR_BATCH 3
#endif
#ifndef MK_PA0
#define MK_PA0 0
#define MK_PA1 1
#define MK_PB0 1
#define MK_PB1 2
#endif
#ifndef MK_NAIVE_MIX
#define MK_NAIVE_MIX 0
#endif
#ifndef MK_MODE
#ifndef MK_P1_ALIGN
#define MK_P1_ALIGN true
#endif
#ifndef MK_P1_SP2
#define MK_P1_SP2 true
#endif
#ifndef MK_HEAD_V1
#define MK_HEAD_V1 0
#endif
#define MK_MODE 0
#endif

constexpr size_t MiB = 1u << 20;
constexpr size_t WS_SLOTTOK = 262144;
constexpr size_t WS_CTL = 0, CTL_ZERO_BYTES = 262144 + 73728 * 4;
constexpr size_t WS_LB = 1 * MiB;
constexpr size_t WS_CNTM = WS_LB + 4096;
constexpr size_t WS_TOPG = WS_CNTM + 32768;
constexpr size_t WS_DEST = WS_TOPG + 262144;
constexpr size_t WS_RWT = WS_DEST + 262144;
constexpr size_t WS_XB = 3 * MiB;
constexpr size_t WS_WINT = WS_XB + 32 * MiB;
constexpr size_t WS_WBST = WS_WINT + 12 * MiB;
constexpr size_t WS_WBHT = WS_WBST + 1 * MiB;
constexpr size_t WS_WOT = WS_WBHT + 1 * MiB;
constexpr size_t WS_WUPT = WS_WOT + 2 * MiB;
constexpr size_t WS_WDNT = WS_WUPT + 128 * MiB;
constexpr size_t WS_Q = WS_WDNT + 64 * MiB;
constexpr size_t WS_K = WS_Q + 16 * MiB;
constexpr size_t WS_V = WS_K + 16 * MiB;
constexpr size_t WS_HQ = WS_V + 16 * MiB;
constexpr size_t WS_HK = WS_HQ + 16 * MiB;
constexpr size_t WS_HV = WS_HK + 16 * MiB;
constexpr size_t WS_HG = WS_HV + 16 * MiB;
constexpr size_t WS_LOGF = WS_HG + 16 * MiB;
constexpr size_t WS_GS = WS_LOGF + 32 * MiB;
constexpr size_t WS_GH = WS_GS + 32 * MiB;
constexpr size_t WS_OSB = WS_GH + 32 * MiB;
constexpr size_t WS_OHG = WS_OSB + 16 * MiB;
constexpr size_t WS_ORAW = WS_OHG + 16 * MiB;
constexpr size_t WS_MERGED = WS_ORAW + 32 * MiB;
constexpr size_t WS_H = WS_MERGED + 32 * MiB;
constexpr size_t WS_XS = WS_H + 64 * MiB;
constexpr size_t WS_ACT = WS_XS + 144 * MiB;
constexpr size_t WS_QC = WS_ACT + 144 * MiB;
constexpr size_t WS_DS = WS_QC + 16 * MiB;
constexpr size_t WS_DG = WS_DS + 16 * MiB;
constexpr size_t WS_XB8 = WS_DG + 1 * MiB;
constexpr size_t WS_WINT8 = WS_XB8 + 16 * MiB;
constexpr size_t WS_END = WS_WINT8 + 3 * MiB;
constexpr size_t WS_PRE = WS_Q;
constexpr size_t WS_Y = WS_HK;
static_assert(WS_Y + 144 * MiB <= WS_OSB && WS_PRE + 64 * MiB <= WS_HK, "overlays");
static_assert(WS_END <= 1020 * MiB, "ws budget");
constexpr int CW_NTILES = 16;
constexpr int CW_ATTNQ = 32;
constexpr int CW_BGQ = 48;
constexpr int CW_TILEEXP = 64;
constexpr int CW_BAR = 1024;
constexpr int LDS_SCRATCH = 147456;
constexpr int LDSCTL_OFF = LDS_SCRATCH, LDS_BYTES = LDS_SCRATCH + 512;
constexpr int LDS_IDX = 131072 + 1280;
constexpr int LDS_TILEEXP = 131072;
constexpr int MISC_OFF = LDSCTL_OFF;

__device__ __forceinline__ unsigned f2bf(float f) { unsigned u = __builtin_bit_cast(unsigned, f); return (u + 0x7fffu + ((u >> 16) & 1u)) >> 16; }
__device__ __forceinline__ unsigned pk2(float lo, float hi) { return f2bf(lo) | (f2bf(hi) << 16); }
__device__ __forceinline__ float bf2f(unsigned short b) { return __builtin_bit_cast(float, (unsigned)b << 16); }
__device__ __forceinline__ float bflo(unsigned w) { return __builtin_bit_cast(float, w << 16); }
__device__ __forceinline__ float bfhi(unsigned w) { return __builtin_bit_cast(float, w & 0xffff0000u); }
__device__ __forceinline__ float fsigmoid(float v) { return __builtin_amdgcn_rcpf(1.0f + __builtin_amdgcn_exp2f(-v * LOG2E)); }
__device__ __forceinline__ f32x4 fsigmoid4(f32x4 v) { const f32x4 x = v * (f32x4){-LOG2E, -LOG2E, -LOG2E, -LOG2E};
    const f32x4 d = (f32x4){__builtin_amdgcn_exp2f(x[0]), __builtin_amdgcn_exp2f(x[1]), __builtin_amdgcn_exp2f(x[2]), __builtin_amdgcn_exp2f(x[3])} + (f32x4){1.0f, 1.0f, 1.0f, 1.0f};
    return (f32x4){__builtin_amdgcn_rcpf(d[0]), __builtin_amdgcn_rcpf(d[1]), __builtin_amdgcn_rcpf(d[2]), __builtin_amdgcn_rcpf(d[3])}; }
template <int CTRL> __device__ __forceinline__ float dpp_f(float v) { return __builtin_bit_cast(float, __builtin_amdgcn_update_dpp(0, __builtin_bit_cast(int, v), CTRL, 0xF, 0xF, false)); }
__device__ __forceinline__ float row16_sum(float v) { v += dpp_f<0xB1>(v); v += dpp_f<0x4E>(v); v += dpp_f<0x141>(v); v += dpp_f<0x140>(v); return v; }
__device__ __forceinline__ float wave_sum(float v) {
    v = row16_sum(v);
    const float r0 = __builtin_bit_cast(float, __builtin_amdgcn_readlane(__builtin_bit_cast(int, v), 0)), r1 = __builtin_bit_cast(float, __builtin_amdgcn_readlane(__builtin_bit_cast(int, v), 16));
    const float r2 = __builtin_bit_cast(float, __builtin_amdgcn_readlane(__builtin_bit_cast(int, v), 32)), r3 = __builtin_bit_cast(float, __builtin_amdgcn_readlane(__builtin_bit_cast(int, v), 48));
    return (r0 + r1) + (r2 + r3);
}
__device__ __forceinline__ unsigned pk4_fp8(float a, float b, float c, float d) { int w = 0; w = __builtin_amdgcn_cvt_pk_fp8_f32(a, b, w, false); w = __builtin_amdgcn_cvt_pk_fp8_f32(c, d, w, true); return (unsigned)w; }
#define LDS_WAIT() asm volatile("s_waitcnt lgkmcnt(0)" ::: "memory")
#define VM_WAIT() asm volatile("s_waitcnt vmcnt(0)" ::: "memory")

struct InProjOut { bf16_t *Q, *K, *V, *HQ, *HK, *HV, *HG, *GS, *GH; float* LOGF; const float* lb; };

namespace pg8 {
#define PG8_LAS __attribute__((address_space(3)))
constexpr int BM = 256, BK = 64, HALF = 128, HTB = HALF * BK * 2  , STAGE_BYTES = 8 * HTB, NXCD = 8, WGM = 8;
__host__ __device__ __forceinline__ int lds_byte(int r, int c) { const int st = (r >> 4) * 2 + (c >> 5), rr = r & 15, cc = c & 31, ob = rr * 64 + cc * 2; return st * 1024 + (ob ^ (((ob >> 9) & 1) << 5)); }
__host__ __device__ __forceinline__ void stage_rc(int b, int& R, int& C) { const int st = b / 1024, sb = b % 1024, swz = sb ^ (((sb >> 9) & 1) << 5); R = (st >> 1) * 16 + swz / 64; C = (st & 1) * 32 + (swz % 64) / 2; }
__host__ __device__ __forceinline__ int perm32(int rho) { const int n = rho >> 4, i = rho & 15; return 8 * (i >> 2) + 4 * n + (i & 3); }

struct Unit { int pm, pn, aux; const char* a; const char* b; };
struct Gemm { int K; int scale_a = 0x7f7f7f7f, scale_b = 0x7f7f7f7f; };
struct TileOrder {
    int nM, nN, nwg, G, c, wgm;
    __device__ void init(int nM_, int nN_, int G_, int c_, int wgm_ = WGM) { nM = nM_; nN = nN_; nwg = nM * nN; G = G_; c = c_; wgm = wgm_; }
    __device__ bool tile(int i, int& pm, int& pn) const {
        const long L = (long)i * G + c; if (L >= nwg) return false;
        int wgid = (int)L; { const int q = nwg / NXCD, r = nwg % NXCD, xcd = wgid % NXCD, off = wgid / NXCD; wgid = (xcd < r ? xcd * (q + 1) : r * (q + 1) + (xcd - r) * q) + off; }
        const int nig = wgm * nN, gid = wgid / nig, fm = gid * wgm, gsz = (nM - fm) < wgm ? (nM - fm) : wgm;
        pm = fm + ((wgid % nig) % gsz); pn = (wgid % nig) / gsz; return true;
    }
};
struct DenseSched { static constexpr bool GATHER_A = false; TileOrder o; const char* A; const char* Bt; size_t tstep;
    __device__ __forceinline__ bool next(int i, Unit& u) const { if (!o.tile(i, u.pm, u.pn)) return false; u.aux = 0; u.a = A + (size_t)u.pm * tstep; u.b = Bt + (size_t)u.pn * tstep; return true; }
    __device__ __forceinline__ void a_ready(const Unit&) const {}
    __device__ __forceinline__ void done(const Unit&) const {} };
struct BranchSched { static constexpr bool GATHER_A = false; TileOrder o; const char *A0, *B0, *A1, *B1; size_t tstep;
    __device__ __forceinline__ bool next(int i, Unit& u) const { if (!o.tile(i >> 1, u.pm, u.pn)) return false; u.aux = i & 1; u.a = ((i & 1) ? A1 : A0) + (size_t)u.pm * tstep; u.b = ((i & 1) ? B1 : B0) + (size_t)u.pn * tstep; return true; }
    __device__ __forceinline__ void a_ready(const Unit&) const {}
    __device__ __forceinline__ void done(const Unit&) const {} };
struct MoeSched { static constexpr bool GATHER_A = false; TileOrder o; const char* A; const char* W; const LAS int* tile_exp; size_t tstep, estep;
    __device__ __forceinline__ bool next(int i, Unit& u) const { if (!o.tile(i, u.pm, u.pn)) return false; const int e = __builtin_amdgcn_readfirstlane(tile_exp[u.pm]); u.aux = e; u.a = A + (size_t)u.pm * tstep; u.b = W + (size_t)e * estep + (size_t)u.pn * tstep; return true; }
    __device__ __forceinline__ void a_ready(const Unit&) const {}
    __device__ __forceinline__ void done(const Unit&) const {} };

struct MoeGatherSched : MoeSched { static constexpr bool GATHER_A = true; const int* slot_tok;
    __device__ __forceinline__ bool next(int i, Unit& u) const { if (!MoeSched::next(i, u)) return false; u.a = A; return true; }
    __device__ __forceinline__ const int* idx(const Unit& u) const { return slot_tok + u.pm * BM; } };
typedef __bf16 bf16x2_t __attribute__((ext_vector_type(2)));
__device__ __forceinline__ unsigned cvt_pk_bf16(float lo, float hi) { f32x2_t v = {lo, hi}; bf16x2_t b = __builtin_convertvector(v, bf16x2_t); return __builtin_bit_cast(unsigned, b); }
template <int MODE> __device__ __forceinline__ void inproj_store(const f32x4 (&acc)[2][2][4][2], bf16_t* dst, int ld, int row0, int col0, float scale, const float* lb, float* logf_out) {
    f32x4 lbq[2][2];
    if (MODE == 2) {
#pragma unroll
        for (int bj = 0; bj < 2; ++bj) { lbq[bj][0] = *(const f32x4*)(lb + col0 + bj * HALF); lbq[bj][1] = *(const f32x4*)(lb + col0 + bj * HALF + 4); } }
#pragma unroll
    for (int ai = 0; ai < 2; ++ai)
#pragma unroll
        for (int m = 0; m < 4; ++m)
#pragma unroll
            for (int bj = 0; bj < 2; ++bj) {
                const size_t off = (size_t)(row0 + ai * HALF + m * 16) * ld + col0 + bj * HALF;
                f32x4 v[2] = {acc[ai][bj][m][0], acc[ai][bj][m][1]};
                if (MODE == 0) { v[0] = v[0] * scale; v[1] = v[1] * scale; }
                if (MODE == 1) { v[0] = v[0] * fsigmoid4(v[0]); v[1] = v[1] * fsigmoid4(v[1]); }
                if (MODE == 3) { v[0] = fsigmoid4(v[0]); v[1] = fsigmoid4(v[1]); }
                if (MODE == 2) {
                    f32x4 lg[2]; const f32x4 lbv[2] = {lbq[bj][0], lbq[bj][1]};
#pragma unroll
                    for (int n = 0; n < 2; ++n) { const f32x4 one = {1.0f, 1.0f, 1.0f, 1.0f}, l = lbv[n], f = l + (one - l) * fsigmoid4(v[n]); v[n] = one - f;
                        lg[n] = (f32x4){__builtin_amdgcn_logf(f[0]), __builtin_amdgcn_logf(f[1]), __builtin_amdgcn_logf(f[2]), __builtin_amdgcn_logf(f[3])} * (f32x4){LN2, LN2, LN2, LN2}; }
                    *(f32x4*)(logf_out + off) = lg[0]; *(f32x4*)(logf_out + off + 4) = lg[1];
                }
                u32x4 w; w.x = cvt_pk_bf16(v[0][0], v[0][1]); w.y = cvt_pk_bf16(v[0][2], v[0][3]); w.z = cvt_pk_bf16(v[1][0], v[1][1]); w.w = cvt_pk_bf16(v[1][2], v[1][3]);
                *(u32x4*)(dst + off) = w;
            }
}
template <int PN0> struct EpiInProjT { static constexpr bool PERM = true, AFTER_DRAIN = false, ACC_CHAIN = false; static constexpr int INIT = 0; InProjOut o;
    __device__ __forceinline__ void operator()(f32x4 (&acc)[2][2][4][2], const Unit& u, int wr, int wc, int fr, int fq) const {
        const int row0 = u.pm * BM + wr * 64 + fr, pn = u.pn + PN0;
        int seg, cb, ld;
        if (pn < 14) { seg = pn >> 1; cb = (pn & 1) * 256; ld = 512; } else if (pn < 18) { seg = 7; cb = (pn - 14) * 256; ld = 1024; } else { seg = 8; cb = (pn - 18) * 256; ld = 1024; }
        const int col0 = cb + wc * 32 + 8 * fq;
        if constexpr (PN0 != 0) { const size_t off = seg == 6 ? (size_t)(WS_HG - WS_HG) : (seg == 7 ? (size_t)(WS_GS - WS_HG) : (size_t)(WS_GH - WS_HG));
            inproj_store<3>(acc, (bf16_t*)((unsigned char*)o.HG + off), ld, row0, col0, 1.0f, nullptr, nullptr); return; }
        switch (seg) {
            case 0: inproj_store<0>(acc, o.Q, ld, row0, col0, 0.125f * LOG2E, nullptr, nullptr); break;
            case 1: inproj_store<0>(acc, o.K, ld, row0, col0, 1.0f, nullptr, nullptr); break;
            case 2: inproj_store<0>(acc, o.V, ld, row0, col0, 1.0f, nullptr, nullptr); break;
            case 3: inproj_store<1>(acc, o.HQ, ld, row0, col0, 1.0f, nullptr, nullptr); break;
            case 4: inproj_store<2>(acc, o.HK, ld, row0, col0, 1.0f, o.lb, o.LOGF); break;
            case 5: inproj_store<0>(acc, o.HV, ld, row0, col0, 1.0f, nullptr, nullptr); break;
            case 6: inproj_store<3>(acc, o.HG, ld, row0, col0, 1.0f, nullptr, nullptr); break;
            case 7: inproj_store<3>(acc, o.GS, ld, row0, col0, 1.0f, nullptr, nullptr); break;
            default: inproj_store<3>(acc, o.GH, ld, row0, col0, 1.0f, nullptr, nullptr); break;
        }
    }
};
struct EpiBranch { static constexpr bool PERM = true, AFTER_DRAIN = false, ACC_CHAIN = true; static constexpr int INIT = 0; const bf16_t* GS; const bf16_t* GH; bf16_t* MERGED;
    __device__ __forceinline__ void operator()(f32x4 (&acc)[2][2][4][2], const Unit& u, int wr, int wc, int fr, int fq) const {
        const int row0 = u.pm * BM + wr * 64 + fr, col0 = u.pn * BM + wc * 32 + 8 * fq;
        u32x4 ghq[MK_BR_BATCH + 1];
#pragma unroll
        for (int it = 0; it < MK_BR_BATCH; ++it) ghq[it] = *(const u32x4*)(GH + (size_t)(row0 + (it >> 3) * HALF + ((it >> 1) & 3) * 16) * DM + col0 + (it & 1) * HALF);
#pragma unroll
        for (int it = 0; it < 16; ++it) { const int ai = it >> 3, m = (it >> 1) & 3, bj = it & 1;
                    const size_t off = (size_t)(row0 + ai * HALF + m * 16) * DM + col0 + bj * HALF;
                    if (it + MK_BR_BATCH < 16) { const int i2 = it + MK_BR_BATCH; ghq[i2 % (MK_BR_BATCH + 1)] = *(const u32x4*)(GH + (size_t)(row0 + (i2 >> 3) * HALF + ((i2 >> 1) & 3) * 16) * DM + col0 + (i2 & 1) * HALF); }
                    const u32x4 gh = ghq[it % (MK_BR_BATCH + 1)];
                    const float h[8] = {bflo(gh.x), bfhi(gh.x), bflo(gh.y), bfhi(gh.y), bflo(gh.z), bfhi(gh.z), bflo(gh.w), bfhi(gh.w)};
                    if (u.aux == 0) {
                        const u32x4 gs = *(const u32x4*)(GS + off);
                        const float s[8] = {bflo(gs.x), bfhi(gs.x), bflo(gs.y), bfhi(gs.y), bflo(gs.z), bfhi(gs.z), bflo(gs.w), bfhi(gs.w)};
#pragma unroll
                        for (int n = 0; n < 2; ++n)
#pragma unroll
                            for (int j = 0; j < 4; ++j) acc[ai][bj][m][n][j] *= s[4 * n + j] * __builtin_amdgcn_rcpf(h[4 * n + j]);
                    } else {
                        float r[8];
#pragma unroll
                        for (int n = 0; n < 2; ++n)
#pragma unroll
                            for (int j = 0; j < 4; ++j) { r[4 * n + j] = acc[ai][bj][m][n][j] * h[4 * n + j]; acc[ai][bj][m][n][j] = 0.f; }
                        u32x4 w; w.x = cvt_pk_bf16(r[0], r[1]); w.y = cvt_pk_bf16(r[2], r[3]); w.z = cvt_pk_bf16(r[4], r[5]); w.w = cvt_pk_bf16(r[6], r[7]);
                        *(u32x4*)(MERGED + off) = w;
                    }
        }
    }
};
struct EpiOut { static constexpr bool PERM = true, AFTER_DRAIN = false, ACC_CHAIN = false; static constexpr int INIT = 2;     const bf16_t* xb; bf16_t* PRE;
    __device__ __forceinline__ void tile_init(f32x4 (&acc)[2][2][4][2], const Unit& u, int wr, int wc, int fr, int fq) const {
        const int row0 = u.pm * BM + wr * 64 + fr, col0 = u.pn * BM + wc * 32 + 8 * fq;
#pragma unroll
        for (int ai = 0; ai < 2; ++ai)
#pragma unroll
            for (int m = 0; m < 4; ++m)
#pragma unroll
                for (int bj = 0; bj < 2; ++bj) { const size_t off = (size_t)(row0 + ai * HALF + m * 16) * DM + col0 + bj * HALF;
                    const u32x4 xv = *(const u32x4*)(xb + off);
                    acc[ai][bj][m][0] = (f32x4){bflo(xv.x), bfhi(xv.x), bflo(xv.y), bfhi(xv.y)} * DN_ALPHA; acc[ai][bj][m][1] = (f32x4){bflo(xv.z), bfhi(xv.z), bflo(xv.w), bfhi(xv.w)} * DN_ALPHA; }
    }
    __device__ __forceinline__ void operator()(f32x4 (&acc)[2][2][4][2], const Unit& u, int wr, int wc, int fr, int fq) const {
        const int row0 = u.pm * BM + wr * 64 + fr, col0 = u.pn * BM + wc * 32 + 8 * fq;
#pragma unroll
        for (int ai = 0; ai < 2; ++ai)
#pragma unroll
            for (int m = 0; m < 4; ++m)
#pragma unroll
                for (int bj = 0; bj < 2; ++bj) { const size_t off = (size_t)(row0 + ai * HALF + m * 16) * DM + col0 + bj * HALF;
                    const f32x4 v0 = acc[ai][bj][m][0], v1 = acc[ai][bj][m][1];
                    u32x4 w; w.x = cvt_pk_bf16(v0[0], v0[1]); w.y = cvt_pk_bf16(v0[2], v0[3]); w.z = cvt_pk_bf16(v1[0], v1[1]); w.w = cvt_pk_bf16(v1[2], v1[3]);
                    *(u32x4*)(PRE + off) = w; }
    }
};
template <bool F8OUT> struct EpiUpT { static constexpr bool PERM = true, AFTER_DRAIN = false, ACC_CHAIN = false; static constexpr int INIT = 1;     const float* b_up; bf16_t* ACT;
    __device__ __forceinline__ void bias_load(f32x4 (&bv)[2][2], const Unit& u, int wc, int fq) const { const float* bias = b_up + (size_t)u.aux * UPW + u.pn * BM + wc * 32 + 8 * fq;
#pragma unroll
        for (int bj = 0; bj < 2; ++bj)
#pragma unroll
            for (int n = 0; n < 2; ++n) bv[bj][n] = *(const f32x4*)(bias + bj * HALF + 4 * n); }
    __device__ __forceinline__ void operator()(f32x4 (&acc)[2][2][4][2], const Unit& u, int wr, int wc, int fr, int fq) const {
        const int row0 = u.pm * BM + wr * 64 + fr, col0 = u.pn * BM + wc * 32 + 8 * fq;
        constexpr float OS = F8OUT ? ACT8_SCALE : 1.0f;
#pragma unroll
        for (int ai = 0; ai < 2; ++ai)
#pragma unroll
            for (int bj = 0; bj < 2; ++bj) {
                unsigned d[4]; u32x2 wb[4];
#pragma unroll
                for (int m = 0; m < 4; ++m) {
                    const f32x4 v0 = acc[ai][bj][m][0], v1 = acc[ai][bj][m][1];
                    const float gl[4] = {v0[0], v0[2], v1[0], v1[2]}, li[4] = {v0[1], v0[3], v1[1], v1[3]}; float a[4];
#pragma unroll
                    for (int p = 0; p < 4; p += 2) {
                        const f32x2_t g2 = {__builtin_amdgcn_fmed3f(gl[p], -INFINITY, SW_LIMIT), __builtin_amdgcn_fmed3f(gl[p + 1], -INFINITY, SW_LIMIT)}, l2 = {__builtin_amdgcn_fmed3f(li[p], -SW_LIMIT, SW_LIMIT), __builtin_amdgcn_fmed3f(li[p + 1], -SW_LIMIT, SW_LIMIT)};
                        const f32x2_t x2 = g2 * (f32x2_t){-SW_ALPHA * LOG2E, -SW_ALPHA * LOG2E};
                        const f32x2_t d2 = (f32x2_t){__builtin_amdgcn_exp2f(x2[0]), __builtin_amdgcn_exp2f(x2[1])} + (f32x2_t){1.0f, 1.0f};
                        const f32x2_t r2 = {__builtin_amdgcn_rcpf(d2[0]), __builtin_amdgcn_rcpf(d2[1])};
                        const f32x2_t u2 = l2 * (f32x2_t){OS, OS} + (f32x2_t){OS, OS};
                        const f32x2_t a2 = (g2 * r2) * u2;
                        a[p] = a2[0]; a[p + 1] = a2[1]; }
                    if constexpr (F8OUT) d[m] = pk4_fp8(a[0], a[1], a[2], a[3]);
                    else { wb[m].x = cvt_pk_bf16(a[0], a[1]); wb[m].y = cvt_pk_bf16(a[2], a[3]); }
                }
                if constexpr (F8OUT) {
                    auto r = __builtin_amdgcn_permlane16_swap(d[0], d[1], false, false); d[0] = r[0]; d[1] = r[1];
                    r = __builtin_amdgcn_permlane16_swap(d[2], d[3], false, false); d[2] = r[0]; d[3] = r[1];
                    r = __builtin_amdgcn_permlane32_swap(d[0], d[2], false, false); d[0] = r[0]; d[2] = r[1];
                    r = __builtin_amdgcn_permlane32_swap(d[1], d[3], false, false); d[1] = r[0]; d[3] = r[1];
                    *(u32x4*)((unsigned char*)ACT + (size_t)(row0 + ai * HALF + 16 * fq) * DFF + (u.pn * (BM / 2) + wc * 16 + bj * (HALF / 2))) = (u32x4){d[0], d[1], d[2], d[3]};
                } else {
#pragma unroll
                    for (int m = 0; m < 4; ++m) *(u32x2*)(ACT + (size_t)(row0 + ai * HALF + m * 16) * DFF + ((col0 + bj * HALF) >> 1)) = wb[m];
                }
            }
    }
};
struct EpiDown { static constexpr bool PERM = true, AFTER_DRAIN = false, ACC_CHAIN = false; static constexpr int INIT = 1; const float* b_dn; bf16_t* Y;
    __device__ __forceinline__ void bias_load(f32x4 (&bv)[2][2], const Unit& u, int wc, int fq) const { const float* bias = b_dn + (size_t)u.aux * DM + u.pn * BM + wc * 32 + 8 * fq;
#pragma unroll
        for (int bj = 0; bj < 2; ++bj)
#pragma unroll
            for (int n = 0; n < 2; ++n) bv[bj][n] = *(const f32x4*)(bias + bj * HALF + 4 * n); }
    __device__ __forceinline__ void operator()(f32x4 (&acc)[2][2][4][2], const Unit& u, int wr, int wc, int fr, int fq) const {
        const int row0 = u.pm * BM + wr * 64 + fr, col0 = u.pn * BM + wc * 32 + 8 * fq;
#if MK_Y8
#pragma unroll
        for (int ai = 0; ai < 2; ++ai)
#pragma unroll
            for (int bj = 0; bj < 2; ++bj)
#pragma unroll
                for (int mp = 0; mp < 4; mp += 2) {
                    u32x2 w[2];
#pragma unroll
                    for (int q = 0; q < 2; ++q) { const f32x4 v0 = acc[ai][bj][mp + q][0], v1 = acc[ai][bj][mp + q][1];
                        w[q].x = pk4_fp8(v0[0] * Y8_SCALE, v0[1] * Y8_SCALE, v0[2] * Y8_SCALE, v0[3] * Y8_SCALE); w[q].y = pk4_fp8(v1[0] * Y8_SCALE, v1[1] * Y8_SCALE, v1[2] * Y8_SCALE, v1[3] * Y8_SCALE); }
                    auto r = __builtin_amdgcn_permlane16_swap(w[0].x, w[1].x, false, false); w[0].x = r[0]; w[1].x = r[1];
                    r = __builtin_amdgcn_permlane16_swap(w[0].y, w[1].y, false, false); w[0].y = r[0]; w[1].y = r[1];
                    *(u32x4*)((unsigned char*)Y + (size_t)(row0 + ai * HALF + (mp + (fq & 1)) * 16) * DM + (u.pn * BM + wc * 32 + 8 * (fq & 2) + bj * HALF)) = (u32x4){w[0].x, w[0].y, w[1].x, w[1].y};
                }
#else
#pragma unroll
        for (int ai = 0; ai < 2; ++ai)
#pragma unroll
            for (int m = 0; m < 4; ++m)
#pragma unroll
                for (int bj = 0; bj < 2; ++bj) {
                    const f32x4 v0 = acc[ai][bj][m][0], v1 = acc[ai][bj][m][1];
                    u32x4 w; w.x = cvt_pk_bf16(v0[0], v0[1]); w.y = cvt_pk_bf16(v0[2], v0[3]); w.z = cvt_pk_bf16(v1[0], v1[1]); w.w = cvt_pk_bf16(v1[2], v1[3]);
                    *(u32x4*)(Y + (size_t)(row0 + ai * HALF + m * 16) * DM + col0 + bj * HALF) = w;
                }
#endif
    }
};

template <class Epi, class Sched, bool ALIGN_EPI = false, bool SP2 = false>
__device__ __forceinline__ void gemm_phase(PG8_LAS unsigned char* lds, const Gemm g, const Sched& S, const Epi& E) {
    int tid = threadIdx.x; asm volatile("" : "+v"(tid));
    const int wid = __builtin_amdgcn_readfirstlane(tid >> 6), lane = tid & 63, wr = wid >> 2, wc = wid & 3, fr = lane & 15, fq = lane >> 4;
    const int K = g.K, nt = K / BK;
    unsigned voffA[2], voffB[2];
#pragma unroll
    for (int i = 0; i < 2; ++i) { int R, C; stage_rc(tid * 16 + i * 8192, R, C); const int Rb = Epi::PERM ? ((R & ~31) + perm32(R & 31)) : R;
        voffA[i] = (unsigned)(R * K + C) * 2u; voffB[i] = (unsigned)(Rb * K + C) * 2u; }
    const size_t kstep = (size_t)(BK * 2);
    const size_t hstep = (size_t)HALF * K * 2;
    const unsigned ldsw = (unsigned)wid * 1024u;
    const int aoff = lds_byte(wr * 64 + fr, fq * 8), boff = lds_byte(wc * 32 + fr, fq * 8);
#define PG8_SA(b, h) (((b) * 2 + (h)) * HTB)
#define PG8_SB(b, h) ((4 + (b) * 2 + (h)) * HTB)
#define PG8_STAGE(bufoff, gbase, voff) do { _Pragma("unroll") for (int _i = 0; _i < 2; ++_i) \
        __builtin_amdgcn_global_load_lds((const unsigned*)((const char*)(gbase) + (voff)[_i]), (PG8_LAS unsigned*)(lds + (bufoff) + ldsw + _i * 8192), 16, 0, 0); } while (0)
#define PG8_LDA(dst, b, h) do { _Pragma("unroll") for (int m = 0; m < 4; ++m) _Pragma("unroll") for (int k = 0; k < 2; ++k) dst[m][k] = *(const PG8_LAS bf16x8*)(lds + PG8_SA(b, h) + aoff + m * 2048 + k * 1024); } while (0)
#define PG8_LDB(dst, b, h) do { _Pragma("unroll") for (int n = 0; n < 2; ++n) _Pragma("unroll") for (int k = 0; k < 2; ++k) dst[n][k] = *(const PG8_LAS bf16x8*)(lds + PG8_SB(b, h) + boff + n * 2048 + k * 1024); } while (0)
#define PG8_MMA(ai, bj, At, Bt) do { __builtin_amdgcn_s_setprio(1); _Pragma("unroll") for (int m = 0; m < 4; ++m) _Pragma("unroll") for (int n = 0; n < 2; ++n) _Pragma("unroll") for (int k = 0; k < 2; ++k) \
        acc[ai][bj][m][n] = __builtin_amdgcn_mfma_f32_16x16x32_bf16(Bt[n][k], At[m][k], acc[ai][bj][m][n], 0, 0, 0); __builtin_amdgcn_s_setprio(0); } while (0)
#define PG8_WAIT_V(n) asm volatile("s_waitcnt vmcnt(" #n ")" ::: "memory")
#define PG8_WAIT_L(n) asm volatile("s_waitcnt lgkmcnt(" #n ")" ::: "memory")
#define PG8_BAR __builtin_amdgcn_s_barrier()
#define PG8_SCHED __builtin_amdgcn_sched_barrier(0)
    Unit cur, nxt; int ui = 0;
    if (!S.next(0, cur)) return;
    f32x4 acc[2][2][4][2];
    f32x4 bv0[2][2];
    if constexpr (Epi::INIT == 1) E.bias_load(bv0, cur, wc, fq);
#pragma unroll
    for (int a = 0; a < 2; ++a)
#pragma unroll
        for (int b = 0; b < 2; ++b)
#pragma unroll
            for (int m = 0; m < 4; ++m)
#pragma unroll
                for (int n = 0; n < 2; ++n) { if constexpr (Epi::INIT == 1) acc[a][b][m][n] = bv0[b][n]; else acc[a][b][m][n] = (f32x4){0.f, 0.f, 0.f, 0.f}; }
    if constexpr (Epi::INIT == 2) E.tile_init(acc, cur, wr, wc, fr, fq);
    bf16x8 At[4][2], B0[2][2], B1[2][2];
    const char* cA = cur.a; const char* cB = cur.b;
    S.a_ready(cur);
    if constexpr (SP2) {
        PG8_STAGE(PG8_SB(0, 0), cB, voffB); PG8_STAGE(PG8_SB(0, 1), cB + hstep, voffB); PG8_STAGE(PG8_SA(0, 0), cA, voffA); PG8_STAGE(PG8_SA(0, 1), cA + hstep, voffA);
        if (wr == 1) PG8_BAR;
        PG8_WAIT_V(2); PG8_BAR;
        PG8_STAGE(PG8_SB(1, 0), cB + kstep, voffB); PG8_STAGE(PG8_SA(1, 0), cA + kstep, voffA); PG8_STAGE(PG8_SB(1, 1), cB + hstep + kstep, voffB);
        PG8_WAIT_V(6); PG8_BAR;
    } else {
        PG8_STAGE(PG8_SB(0, 0), cB, voffB); PG8_STAGE(PG8_SA(0, 0), cA, voffA); PG8_STAGE(PG8_SB(0, 1), cB + hstep, voffB); PG8_STAGE(PG8_SA(0, 1), cA + hstep, voffA);
        if (wr == 1) PG8_BAR;
        PG8_WAIT_V(4); PG8_BAR;
        PG8_STAGE(PG8_SB(1, 0), cB + kstep, voffB); PG8_STAGE(PG8_SA(1, 0), cA + kstep, voffA); PG8_STAGE(PG8_SB(1, 1), cB + hstep + kstep, voffB);
        PG8_WAIT_V(6); PG8_BAR;
    }
    for (;;) {
        const bool has_next = S.next(ui + 1, nxt);
        const char* nA = has_next ? nxt.a : cA; const char* nB = has_next ? nxt.b : cB;
        for (int t = 0; t < nt; t += 2) {
            const bool last = (t == nt - 2);
            const char* a1 = cA + (size_t)(t + 1) * kstep;
            const char* a2 = last ? nA : cA + (size_t)(t + 2) * kstep; const char* b2 = last ? nB : cB + (size_t)(t + 2) * kstep;
            const char* a3 = a2 + kstep; const char* b3 = b2 + kstep;
            if (last && has_next) S.a_ready(nxt);
            if constexpr (SP2) {
            PG8_LDB(B0, 0, 0); PG8_LDB(B1, 0, 1); PG8_SCHED; PG8_LDA(At, 0, 0); PG8_STAGE(PG8_SA(1, 1), a1 + hstep, voffA);
            PG8_WAIT_V(8); PG8_WAIT_L(0); PG8_BAR; PG8_MMA(0, 0, At, B0); PG8_MMA(0, 1, At, B1); PG8_BAR; PG8_SCHED;
            PG8_LDA(At, 0, 1); PG8_STAGE(PG8_SB(0, 0), b2, voffB); PG8_STAGE(PG8_SB(0, 1), b2 + hstep, voffB); PG8_STAGE(PG8_SA(0, 0), a2, voffA);
            PG8_WAIT_V(8); PG8_WAIT_L(0); PG8_BAR; PG8_MMA(1, 0, At, B0); PG8_MMA(1, 1, At, B1); PG8_BAR; PG8_SCHED;
            PG8_LDB(B0, 1, 0); PG8_LDB(B1, 1, 1); PG8_SCHED; PG8_LDA(At, 1, 0); PG8_STAGE(PG8_SA(0, 1), a2 + hstep, voffA);
            PG8_WAIT_V(8); PG8_WAIT_L(0); PG8_BAR; PG8_MMA(0, 0, At, B0); PG8_MMA(0, 1, At, B1); PG8_BAR; PG8_SCHED;
            PG8_LDA(At, 1, 1); PG8_STAGE(PG8_SB(1, 0), b3, voffB); PG8_STAGE(PG8_SB(1, 1), b3 + hstep, voffB); PG8_STAGE(PG8_SA(1, 0), a3, voffA);
            PG8_WAIT_V(8); PG8_WAIT_L(0); PG8_BAR; PG8_MMA(1, 0, At, B0); PG8_MMA(1, 1, At, B1); PG8_BAR; PG8_SCHED;
            } else {
            PG8_LDB(B0, 0, 0); PG8_SCHED; PG8_LDA(At, 0, 0); PG8_STAGE(PG8_SA(1, 1), a1 + hstep, voffA);
            PG8_WAIT_L(8); PG8_BAR; PG8_WAIT_L(0); PG8_MMA(0, 0, At, B0); PG8_BAR; PG8_SCHED;
            PG8_LDB(B1, 0, 1); PG8_STAGE(PG8_SB(0, 0), b2, voffB);
            PG8_BAR; PG8_WAIT_L(0); PG8_MMA(0, 1, At, B1); PG8_BAR;
            PG8_LDA(At, 0, 1); PG8_STAGE(PG8_SA(0, 0), a2, voffA);
            PG8_BAR; PG8_WAIT_L(0); PG8_MMA(1, 0, At, B0); PG8_BAR; PG8_SCHED;
            PG8_STAGE(PG8_SB(0, 1), b2 + hstep, voffB);
            PG8_WAIT_V(6); PG8_BAR; PG8_MMA(1, 1, At, B1); PG8_BAR;
            PG8_LDB(B0, 1, 0); PG8_SCHED; PG8_LDA(At, 1, 0); PG8_STAGE(PG8_SA(0, 1), a2 + hstep, voffA);
            PG8_WAIT_L(8); PG8_BAR; PG8_WAIT_L(0); PG8_MMA(0, 0, At, B0); PG8_BAR; PG8_SCHED;
            PG8_LDB(B1, 1, 1); PG8_STAGE(PG8_SB(1, 0), b3, voffB);
            PG8_BAR; PG8_WAIT_L(0); PG8_MMA(0, 1, At, B1); PG8_BAR;
            PG8_LDA(At, 1, 1); PG8_STAGE(PG8_SA(1, 0), a3, voffA);
            PG8_BAR; PG8_WAIT_L(0); PG8_MMA(1, 0, At, B0); PG8_BAR; PG8_SCHED;
            PG8_STAGE(PG8_SB(1, 1), b3 + hstep, voffB);
            PG8_WAIT_V(6); PG8_BAR; PG8_MMA(1, 1, At, B1); PG8_BAR;
            }
        }
        if constexpr (ALIGN_EPI) { if (wr == 0) PG8_BAR; }
        f32x4 bvn[2][2]; if constexpr (Epi::INIT == 1) { if (has_next) E.bias_load(bvn, nxt, wc, fq); }
        if constexpr (!Epi::AFTER_DRAIN) { E(acc, cur, wr, wc, fr, fq); S.done(cur); }
        if (!has_next) break;
        if constexpr (!Epi::ACC_CHAIN) {
#pragma unroll
        for (int a = 0; a < 2; ++a)
#pragma unroll
            for (int b = 0; b < 2; ++b)
#pragma unroll
                for (int m = 0; m < 4; ++m)
#pragma unroll
                    for (int n = 0; n < 2; ++n) { if constexpr (Epi::INIT == 1) acc[a][b][m][n] = bvn[b][n]; else acc[a][b][m][n] = (f32x4){0.f, 0.f, 0.f, 0.f}; }
        if constexpr (Epi::INIT == 2) E.tile_init(acc, nxt, wr, wc, fr, fq);
        }
        cur = nxt; cA = nA; cB = nB; ++ui;
        if constexpr (ALIGN_EPI) { if (wr == 1) PG8_BAR; }
    }
    PG8_WAIT_V(0);
    if constexpr (!ALIGN_EPI) { if (wr == 0) PG8_BAR; }
    PG8_BAR;
    if constexpr (Epi::AFTER_DRAIN) { E.fused(acc, cur, wr, wc, fr, fq, lds, wid, lane); S.done(cur); }
#undef PG8_SA
#undef PG8_SB
#undef PG8_STAGE
#undef PG8_LDA
#undef PG8_LDB
#undef PG8_MMA
#undef PG8_WAIT_V
#undef PG8_WAIT_L
#undef PG8_BAR
#undef PG8_SCHED
}
typedef int v8i_t __attribute__((ext_vector_type(8)));
template <class Epi, class Sched, bool ALIGN_EPI = false, bool SP2 = false>
__device__ __forceinline__ void gemm_phase_f8(PG8_LAS unsigned char* lds, const Gemm g, const Sched& S, const Epi& E) {
    int tid = threadIdx.x; asm volatile("" : "+v"(tid));
    const int wid = __builtin_amdgcn_readfirstlane(tid >> 6), lane = tid & 63, wr = wid >> 2, wc = wid & 3, fr = lane & 15, fq = lane >> 4;
    const int K = g.K, nt = K / BK;
    unsigned voffA[2], voffB[2];
#pragma unroll
    for (int i = 0; i < 2; ++i) { int R, C; stage_rc(tid * 16 + i * 8192, R, C); const int Rb = Epi::PERM ? ((R & ~31) + perm32(R & 31)) : R;
        voffA[i] = (unsigned)(R * K + C) * 2u; voffB[i] = (unsigned)(Rb * K + C) * 2u; }
    const size_t kstep = (size_t)(BK * 2);
    const size_t hstep = (size_t)HALF * K * 2;
    const unsigned ldsw = (unsigned)wid * 1024u;
    const int aoff = lds_byte(wr * 64 + fr, fq * 16), boff = lds_byte(wc * 32 + fr, fq * 16);
#define PG8_SA(b, h) (((b) * 2 + (h)) * HTB)
#define PG8_SB(b, h) ((4 + (b) * 2 + (h)) * HTB)
#define PG8_STAGE(bufoff, gbase, voff) do { _Pragma("unroll") for (int _i = 0; _i < 2; ++_i) \
        __builtin_amdgcn_global_load_lds((const unsigned*)((const char*)(gbase) + (voff)[_i]), (PG8_LAS unsigned*)(lds + (bufoff) + ldsw + _i * 8192), 16, 0, 0); } while (0)
#define PG8_STAGE_A(bufoff, gbase, h) do { if constexpr (Sched::GATHER_A) { PG8_STAGE(bufoff, gbase, goff[h]); } else { PG8_STAGE(bufoff, (gbase) + (size_t)(h) * hstep, voffA); } } while (0)
#define PG8_LDA(dst, b, h) do { _Pragma("unroll") for (int m = 0; m < 4; ++m) dst[m] = *(const PG8_LAS v8i_t*)(lds + PG8_SA(b, h) + aoff + m * 2048); } while (0)
#define PG8_LDB(dst, b, h) do { _Pragma("unroll") for (int n = 0; n < 2; ++n) dst[n] = *(const PG8_LAS v8i_t*)(lds + PG8_SB(b, h) + boff + n * 2048); } while (0)
#define PG8_F8(x) (x)
#define PG8_MMA(ai, bj, At, Bt) do { __builtin_amdgcn_s_setprio(1); _Pragma("unroll") for (int m = 0; m < 4; ++m) _Pragma("unroll") for (int n = 0; n < 2; ++n) \
        asm volatile("v_mfma_scale_f32_16x16x128_f8f6f4 %0, %1, %2, %0, %3, %4 op_sel_hi:[0,0,0]" : "+v"(acc[ai][bj][m][n]) : "v"(Bt[n]), "v"(At[m]), "v"(sc_w), "v"(sc_x)); __builtin_amdgcn_s_setprio(0); } while (0)
#define PG8_WAIT_V(n) asm volatile("s_waitcnt vmcnt(" #n ")" ::: "memory")
#define PG8_WAIT_L(n) asm volatile("s_waitcnt lgkmcnt(" #n ")" ::: "memory")
#define PG8_BAR __builtin_amdgcn_s_barrier()
#define PG8_SCHED __builtin_amdgcn_sched_barrier(0)
    const int sc_w = g.scale_b, sc_x = g.scale_a;
    Unit cur, nxt; int ui = 0;
    if (!S.next(0, cur)) return;
    f32x4 acc[2][2][4][2];
    f32x4 bv0[2][2];
    if constexpr (Epi::INIT == 1) E.bias_load(bv0, cur, wc, fq);
#pragma unroll
    for (int a = 0; a < 2; ++a)
#pragma unroll
        for (int b = 0; b < 2; ++b)
#pragma unroll
            for (int m = 0; m < 4; ++m)
#pragma unroll
                for (int n = 0; n < 2; ++n) { if constexpr (Epi::INIT == 1) acc[a][b][m][n] = bv0[b][n]; else acc[a][b][m][n] = (f32x4){0.f, 0.f, 0.f, 0.f}; }
    if constexpr (Epi::INIT == 2) E.tile_init(acc, cur, wr, wc, fr, fq);
    v8i_t At[4], B0[2], B1[2];
    const char* cA = cur.a; const char* cB = cur.b;
    unsigned goff[2][2]; int Rg[2], Cg[2];
    if constexpr (Sched::GATHER_A) {
#pragma unroll
        for (int i = 0; i < 2; ++i) { stage_rc(tid * 16 + i * 8192, Rg[i], Cg[i]); }
        const int* ix = S.idx(cur);
#pragma unroll
        for (int h = 0; h < 2; ++h)
#pragma unroll
            for (int i = 0; i < 2; ++i) goff[h][i] = (unsigned)ix[h * HALF + Rg[i]] * (unsigned)(K * 2) + (unsigned)(Cg[i] * 2);
    }
#define PG8_VA(h) goff[h]
#define PG8_AH(h) (Sched::GATHER_A ? (size_t)0 : (size_t)(h) * hstep)
    S.a_ready(cur);
    if constexpr (SP2) {
        PG8_STAGE(PG8_SB(0, 0), cB, voffB); PG8_STAGE(PG8_SB(0, 1), cB + hstep, voffB); PG8_STAGE_A(PG8_SA(0, 0), cA, 0); PG8_STAGE_A(PG8_SA(0, 1), cA, 1);
        if (wr == 1) PG8_BAR;
        PG8_WAIT_V(2); PG8_BAR;
        PG8_STAGE(PG8_SB(1, 0), cB + kstep, voffB); PG8_STAGE_A(PG8_SA(1, 0), cA + kstep, 0); PG8_STAGE(PG8_SB(1, 1), cB + hstep + kstep, voffB);
        PG8_WAIT_V(6); PG8_BAR;
    } else {
        PG8_STAGE(PG8_SB(0, 0), cB, voffB); PG8_STAGE_A(PG8_SA(0, 0), cA, 0); PG8_STAGE(PG8_SB(0, 1), cB + hstep, voffB); PG8_STAGE_A(PG8_SA(0, 1), cA, 1);
        if (wr == 1) PG8_BAR;
        PG8_WAIT_V(4); PG8_BAR;
        PG8_STAGE(PG8_SB(1, 0), cB + kstep, voffB); PG8_STAGE_A(PG8_SA(1, 0), cA + kstep, 0); PG8_STAGE(PG8_SB(1, 1), cB + hstep + kstep, voffB);
        PG8_WAIT_V(6); PG8_BAR;
    }
    for (;;) {
        const bool has_next = S.next(ui + 1, nxt);
        if constexpr (Sched::GATHER_A) { if (has_next && wid < 4) __builtin_amdgcn_global_load_lds((const unsigned*)(S.idx(nxt) + wid * 64 + lane), (PG8_LAS unsigned*)(lds + LDS_IDX + wid * 256), 4, 0, 0); }
        const char* nA = has_next ? nxt.a : cA; const char* nB = has_next ? nxt.b : cB;
#pragma unroll 1
        for (int t = 0; t < nt; t += 2) {
            const bool last = (t == nt - 2);
            const char* a1 = cA + (size_t)(t + 1) * kstep;
            const char* a2 = last ? nA : cA + (size_t)(t + 2) * kstep; const char* b2 = last ? nB : cB + (size_t)(t + 2) * kstep;
            const char* a3 = a2 + kstep; const char* b3 = b2 + kstep;
            if (last && has_next) S.a_ready(nxt);
            if constexpr (SP2) {
            PG8_LDB(B0, 0, 0); PG8_LDB(B1, 0, 1); PG8_SCHED; PG8_LDA(At, 0, 0); PG8_STAGE_A(PG8_SA(1, 1), a1, 1);
            if constexpr (Sched::GATHER_A) { if (last && has_next) {
                const PG8_LAS int* ixl = (const PG8_LAS int*)(lds + LDS_IDX);
#pragma unroll
                for (int h = 0; h < 2; ++h)
#pragma unroll
                    for (int i = 0; i < 2; ++i) goff[h][i] = (unsigned)ixl[h * HALF + Rg[i]] * (unsigned)(K * 2) + (unsigned)(Cg[i] * 2); } }
            PG8_WAIT_V(8); PG8_WAIT_L(0); PG8_BAR; PG8_MMA(0, 0, At, B0); PG8_MMA(0, 1, At, B1); PG8_BAR; PG8_SCHED;
            PG8_LDA(At, 0, 1); PG8_STAGE(PG8_SB(0, 0), b2, voffB); PG8_STAGE(PG8_SB(0, 1), b2 + hstep, voffB); PG8_STAGE_A(PG8_SA(0, 0), a2, 0);
            PG8_WAIT_V(8); PG8_WAIT_L(0); PG8_BAR; PG8_MMA(1, 0, At, B0); PG8_MMA(1, 1, At, B1); PG8_BAR; PG8_SCHED;
            PG8_LDB(B0, 1, 0); PG8_LDB(B1, 1, 1); PG8_SCHED; PG8_LDA(At, 1, 0); PG8_STAGE_A(PG8_SA(0, 1), a2, 1);
            PG8_WAIT_V(8); PG8_WAIT_L(0); PG8_BAR; PG8_MMA(0, 0, At, B0); PG8_MMA(0, 1, At, B1); PG8_BAR; PG8_SCHED;
            PG8_LDA(At, 1, 1); PG8_STAGE(PG8_SB(1, 0), b3, voffB); PG8_STAGE(PG8_SB(1, 1), b3 + hstep, voffB); PG8_STAGE_A(PG8_SA(1, 0), a3, 0);
            PG8_WAIT_V(8); PG8_WAIT_L(0); PG8_BAR; PG8_MMA(1, 0, At, B0); PG8_MMA(1, 1, At, B1); PG8_BAR; PG8_SCHED;
            } else {
            PG8_LDB(B0, 0, 0); PG8_SCHED; PG8_LDA(At, 0, 0); PG8_STAGE_A(PG8_SA(1, 1), a1, 1);
            PG8_WAIT_L(8); PG8_BAR; PG8_WAIT_L(0); PG8_MMA(0, 0, At, B0); PG8_BAR; PG8_SCHED;
            PG8_LDB(B1, 0, 1); PG8_STAGE(PG8_SB(0, 0), b2, voffB);
            PG8_BAR; PG8_WAIT_L(0); PG8_MMA(0, 1, At, B1); PG8_BAR;
            PG8_LDA(At, 0, 1); PG8_STAGE_A(PG8_SA(0, 0), a2, 0);
            PG8_BAR; PG8_WAIT_L(0); PG8_MMA(1, 0, At, B0); PG8_BAR; PG8_SCHED;
            PG8_STAGE(PG8_SB(0, 1), b2 + hstep, voffB);
            PG8_WAIT_V(6); PG8_BAR; PG8_MMA(1, 1, At, B1); PG8_BAR;
            PG8_LDB(B0, 1, 0); PG8_SCHED; PG8_LDA(At, 1, 0); PG8_STAGE_A(PG8_SA(0, 1), a2, 1);
            PG8_WAIT_L(8); PG8_BAR; PG8_WAIT_L(0); PG8_MMA(0, 0, At, B0); PG8_BAR; PG8_SCHED;
            PG8_LDB(B1, 1, 1); PG8_STAGE(PG8_SB(1, 0), b3, voffB);
            PG8_BAR; PG8_WAIT_L(0); PG8_MMA(0, 1, At, B1); PG8_BAR;
            PG8_LDA(At, 1, 1); PG8_STAGE_A(PG8_SA(1, 0), a3, 0);
            PG8_BAR; PG8_WAIT_L(0); PG8_MMA(1, 0, At, B0); PG8_BAR; PG8_SCHED;
            PG8_STAGE(PG8_SB(1, 1), b3 + hstep, voffB);
            PG8_WAIT_V(6); PG8_BAR; PG8_MMA(1, 1, At, B1); PG8_BAR;
            }
        }
        if constexpr (ALIGN_EPI) { if (wr == 0) PG8_BAR; }
        asm volatile("s_nop 15\n\ts_nop 7" ::: "memory"); __builtin_amdgcn_sched_barrier(0);
        f32x4 bvn[2][2]; if constexpr (Epi::INIT == 1) { if (has_next) E.bias_load(bvn, nxt, wc, fq); }
        if constexpr (!Epi::AFTER_DRAIN) { E(acc, cur, wr, wc, fr, fq); S.done(cur); }
        if (!has_next) break;
        if constexpr (!Epi::ACC_CHAIN) {
#pragma unroll
        for (int a = 0; a < 2; ++a)
#pragma unroll
            for (int b = 0; b < 2; ++b)
#pragma unroll
                for (int m = 0; m < 4; ++m)
#pragma unroll
                    for (int n = 0; n < 2; ++n) { if constexpr (Epi::INIT == 1) acc[a][b][m][n] = bvn[b][n]; else acc[a][b][m][n] = (f32x4){0.f, 0.f, 0.f, 0.f}; }
        if constexpr (Epi::INIT == 2) E.tile_init(acc, nxt, wr, wc, fr, fq);
        }
        cur = nxt; cA = nA; cB = nB; ++ui;
        if constexpr (ALIGN_EPI) { if (wr == 1) PG8_BAR; }
    }
    PG8_WAIT_V(0);
    if constexpr (!ALIGN_EPI) { if (wr == 0) PG8_BAR; }
    PG8_BAR;
    if constexpr (Epi::AFTER_DRAIN) { E.fused(acc, cur, wr, wc, fr, fq, lds, wid, lane); S.done(cur); }
#undef PG8_SA
#undef PG8_SB
#undef PG8_STAGE
#undef PG8_STAGE_A
#undef PG8_VA
#undef PG8_AH
#undef PG8_LDA
#undef PG8_LDB
#undef PG8_MMA
#undef PG8_F8
#undef PG8_WAIT_V
#undef PG8_WAIT_L
#undef PG8_BAR
#undef PG8_SCHED
}
}

typedef GAS unsigned gu32;
#define RLX_AGENT __ATOMIC_RELAXED, __HIP_MEMORY_SCOPE_AGENT
#define XB_TMO      128
#define XB_XCNT(j)  (256  + 64 * (j))
#define XB_XSUB(j)  (1280 + 64 * (j))
#define XB_XGEN(j)  (2304 + 64 * (j))
#define XB_TOP      3328
#define XB_TOPGEN   3392
#define XCD_BAR_WORDS 3456
#define XB_SPIN_CAP (1u << 26)

__device__ __forceinline__ unsigned xb_ld(unsigned* p)              { return __hip_atomic_load(p, __ATOMIC_RELAXED, __HIP_MEMORY_SCOPE_AGENT); }
__device__ __forceinline__ unsigned xb_add(unsigned* p, unsigned v) { return __hip_atomic_fetch_add(p, v, __ATOMIC_RELAXED, __HIP_MEMORY_SCOPE_AGENT); }
__device__ __forceinline__ unsigned xb_xcc_id() { return (unsigned)__builtin_amdgcn_s_getreg((3 << 11) | 20) & 0xFu; }
#define XB_SPIN(cond, bar) do { unsigned _sp = 0; while (cond) { __builtin_amdgcn_s_sleep(1); \
    if ((++_sp & 255u) == 0u) { if (xb_ld(&(bar)[XB_TMO])) break; if (_sp > XB_SPIN_CAP) { atomicAdd(&(bar)[XB_TMO], 1u); break; } } } } while (0)

struct XcdBarrier {
    unsigned* bar; unsigned x;
    volatile LAS unsigned* st;
};

__device__ __forceinline__ XcdBarrier xcd_barrier_post(unsigned* bar, volatile LAS unsigned* st) {
    XcdBarrier b; b.bar = bar; b.x = xb_xcc_id(); b.st = st;
    if (threadIdx.x == 0) (void)xb_add(&bar[XB_XCNT(b.x)], 1u);
    return b;
}
__device__ __forceinline__ void xcd_barrier_complete(unsigned* bar, unsigned x, unsigned& nloc, unsigned& nx) {
    const unsigned G = gridDim.x * gridDim.y * gridDim.z;
    unsigned sum, cnt, mine, sp = 0u;
    for (;;) {
        sum = 0u; cnt = 0u; mine = 0u;
#pragma unroll
        for (unsigned j = 0; j < 16; ++j) { const unsigned c = xb_ld(&bar[XB_XCNT(j)]); sum += c; cnt += (c > 0u) ? 1u : 0u; mine = (j == x) ? c : mine; }
        if (sum == G) break;
        __builtin_amdgcn_s_sleep(1);
        if ((++sp & 255u) == 0u) { if (xb_ld(&bar[XB_TMO])) break; if (sp > XB_SPIN_CAP) { atomicAdd(&bar[XB_TMO], 1u); break; } }
    }
    nloc = mine > 0u ? mine : 1u; nx = cnt > 0u ? cnt : 1u;
}

__device__ __forceinline__ void xcd_barrier(const XcdBarrier& b) {
    asm volatile("s_waitcnt vmcnt(0)" ::: "memory");
    __syncthreads();
    if (threadIdx.x == 0) {
        unsigned* bar = b.bar;
        __builtin_amdgcn_s_waitcnt(0);
        unsigned nloc = b.st[0], nx = b.st[1];
        if (nloc == 0u) { xcd_barrier_complete(bar, b.x, nloc, nx); b.st[0] = nloc; b.st[1] = nx; }
        const unsigned old = xb_add(&bar[XB_XSUB(b.x)], 1u);
        const unsigned gen = old / nloc;
        if (old + 1u == (gen + 1u) * nloc) {
            __builtin_amdgcn_fence(__ATOMIC_RELEASE, "agent");
            asm volatile("s_waitcnt vmcnt(0)" ::: "memory");
            const unsigned og = xb_add(&bar[XB_TOP], 1u);
            const unsigned tg = og / nx;
            if (og + 1u == (tg + 1u) * nx) xb_add(&bar[XB_TOPGEN], 1u);
            else XB_SPIN(xb_ld(&bar[XB_TOPGEN]) == tg, bar);
            __builtin_amdgcn_fence(__ATOMIC_ACQUIRE, "");
            xb_add(&bar[XB_XGEN(b.x)], 1u);
            asm volatile("s_waitcnt vmcnt(0)" ::: "memory");
        } else {
            XB_SPIN(xb_ld(&bar[XB_XGEN(b.x)]) == gen, bar);
            __builtin_amdgcn_fence(__ATOMIC_ACQUIRE, "");
            asm volatile("s_waitcnt vmcnt(0)" ::: "memory");
        }
    }
    __syncthreads();
}


template <bool BG, class ArgsT> __device__ __forceinline__ void xcd_barrier_bg(const XcdBarrier& b, const ArgsT& A, LAS unsigned char* lds, volatile LAS unsigned* MISC);
__device__ __forceinline__ int fresh_tid() { int t = threadIdx.x; asm volatile("" : "+v"(t)); return t; }
#define FRESH_IDS() const int tid = fresh_tid(), lane = tid & 63, wave = __builtin_amdgcn_readfirstlane(tid >> 6); (void)tid; (void)lane; (void)wave
struct Args { const float* in[17]; float* out; unsigned char* ws; int ph_lo, ph_hi, li, pad; };

__device__ __forceinline__ void p0_transpose_item(const float* W, int K, int N, bf16_t* WT, LAS float* scr, int item, int lane) {
    (void)scr;
    const int nblk = N / 32, kb = item / nblk, nb = item % nblk, k0 = 64 * kb + 8 * (lane >> 3), n0 = 32 * nb + 4 * (lane & 7);
    f32x4 v[8];
#pragma unroll
    for (int j2 = 0; j2 < 8; ++j2) v[j2] = *(const GAS f32x4*)(W + (size_t)(k0 + j2) * N + n0);
#pragma unroll
    for (int i2 = 0; i2 < 4; ++i2) { u32x4 o; o.x = pk2(v[0][i2], v[1][i2]); o.y = pk2(v[2][i2], v[3][i2]); o.z = pk2(v[4][i2], v[5][i2]); o.w = pk2(v[6][i2], v[7][i2]);
        *(GAS u32x4*)(WT + (size_t)(n0 + i2) * K + k0) = o; }
}
__device__ __forceinline__ void p0_transpose_item_f8(const float* W, int K, int N, unsigned char* WT8, LAS float* scr, int item, int lane, float wscale, int nblk_sub = 0) {
    (void)scr;
    const int nblk = nblk_sub ? nblk_sub : N / 32, kb = (item / (2 * nblk)) * 2 + (item & 1), nb = (item >> 1) % nblk, k0 = 64 * kb + 8 * (lane >> 3), n0 = 32 * nb + 4 * (lane & 7);
    f32x4 v[8];
#pragma unroll
    for (int j2 = 0; j2 < 8; ++j2) v[j2] = *(const GAS f32x4*)(W + (size_t)(k0 + j2) * N + n0);
#pragma unroll
    for (int i = 0; i < 4; ++i) { u32x2 o; o.x = pk4_fp8(v[0][i] * wscale, v[1][i] * wscale, v[2][i] * wscale, v[3][i] * wscale); o.y = pk4_fp8(v[4][i] * wscale, v[5][i] * wscale, v[6][i] * wscale, v[7][i] * wscale);
        *(GAS u32x2*)(WT8 + (size_t)(n0 + i) * K + k0) = o; }
}
constexpr int BG_BATCH = 8, BG_I_UP1 = (DM / 64) * (UPW / 32), BG_I_DN1 = (DFF / 64) * (DM / 32), BG_I_UP = NEXP * BG_I_UP1, BG_TOTAL = BG_I_UP + NEXP * BG_I_DN1;
static_assert(BG_I_UP % BG_BATCH == 0 && BG_TOTAL % BG_BATCH == 0, "batches do not straddle the up/down boundary");
__device__ __forceinline__ void bg_item(const Args& A, int it, LAS float* scr, int lane) {
    if (it < BG_I_UP) { const int e = it / BG_I_UP1;
#if MK_FP8_UP
        p0_transpose_item_f8(A.in[11] + (size_t)e * DM * UPW, DM, UPW, (unsigned char*)(A.ws + WS_WUPT) + (size_t)e * DM * UPW, scr, it % BG_I_UP1, lane, W8_SCALE);
#else
        p0_transpose_item(A.in[11] + (size_t)e * DM * UPW, DM, UPW, (bf16_t*)(A.ws + WS_WUPT) + (size_t)e * DM * UPW, scr, it % BG_I_UP1, lane);
#endif
    }
    else { const int r = it - BG_I_UP, e = r / BG_I_DN1;
#if MK_FP8_DN
        p0_transpose_item_f8(A.in[13] + (size_t)e * DFF * DM, DFF, DM, (unsigned char*)(A.ws + WS_WDNT) + (size_t)e * DFF * DM, scr, r % BG_I_DN1, lane, W8_SCALE);
#else
        p0_transpose_item(A.in[13] + (size_t)e * DFF * DM, DFF, DM, (bf16_t*)(A.ws + WS_WDNT) + (size_t)e * DFF * DM, scr, r % BG_I_DN1, lane);
#endif
    }
}
__device__ __forceinline__ bool bg_step(const Args& A, volatile LAS int* st, LAS float* scr, int lane, int limit) {
    int cur = st[0], end = st[1];
    if (cur >= end) {
        if (cur >= BG_TOTAL) return false;
        int start = 0; if (lane == 0) start = __hip_atomic_fetch_add((int*)(A.ws + WS_CTL) + CW_BGQ, BG_BATCH, __ATOMIC_RELAXED, __HIP_MEMORY_SCOPE_AGENT);
        start = __builtin_amdgcn_readfirstlane(start);
        if (start >= BG_TOTAL) { if (lane == 0) { st[0] = BG_TOTAL; st[1] = BG_TOTAL; } return false; }
        cur = start; end = start + BG_BATCH; if (lane == 0) { st[0] = cur; st[1] = end; }
    }
    if (cur >= limit) return false;
    bg_item(A, cur, scr, lane);
    if (lane == 0) st[0] = cur + 1;
    return true;
}
__device__ __forceinline__ void phase_prologue(const Args& A, LAS unsigned char* lds, int gw, int NGW, int lane, int wave) {
    unsigned char* ws = A.ws;
    LAS float* scr = (LAS float*)(lds + wave * 16384);
    constexpr int I_IN = (DM / 64) * (INW / 32), I_BS = (SBW / 64) * (DM / 32), I_WO = (DM / 64) * (DM / 32), I_RW = (DM / 64) * (NEXP / 32);
    constexpr int I_UP1 = (DM / 64) * (UPW / 32), I_DN1 = (DFF / 64) * (DM / 32), I_UP = NEXP * I_UP1, I_DN = NEXP * I_DN1;
    constexpr int NITEMS = I_IN + 2 * I_BS + I_WO + I_RW + (MK_BG ? 0 : I_UP + I_DN);
    for (int it = gw; it < NITEMS; it += NGW) {
        int r = it;
#if MK_FP8_GATES
        if (r < I_IN) { constexpr int NB16 = 3072 / 32, NB8 = (INW - 3072) / 32, I16 = (DM / 64) * NB16;
            if (r < I16) { const int kb = r / NB16, nb = r % NB16; p0_transpose_item(A.in[1], DM, INW, (bf16_t*)(ws + WS_WINT), scr, kb * (INW / 32) + nb, lane); }
            else p0_transpose_item_f8(A.in[1] + 3072, DM, INW, (unsigned char*)(ws + WS_WINT8), scr, r - I16, lane, W8_SCALE, NB8);
            continue; } r -= I_IN;
#else
        if (r < I_IN) { p0_transpose_item(A.in[1], DM, INW, (bf16_t*)(ws + WS_WINT), scr, r, lane); continue; } r -= I_IN;
#endif
        if (r < I_BS) { p0_transpose_item(A.in[4], SBW, DM, (bf16_t*)(ws + WS_WBST), scr, r, lane); continue; } r -= I_BS;
        if (r < I_BS) { p0_transpose_item(A.in[5], HGW, DM, (bf16_t*)(ws + WS_WBHT), scr, r, lane); continue; } r -= I_BS;
        if (r < I_WO) { p0_transpose_item(A.in[6], DM, DM, (bf16_t*)(ws + WS_WOT), scr, r, lane); continue; } r -= I_WO;
        if (r < I_RW) { p0_transpose_item(A.in[9], DM, NEXP, (bf16_t*)(ws + WS_RWT), scr, r, lane); continue; } r -= I_RW;
        if (r < I_UP) { const int e = r / I_UP1; p0_transpose_item(A.in[11] + (size_t)e * DM * UPW, DM, UPW, (bf16_t*)(ws + WS_WUPT) + (size_t)e * DM * UPW, scr, r % I_UP1, lane); continue; } r -= I_UP;
        { const int e = r / I_DN1; p0_transpose_item(A.in[13] + (size_t)e * DFF * DM, DFF, DM, (bf16_t*)(ws + WS_WDNT) + (size_t)e * DFF * DM, scr, r % I_DN1, lane); }
    }
    bf16_t* XB = (bf16_t*)(ws + WS_XB);
    for (int m0 = gw; m0 < NTOK; m0 += MK_P0_ROWS * NGW) {
        f32x4 xv[MK_P0_ROWS][4];
#pragma unroll
        for (int q = 0; q < MK_P0_ROWS; ++q) { const int m = m0 + q * NGW; const GAS f32x4* xr = (const GAS f32x4*)(A.in[0] + (size_t)(m < NTOK ? m : m0) * DM) + lane;
#pragma unroll
            for (int j = 0; j < 4; ++j) xv[q][j] = xr[64 * j]; }
#pragma unroll
        for (int q = 0; q < MK_P0_ROWS; ++q) { const int m = m0 + q * NGW; if (m < NTOK) { GAS u32x2* o8 = (GAS u32x2*)(XB + (size_t)m * DM) + lane;
#pragma unroll
            for (int j = 0; j < 4; ++j) { const f32x4 v = xv[q][j]; u32x2 w; w.x = pk2(v[0], v[1]); w.y = pk2(v[2], v[3]); o8[64 * j] = w;
#if MK_FP8_GATES
                ((GAS unsigned*)((unsigned char*)(ws + WS_XB8) + (size_t)m * DM))[lane + 64 * j] = pk4_fp8(v[0], v[1], v[2], v[3]);
#endif
            } } }
    }
    if (gw < 8) { const int c = gw * 64 + lane; const float l0 = A.in[2][c], l1 = A.in[2][HGW + c]; ((float*)(ws + WS_LB))[c] = 1.0f / (1.0f + expf(l1 - l0)); }
}

__device__ __forceinline__ void attn_naive_unit(const bf16_t* __restrict__ Q, const bf16_t* __restrict__ K, const bf16_t* __restrict__ V, bf16_t* __restrict__ O, int bh, int qb, int lane) {
    const int b = bh >> 3, h = bh & 7, t = qb * 64 + lane; const size_t rowbase = (size_t)b * SEQ;
    float q[64], o[64];
    { const bf16_t* qp = Q + (rowbase + t) * SBW + h * SBD;
#pragma unroll
      for (int d = 0; d < 64; ++d) { q[d] = bf2f(qp[d]); o[d] = 0.f; } }
    float R = 1.0f;
    for (int s = qb * 64 + 63; s >= 0; --s) {
        const bf16_t* kr = K + (rowbase + s) * SBW + h * SBD; const bf16_t* vr = V + (rowbase + s) * SBW + h * SBD;
        float z = 0.f;
#pragma unroll
        for (int d = 0; d < 64; ++d) z += q[d] * bf2f(kr[d]);
        const bool valid = s < t;
        const float ez = expf(fminf(z, 60.0f)), keep = 1.0f / (1.0f + ez);
        const float a = valid ? ez * keep * R : 0.f;
        R = valid ? R * keep : R;
#pragma unroll
        for (int d = 0; d < 64; ++d) o[d] += a * bf2f(vr[d]);
    }
    bf16_t* op = O + (rowbase + t) * SBW + h * SBD;
#pragma unroll
    for (int d = 0; d < 64; ++d) op[d] = (bf16_t)f2bf(o[d]);
}
__device__ __forceinline__ void hgrn_naive_block(const bf16_t* __restrict__ HQ, const bf16_t* __restrict__ HK, const float* __restrict__ LOGF, const bf16_t* __restrict__ HV, float* __restrict__ ORAW,
                                                 LAS unsigned char* lds, int blk, int tid) {
    const int grp = tid >> 7, v = tid & 127, bh = blk * 4 + grp, b = bh >> 2, hh = bh & 3;
    LAS float* sf = (LAS float*)lds + grp * 384; LAS float* sk = sf + 128; LAS float* sq = sf + 256;
    float S[128];
#pragma unroll
    for (int k = 0; k < 128; ++k) S[k] = 0.f;
    for (int t = 0; t < SEQ; ++t) {
        const size_t base = ((size_t)b * SEQ + t) * HGW + hh * HGD;
        sf[v] = expf(LOGF[base + v]); sk[v] = bf2f(HK[base + v]); sq[v] = bf2f(HQ[base + v]);
        const float vv = bf2f(HV[base + v]);
        __syncthreads();
        float o = 0.f;
#pragma unroll
        for (int k = 0; k < 128; ++k) { S[k] = sf[k] * S[k] + sk[k] * vv; o += sq[k] * S[k]; }
        ORAW[base + v] = o;
        __syncthreads();
    }
}
__device__ __forceinline__ void hgrn_post_item(const float* __restrict__ ORAW, const bf16_t* __restrict__ HG, const float* __restrict__ norm_g, bf16_t* __restrict__ OHG, int item, int lane) {
    const size_t base = (size_t)item * HGD; const int c0 = (item & 3) * HGD;
    const float x0 = ORAW[base + lane], x1 = ORAW[base + 64 + lane];
    const float r = 1.0f / sqrtf(wave_sum(x0 * x0 + x1 * x1) * (1.0f / HGD) + RMS_EPS);
    OHG[base + lane] = (bf16_t)f2bf(x0 * r * norm_g[c0 + lane] * bf2f(HG[base + lane]));
    OHG[base + 64 + lane] = (bf16_t)f2bf(x1 * r * norm_g[c0 + 64 + lane] * bf2f(HG[base + 64 + lane]));
}

__device__ __forceinline__ int crow(int r, int hi) { return (r & 3) + 8 * (r >> 2) + 4 * hi; }
typedef short v4i16_t __attribute__((ext_vector_type(4)));
__device__ __forceinline__ v4i16_t tr16(LAS const unsigned char* p) { return __builtin_amdgcn_ds_read_tr16_b64_v4i16((LAS v4i16_t*)p); }
__device__ __forceinline__ bf16x8 cat8(v4i16_t lo, v4i16_t hi) { return (bf16x8){lo[0], lo[1], lo[2], lo[3], hi[0], hi[1], hi[2], hi[3]}; }
__device__ __forceinline__ bf16x8 pack8(const f32x16& p, int base) {
    u32x4 w; w.x = pg8::cvt_pk_bf16(p[base + 0], p[base + 1]); w.y = pg8::cvt_pk_bf16(p[base + 2], p[base + 3]); w.z = pg8::cvt_pk_bf16(p[base + 4], p[base + 5]); w.w = pg8::cvt_pk_bf16(p[base + 6], p[base + 7]);
    return __builtin_bit_cast(bf16x8, w);
}
__device__ __forceinline__ float xhalf(float v) {
    auto rr = __builtin_amdgcn_permlane32_swap(__float_as_uint(v), __float_as_uint(v), false, false);
    return __uint_as_float((threadIdx.x & 32) ? rr[0] : rr[1]);
}
#define WAIT_ALL_BAR() asm volatile("s_waitcnt vmcnt(0) lgkmcnt(0)\n\ts_barrier" ::: "memory")

constexpr int AT_K = 0, AT_V = 16384, AT_OST = 32768, AT_Q = 65536, AT_FLAG = 65600;
__device__ __forceinline__ void attn_unit(const bf16_t* Q, const bf16_t* K, const bf16_t* V, bf16_t* O, int bh, int qb, LAS unsigned char* lds, int lane, int wid) {
    const int b = bh >> 3, h = bh & 7, r32 = lane & 31, hi = lane >> 5;
    const size_t rowbase = (size_t)b * SEQ; const int q0 = qb * 256, qw0 = q0 + wid * 32;
    bf16x8 qr[4];
    { const bf16_t* qp = Q + (rowbase + qw0 + r32) * SBW + h * SBD + hi * 8;
#pragma unroll
      for (int d0 = 0; d0 < 4; ++d0) qr[d0] = *(const bf16x8*)(qp + d0 * 16); }
    f32x16 o0 = {}, o1 = {}; float R = 1.0f;
    const int NT = 4 * qb + 4;
    const bf16_t* ksrc = K + (rowbase + lane) * SBW + h * SBD + wid * 8;
    const bf16_t* vsrc = V + (rowbase + 16 * (wid & 3) + (lane >> 2)) * SBW + h * SBD + (wid >> 2) * 32 + (lane & 3) * 8;
    LAS unsigned char* kdst = lds + AT_K + wid * 1024; LAS unsigned char* vdst = lds + AT_V + wid * 1024;
    const int vb = ((lane >> 4) & 1) * 32 + (lane & 3) * 8 + (4 * hi + ((lane & 15) >> 2)) * 64;
    { const size_t go = (size_t)(NT - 1) * 64 * SBW;
      __builtin_amdgcn_global_load_lds((const unsigned*)(ksrc + go), (LAS unsigned*)kdst, 16, 0, 0);
      __builtin_amdgcn_global_load_lds((const unsigned*)(vsrc + go), (LAS unsigned*)vdst, 16, 0, 0); }
    if (lane == 0) *(LAS int*)(lds + AT_FLAG + wid * 4) = 0;
    bool wz = false;
    for (int it = 0; it < NT; ++it) {
        const int kt = NT - 1 - it, slot = (it & 1) * 8192, k0 = kt * 64;
        WAIT_ALL_BAR();
        { const u32x4 f0 = *(const LAS u32x4*)(lds + AT_FLAG), f1 = *(const LAS u32x4*)(lds + AT_FLAG + 16);
          if (__builtin_amdgcn_readfirstlane((f0.x & f0.y & f0.z & f0.w & f1.x & f1.y & f1.z & f1.w) != 0u)) break; }
        if (it + 1 < NT) { const size_t go = (size_t)(kt - 1) * 64 * SBW;
            __builtin_amdgcn_global_load_lds((const unsigned*)(ksrc + go), (LAS unsigned*)(kdst + (slot ^ 8192)), 16, 0, 0);
            __builtin_amdgcn_global_load_lds((const unsigned*)(vsrc + go), (LAS unsigned*)(vdst + (slot ^ 8192)), 16, 0, 0); }
        if (k0 < qw0 + 31 && !wz) {
            f32x16 p0 = {}, p1 = {};
            const LAS unsigned char* kb = lds + AT_K + slot + hi * 1024 + r32 * 16;
#pragma unroll
            for (int d0 = 0; d0 < 4; ++d0) {
                const bf16x8 a0 = *(const LAS bf16x8*)(kb + d0 * 2048), a1 = *(const LAS bf16x8*)(kb + d0 * 2048 + 512);
                p0 = __builtin_amdgcn_mfma_f32_32x32x16_bf16(a0, qr[d0], p0, 0, 0, 0);
                p1 = __builtin_amdgcn_mfma_f32_32x32x16_bf16(a1, qr[d0], p1, 0, 0, 0);
            }
#pragma unroll
            for (int r = 0; r < 16; ++r) { p0[r] = __builtin_amdgcn_rcpf(1.0f + __builtin_amdgcn_exp2f(p0[r])); p1[r] = __builtin_amdgcn_rcpf(1.0f + __builtin_amdgcn_exp2f(p1[r])); }
            if (k0 + 63 >= qw0) {
                const int tq = qw0 + r32 - k0 - 4 * hi;
#pragma unroll
                for (int r = 0; r < 16; ++r) { const int kv = (r & 3) + 8 * (r >> 2); if (kv >= tq) p0[r] = 1.0f; if (kv + 32 >= tq) p1[r] = 1.0f; }
            }
            float gm[8], gp[8];
#pragma unroll
            for (int i = 0; i < 4; ++i) { gm[i] = (p0[4 * i] * p0[4 * i + 1]) * (p0[4 * i + 2] * p0[4 * i + 3]); gm[4 + i] = (p1[4 * i] * p1[4 * i + 1]) * (p1[4 * i + 2] * p1[4 * i + 3]); }
#pragma unroll
            for (int i = 0; i < 8; ++i) gp[i] = xhalf(gm[i]);
            float run = R, E[8];
#pragma unroll
            for (int i = 7; i >= 0; --i) {
                const float pre = hi ? 1.0f : gp[i], post = hi ? gp[i] : 1.0f;
                run *= pre; E[i] = run; run *= gm[i]; run *= post;
            }
            R = run;
#pragma unroll
            for (int i = 0; i < 4; ++i) {
                { float X = E[i];
#pragma unroll
                  for (int j = 3; j >= 0; --j) { const float s = p0[4 * i + j] * X; p0[4 * i + j] = X - s; X = s; } }
                { float X = E[4 + i];
#pragma unroll
                  for (int j = 3; j >= 0; --j) { const float s = p1[4 * i + j] * X; p1[4 * i + j] = X - s; X = s; } }
            }
            const bf16x8 pa0 = pack8(p0, 0), pa1 = pack8(p0, 8), pa2 = pack8(p1, 0), pa3 = pack8(p1, 8);
            const LAS unsigned char* vp = lds + AT_V + slot + vb;
#pragma unroll
            for (int d0 = 0; d0 < 2; ++d0) {
                f32x16 acc = d0 ? o1 : o0;
                acc = __builtin_amdgcn_mfma_f32_32x32x16_bf16(pa0, cat8(tr16(vp + d0 * 4096), tr16(vp + d0 * 4096 + 512)), acc, 0, 0, 0);
                acc = __builtin_amdgcn_mfma_f32_32x32x16_bf16(pa1, cat8(tr16(vp + d0 * 4096 + 1024), tr16(vp + d0 * 4096 + 1024 + 512)), acc, 0, 0, 0);
                acc = __builtin_amdgcn_mfma_f32_32x32x16_bf16(pa2, cat8(tr16(vp + d0 * 4096 + 2048), tr16(vp + d0 * 4096 + 2048 + 512)), acc, 0, 0, 0);
                acc = __builtin_amdgcn_mfma_f32_32x32x16_bf16(pa3, cat8(tr16(vp + d0 * 4096 + 3072), tr16(vp + d0 * 4096 + 3072 + 512)), acc, 0, 0, 0);
                if (d0) o1 = acc; else o0 = acc;
            }
            { const int allz = __all(R == 0.0f) ? 1 : 0; if (lane == 0) *(LAS int*)(lds + AT_FLAG + wid * 4) = allz; wz = allz != 0; }
        }
    }
    { LAS unsigned short* stg = (LAS unsigned short*)(lds + AT_OST + wid * 4096);
#pragma unroll
      for (int r = 0; r < 16; ++r) { const int orow = crow(r, hi); stg[orow * 64 + r32] = (unsigned short)f2bf(o0[r]); stg[orow * 64 + 32 + r32] = (unsigned short)f2bf(o1[r]); }
      LDS_WAIT();
      bf16_t* Ow = O + (rowbase + qw0) * SBW + h * SBD;
#pragma unroll
      for (int i = 0; i < 4; ++i) { const int row = i * 8 + (lane >> 3), ch = lane & 7; const u32x4 v = *(const LAS u32x4*)((LAS unsigned char*)stg + row * 128 + ch * 16); *(u32x4*)(Ow + (size_t)row * SBW + ch * 8) = v; } }
}

constexpr int HP_RD = 272, HP_TR = 320;
constexpr int HL_QT = 0, HL_KH = HL_QT + 64 * HP_RD, HL_KD = HL_KH + 64 * HP_RD, HL_VT = HL_KD + 64 * HP_TR, HL_SB = HL_VT + 64 * HP_TR, HL_DEC = HL_SB + 128 * HP_TR, HL_SEG = HL_DEC + 512, HL_END = HL_SEG + 8 * 128 * 4;
static_assert(HL_END <= LDS_SCRATCH, "HGRN LDS map");
constexpr int HG_GROUPS = 8, HG_CHUNKS = SEQ / 64 / HG_GROUPS;
#define LDS_BAR() asm volatile("s_waitcnt lgkmcnt(0)\n\ts_barrier" ::: "memory")
__device__ __forceinline__ void hgrn_unit_a(const bf16_t* HQ, const bf16_t* HK, const float* LOGF, const bf16_t* HV, float* ORAW, bf16_t* QC, float* DS, float* DG, int unit, LAS unsigned char* lds, int tid, int lane, int wid) {
    const int bh = unit >> 3, g = unit & 7, b = bh >> 2, hh = bh & 3, r32 = lane & 31, hi = lane >> 5, tb = wid >> 2, vj = wid & 3;
    const size_t row0 = (size_t)b * SEQ + (size_t)g * (SEQ / HG_GROUPS); const int cb = hh * HGD;
    const int kp = lane, seg = wid;
    const int vr = tid >> 3, vp8 = tid & 7;
    for (int i = tid; i < 128 * HP_TR / 16; i += NTHREADS) *(LAS u32x4*)(lds + HL_SB + i * 16) = (u32x4){0u, 0u, 0u, 0u};
    f32x16 S0 = {}, S1 = {};
    float gb0 = 0.f, gb1 = 0.f;
    f32x2_t lf[8]; unsigned qv[8], kv[8]; u32x4 vv0, vv1;
#define HG_LOAD(c) do { const size_t base_ = (row0 + (size_t)(c) * 64 + 8 * seg) * HGW + cb + 2 * kp; \
        _Pragma("unroll") for (int i = 0; i < 8; ++i) { lf[i] = *(const f32x2_t*)(LOGF + base_ + (size_t)i * HGW); qv[i] = *(const unsigned*)(HQ + base_ + (size_t)i * HGW); kv[i] = *(const unsigned*)(HK + base_ + (size_t)i * HGW); } \
        const bf16_t* vsrc_ = HV + (row0 + (size_t)(c) * 64 + vr) * HGW + cb + vp8 * 16; vv0 = *(const u32x4*)vsrc_; vv1 = *(const u32x4*)(vsrc_ + 8); } while (0)
    HG_LOAD(0);
    for (int c = 0; c < HG_CHUNKS; ++c) {
        float cs0[8], cs1[8]; { float a0 = 0.f, a1 = 0.f;
#pragma unroll
            for (int i = 0; i < 8; ++i) { a0 += lf[i].x; a1 += lf[i].y; cs0[i] = a0; cs1[i] = a1; } }
        *(LAS f32x2_t*)(lds + HL_SEG + (seg * 128 + 2 * kp) * 4) = (f32x2_t){cs0[7], cs1[7]};
        *(LAS u32x4*)(lds + HL_VT + vr * HP_TR + vp8 * 32) = vv0; *(LAS u32x4*)(lds + HL_VT + vr * HP_TR + vp8 * 32 + 16) = vv1;
        LDS_BAR();
        { float pre0 = 0.f, pre1 = 0.f, bl0 = 0.f, bl1 = 0.f;
#pragma unroll
          for (int s2 = 0; s2 < 8; ++s2) { const f32x2_t t = *(const LAS f32x2_t*)(lds + HL_SEG + (s2 * 128 + 2 * kp) * 4); if (s2 < seg) { pre0 += t.x; pre1 += t.y; } bl0 += t.x; bl1 += t.y; }
          if (seg == 0) *(LAS f32x2_t*)(lds + HL_DEC + 2 * kp * 4) = (f32x2_t){__builtin_amdgcn_exp2f(bl0 * LOG2E), __builtin_amdgcn_exp2f(bl1 * LOG2E)};
          const size_t qcb = (row0 + (size_t)c * 64 + 8 * seg) * HGW + cb + 2 * kp;
          const float eB0 = __builtin_amdgcn_exp2f(bl0 * LOG2E), eB1 = __builtin_amdgcn_exp2f(bl1 * LOG2E), eG0 = __builtin_amdgcn_exp2f(fmaxf(gb0 * LOG2E, -120.f)), eG1 = __builtin_amdgcn_exp2f(fmaxf(gb1 * LOG2E, -120.f));
#pragma unroll
          for (int i = 0; i < 8; ++i) { const int t = 8 * seg + i;
              const float bb0 = (pre0 + cs0[i]) * LOG2E, bb1 = (pre1 + cs1[i]) * LOG2E, q0 = bflo(qv[i]), q1 = bfhi(qv[i]), k0 = bflo(kv[i]), k1 = bfhi(kv[i]);
              const float qe0 = q0 * __builtin_amdgcn_exp2f(fmaxf(bb0, -120.f)), qe1 = q1 * __builtin_amdgcn_exp2f(fmaxf(bb1, -120.f)), ke0 = k0 * __builtin_amdgcn_exp2f(fminf(-bb0, 120.f)), ke1 = k1 * __builtin_amdgcn_exp2f(fminf(-bb1, 120.f));
              *(LAS unsigned*)(lds + HL_QT + t * HP_RD + kp * 4) = pg8::cvt_pk_bf16(qe0, qe1);
              *(LAS unsigned*)(lds + HL_KH + t * HP_RD + kp * 4) = pg8::cvt_pk_bf16(ke0, ke1);
              *(LAS unsigned*)(lds + HL_KD + t * HP_TR + kp * 4) = pg8::cvt_pk_bf16(ke0 * eB0, ke1 * eB1);
              if (g > 0) *(unsigned*)(QC + qcb + (size_t)i * HGW) = pg8::cvt_pk_bf16(qe0 * eG0, qe1 * eG1); }
          gb0 += bl0; gb1 += bl1; }
        if (c + 1 < HG_CHUNKS) HG_LOAD(c + 1);
        LDS_BAR();
        f32x16 oacc = {};
        bf16x8 pa[2][2];
#pragma unroll
        for (int a = 0; a < 2; ++a) if (a <= tb) {
            f32x16 x = {};
#pragma unroll
            for (int ks = 0; ks < 8; ++ks) {
                const bf16x8 af = *(const LAS bf16x8*)(lds + HL_KH + (32 * a + r32) * HP_RD + (16 * ks + 8 * hi) * 2);
                const bf16x8 bfr = *(const LAS bf16x8*)(lds + HL_QT + (32 * tb + r32) * HP_RD + (16 * ks + 8 * hi) * 2);
                x = __builtin_amdgcn_mfma_f32_32x32x16_bf16(af, bfr, x, 0, 0, 0);
            }
            if (a == tb) {
#pragma unroll
                for (int r = 0; r < 16; ++r) if (crow(r, hi) > r32) x[r] = 0.f;
            }
            pa[a][0] = pack8(x, 0); pa[a][1] = pack8(x, 8);
        }
#pragma unroll
        for (int ks = 0; ks < 8; ++ks) {
            const bf16x8 af = *(const LAS bf16x8*)(lds + HL_QT + (32 * tb + r32) * HP_RD + (16 * ks + 8 * hi) * 2);
            const LAS unsigned char* sp = lds + HL_SB + (16 * ks + 8 * hi + ((lane & 15) >> 2)) * HP_TR + (32 * vj + 16 * ((lane >> 4) & 1) + 4 * (lane & 3)) * 2;
            oacc = __builtin_amdgcn_mfma_f32_32x32x16_bf16(af, cat8(tr16(sp), tr16(sp + 4 * HP_TR)), oacc, 0, 0, 0);
        }
#pragma unroll
        for (int a = 0; a < 2; ++a) if (a <= tb) {
#pragma unroll
            for (int s2 = 0; s2 < 2; ++s2) {
                const LAS unsigned char* vp = lds + HL_VT + (32 * a + 16 * s2 + 4 * hi + ((lane & 15) >> 2)) * HP_TR + (32 * vj + 16 * ((lane >> 4) & 1) + 4 * (lane & 3)) * 2;
                oacc = __builtin_amdgcn_mfma_f32_32x32x16_bf16(pa[a][s2], cat8(tr16(vp), tr16(vp + 8 * HP_TR)), oacc, 0, 0, 0);
            }
        }
#pragma unroll
        for (int u = 0; u < 2; ++u) {
            f32x16 Sx = u ? S1 : S0; const int kt = 2 * tb + u;
            const LAS float* dec = (const LAS float*)(lds + HL_DEC) + 32 * kt;
#pragma unroll
            for (int r = 0; r < 16; ++r) Sx[r] *= dec[crow(r, hi)];
#pragma unroll
            for (int ks = 0; ks < 4; ++ks) {
                const int srow = 16 * ks + 8 * hi + ((lane & 15) >> 2), cq = 16 * ((lane >> 4) & 1) + 4 * (lane & 3);
                const LAS unsigned char* ap = lds + HL_KD + srow * HP_TR + (32 * kt + cq) * 2;
                const LAS unsigned char* bp = lds + HL_VT + srow * HP_TR + (32 * vj + cq) * 2;
                Sx = __builtin_amdgcn_mfma_f32_32x32x16_bf16(cat8(tr16(ap), tr16(ap + 4 * HP_TR)), cat8(tr16(bp), tr16(bp + 4 * HP_TR)), Sx, 0, 0, 0);
            }
            if (u) S1 = Sx; else S0 = Sx;
        }
        { float* op = ORAW + (row0 + (size_t)c * 64 + 32 * tb) * HGW + cb + 32 * vj + r32;
#pragma unroll
          for (int r = 0; r < 16; ++r) op[(size_t)crow(r, hi) * HGW] = oacc[r]; }
        LDS_BAR();
        if (c + 1 < HG_CHUNKS) {
#pragma unroll
            for (int u = 0; u < 2; ++u) { const f32x16 Sx = u ? S1 : S0; const int kt = 2 * tb + u;
#pragma unroll
                for (int r = 0; r < 16; ++r) *(LAS unsigned short*)(lds + HL_SB + (32 * kt + crow(r, hi)) * HP_TR + (32 * vj + r32) * 2) = (unsigned short)f2bf(Sx[r]); }
        }
    }
#undef HG_LOAD
    if (g + 1 < HG_GROUPS) {
        float* ds = DS + (size_t)unit * (HGD * HGD);
#pragma unroll
        for (int u = 0; u < 2; ++u) { const f32x16 Sx = u ? S1 : S0; const int kt = 2 * tb + u;
#pragma unroll
            for (int r = 0; r < 16; ++r) ds[(32 * kt + crow(r, hi)) * HGD + 32 * vj + r32] = Sx[r]; }
        if (seg == 0) *(f32x2_t*)(DG + (size_t)unit * HGD + 2 * kp) = (f32x2_t){__builtin_amdgcn_exp2f(gb0 * LOG2E), __builtin_amdgcn_exp2f(gb1 * LOG2E)};
    }
    LDS_BAR();
}
__device__ __forceinline__ void hgrn_unit_b(const float* ORAW, const bf16_t* QC, const float* DS, const float* DG, const bf16_t* HG, const float* norm_g, bf16_t* OHG, int unit, LAS unsigned char* lds, int tid, int lane, int wid) {
    const int bh = unit >> 3, g = unit & 7, b = bh >> 2, hh = bh & 3, r32 = lane & 31, hi = lane >> 5;
    const size_t tok0 = (size_t)b * SEQ + (size_t)g * (SEQ / HG_GROUPS) + 32 * wid; const int cb = hh * HGD;
    if (g > 0) {
        { float S[32];
#pragma unroll
          for (int i = 0; i < 32; ++i) S[i] = 0.f;
          const int k = tid >> 2;
          for (int g2 = 0; g2 < g; ++g2) { const float* ds = DS + (size_t)(bh * 8 + g2) * (HGD * HGD) + tid * 32; const float d = DG[(size_t)(bh * 8 + g2) * HGD + k];
#pragma unroll
              for (int j = 0; j < 8; ++j) { const f32x4 x = *(const f32x4*)(ds + 4 * j);
#pragma unroll
                  for (int t = 0; t < 4; ++t) S[4 * j + t] = d * S[4 * j + t] + x[t]; } }
#pragma unroll
          for (int j = 0; j < 4; ++j) { u32x4 w; w.x = pg8::cvt_pk_bf16(S[8 * j], S[8 * j + 1]); w.y = pg8::cvt_pk_bf16(S[8 * j + 2], S[8 * j + 3]); w.z = pg8::cvt_pk_bf16(S[8 * j + 4], S[8 * j + 5]); w.w = pg8::cvt_pk_bf16(S[8 * j + 6], S[8 * j + 7]);
              *(LAS u32x4*)(lds + HL_SB + k * HP_TR + (tid & 3) * 64 + j * 16) = w; } }
        LDS_BAR();
    }
    asm volatile("" ::: "memory");
    f32x16 acc[4];
#pragma unroll
    for (int vj = 0; vj < 4; ++vj)
#pragma unroll
        for (int r = 0; r < 16; ++r) acc[vj][r] = ORAW[(tok0 + crow(r, hi)) * HGW + cb + 32 * vj + r32];
    if (g > 0) {
#pragma unroll
        for (int ks = 0; ks < 8; ++ks) {
            const bf16x8 af = *(const bf16x8*)(QC + (tok0 + r32) * HGW + cb + 16 * ks + 8 * hi);
#pragma unroll
            for (int vj = 0; vj < 4; ++vj) {
                const LAS unsigned char* sp = lds + HL_SB + (16 * ks + 8 * hi + ((lane & 15) >> 2)) * HP_TR + (32 * vj + 16 * ((lane >> 4) & 1) + 4 * (lane & 3)) * 2;
                acc[vj] = __builtin_amdgcn_mfma_f32_32x32x16_bf16(af, cat8(tr16(sp), tr16(sp + 4 * HP_TR)), acc[vj], 0, 0, 0);
            }
        }
    }
    float ng[4];
#pragma unroll
    for (int vj = 0; vj < 4; ++vj) ng[vj] = norm_g[cb + 32 * vj + r32];
#pragma unroll
    for (int rb = 0; rb < 16; rb += MK_PB_GROWS) {
        bf16_t hgv[MK_PB_GROWS][4];
#pragma unroll
        for (int r2 = 0; r2 < MK_PB_GROWS; ++r2) { const size_t ro = (tok0 + crow(rb + r2, hi)) * HGW + cb + r32;
#pragma unroll
            for (int vj = 0; vj < 4; ++vj) hgv[r2][vj] = HG[ro + 32 * vj]; }
#pragma unroll
        for (int r2 = 0; r2 < MK_PB_GROWS; ++r2) { const int r = rb + r2;
            float ss = (acc[0][r] * acc[0][r] + acc[1][r] * acc[1][r]) + (acc[2][r] * acc[2][r] + acc[3][r] * acc[3][r]);
            ss = row16_sum(ss); ss += __shfl_xor(ss, 16);
            const float rs = __builtin_amdgcn_rsqf(ss * (1.0f / HGD) + RMS_EPS);
            const size_t ro = (tok0 + crow(r, hi)) * HGW + cb + r32;
#pragma unroll
            for (int vj = 0; vj < 4; ++vj) OHG[ro + 32 * vj] = (bf16_t)f2bf(acc[vj][r] * rs * ng[vj] * bf2f(hgv[r2][vj]));
        }
        asm volatile("" ::: "memory");
    }
    LDS_BAR();
}

constexpr int TROW = 2064;
constexpr int L_TILE = 0, L_LOGITS = 64 * TROW, L_TOPI = L_LOGITS + 64 * 32 * 4, L_HIST = L_TOPI + 1024, L_SLOT = L_HIST + 128, L_TOT = L_SLOT + 1024, L_BEF = L_TOT + 128, L_PAD = L_BEF + 128, L_PART = L_PAD + 256, L_END5 = L_PART + 2 * 16 * 32 * 4;
static_assert(L_END5 <= LDS_SCRATCH, "P5/P6 LDS map");
__device__ __forceinline__ void phase_ln1_router(const Args& A, LAS unsigned char* lds, int vb, int tid, int lane, int wave) {
    unsigned char* ws = A.ws;
    const bf16_t* PRE = (const bf16_t*)(ws + WS_PRE); float* STATS = (float*)(ws + WS_H); const float* g = A.in[7]; const float* bta = A.in[8];
    LAS int* HIST = (LAS int*)(lds + L_HIST);
    if (tid < NEXP) HIST[tid] = 0;
    u32x4 pp[8][2];
#pragma unroll
    for (int rr = 0; rr < 8; ++rr)
#pragma unroll
        for (int h = 0; h < 2; ++h) pp[rr][h] = *(const u32x4*)(PRE + (size_t)(vb * 64 + wave * 8 + rr) * DM + lane * 8 + 512 * h);
    f32x4 gq[4], bq[4];
#pragma unroll
    for (int j = 0; j < 4; ++j) { const int c = lane * 8 + 512 * (j >> 1) + 4 * (j & 1); gq[j] = *(const f32x4*)(g + c); bq[j] = *(const f32x4*)(bta + c); }
    bf16x8 rwf[16];
    { const bf16_t* RWT = (const bf16_t*)(ws + WS_RWT); const int kq = wave >> 1, r = lane & 31, hh = lane >> 5;
#pragma unroll
      for (int ks = 0; ks < 16; ++ks) rwf[ks] = *(const bf16x8*)(RWT + (size_t)r * DM + 256 * kq + 16 * ks + 8 * hh); }
#pragma unroll
    for (int rr = 0; rr < 8; ++rr) {
        const int rl = wave * 8 + rr, row = vb * 64 + rl;
        f32x4 v[4]; float s = 0.f;
#pragma unroll
        for (int j = 0; j < 4; ++j) { const u32x4 q = pp[rr][j >> 1]; const unsigned px = (j & 1) ? q.z : q.x, py = (j & 1) ? q.w : q.y; v[j] = (f32x4){bflo(px), bfhi(px), bflo(py), bfhi(py)}; s += (v[j][0] + v[j][1]) + (v[j][2] + v[j][3]); }
        const float mean = wave_sum(s) * (1.0f / DM); float s2 = 0.f;
#pragma unroll
        for (int j = 0; j < 4; ++j) { v[j] = v[j] - mean; s2 += (v[j][0] * v[j][0] + v[j][1] * v[j][1]) + (v[j][2] * v[j][2] + v[j][3] * v[j][3]); }
        const float rstd = __builtin_amdgcn_rsqf(wave_sum(s2) * (1.0f / DM) + LN_EPS);
        if (lane == 0) *(f32x2_t*)(STATS + (size_t)row * 2) = (f32x2_t){mean, rstd};
#pragma unroll
        for (int h = 0; h < 2; ++h) { const f32x4 ha = v[2 * h] * rstd * gq[2 * h] + bq[2 * h], hb = v[2 * h + 1] * rstd * gq[2 * h + 1] + bq[2 * h + 1];
            u32x4 w; w.x = pk2(ha[0], ha[1]); w.y = pk2(ha[2], ha[3]); w.z = pk2(hb[0], hb[1]); w.w = pk2(hb[2], hb[3]); *(LAS u32x4*)(lds + L_TILE + rl * TROW + (lane * 8 + 512 * h) * 2) = w; }
    }
    LDS_BAR();
    {
        const int rt = wave & 1, kq = wave >> 1, r = lane & 31, hh = lane >> 5;
        const bf16_t* RWT = (const bf16_t*)(ws + WS_RWT);
        f32x16 acc = {};
#pragma unroll
        for (int ks = 0; ks < 16; ++ks) {
            const int k = 256 * kq + 16 * ks + 8 * hh;
            const bf16x8 af = *(const LAS bf16x8*)(lds + L_TILE + (32 * rt + r) * TROW + k * 2);
            acc = __builtin_amdgcn_mfma_f32_32x32x16_bf16(af, rwf[ks], acc, 0, 0, 0);
        }
        (void)RWT;
        LAS float* LG = (LAS float*)(lds + L_LOGITS);
        for (int q = 0; q < 4; ++q) {
            if (kq == q) {
#pragma unroll
                for (int i = 0; i < 16; ++i) { const int rowl = 32 * rt + (i & 3) + 8 * (i >> 2) + 4 * hh; LAS float* p = LG + rowl * 32 + r; if (q == 0) *p = acc[i]; else *p += acc[i]; }
            }
            LDS_BAR();
        }
    }
    {
        const float* rb = A.in[10]; float* TOPG = (float*)(ws + WS_TOPG); LAS int* TOPI = (LAS int*)(lds + L_TOPI); const LAS float* LG = (const LAS float*)(lds + L_LOGITS);
        const int el = lane & 15, rg = lane >> 4; const float rb0 = rb[el], rb1 = rb[el + 16];
#pragma unroll
        for (int it = 0; it < 2; ++it) {
            const int rl = wave * 8 + it * 4 + rg;
            float val0 = LG[rl * 32 + el] + rb0, val1 = LG[rl * 32 + el + 16] + rb1; float tv[4]; int ti[4];
#pragma unroll
            for (int rnk = 0; rnk < 4; ++rnk) {
                float bv = val0; int bi = el;
#define TOPK_STEP(OV, OI) do { const float ov = (OV); const int oi = (OI); if (ov > bv || (ov == bv && oi < bi)) { bv = ov; bi = oi; } } while (0)
                TOPK_STEP(val1, el + 16);
                TOPK_STEP(dpp_f<0xB1>(bv), __builtin_amdgcn_update_dpp(0, bi, 0xB1, 0xF, 0xF, false)); TOPK_STEP(dpp_f<0x4E>(bv), __builtin_amdgcn_update_dpp(0, bi, 0x4E, 0xF, 0xF, false));
                TOPK_STEP(dpp_f<0x141>(bv), __builtin_amdgcn_update_dpp(0, bi, 0x141, 0xF, 0xF, false)); TOPK_STEP(dpp_f<0x140>(bv), __builtin_amdgcn_update_dpp(0, bi, 0x140, 0xF, 0xF, false));
#undef TOPK_STEP
                tv[rnk] = bv; ti[rnk] = bi; if (bi == el) val0 = -INFINITY; if (bi == el + 16) val1 = -INFINITY;
            }
            if (el == 0) {
                const float e1 = expf(tv[1] - tv[0]), e2 = expf(tv[2] - tv[0]), e3 = expf(tv[3] - tv[0]), inv = 1.0f / (1.0f + e1 + e2 + e3);
                *(float4*)(TOPG + (size_t)(vb * 64 + rl) * 4) = make_float4(inv, e1 * inv, e2 * inv, e3 * inv);
#pragma unroll
                for (int k = 0; k < 4; ++k) { TOPI[rl * 4 + k] = ti[k]; __hip_atomic_fetch_add(&HIST[ti[k]], 1, __ATOMIC_RELAXED, __HIP_MEMORY_SCOPE_WORKGROUP); }
            }
        }
    }
    LDS_BAR();
    if (tid < NEXP) ((int*)(ws + WS_CNTM))[vb * NEXP + tid] = HIST[tid];
}
__device__ __forceinline__ void phase_assign(const Args& A, LAS unsigned char* lds, int vb, int G, int tid, int lane, int wave) {
    unsigned char* ws = A.ws; const int* CNTM = (const int*)(ws + WS_CNTM); int* ctl = (int*)(ws + WS_CTL);
    LAS int* PART = (LAS int*)(lds + L_PART); LAS int* TOT = (LAS int*)(lds + L_TOT); LAS int* BEF = (LAS int*)(lds + L_BEF); LAS int* PAD = (LAS int*)(lds + L_PAD);
    LAS int* TOPI = (LAS int*)(lds + L_TOPI); LAS int* SLOT = (LAS int*)(lds + L_SLOT);
    { const int e = tid & 31, part = tid >> 5; int tot = 0, bef = 0;
      int cv[16];
#pragma unroll
      for (int q = 0; q < 16; ++q) { const int b2 = part * 16 + q; cv[q] = CNTM[(b2 < G ? b2 : G - 1) * NEXP + e]; }
#pragma unroll
      for (int q = 0; q < 16; ++q) { const int b2 = part * 16 + q; const int c = (b2 < G) ? cv[q] : 0; tot += c; if (b2 < vb) bef += c; }
      PART[part * 32 + e] = tot; PART[512 + part * 32 + e] = bef; }
    LDS_BAR();
    if (tid < NEXP) { int tot = 0, bef = 0;
#pragma unroll
        for (int p = 0; p < 16; ++p) { tot += PART[p * 32 + tid]; bef += PART[512 + p * 32 + tid]; }
        TOT[tid] = tot; BEF[tid] = bef; }
    LDS_BAR();
    if (tid < 64) {
        const int te = (tid < NEXP) ? (TOT[tid & 31] + SLOT_PAD - 1) / SLOT_PAD : 0; int inc = te;
#pragma unroll
        for (int d = 1; d < 32; d <<= 1) { const int o = __shfl_up(inc, d); if ((tid & 63) >= d) inc += o; }
        const int tb = inc - te;
        if (tid < NEXP) { PAD[tid] = tb * SLOT_PAD; if (vb == 0) for (int i = 0; i < te; ++i) ctl[CW_TILEEXP + tb + i] = tid; }
        if (vb == 0 && tid == NEXP - 1) ctl[CW_NTILES] = inc; }
    LDS_BAR();
    if (tid < 256) { const int e = TOPI[tid]; int rank = 0; for (int j = 0; j < tid; ++j) rank += (TOPI[j] == e) ? 1 : 0;
        const int slot = PAD[e] + BEF[e] + rank; SLOT[tid] = slot; ((int*)(ws + WS_DEST))[vb * 256 + tid] = slot;
#if MK_GATHER_A
        ((int*)(ws + WS_SLOTTOK))[slot] = vb * 64 + (tid >> 2);
#endif
    }
    LDS_BAR();
    bf16_t* XS = (bf16_t*)(ws + WS_XS);
#if MK_GATHER_A
#pragma unroll
    for (int rq = 0; rq < 8; ++rq) { const int r = wave * 8 + rq;
        const int i = 4 * r; const int slot = vb * 64 + r; const LAS unsigned char* src = lds + L_TILE + (i >> 2) * TROW; unsigned char* dst = (unsigned char*)(XS + (size_t)slot * DM);
#else
    for (int i = wave * 32; i < wave * 32 + 32; ++i) {
        const int slot = SLOT[i]; const LAS unsigned char* src = lds + L_TILE + (i >> 2) * TROW; unsigned char* dst = (unsigned char*)(XS + (size_t)slot * DM);
#endif
#if MK_FP8_UP
        { const u32x4 a = *(const LAS u32x4*)(src + lane * 32), b = *(const LAS u32x4*)(src + lane * 32 + 16); u32x4 o;
          o.x = pk4_fp8(bflo(a.x), bfhi(a.x), bflo(a.y), bfhi(a.y)); o.y = pk4_fp8(bflo(a.z), bfhi(a.z), bflo(a.w), bfhi(a.w)); o.z = pk4_fp8(bflo(b.x), bfhi(b.x), bflo(b.y), bfhi(b.y)); o.w = pk4_fp8(bflo(b.z), bfhi(b.z), bflo(b.w), bfhi(b.w));
          *(u32x4*)((unsigned char*)(ws + WS_XS) + (size_t)slot * DM + lane * 16) = o; (void)dst; }
#else
        const u32x4 a = *(const LAS u32x4*)(src + lane * 16), b = *(const LAS u32x4*)(src + 1024 + lane * 16);
        *(u32x4*)(dst + lane * 16) = a; *(u32x4*)(dst + 1024 + lane * 16) = b;
#endif
    }
}
template <int NR> __device__ __forceinline__ void combine_rows(const Args& A, int row0, int rstep, int lane, const float* g1p, const float* b1p, const f32x4 (&g2)[4], const f32x4 (&b2)[4]) {
    unsigned char* ws = A.ws; const bf16_t* PRE = (const bf16_t*)(ws + WS_PRE); const unsigned char* Y = (const unsigned char*)(ws + WS_Y);
    f32x2_t st[NR]; int4 d[NR]; float4 gt[NR]; u32x4 p[NR][2]; u32x2 y[NR][2][4];
    f32x4 g1[4], b1[4];
#pragma unroll
    for (int j = 0; j < 4; ++j) { const int c = lane * 8 + 512 * (j >> 1) + 4 * (j & 1); g1[j] = *(const f32x4*)(g1p + c); b1[j] = *(const f32x4*)(b1p + c); }
#pragma unroll
    for (int q = 0; q < NR; ++q) { const int row = row0 + q * rstep; st[q] = *(const f32x2_t*)((const float*)(ws + WS_H) + (size_t)row * 2); d[q] = *(const int4*)((const int*)(ws + WS_DEST) + row * 4); gt[q] = *(const float4*)((const float*)(ws + WS_TOPG) + row * 4);
#pragma unroll
        for (int h = 0; h < 2; ++h) p[q][h] = *(const u32x4*)(PRE + (size_t)row * DM + lane * 8 + 512 * h); }
#pragma unroll
    for (int q = 0; q < NR; ++q) { const int ds[4] = {d[q].x, d[q].y, d[q].z, d[q].w};
#pragma unroll
        for (int h = 0; h < 2; ++h)
#pragma unroll
            for (int k = 0; k < 4; ++k) y[q][h][k] = *(const u32x2*)(Y + (size_t)ds[k] * DM + lane * 8 + 512 * h); }
#pragma unroll
    for (int q = 0; q < NR; ++q) { const int row = row0 + q * rstep;
        const float gs[4] = {gt[q].x * (1.0f / Y8_SCALE), gt[q].y * (1.0f / Y8_SCALE), gt[q].z * (1.0f / Y8_SCALE), gt[q].w * (1.0f / Y8_SCALE)};
        f32x4 v[4]; float s = 0.f;
#pragma unroll
        for (int j = 0; j < 4; ++j) { const int h = j >> 1; const unsigned pa = (j & 1) ? p[q][h].z : p[q][h].x, pb = (j & 1) ? p[q][h].w : p[q][h].y;
            f32x4 a = (((f32x4){bflo(pa), bfhi(pa), bflo(pb), bfhi(pb)} - st[q][0]) * st[q][1] * g1[j] + b1[j]) * DN_ALPHA;
#pragma unroll
            for (int k = 0; k < 4; ++k) { const unsigned yw = (j & 1) ? y[q][h][k].y : y[q][h][k].x; const f32x2_t y01 = __builtin_amdgcn_cvt_pk_f32_fp8(yw, false), y23 = __builtin_amdgcn_cvt_pk_f32_fp8(yw, true);
                a[0] += gs[k] * y01[0]; a[1] += gs[k] * y01[1]; a[2] += gs[k] * y23[0]; a[3] += gs[k] * y23[1]; }
            v[j] = a; s += (a[0] + a[1]) + (a[2] + a[3]); }
        const float mean = wave_sum(s) * (1.0f / DM); float s2 = 0.f;
#pragma unroll
        for (int j = 0; j < 4; ++j) { v[j] = v[j] - mean; s2 += (v[j][0] * v[j][0] + v[j][1] * v[j][1]) + (v[j][2] * v[j][2] + v[j][3] * v[j][3]); }
        const float rstd = __builtin_amdgcn_rsqf(wave_sum(s2) * (1.0f / DM) + LN_EPS);
#pragma unroll
        for (int j = 0; j < 4; ++j) { const int c = lane * 8 + 512 * (j >> 1) + 4 * (j & 1); *(f32x4*)(A.out + (size_t)row * DM + c) = v[j] * rstd * g2[j] + b2[j]; }
    }
}

template <bool BG, class ArgsT> __device__ __forceinline__ void xcd_barrier_bg(const XcdBarrier& b, const ArgsT& A, LAS unsigned char* lds, volatile LAS unsigned* MISC) {
    const int wave = __builtin_amdgcn_readfirstlane(threadIdx.x >> 6), lane = threadIdx.x & 63;
    const unsigned e0 = MISC[10];
    asm volatile("s_waitcnt vmcnt(0)" ::: "memory");
    __syncthreads();
    if (wave == 0) {
        if (threadIdx.x == 0) {
            unsigned* bar = b.bar;
            __builtin_amdgcn_s_waitcnt(0);
            unsigned nloc = b.st[0], nx = b.st[1];
            if (nloc == 0u) { xcd_barrier_complete(bar, b.x, nloc, nx); b.st[0] = nloc; b.st[1] = nx; }
            const unsigned old = xb_add(&bar[XB_XSUB(b.x)], 1u);
            const unsigned gen = old / nloc;
            if (old + 1u == (gen + 1u) * nloc) {
                __builtin_amdgcn_fence(__ATOMIC_RELEASE, "agent");
                asm volatile("s_waitcnt vmcnt(0)" ::: "memory");
                const unsigned og = xb_add(&bar[XB_TOP], 1u);
                const unsigned tg = og / nx;
                if (og + 1u == (tg + 1u) * nx) xb_add(&bar[XB_TOPGEN], 1u);
                else XB_SPIN(xb_ld(&bar[XB_TOPGEN]) == tg, bar);
                __builtin_amdgcn_fence(__ATOMIC_ACQUIRE, "");
                xb_add(&bar[XB_XGEN(b.x)], 1u);
                asm volatile("s_waitcnt vmcnt(0)" ::: "memory");
            } else {
                XB_SPIN(xb_ld(&bar[XB_XGEN(b.x)]) == gen, bar);
                __builtin_amdgcn_fence(__ATOMIC_ACQUIRE, "");
                asm volatile("s_waitcnt vmcnt(0)" ::: "memory");
            }
            MISC[10] = e0 + 1u;
        }
    } else if (BG && wave <= MK_BG_WAVES) {
        volatile LAS int* st = (volatile LAS int*)(MISC + 16 + 2 * wave);
        LAS float* scr = (LAS float*)(lds + wave * 16384);
        while (MISC[10] == e0) { if (!bg_step(A, st, scr, lane, BG_TOTAL)) __builtin_amdgcn_s_sleep(16); }
    }
    __syncthreads();
}
__device__ __forceinline__ void bg_drain(const Args& A, LAS unsigned char* lds, volatile LAS unsigned* MISC, int limit) {
    const int wave = __builtin_amdgcn_readfirstlane(threadIdx.x >> 6), lane = threadIdx.x & 63;
    volatile LAS int* st = (volatile LAS int*)(MISC + 16 + 2 * wave);
    while (bg_step(A, st, (LAS float*)(lds + wave * 16384), lane, limit)) {}
}
template <int LO, int HI> __global__ void __launch_bounds__(NTHREADS, 2) mk_fwd(Args args) {
    extern __shared__ __attribute__((aligned(16))) unsigned char lds_raw[];
    LAS unsigned char* lds = (LAS unsigned char*)lds_raw;
    volatile LAS unsigned* MISC = (volatile LAS unsigned*)(lds + MISC_OFF);
    const int G = gridDim.x, bx = blockIdx.x, vcu = (G % 8 == 0) ? (bx % 8) * (G / 8) + bx / 8 : bx;
    const int NGW = G * NWAVES;
#define GW (vcu * NWAVES + wave)
    unsigned char* ws = args.ws;
    for (int u = threadIdx.x; u < (LDS_BYTES - LDSCTL_OFF) / 4; u += NTHREADS) ((LAS unsigned*)(lds + LDSCTL_OFF))[u] = 0u;
    __syncthreads();
    XcdBarrier bar = xcd_barrier_post((unsigned*)(ws + WS_CTL) + CW_BAR + args.li * XCD_BAR_WORDS, MISC + 8);
#define IN(k) (LO <= (k) && (k) < HI)
#if MK_PROBE
    unsigned long long ts[16]; ts[0] = __builtin_amdgcn_s_memrealtime();
#define TS(i) ts[i] = __builtin_amdgcn_s_memrealtime()
#else
#define TS(i) do { } while (0)
#endif
#if 1
#if MK_BG
#define SEAM(k) do { if constexpr (IN(k) && IN((k) + 1)) { \
        if constexpr ((k) == 7) { __syncthreads(); bg_drain(args, lds, MISC, BG_I_UP); } \
        if constexpr ((k) == 8) { TS(13); bg_drain(args, lds, MISC, BG_TOTAL); TS(14); } \
        if constexpr (((MK_BG_SEAMS) >> (k)) & 1) xcd_barrier_bg<true>(bar, args, lds, MISC); else xcd_barrier_bg<false>(bar, args, lds, MISC); } } while (0)
#else
#define SEAM(k) do { if constexpr (IN(k) && IN((k) + 1)) xcd_barrier(bar); } while (0)
#endif
#endif
    InProjOut ip; ip.Q = (bf16_t*)(ws + WS_Q); ip.K = (bf16_t*)(ws + WS_K); ip.V = (bf16_t*)(ws + WS_V); ip.HQ = (bf16_t*)(ws + WS_HQ); ip.HK = (bf16_t*)(ws + WS_HK); ip.HV = (bf16_t*)(ws + WS_HV);
    ip.HG = (bf16_t*)(ws + WS_HG); ip.GS = (bf16_t*)(ws + WS_GS); ip.GH = (bf16_t*)(ws + WS_GH); ip.LOGF = (float*)(ws + WS_LOGF); ip.lb = (const float*)(ws + WS_LB);

    if constexpr (IN(0)) { FRESH_IDS(); phase_prologue(args, lds, GW, NGW, lane, wave); }
#if MK_PROBE_CONV
    bg_drain(args, lds, MISC, BG_TOTAL);
#if MK_PROBE_CONV > 1
    xcd_barrier(bar);
    if (threadIdx.x == 0) __hip_atomic_store((int*)(ws + WS_CTL) + CW_BGQ, 0, __ATOMIC_RELAXED, __HIP_MEMORY_SCOPE_AGENT);
    { const int w_ = __builtin_amdgcn_readfirstlane(threadIdx.x >> 6); if ((threadIdx.x & 63) == 0) { MISC[16 + 2 * w_] = 0; MISC[17 + 2 * w_] = 0; } }
    xcd_barrier(bar);
    bg_drain(args, lds, MISC, BG_TOTAL);
#endif
#endif
    SEAM(0); TS(1);
    if constexpr (IN(1)) {
#if MK_FP8_GATES
      { pg8::Gemm g{DM}; pg8::DenseSched S; S.o.init(NTOK / 256, 12, G, bx, MK_WGM_P1A); S.A = (const char*)(ws + WS_XB); S.Bt = (const char*)(ws + WS_WINT); S.tstep = (size_t)256 * DM * 2;
        pg8::EpiInProjT<0> E{ip};
        pg8::gemm_phase<pg8::EpiInProjT<0>, pg8::DenseSched, true, true>(lds, g, S, E); }
      { pg8::Gemm g{DM / 2, 0x7f7f7f7f, W8_E8M0}; pg8::DenseSched S; S.o.init(NTOK / 256, 10, G, G - 1 - bx, MK_WGM_P1B); S.A = (const char*)(ws + WS_XB8);     S.Bt = (const char*)(ws + WS_WINT8); S.tstep = (size_t)256 * DM;
        pg8::EpiInProjT<12> E{ip};
        pg8::gemm_phase_f8<pg8::EpiInProjT<12>, pg8::DenseSched, true, true>(lds, g, S, E); }
#else
      { pg8::Gemm g{DM}; pg8::DenseSched S; S.o.init(NTOK / 256, INW / 256, G, bx); S.A = (const char*)(ws + WS_XB); S.Bt = (const char*)(ws + WS_WINT); S.tstep = (size_t)256 * DM * 2;
        pg8::EpiInProjT<0> E{ip};
        pg8::gemm_phase<pg8::EpiInProjT<0>, pg8::DenseSched, true, true>(lds, g, S, E); }
#endif
    }
    SEAM(1); TS(2);
    if constexpr (IN(2)) { _Pragma("unroll 1") for (int rp2_ = 0; rp2_ < MK_LOOP_P2; ++rp2_) { if (rp2_) xcd_barrier(bar); FRESH_IDS(); const int gw = GW; (void)gw; const int qw_ = rp2_;
#if MK_NAIVE_MIX
    { const int u = gw; if (u < 2048) attn_naive_unit(ip.Q, ip.K, ip.V, (bf16_t*)(ws + WS_OSB), u & 63, 31 - (u >> 6), lane); }
    __syncthreads();
    if (vcu < 8) hgrn_naive_block(ip.HQ, ip.HK, ip.LOGF, ip.HV, (float*)(ws + WS_ORAW), lds, vcu, tid);
#else
#define MK_P2_BODY(QW) \
    hgrn_unit_a(ip.HQ, ip.HK, ip.LOGF, ip.HV, (float*)(ws + WS_ORAW), (bf16_t*)(ws + WS_QC), (float*)(ws + WS_DS), (float*)(ws + WS_DG), vcu, lds, tid, lane, wave); TS(12); \
    for (;;) { \
        if (tid == 0) *(LAS int*)(lds + AT_Q) = __hip_atomic_fetch_add((int*)(ws + WS_CTL) + CW_ATTNQ + (QW), 1, __ATOMIC_RELAXED, __HIP_MEMORY_SCOPE_AGENT); \
        LDS_BAR(); \
        const int u = __builtin_amdgcn_readfirstlane(*(LAS int*)(lds + AT_Q)); \
        LDS_BAR(); \
        if (u >= 512) break; \
        attn_unit(ip.Q, ip.K, ip.V, (bf16_t*)(ws + WS_OSB), u & 63, 7 - (u >> 6), lds, lane, wave); \
    }
    MK_P2_BODY(qw_)
#if MK_DUP_P2 > 1
    xcd_barrier(bar);
#if MK_DUP_WHAT == 1
    hgrn_unit_a(ip.HQ, ip.HK, ip.LOGF, ip.HV, (float*)(ws + WS_ORAW), (bf16_t*)(ws + WS_QC), (float*)(ws + WS_DS), (float*)(ws + WS_DG), vcu, lds, tid, lane, wave);
#elif MK_DUP_WHAT == 2
    for (;;) {
        if (tid == 0) *(LAS int*)(lds + AT_Q) = __hip_atomic_fetch_add((int*)(ws + WS_CTL) + CW_ATTNQ + 1, 1, __ATOMIC_RELAXED, __HIP_MEMORY_SCOPE_AGENT);
        __syncthreads();
        const int u = __builtin_amdgcn_readfirstlane(*(LAS int*)(lds + AT_Q));
        __syncthreads();
        if (u >= 512) break;
        attn_unit(ip.Q, ip.K, ip.V, (bf16_t*)(ws + WS_OSB), u & 63, 7 - (u >> 6), lds, lane, wave);
    }
#else
    MK_P2_BODY(1)
#endif
#endif
#if 0
    for (;;) {
        if (tid == 0) {
        __syncthreads();
        const int u = __builtin_amdgcn_readfirstlane(*(LAS int*)(lds + AT_Q));
        __syncthreads();
        if (u >= 512) break;
        attn_unit(ip.Q, ip.K, ip.V, (bf16_t*)(ws + WS_OSB), u & 63, 7 - (u >> 6), lds, lane, wave);
    }
#endif
#endif
    } }
    SEAM(2); TS(3);
#if MK_NAIVE_MIX
    if constexpr (IN(3)) { FRESH_IDS(); const int gw = GW; for (int it = gw; it < NTOK * HGH; it += NGW) hgrn_post_item((const float*)(ws + WS_ORAW), ip.HG, args.in[3], (bf16_t*)(ws + WS_OHG), it, lane); }
#else
    if constexpr (IN(3)) { _Pragma("unroll 1") for (int rb_ = 0; rb_ < MK_DUP_HGB; ++rb_) { if (rb_) xcd_barrier(bar); FRESH_IDS(); hgrn_unit_b((const float*)(ws + WS_ORAW), (const bf16_t*)(ws + WS_QC), (const float*)(ws + WS_DS), (const float*)(ws + WS_DG), ip.HG, args.in[3], (bf16_t*)(ws + WS_OHG), vcu, lds, tid, lane, wave); } }
#endif
    SEAM(3); TS(4);
#if MK_PROBE_BAR
    for (int rb2_ = 0; rb2_ < MK_PROBE_BAR; ++rb2_) xcd_barrier(bar);
#endif
#pragma unroll 1
    for (int rep4_ = 0; rep4_ < MK_DUP_P45; ++rep4_) { if (rep4_) xcd_barrier(bar);
    if constexpr (IN(4)) { pg8::Gemm g{SBW}; pg8::BranchSched S; S.o.init(NTOK / 256, DM / 256, G, bx, MK_WGM_P4); S.A0 = (const char*)(ws + WS_OSB); S.B0 = (const char*)(ws + WS_WBST); S.A1 = (const char*)(ws + WS_OHG); S.B1 = (const char*)(ws + WS_WBHT); S.tstep = (size_t)256 * SBW * 2;
      pg8::EpiBranch E{ip.GS, ip.GH, (bf16_t*)(ws + WS_MERGED)};
      pg8::gemm_phase<pg8::EpiBranch, pg8::BranchSched, true, true>(lds, g, S, E); }
    SEAM(4); TS(5);
    if constexpr (IN(5)) { pg8::Gemm g{DM}; pg8::DenseSched S; S.o.init(NTOK / 256, DM / 256, G, bx, MK_WGM_P5); S.A = (const char*)(ws + WS_MERGED); S.Bt = (const char*)(ws + WS_WOT); S.tstep = (size_t)256 * DM * 2;
      pg8::EpiOut E{(const bf16_t*)(ws + WS_XB), (bf16_t*)(ws + WS_PRE)};
      pg8::gemm_phase<pg8::EpiOut, pg8::DenseSched, true, true>(lds, g, S, E); }
    }
    SEAM(5); TS(6);
#if MK_DUP_TAIL & 1
    { FRESH_IDS(); phase_ln1_router(args, lds, bx, tid, lane, wave); } xcd_barrier(bar);
    { FRESH_IDS(); phase_assign(args, lds, bx, G, tid, lane, wave); } xcd_barrier(bar);
#endif
    if constexpr (IN(6)) { FRESH_IDS(); phase_ln1_router(args, lds, bx, tid, lane, wave); }
    SEAM(6); TS(7);
    if constexpr (IN(7)) { FRESH_IDS(); phase_assign(args, lds, bx, G, tid, lane, wave); }
    SEAM(7); TS(8);
    int ntiles = 0; if constexpr (IN(8) || IN(9)) ntiles = __builtin_amdgcn_readfirstlane(__hip_atomic_load((const int*)(ws + WS_CTL) + CW_NTILES, __ATOMIC_RELAXED, __HIP_MEMORY_SCOPE_AGENT)); const LAS int* tile_exp = (const LAS int*)(lds + LDS_TILEEXP);
    if constexpr (IN(8) || IN(9)) { for (int i = threadIdx.x; i < ntiles; i += NTHREADS) ((LAS int*)(lds + LDS_TILEEXP))[i] = __hip_atomic_load((const int*)(ws + WS_CTL) + CW_TILEEXP + i, __ATOMIC_RELAXED, __HIP_MEMORY_SCOPE_AGENT); __syncthreads(); }
#if MK_FP8_UP
#if MK_GATHER_A
    if constexpr (IN(8)) { pg8::Gemm g{DM / 2, 0x7f7f7f7f, W8_E8M0}; pg8::MoeGatherSched S; S.o.init(ntiles, UPW / 256, G, bx, MK_WGM_UP); S.A = (const char*)(ws + WS_XS); S.W = (const char*)(ws + WS_WUPT); S.tile_exp = tile_exp; S.tstep = (size_t)256 * DM; S.estep = (size_t)UPW * DM; S.slot_tok = (const int*)(ws + WS_SLOTTOK);
      pg8::EpiUpT<MK_FP8_DN != 0> E{args.in[12], (bf16_t*)(ws + WS_ACT)};
      pg8::gemm_phase_f8<pg8::EpiUpT<MK_FP8_DN != 0>, pg8::MoeGatherSched, true, true>(lds, g, S, E); }
#else
    if constexpr (IN(8)) { pg8::Gemm g{DM / 2, 0x7f7f7f7f, W8_E8M0}; pg8::MoeSched S; S.o.init(ntiles, UPW / 256, G, bx); S.A = (const char*)(ws + WS_XS); S.W = (const char*)(ws + WS_WUPT); S.tile_exp = tile_exp; S.tstep = (size_t)256 * DM; S.estep = (size_t)UPW * DM;
      pg8::EpiUpT<MK_FP8_DN != 0> E{args.in[12], (bf16_t*)(ws + WS_ACT)};
      pg8::gemm_phase_f8<pg8::EpiUpT<MK_FP8_DN != 0>, pg8::MoeSched, true, true>(lds, g, S, E); }
#endif
#else
    if constexpr (IN(8)) { pg8::Gemm g{DM}; pg8::MoeSched S; S.o.init(ntiles, UPW / 256, G, bx); S.A = (const char*)(ws + WS_XS); S.W = (const char*)(ws + WS_WUPT); S.tile_exp = tile_exp; S.tstep = (size_t)256 * DM * 2; S.estep = (size_t)UPW * DM * 2;
      pg8::EpiUpT<MK_FP8_DN != 0> E{args.in[12], (bf16_t*)(ws + WS_ACT)};
      pg8::gemm_phase<pg8::EpiUpT<MK_FP8_DN != 0>, pg8::MoeSched, true, true>(lds, g, S, E); }
#endif
    SEAM(8); TS(9);
#if MK_FP8_DN
    if constexpr (IN(9)) { pg8::Gemm g{DFF / 2, ACT8_E8M0, W8_E8M0}; pg8::MoeSched S; S.o.init(ntiles, DM / 256, G, bx, MK_WGM_DN); S.A = (const char*)(ws + WS_ACT); S.W = (const char*)(ws + WS_WDNT); S.tile_exp = tile_exp; S.tstep = (size_t)256 * DFF; S.estep = (size_t)DM * DFF;
      pg8::EpiDown E{args.in[14], (bf16_t*)(ws + WS_Y)};
      pg8::gemm_phase_f8<pg8::EpiDown, pg8::MoeSched, true, true>(lds, g, S, E); }
#else
    if constexpr (IN(9)) { pg8::Gemm g{DFF}; pg8::MoeSched S; S.o.init(ntiles, DM / 256, G, bx); S.A = (const char*)(ws + WS_ACT); S.W = (const char*)(ws + WS_WDNT); S.tile_exp = tile_exp; S.tstep = (size_t)256 * DFF * 2; S.estep = (size_t)DM * DFF * 2;
      pg8::EpiDown E{args.in[14], (bf16_t*)(ws + WS_Y)};
      pg8::gemm_phase<pg8::EpiDown, pg8::MoeSched, true, true>(lds, g, S, E); }
#endif
    SEAM(9); TS(10);
    if constexpr (IN(10)) { FRESH_IDS(); f32x4 g2[4], b2[4];
#pragma unroll
        for (int j = 0; j < 4; ++j) { const int c = lane * 8 + 512 * (j >> 1) + 4 * (j & 1); g2[j] = *(const f32x4*)(args.in[15] + c); b2[j] = *(const f32x4*)(args.in[16] + c); }
        int row = GW;
        for (; row + (MK_P10_ROWS - 1) * NGW < NTOK; row += MK_P10_ROWS * NGW) combine_rows<MK_P10_ROWS>(args, row, NGW, lane, args.in[7], args.in[8], g2, b2);
        if (row + NGW < NTOK) { combine_rows<2>(args, row, NGW, lane, args.in[7], args.in[8], g2, b2); row += 2 * NGW; }
        for (; row < NTOK; row += NGW) combine_rows<1>(args, row, NGW, lane, args.in[7], args.in[8], g2, b2); }
#if MK_PROBE
    xcd_barrier(bar); TS(11);
    if (bx == 0 && threadIdx.x == 0) { unsigned* mk = (unsigned*)(ws + WS_LB + 3072); const bool warm = __hip_atomic_load(mk, __ATOMIC_RELAXED, __HIP_MEMORY_SCOPE_AGENT) == 0x51a7e5u; __hip_atomic_store(mk, 0x51a7e5u, __ATOMIC_RELAXED, __HIP_MEMORY_SCOPE_AGENT);
        const float dA = (float)(ts[MK_PA1] - ts[MK_PA0]) * 0.01f;
        __hip_atomic_store((float*)(ws + WS_CTL) + 40, warm ? dA * (1.0f / 500.0f) : 0.f, __ATOMIC_RELAXED, __HIP_MEMORY_SCOPE_AGENT); }
    xcd_barrier(bar);
    { FRESH_IDS(); const float eps = __hip_atomic_load((float*)(ws + WS_CTL) + 40, __ATOMIC_RELAXED, __HIP_MEMORY_SCOPE_AGENT);
      for (int row = GW; row < NTOK; row += NGW) for (int j2 = 0; j2 < 4; ++j2) { f32x4* p = (f32x4*)(args.out + (size_t)row * DM + lane * 4 + 256 * j2); *p = *p * (1.0f + eps); } }
#endif
}


#if MK_MODE == 2
namespace v1 {
constexpr int CW_CNT = 60000, CW_CUR = 60064, CW_PADSTART = 60128, CW_NTILES = 60192, CW_TILEEXP = 60256;
__device__ __forceinline__ float sigmoidf_(float v) { return 1.0f / (1.0f + expf(-v)); }
__global__ __launch_bounds__(256) void k_transpose_bf16(const float* __restrict__ W, bf16_t* __restrict__ WT, int K, int N) {
    __shared__ float tile[64][65];
    const size_t g = blockIdx.z; W += g * (size_t)K * N; WT += g * (size_t)K * N;
    const int k0 = blockIdx.y * 64, n0 = blockIdx.x * 64, tx = threadIdx.x & 63, ty = threadIdx.x >> 6;
    for (int i = ty; i < 64; i += 4) tile[i][tx] = W[(size_t)(k0 + i) * N + n0 + tx];
    __syncthreads();
    for (int i = ty; i < 64; i += 4) WT[(size_t)(n0 + i) * K + k0 + tx] = (bf16_t)f2bf(tile[tx][i]);
}
__global__ __launch_bounds__(256) void k_convert_x(const float* __restrict__ x, bf16_t* __restrict__ xb, const float* __restrict__ lbl, float* __restrict__ lb) {
    const size_t i = (size_t)blockIdx.x * 256 + threadIdx.x;
    const f32x4 v = ((const f32x4*)x)[i];
    uint2 o; o.x = f2bf(v[0]) | (f2bf(v[1]) << 16); o.y = f2bf(v[2]) | (f2bf(v[3]) << 16);
    ((uint2*)xb)[i] = o;
    if (blockIdx.x == 0) for (int c = threadIdx.x; c < HGW; c += 256) { const float l0 = lbl[c], l1 = lbl[HGW + c]; lb[c] = 1.0f / (1.0f + expf(l1 - l0)); }
}

constexpr int G_BM = 128, G_BK = 32, G_HTB = G_BM * G_BK * 2;
__device__ __forceinline__ void g128_loop(f32x4 (&acc)[4][4], const bf16_t* a0, const bf16_t* a1, const bf16_t* b0, const bf16_t* b1, int K, LAS unsigned char* shm) {
    const int tid = threadIdx.x, wid = tid >> 6, lane = tid & 63, wr = wid >> 1, wc = wid & 1, fr = lane & 15, fq = lane >> 4;
    LAS unsigned char* SA = shm; LAS unsigned char* SB = shm + G_HTB;
    for (int t = 0; t < K / G_BK; ++t) {
        __builtin_amdgcn_global_load_lds((const unsigned*)(a0 + t * G_BK), (LAS unsigned*)(SA + tid * 16), 16, 0, 0);
        __builtin_amdgcn_global_load_lds((const unsigned*)(a1 + t * G_BK), (LAS unsigned*)(SA + tid * 16 + 4096), 16, 0, 0);
        __builtin_amdgcn_global_load_lds((const unsigned*)(b0 + t * G_BK), (LAS unsigned*)(SB + tid * 16), 16, 0, 0);
        __builtin_amdgcn_global_load_lds((const unsigned*)(b1 + t * G_BK), (LAS unsigned*)(SB + tid * 16 + 4096), 16, 0, 0);
        asm volatile("s_waitcnt vmcnt(0)" ::: "memory"); __syncthreads();
        bf16x8 At[4], Bt[4];
#pragma unroll
        for (int m = 0; m < 4; ++m) { At[m] = *(const LAS bf16x8*)(SA + (wr * 64 + m * 16 + fr) * (G_BK * 2) + fq * 16); Bt[m] = *(const LAS bf16x8*)(SB + (wc * 64 + m * 16 + fr) * (G_BK * 2) + fq * 16); }
        asm volatile("s_waitcnt lgkmcnt(0)" ::: "memory"); __builtin_amdgcn_sched_barrier(0);
#pragma unroll
        for (int m = 0; m < 4; ++m)
#pragma unroll
            for (int n = 0; n < 4; ++n) acc[m][n] = __builtin_amdgcn_mfma_f32_16x16x32_bf16(At[m], Bt[n], acc[m][n], 0, 0, 0);
        __syncthreads();
    }
}
#define G128_ZERO(acc) _Pragma("unroll") for (int m_ = 0; m_ < 4; ++m_) _Pragma("unroll") for (int n_ = 0; n_ < 4; ++n_) acc[m_][n_] = (f32x4){0.f, 0.f, 0.f, 0.f}
#define G128_FOREACH(...) do { const int wid_ = threadIdx.x >> 6, lane_ = threadIdx.x & 63, wr_ = wid_ >> 1, wc_ = wid_ & 1, fr_ = lane_ & 15, fq_ = lane_ >> 4; \
    _Pragma("unroll") for (int m_ = 0; m_ < 4; ++m_) _Pragma("unroll") for (int n_ = 0; n_ < 4; ++n_) _Pragma("unroll") for (int j_ = 0; j_ < 4; ++j_) { \
        const int trow = wr_ * 64 + m_ * 16 + fq_ * 4 + j_, tcol = wc_ * 64 + n_ * 16 + fr_; __VA_ARGS__ } } while (0)


__global__ __launch_bounds__(256) void k_inproj(const bf16_t* __restrict__ XB, const bf16_t* __restrict__ WinT, InProjOut o) {
    __shared__ __attribute__((aligned(16))) unsigned char shm[2 * G_HTB];
    const int bcol = blockIdx.x * G_BM, brow = blockIdx.y * G_BM, tid = threadIdx.x, r0 = tid >> 2, c = (tid & 3) * 8;
    f32x4 acc[4][4]; G128_ZERO(acc);
    g128_loop(acc, XB + (size_t)(brow + r0) * DM + c, XB + (size_t)(brow + r0 + 64) * DM + c, WinT + (size_t)(bcol + r0) * DM + c, WinT + (size_t)(bcol + r0 + 64) * DM + c, DM, (LAS unsigned char*)shm);
    const int seg = bcol / 512;
    G128_FOREACH({
        const int row = brow + trow, col = bcol + tcol; const float v = acc[m_][n_][j_];
        if (seg == 0) o.Q[(size_t)row * 512 + col] = (bf16_t)f2bf(v * 0.125f);
        else if (seg == 1) o.K[(size_t)row * 512 + (col - 512)] = (bf16_t)f2bf(v);
        else if (seg == 2) o.V[(size_t)row * 512 + (col - 1024)] = (bf16_t)f2bf(v);
        else if (seg == 3) o.HQ[(size_t)row * 512 + (col - 1536)] = (bf16_t)f2bf(v * sigmoidf_(v));
        else if (seg == 4) { const int cc = col - 2048; const float l = o.lb[cc], f = l + (1.0f - l) * sigmoidf_(v);
            o.HK[(size_t)row * 512 + cc] = (bf16_t)f2bf(1.0f - f); o.LOGF[(size_t)row * 512 + cc] = logf(f); }
        else if (seg == 5) o.HV[(size_t)row * 512 + (col - 2560)] = (bf16_t)f2bf(v);
        else if (seg == 6) o.HG[(size_t)row * 512 + (col - 3072)] = (bf16_t)f2bf(sigmoidf_(v));
        else if (seg < 9) o.GS[(size_t)row * 1024 + (col - 3584)] = (bf16_t)f2bf(sigmoidf_(v));
        else o.GH[(size_t)row * 1024 + (col - 4608)] = (bf16_t)f2bf(sigmoidf_(v));
    });
}

__global__ __launch_bounds__(256) void k_branch(const bf16_t* __restrict__ OSB, const bf16_t* __restrict__ OHG, const bf16_t* __restrict__ WbsT, const bf16_t* __restrict__ WbhT,
                                                const bf16_t* __restrict__ GS, const bf16_t* __restrict__ GH, bf16_t* __restrict__ MERGED) {
    __shared__ __attribute__((aligned(16))) unsigned char shm[2 * G_HTB];
    const int bcol = blockIdx.x * G_BM, brow = blockIdx.y * G_BM, tid = threadIdx.x, r0 = tid >> 2, c = (tid & 3) * 8;
    f32x4 accA[4][4], accB[4][4]; G128_ZERO(accA); G128_ZERO(accB);
    g128_loop(accA, OSB + (size_t)(brow + r0) * SBW + c, OSB + (size_t)(brow + r0 + 64) * SBW + c, WbsT + (size_t)(bcol + r0) * SBW + c, WbsT + (size_t)(bcol + r0 + 64) * SBW + c, SBW, (LAS unsigned char*)shm);
    g128_loop(accB, OHG + (size_t)(brow + r0) * HGW + c, OHG + (size_t)(brow + r0 + 64) * HGW + c, WbhT + (size_t)(bcol + r0) * HGW + c, WbhT + (size_t)(bcol + r0 + 64) * HGW + c, HGW, (LAS unsigned char*)shm);
    G128_FOREACH({
        const size_t idx = (size_t)(brow + trow) * DM + bcol + tcol;
        MERGED[idx] = (bf16_t)f2bf(bf2f(GS[idx]) * accA[m_][n_][j_] + bf2f(GH[idx]) * accB[m_][n_][j_]);
    });
}

__global__ __launch_bounds__(256) void k_outproj(const bf16_t* __restrict__ MERGED, const bf16_t* __restrict__ WoT, const float* __restrict__ x, float* __restrict__ PRE) {
    __shared__ __attribute__((aligned(16))) unsigned char shm[2 * G_HTB];
    const int bcol = blockIdx.x * G_BM, brow = blockIdx.y * G_BM, tid = threadIdx.x, r0 = tid >> 2, c = (tid & 3) * 8;
    f32x4 acc[4][4]; G128_ZERO(acc);
    g128_loop(acc, MERGED + (size_t)(brow + r0) * DM + c, MERGED + (size_t)(brow + r0 + 64) * DM + c, WoT + (size_t)(bcol + r0) * DM + c, WoT + (size_t)(bcol + r0 + 64) * DM + c, DM, (LAS unsigned char*)shm);
    G128_FOREACH({ const size_t idx = (size_t)(brow + trow) * DM + bcol + tcol; PRE[idx] = DN_ALPHA * x[idx] + acc[m_][n_][j_]; });
}

__global__ __launch_bounds__(256) void k_moe_up(const bf16_t* __restrict__ HB, const bf16_t* __restrict__ WupT, const float* __restrict__ b_up, const int* __restrict__ ctl,
                                                const int* __restrict__ slot_tok, bf16_t* __restrict__ ACT) {
    __shared__ __attribute__((aligned(16))) unsigned char shm[2 * G_HTB];
    const int rt = blockIdx.y; if (rt >= 2 * ctl[CW_NTILES]) return;
    const int e = ctl[CW_TILEEXP + (rt >> 1)];
    const int bcol = blockIdx.x * G_BM, brow = rt * G_BM, tid = threadIdx.x, r0 = tid >> 2, c = (tid & 3) * 8;
    int t0 = slot_tok[brow + r0], t1 = slot_tok[brow + r0 + 64]; if (t0 < 0) t0 = 0; if (t1 < 0) t1 = 0;
    const bf16_t* W = WupT + (size_t)e * UPW * DM;
    f32x4 acc[4][4]; G128_ZERO(acc);
    g128_loop(acc, HB + (size_t)t0 * DM + c, HB + (size_t)t1 * DM + c, W + (size_t)(bcol + r0) * DM + c, W + (size_t)(bcol + r0 + 64) * DM + c, DM, (LAS unsigned char*)shm);
    G128_FOREACH({
        const int col = bcol + tcol; const float v = acc[m_][n_][j_] + b_up[e * UPW + col];
        const float other = __shfl_xor(v, 1);
        if ((col & 1) == 0) { const float g = fminf(v, SW_LIMIT), l = fminf(fmaxf(other, -SW_LIMIT), SW_LIMIT);
            ACT[(size_t)(brow + trow) * DFF + (col >> 1)] = (bf16_t)f2bf(g * sigmoidf_(SW_ALPHA * g) * (l + 1.0f)); }
    });
}
__global__ __launch_bounds__(256) void k_moe_down(const bf16_t* __restrict__ ACT, const bf16_t* __restrict__ WdnT, const float* __restrict__ b_dn, const int* __restrict__ ctl, bf16_t* __restrict__ Y) {
    __shared__ __attribute__((aligned(16))) unsigned char shm[2 * G_HTB];
    const int rt = blockIdx.y; if (rt >= 2 * ctl[CW_NTILES]) return;
    const int e = ctl[CW_TILEEXP + (rt >> 1)];
    const int bcol = blockIdx.x * G_BM, brow = rt * G_BM, tid = threadIdx.x, r0 = tid >> 2, c = (tid & 3) * 8;
    const bf16_t* W = WdnT + (size_t)e * DM * DFF;
    f32x4 acc[4][4]; G128_ZERO(acc);
    g128_loop(acc, ACT + (size_t)(brow + r0) * DFF + c, ACT + (size_t)(brow + r0 + 64) * DFF + c, W + (size_t)(bcol + r0) * DFF + c, W + (size_t)(bcol + r0 + 64) * DFF + c, DFF, (LAS unsigned char*)shm);
    G128_FOREACH({ const int col = bcol + tcol; Y[(size_t)(brow + trow) * DM + col] = (bf16_t)f2bf(acc[m_][n_][j_] + b_dn[e * DM + col]); });
}

__global__ __launch_bounds__(64) void k_attn_naive(const bf16_t* __restrict__ Q, const bf16_t* __restrict__ K, const bf16_t* __restrict__ V, bf16_t* __restrict__ O) {
    const int qb = 31 - (int)blockIdx.x, bh = blockIdx.y, b = bh >> 3, h = bh & 7;
    const int t = qb * 64 + threadIdx.x; const size_t rowbase = (size_t)b * SEQ;
    float q[64], o[64];
    { const bf16_t* qp = Q + (rowbase + t) * SBW + h * SBD;
#pragma unroll
      for (int d = 0; d < 64; ++d) { q[d] = bf2f(qp[d]); o[d] = 0.f; } }
    float R = 1.0f;
    for (int s = qb * 64 + 63; s >= 0; --s) {
        const bf16_t* kr = K + (rowbase + s) * SBW + h * SBD; const bf16_t* vr = V + (rowbase + s) * SBW + h * SBD;
        float z = 0.f;
#pragma unroll
        for (int d = 0; d < 64; ++d) z += q[d] * bf2f(kr[d]);
        const bool valid = s < t;
        const float ez = expf(fminf(z, 60.0f)), keep = 1.0f / (1.0f + ez);
        const float a = valid ? ez * keep * R : 0.f;
        R = valid ? R * keep : R;
#pragma unroll
        for (int d = 0; d < 64; ++d) o[d] += a * bf2f(vr[d]);
    }
    bf16_t* op = O + (rowbase + t) * SBW + h * SBD;
#pragma unroll
    for (int d = 0; d < 64; ++d) op[d] = (bf16_t)f2bf(o[d]);
}

__global__ __launch_bounds__(128) void k_hgrn_naive(const bf16_t* __restrict__ HQ, const bf16_t* __restrict__ HK, const float* __restrict__ LOGF, const bf16_t* __restrict__ HV, float* __restrict__ ORAW) {
    __shared__ __attribute__((aligned(16))) float sf[128], sk[128], sq[128];
    const int bh = blockIdx.x, b = bh >> 2, hh = bh & 3, v = threadIdx.x;
    float S[128];
#pragma unroll
    for (int k = 0; k < 128; ++k) S[k] = 0.f;
    for (int t = 0; t < SEQ; ++t) {
        const size_t base = ((size_t)b * SEQ + t) * HGW + hh * HGD;
        sf[v] = expf(LOGF[base + v]); sk[v] = bf2f(HK[base + v]); sq[v] = bf2f(HQ[base + v]);
        const float vv = bf2f(HV[base + v]);
        __syncthreads();
        float o = 0.f;
#pragma unroll
        for (int k = 0; k < 128; ++k) { S[k] = sf[k] * S[k] + sk[k] * vv; o += sq[k] * S[k]; }
        ORAW[base + v] = o;
        __syncthreads();
    }
}
__global__ __launch_bounds__(256) void k_hgrn_post(const float* __restrict__ ORAW, const bf16_t* __restrict__ HG, const float* __restrict__ norm_g, bf16_t* __restrict__ OHG) {
    const int gw = blockIdx.x * 4 + (threadIdx.x >> 6), lane = threadIdx.x & 63;
    const size_t base = (size_t)gw * HGD; const int c0 = (gw & 3) * HGD;
    const float x0 = ORAW[base + lane], x1 = ORAW[base + 64 + lane];
    const float r = 1.0f / sqrtf(wave_sum(x0 * x0 + x1 * x1) * (1.0f / HGD) + RMS_EPS);
    OHG[base + lane] = (bf16_t)f2bf(x0 * r * norm_g[c0 + lane] * bf2f(HG[base + lane]));
    OHG[base + 64 + lane] = (bf16_t)f2bf(x1 * r * norm_g[c0 + 64 + lane] * bf2f(HG[base + 64 + lane]));
}

__global__ __launch_bounds__(256) void k_ln1_router(const float* __restrict__ PRE, const float* __restrict__ g, const float* __restrict__ bta, const float* __restrict__ rw, const float* __restrict__ rb,
                                                    float* __restrict__ H, bf16_t* __restrict__ HB, int* __restrict__ TOPI, float* __restrict__ TOPG) {
    __shared__ __attribute__((aligned(16))) float hs[4][DM];
    const int w = threadIdx.x >> 6, lane = threadIdx.x & 63, row = blockIdx.x * 4 + w;
    f32x4 v[4]; float s = 0.f;
#pragma unroll
    for (int j = 0; j < 4; ++j) { v[j] = *(const f32x4*)(PRE + (size_t)row * DM + lane * 4 + 256 * j); s += (v[j][0] + v[j][1]) + (v[j][2] + v[j][3]); }
    const float mean = wave_sum(s) * (1.0f / DM); float s2 = 0.f;
#pragma unroll
    for (int j = 0; j < 4; ++j) { v[j] = v[j] - mean; s2 += (v[j][0] * v[j][0] + v[j][1] * v[j][1]) + (v[j][2] * v[j][2] + v[j][3] * v[j][3]); }
    const float rstd = 1.0f / sqrtf(wave_sum(s2) * (1.0f / DM) + LN_EPS);
#pragma unroll
    for (int j = 0; j < 4; ++j) { const int c = lane * 4 + 256 * j; const f32x4 gg = *(const f32x4*)(g + c), bb = *(const f32x4*)(bta + c);
        f32x4 hv = v[j] * rstd * gg + bb; *(f32x4*)(H + (size_t)row * DM + c) = hv; *(f32x4*)(&hs[w][c]) = hv;
        uint2 o; o.x = f2bf(hv[0]) | (f2bf(hv[1]) << 16); o.y = f2bf(hv[2]) | (f2bf(hv[3]) << 16); *(uint2*)(HB + (size_t)row * DM + c) = o; }
    __syncthreads();
    const int e = lane & 31, half = lane >> 5; float a = 0.f;
    for (int c = half * 512; c < half * 512 + 512; ++c) a += hs[w][c] * rw[c * NEXP + e];
    a += __shfl_xor(a, 32);
    float val = (lane < 32) ? a + rb[e] : -INFINITY; int idx = e;
    float tv[4]; int ti[4];
#pragma unroll
    for (int r = 0; r < 4; ++r) {
        float bv = val; int bi = idx;
#pragma unroll
        for (int off = 32; off >= 1; off >>= 1) { const float ov = __shfl_xor(bv, off); const int oi = __shfl_xor(bi, off); if (ov > bv || (ov == bv && oi < bi)) { bv = ov; bi = oi; } }
        tv[r] = bv; ti[r] = bi; if (lane < 32 && e == bi) val = -INFINITY;
    }
    if (lane == 0) { const float e1 = expf(tv[1] - tv[0]), e2 = expf(tv[2] - tv[0]), e3 = expf(tv[3] - tv[0]), inv = 1.0f / (1.0f + e1 + e2 + e3);
        *(int4*)(TOPI + row * 4) = make_int4(ti[0], ti[1], ti[2], ti[3]); *(float4*)(TOPG + row * 4) = make_float4(inv, e1 * inv, e2 * inv, e3 * inv); }
}

__global__ __launch_bounds__(256) void k_count(const int* __restrict__ TOPI, int* __restrict__ ctl, int* __restrict__ slot_tok) {
    __shared__ int hist[NEXP];
    if (threadIdx.x < NEXP) hist[threadIdx.x] = 0;
    __syncthreads();
    const int i = blockIdx.x * 256 + threadIdx.x;
    atomicAdd(&hist[TOPI[i]], 1);
    __syncthreads();
    if (threadIdx.x < NEXP) atomicAdd(&ctl[CW_CNT + threadIdx.x], hist[threadIdx.x]);
    for (int s = i; s < NSLOT_MAX; s += NASSIGN) slot_tok[s] = -1;
}
__global__ __launch_bounds__(64) void k_plan(int* __restrict__ ctl) {
    if (threadIdx.x == 0) { int ps = 0, nt = 0;
        for (int e = 0; e < NEXP; ++e) { ctl[CW_PADSTART + e] = ps; const int te = (ctl[CW_CNT + e] + SLOT_PAD - 1) / SLOT_PAD; for (int i = 0; i < te; ++i) ctl[CW_TILEEXP + nt++] = e; ps += te * SLOT_PAD; }
        ctl[CW_PADSTART + NEXP] = ps; ctl[CW_NTILES] = nt; }
}
__global__ __launch_bounds__(256) void k_assign(const int* __restrict__ TOPI, int* __restrict__ ctl, int* __restrict__ slot_tok, int* __restrict__ DEST) {
    const int i = blockIdx.x * 256 + threadIdx.x, e = TOPI[i];
    const int slot = ctl[CW_PADSTART + e] + atomicAdd(&ctl[CW_CUR + e], 1);
    slot_tok[slot] = i >> 2; DEST[i] = slot;
}
__global__ __launch_bounds__(256) void k_combine_ln2(const float* __restrict__ H, const bf16_t* __restrict__ Y, const int* __restrict__ DEST, const float* __restrict__ TOPG,
                                                     const float* __restrict__ g, const float* __restrict__ bta, float* __restrict__ out) {
    const int lane = threadIdx.x & 63, row = blockIdx.x * 4 + (threadIdx.x >> 6);
    const int4 d = *(const int4*)(DEST + row * 4); const float4 gt = *(const float4*)(TOPG + row * 4);
    const int ds[4] = {d.x, d.y, d.z, d.w}; const float gs[4] = {gt.x, gt.y, gt.z, gt.w};
    f32x4 v[4]; float s = 0.f;
#pragma unroll
    for (int j = 0; j < 4; ++j) { const int c = lane * 4 + 256 * j; f32x4 a = *(const f32x4*)(H + (size_t)row * DM + c) * DN_ALPHA;
#pragma unroll
        for (int k = 0; k < 4; ++k) { const uint2 y = *(const uint2*)(Y + (size_t)ds[k] * DM + c);
            a[0] += gs[k] * bf2f(y.x & 0xffff); a[1] += gs[k] * bf2f(y.x >> 16); a[2] += gs[k] * bf2f(y.y & 0xffff); a[3] += gs[k] * bf2f(y.y >> 16); }
        v[j] = a; s += (a[0] + a[1]) + (a[2] + a[3]); }
    const float mean = wave_sum(s) * (1.0f / DM); float s2 = 0.f;
#pragma unroll
    for (int j = 0; j < 4; ++j) { v[j] = v[j] - mean; s2 += (v[j][0] * v[j][0] + v[j][1] * v[j][1]) + (v[j][2] * v[j][2] + v[j][3] * v[j][3]); }
    const float rstd = 1.0f / sqrtf(wave_sum(s2) * (1.0f / DM) + LN_EPS);
#pragma unroll
    for (int j = 0; j < 4; ++j) { const int c = lane * 4 + 256 * j; *(f32x4*)(out + (size_t)row * DM + c) = v[j] * rstd * *(const f32x4*)(g + c) + *(const f32x4*)(bta + c); }
}

}
#endif
extern "C" void kernel_launch(void* const* d_in, const int* in_sizes, int n_in, void* d_out, int out_size, void* d_ws, size_t ws_size, hipStream_t stream) {
    static int grid = 0;
    if (grid == 0) {
        if (n_in != 17 || ws_size < WS_END) { fprintf(stderr, "kernel_launch: unexpected n_in %d or ws_size %zu (< %zu)\n", n_in, ws_size, (size_t)WS_END); grid = -1; return; }
        int dev = 0, cus = 0;
        if (hipGetDevice(&dev) != hipSuccess || hipDeviceGetAttribute(&cus, hipDeviceAttributeMultiprocessorCount, dev) != hipSuccess) { grid = -1; return; }
#define MK_ATTR(LO_, HI_) if (hipFuncSetAttribute((const void*)mk_fwd<LO_, HI_>, hipFuncAttributeMaxDynamicSharedMemorySize, LDS_BYTES) != hipSuccess) { fprintf(stderr, "kernel_launch: hipFuncSetAttribute failed\n"); grid = -1; return; }
#if MK_MODE == 0
        MK_ATTR(0, 11)
#elif MK_MODE == 2
        MK_ATTR(0, 1) MK_ATTR(1, 2) MK_ATTR(2, 3) MK_ATTR(3, 4) MK_ATTR(4, 5) MK_ATTR(5, 6)
#else
        MK_ATTR(0, 1) MK_ATTR(1, 2) MK_ATTR(2, 3) MK_ATTR(3, 4) MK_ATTR(4, 5) MK_ATTR(5, 6) MK_ATTR(6, 8) MK_ATTR(8, 9) MK_ATTR(9, 10) MK_ATTR(10, 11)
#endif
        grid = cus;
        if (grid != 256) fprintf(stderr, "kernel_launch: %d CUs (built for 256)\n", grid);
    }
    if (grid < 0) return;
    (void)hipMemsetAsync((char*)d_ws + WS_CTL, 0, CTL_ZERO_BYTES, stream);
    Args a{};
    for (int i = 0; i < 17; ++i) a.in[i] = (const float*)d_in[i];
    a.out = (float*)d_out; a.ws = (unsigned char*)d_ws;
#define MK_LAUNCH(LO_, HI_, LI_) do { a.ph_lo = LO_; a.ph_hi = HI_; a.li = LI_; hipLaunchKernelGGL((mk_fwd<LO_, HI_>), dim3(grid), dim3(NTHREADS), LDS_BYTES, stream, a); } while (0)
#if MK_MODE == 0
    MK_LAUNCH(0, 11, 0);
#elif MK_MODE == 2
    { unsigned char* ws = (unsigned char*)d_ws;
      InProjOut ip{}; ip.Q = (bf16_t*)(ws + WS_Q); ip.K = (bf16_t*)(ws + WS_K); ip.V = (bf16_t*)(ws + WS_V); ip.HQ = (bf16_t*)(ws + WS_HQ); ip.HK = (bf16_t*)(ws + WS_HK); ip.HV = (bf16_t*)(ws + WS_HV);
      ip.HG = (bf16_t*)(ws + WS_HG); ip.GS = (bf16_t*)(ws + WS_GS); ip.GH = (bf16_t*)(ws + WS_GH); ip.LOGF = (float*)(ws + WS_LOGF); ip.lb = (const float*)(ws + WS_LB);
#if MK_HEAD_V1 >= 1
      v1::k_convert_x<<<NTOK * DM / 4 / 256, 256, 0, stream>>>(a.in[0], (bf16_t*)(ws + WS_XB), a.in[2], (float*)(ws + WS_LB));
      v1::k_transpose_bf16<<<dim3(INW / 64, DM / 64, 1), 256, 0, stream>>>(a.in[1], (bf16_t*)(ws + WS_WINT), DM, INW);
      v1::k_transpose_bf16<<<dim3(DM / 64, SBW / 64, 1), 256, 0, stream>>>(a.in[4], (bf16_t*)(ws + WS_WBST), SBW, DM);
      v1::k_transpose_bf16<<<dim3(DM / 64, HGW / 64, 1), 256, 0, stream>>>(a.in[5], (bf16_t*)(ws + WS_WBHT), HGW, DM);
      v1::k_transpose_bf16<<<dim3(DM / 64, DM / 64, 1), 256, 0, stream>>>(a.in[6], (bf16_t*)(ws + WS_WOT), DM, DM);
      v1::k_transpose_bf16<<<dim3(UPW / 64, DM / 64, NEXP), 256, 0, stream>>>(a.in[11], (bf16_t*)(ws + WS_WUPT), DM, UPW);
      v1::k_transpose_bf16<<<dim3(DM / 64, DFF / 64, NEXP), 256, 0, stream>>>(a.in[13], (bf16_t*)(ws + WS_WDNT), DFF, DM);
#else
      MK_LAUNCH(0, 1, 0);
#endif
#if MK_HEAD_V1 >= 2
      v1::k_inproj<<<dim3(INW / v1::G_BM, NTOK / v1::G_BM), 256, 0, stream>>>((const bf16_t*)(ws + WS_XB), (const bf16_t*)(ws + WS_WINT), ip);
#else
      MK_LAUNCH(1, 2, 1);
#endif
      MK_LAUNCH(2, 3, 2); MK_LAUNCH(3, 4, 3); MK_LAUNCH(4, 5, 4); MK_LAUNCH(5, 6, 5); }
    { unsigned char* ws = (unsigned char*)d_ws; int* ctl = (int*)(ws + WS_CTL); bf16_t* HB = (bf16_t*)(ws + WS_XS); int* TOPI = (int*)(ws + WS_XS + 32 * MiB); int* SLOTTOK = (int*)(ws + WS_XS + 33 * MiB);
      float* TOPG = (float*)(ws + WS_TOPG); int* DEST = (int*)(ws + WS_DEST); float* H = (float*)(ws + WS_H); bf16_t* ACT = (bf16_t*)(ws + WS_ACT); bf16_t* Y = (bf16_t*)(ws + WS_Y);
      v1::k_ln1_router<<<NTOK / 4, 256, 0, stream>>>((const float*)(ws + WS_PRE), a.in[7], a.in[8], a.in[9], a.in[10], H, HB, TOPI, TOPG);
      v1::k_count<<<NASSIGN / 256, 256, 0, stream>>>(TOPI, ctl, SLOTTOK);
      v1::k_plan<<<1, 64, 0, stream>>>(ctl);
      v1::k_assign<<<NASSIGN / 256, 256, 0, stream>>>(TOPI, ctl, SLOTTOK, DEST);
      v1::k_moe_up<<<dim3(UPW / v1::G_BM, NSLOT_MAX / v1::G_BM), 256, 0, stream>>>(HB, (const bf16_t*)(ws + WS_WUPT), a.in[12], ctl, SLOTTOK, ACT);
      v1::k_moe_down<<<dim3(DM / v1::G_BM, NSLOT_MAX / v1::G_BM), 256, 0, stream>>>(ACT, (const bf16_t*)(ws + WS_WDNT), a.in[14], ctl, Y);
      v1::k_combine_ln2<<<NTOK / 4, 256, 0, stream>>>(H, Y, DEST, TOPG, a.in[15], a.in[16], (float*)d_out); }
#else
    MK_LAUNCH(0, 1, 0); MK_LAUNCH(1, 2, 1); MK_LAUNCH(2, 3, 2); MK_LAUNCH(3, 4, 3); MK_LAUNCH(4, 5, 4); MK_LAUNCH(5, 6, 5); MK_LAUNCH(6, 8, 6); MK_LAUNCH(8, 9, 7); MK_LAUNCH(9, 10, 8); MK_LAUNCH(10, 11, 9);
#endif
}
```
